# Optimizing an MI355X kernel written in HIP

```python
import jax, jax.numpy as jnp
from jax import lax
import numpy as np

D_MODEL = 1024
BATCH = 2
SEQ = 8192
DEPTH = 4

GRID_W = 64
CTX_LEN = 256
N_MIXERS = 3
N_A = (DEPTH + 2) // 3
N_B = (DEPTH + 1) // 3
N_C = DEPTH // 3
NORM_EPS = 1e-6

CHUNK_A = 128
A_INNER = D_MODEL
A_GROUPS = 8
A_GROUP_W = A_INNER // A_GROUPS

GLA_HEADS = 4
GLA_KEY = D_MODEL // 2
GLA_VAL = D_MODEL
GLA_HK = GLA_KEY // GLA_HEADS
GLA_HV = GLA_VAL // GLA_HEADS
GLA_RANK = 16
GLA_TAU = 16.0
GLA_CHUNK = 64
ROPE_BASE = 10000.0

NA_HEADS = 16
NA_HD = D_MODEL // NA_HEADS
NA_KH = 8
NA_KW = 16
NA_QCOLS = 16
NA_BAND = 32
NEG_INF = -1e30

N_EXPERTS = 32
TOP_K = 4
D_EXPERT = D_MODEL
SWIGLU_LIMIT = 7.0
SWIGLU_ALPHA = 1.702
MOE_BLOCK = 256

kernel_name = "hybrid_gmlp_gla_natten_moe_dit"

F32 = jnp.float32


def rmsnorm(x, g):
    xf = x.astype(F32)
    y = xf * lax.rsqrt(jnp.mean(xf * xf, axis=-1, keepdims=True) + NORM_EPS)
    return (y * g.astype(F32)).astype(x.dtype)


def modulate(x, g, shift, scale):
    return rmsnorm(x, g) * (1 + scale) + shift


def chunk_mlp(h, w_in, g_v, w_s, b_s, w_out):
    B, T, _ = h.shape
    z = jax.nn.gelu(h @ w_in, approximate=False)
    u, v = jnp.split(z, 2, axis=-1)
    v = rmsnorm(v, g_v).reshape(B, T // CHUNK_A, CHUNK_A, A_GROUPS, A_GROUP_W)
    s = jnp.einsum('gpq,bnqgc->bnpgc', w_s, v) + b_s.T[:, :, None]
    return (u * s.reshape(B, T, A_INNER)) @ w_out


def axial_rope(x, rows, cols):
    half = x.shape[-1] // 2
    nf = half // 2
    freqs = jnp.power(ROPE_BASE, -jnp.arange(nf, dtype=F32) / nf)

    def rot(xp, pos):
        ang = pos.astype(F32)[:, None] * freqs
        cos, sin = jnp.cos(ang)[None, :, None, :], jnp.sin(ang)[None, :, None, :]
        x1, x2 = xp[..., :nf].astype(F32), xp[..., nf:].astype(F32)
        return jnp.concatenate([x1 * cos - x2 * sin, x1 * sin + x2 * cos], axis=-1)

    return jnp.concatenate([rot(x[..., :half], rows), rot(x[..., half:], cols)], axis=-1)


def gla_project(h, w_in, w_a2, b_a):
    B, T, _ = h.shape
    p = h @ w_in
    q, k, v, g, r = jnp.split(p, [GLA_KEY, 2 * GLA_KEY, 2 * GLA_KEY + GLA_VAL, 2 * GLA_KEY + 2 * GLA_VAL], axis=-1)
    z = jnp.einsum('btdr,drk->btdk', r.reshape(B, T, 2, GLA_RANK), w_a2) + b_a
    log_a = (jax.nn.log_sigmoid(z.astype(F32)) / GLA_TAU).reshape(B, T, 2, GLA_HEADS, GLA_HK)
    q = q.reshape(B, T, GLA_HEADS, GLA_HK) * (GLA_HK ** -0.5)
    k = k.reshape(B, T, GLA_HEADS, GLA_HK)
    v = v.reshape(B, T, GLA_HEADS, GLA_HV)
    return q, k, v, g, log_a


def gla_scan(q, k, v, log_a, s0):
    B, T, H, K = q.shape
    V = v.shape[-1]
    n = T // GLA_CHUNK
    rs = lambda t: t.astype(F32).reshape(B, n, GLA_CHUNK, H, t.shape[-1])
    q, k, v, la = rs(q), rs(k), rs(v), rs(log_a)
    cum = jnp.cumsum(la, axis=2)
    last = cum[:, :, -1:]
    q_dec = q * jnp.exp(cum)
    k_inv = k * jnp.exp(-cum)
    k_end = k * jnp.exp(last - cum)
    mask = jnp.tril(jnp.ones((GLA_CHUNK, GLA_CHUNK), dtype=bool))
    att = jnp.where(mask, jnp.einsum('bnihk,bnjhk->bnhij', q_dec, k_inv), 0.0)
    o_intra = jnp.einsum('bnhij,bnjhv->bnihv', att, v)
    ds = jnp.einsum('bnjhk,bnjhv->nbhkv', k_end, v)
    dec = jnp.exp(jnp.moveaxis(last[:, :, 0], 1, 0))

    def step(s, inp):
        ds_n, dec_n = inp
        return s * dec_n[..., None] + ds_n, s

    s_fin, s_in = lax.scan(step, s0, (ds, dec))
    o_inter = jnp.einsum('bnihk,nbhkv->bnihv', q_dec, s_in)
    return (o_intra + o_inter).reshape(B, T, H, V), s_fin


def gla_bidir(q, k, v, log_a, s0_f, s0_b):
    flip = lambda t: jnp.flip(t, axis=1)
    o_f, s_f = gla_scan(q, k, v, log_a[:, :, 0], s0_f)
    o_b, s_b = gla_scan(flip(q), flip(k), flip(v), flip(log_a[:, :, 1]), s0_b)
    return o_f + flip(o_b), s_f, s_b


def gla_out(o, g, g_o, w_out):
    B, T = o.shape[:2]
    o = rmsnorm(o, g_o).reshape(B, T, GLA_VAL).astype(g.dtype)
    return (o * jax.nn.silu(g)) @ w_out


def gla_mixer(hl, hc, w_in, w_a2, b_a, g_o, w_out, rows, cols, ctx_out):
    ql, kl, vl, gl, al = gla_project(hl, w_in, w_a2, b_a)
    ql, kl = axial_rope(ql, rows, cols), axial_rope(kl, rows, cols)
    qc, kc, vc, gc, ac = gla_project(hc, w_in, w_a2, b_a)
    zero = jnp.zeros((hc.shape[0], GLA_HEADS, GLA_HK, GLA_HV), F32)
    oc, s_f, s_b = gla_bidir(qc, kc, vc, ac, zero, zero)
    ol, _, _ = gla_bidir(ql, kl, vl, al, s_f, s_b)
    yl = gla_out(ol, gl, g_o, w_out)
    yc = gla_out(oc, gc, g_o, w_out) if ctx_out else None
    return yl, yc


def neighbourhood_attention(q, k, v, kc, vc, rpb):
    B, S, H, Dh = q.shape
    rows = S // GRID_W
    kh = min(NA_KH, rows)
    grid = lambda t: t.reshape(B, rows, GRID_W, H, Dh)
    qg, kg, vg = grid(q * (Dh ** -0.5)), grid(k), grid(v)
    n_cb = GRID_W // NA_QCOLS
    qcol = np.arange(GRID_W).reshape(n_cb, NA_QCOLS)
    cstart = np.clip(qcol - NA_KW // 2, 0, GRID_W - NA_KW)
    bstart = np.minimum(cstart[:, 0], GRID_W - NA_BAND)
    band = bstart[:, None] + np.arange(NA_BAND)
    col_ok = (band[:, None, :] >= cstart[:, :, None]) & (band[:, None, :] < cstart[:, :, None] + NA_KW)
    col_idx = np.clip(band[:, None, :] - qcol[:, :, None] + NA_KW - 1, 0, 2 * NA_KW - 2)
    rpb_c = rpb[:, :, col_idx]

    def one_row(r):
        r0 = jnp.clip(r - kh // 2, 0, rows - kh)
        k_band = lax.dynamic_slice_in_dim(kg, r0, kh, axis=1)[:, :, band]
        v_band = lax.dynamic_slice_in_dim(vg, r0, kh, axis=1)[:, :, band]
        q_r = lax.dynamic_index_in_dim(qg, r, axis=1, keepdims=False).reshape(B, n_cb, NA_QCOLS, H, Dh)
        s_lat = jnp.einsum('bjqhd,bkjmhd->bhjqkm', q_r, k_band).astype(F32)
        row_idx = r0 + jnp.arange(kh) - r + NA_KH - 1
        bias = jnp.take(rpb_c, row_idx, axis=1).transpose(0, 2, 3, 1, 4).astype(F32)
        s_lat = jnp.where(col_ok[:, :, None, :], s_lat + bias, NEG_INF)
        s_ctx = jnp.einsum('bjqhd,blhd->bhjql', q_r, kc).astype(F32)
        s = jnp.concatenate([s_lat.reshape(B, H, n_cb, NA_QCOLS, kh * NA_BAND), s_ctx], axis=-1)
        p = jax.nn.softmax(s, axis=-1).astype(v.dtype)
        p_lat = p[..., :kh * NA_BAND].reshape(B, H, n_cb, NA_QCOLS, kh, NA_BAND)
        o = (jnp.einsum('bhjqkm,bkjmhd->bjqhd', p_lat, v_band)
             + jnp.einsum('bhjql,blhd->bjqhd', p[..., kh * NA_BAND:], vc))
        return o.reshape(B, GRID_W, H, Dh)

    out = lax.map(one_row, jnp.arange(rows))
    return jnp.moveaxis(out, 0, 1).reshape(B, S, H, Dh)


def dense_attention(q, k, v):
    s = jnp.einsum('bqhd,bkhd->bhqk', q, k).astype(F32) * (q.shape[-1] ** -0.5)
    p = jax.nn.softmax(s, axis=-1).astype(v.dtype)
    return jnp.einsum('bhqk,bkhd->bqhd', p, v)


def na_mixer(hl, hc, w_qkv, rpb, w_out, ctx_out):
    B, S, D = hl.shape
    L = hc.shape[1]
    ql, kl, vl = [t.reshape(B, S, NA_HEADS, NA_HD) for t in jnp.split(hl @ w_qkv, 3, axis=-1)]
    qc, kc, vc = [t.reshape(B, L, NA_HEADS, NA_HD) for t in jnp.split(hc @ w_qkv, 3, axis=-1)]
    yl = neighbourhood_attention(ql, kl, vl, kc, vc, rpb).reshape(B, S, D) @ w_out
    yc = dense_attention(qc, kc, vc).reshape(B, L, D) @ w_out if ctx_out else None
    return yl, yc


def moe(h, w_router, b_router, w_gu, b_gu, w_down, b_down):
    N, D = h.shape
    logits = (h @ w_router).astype(F32) + b_router.astype(F32)
    top_val, top_idx = lax.top_k(logits, TOP_K)
    gate = jax.nn.softmax(top_val, axis=-1)
    n_rows = N * TOP_K
    flat_e = top_idx.reshape(-1)
    order = jnp.argsort(flat_e)
    sorted_e = flat_e[order]
    sorted_tok = order // TOP_K
    counts = jnp.bincount(flat_e, length=N_EXPERTS)
    padded = (counts + MOE_BLOCK - 1) // MOE_BLOCK * MOE_BLOCK
    pad_end = jnp.cumsum(padded)
    start = jnp.cumsum(counts) - counts
    dest = (pad_end - padded)[sorted_e] + jnp.arange(n_rows) - start[sorted_e]
    n_blocks = -(-n_rows // MOE_BLOCK) + N_EXPERTS
    buf = jnp.zeros((n_blocks * MOE_BLOCK, D), h.dtype).at[dest].set(h[sorted_tok])
    block_e = jnp.minimum(jnp.searchsorted(pad_end, jnp.arange(n_blocks) * MOE_BLOCK, side='right'), N_EXPERTS - 1)

    def expert_block(args):
        xb, e = args
        glu, lin = jnp.split(xb @ w_gu[e] + b_gu[e], 2, axis=-1)
        glu = jnp.minimum(glu, SWIGLU_LIMIT)
        lin = jnp.clip(lin, -SWIGLU_LIMIT, SWIGLU_LIMIT)
        return (glu * jax.nn.sigmoid(SWIGLU_ALPHA * glu) * (lin + 1)) @ w_down[e] + b_down[e]

    out = lax.map(expert_block, (buf.reshape(n_blocks, MOE_BLOCK, D), block_e))
    rows_out = out.reshape(-1, D)[dest].astype(F32) * gate.reshape(-1)[order][:, None]
    return jax.ops.segment_sum(rows_out, sorted_tok, num_segments=N).astype(h.dtype)


def setup_inputs(seed: int = 0) -> dict:
    key = jax.random.key(seed)
    ks = iter(jax.random.split(key, 40))
    nrm = lambda shape, s: jax.random.normal(next(ks), shape, F32) * s
    D, E, F = D_MODEL, N_EXPERTS, D_EXPERT
    gla_in = 2 * GLA_KEY + 2 * GLA_VAL + 2 * GLA_RANK
    return {
        "x": nrm((BATCH, SEQ, D), 1.0),
        "c": nrm((BATCH, D), 1.0),
        "ctx": nrm((BATCH, CTX_LEN, D), 1.0),
        "c_ctx": nrm((D,), 1.0),
        "ada_w": nrm((DEPTH, D, 6 * D), 0.5 * D ** -0.5),
        "ada_b": nrm((DEPTH, 6 * D), 0.01),
        "norm_mix": 1.0 + nrm((DEPTH, D), 0.02),
        "norm_ffn": 1.0 + nrm((DEPTH, D), 0.02),
        "norm_out": 1.0 + nrm((D,), 0.02),
        "a_w_in": nrm((N_A, D, 2 * A_INNER), D ** -0.5),
        "a_g_v": 1.0 + nrm((N_A, A_INNER), 0.02),
        "a_w_s": nrm((N_A, A_GROUPS, CHUNK_A, CHUNK_A), CHUNK_A ** -0.5),
        "a_b_s": 1.0 + nrm((N_A, A_GROUPS, CHUNK_A), 0.01),
        "a_w_out": nrm((N_A, A_INNER, D), A_INNER ** -0.5),
        "b_w_in": nrm((N_B, D, gla_in), D ** -0.5),
        "b_w_a2": nrm((N_B, 2, GLA_RANK, GLA_KEY), GLA_RANK ** -0.5),
        "b_b_a": nrm((N_B, 2, GLA_KEY), 0.1),
        "b_g_o": 1.0 + nrm((N_B, GLA_HV), 0.02),
        "b_w_out": nrm((N_B, GLA_VAL, D), GLA_VAL ** -0.5),
        "c_w_qkv": nrm((N_C, D, 3 * D), D ** -0.5),
        "c_rpb": nrm((N_C, NA_HEADS, 2 * NA_KH - 1, 2 * NA_KW - 1), 0.1),
        "c_w_out": nrm((N_C, D, D), D ** -0.5),
        "moe_w_router": nrm((DEPTH, D, E), D ** -0.5),
        "moe_b_router": nrm((DEPTH, E), 0.01),
        "moe_w_gu": nrm((DEPTH, E, D, 2 * F), D ** -0.5),
        "moe_b_gu": nrm((DEPTH, E, 2 * F), 0.01),
        "moe_w_down": nrm((DEPTH, E, F, D), F ** -0.5),
        "moe_b_down": nrm((DEPTH, E, D), 0.01),
    }


def reference(x, c, ctx, c_ctx, ada_w, ada_b, norm_mix, norm_ffn, norm_out,
              a_w_in, a_g_v, a_w_s, a_b_s, a_w_out,
              b_w_in, b_w_a2, b_b_a, b_g_o, b_w_out,
              c_w_qkv, c_rpb, c_w_out,
              moe_w_router, moe_b_router, moe_w_gu, moe_b_gu, moe_w_down, moe_b_down):
    B, S, D = x.shape
    L = ctx.shape[1]
    t = jnp.arange(S)
    rows, cols = t // GRID_W, t % GRID_W
    s_lat = jax.nn.silu(c)
    s_ctx = jax.nn.silu(c_ctx)
    xc = ctx
    for i in range(DEPTH):
        kind, j = i % N_MIXERS, i // N_MIXERS
        ctx_later = any(k % N_MIXERS != 0 for k in range(i + 1, DEPTH))
        ctx_here = ctx_later or kind != 0
        ml = jnp.split((s_lat @ ada_w[i] + ada_b[i])[:, None, :], 6, axis=-1)
        mc = jnp.split(s_ctx @ ada_w[i] + ada_b[i], 6, axis=-1)
        hl = modulate(x, norm_mix[i], ml[0], ml[1])
        hc = modulate(xc, norm_mix[i], mc[0], mc[1]) if ctx_here else None
        if kind == 0:
            yl = chunk_mlp(hl, a_w_in[j], a_g_v[j], a_w_s[j], a_b_s[j], a_w_out[j])
            yc = chunk_mlp(hc, a_w_in[j], a_g_v[j], a_w_s[j], a_b_s[j], a_w_out[j]) if ctx_later else None
        elif kind == 1:
            yl, yc = gla_mixer(hl, hc, b_w_in[j], b_w_a2[j], b_b_a[j], b_g_o[j], b_w_out[j], rows, cols, ctx_later)
        else:
            yl, yc = na_mixer(hl, hc, c_w_qkv[j], c_rpb[j], c_w_out[j], ctx_later)
        x = x + ml[2] * yl
        hl2 = modulate(x, norm_ffn[i], ml[3], ml[4]).reshape(-1, D)
        moe_p = (moe_w_router[i], moe_b_router[i], moe_w_gu[i], moe_b_gu[i], moe_w_down[i], moe_b_down[i])
        if ctx_later:
            xc = xc + mc[2] * yc
            hc2 = modulate(xc, norm_ffn[i], mc[3], mc[4]).reshape(-1, D)
            f = moe(jnp.concatenate([hc2, hl2], axis=0), *moe_p)
            xc = xc + mc[5] * f[:B * L].reshape(B, L, D)
            f = f[B * L:]
        else:
            f = moe(hl2, *moe_p)
        x = x + ml[5] * f.reshape(B, S, D)
    return rmsnorm(x, norm_out)
```

```cpp
#include <hip/hip_runtime.h>
#include <cstdio>
#include <cstdint>

#ifndef MK_ONE_LAUNCH
#define MK_ONE_LAUNCH 0
#endif

namespace pg8 {
#define PG8_LAS __attribute__((address_space(3)))
typedef unsigned short bf16_t;
typedef short bf16x8 __attribute__((ext_vector_type(8)));
typedef float f32x4 __attribute__((ext_vector_type(4)));
typedef unsigned u32x4 __attribute__((ext_vector_type(4)));
constexpr int BM = 256, BK = 64, HALF = 128, HTB = HALF * BK * 2, STAGE_BYTES = 8 * HTB, NXCD = 8, WGM = 8;

__host__ __device__ __forceinline__ int lds_byte(int r, int c) { const int st = (r >> 4) * 2 + (c >> 5), rr = r & 15, cc = c & 31, ob = rr * 64 + cc * 2; return st * 1024 + (ob ^ (((ob >> 9) & 1) << 5)); }
__host__ __device__ __forceinline__ void stage_rc(int b, int& R, int& C) { const int st = b / 1024, sb = b % 1024, swz = sb ^ (((sb >> 9) & 1) << 5); R = (st >> 1) * 16 + swz / 64; C = (st & 1) * 32 + (swz % 64) / 2; }
__host__ __device__ __forceinline__ int perm32(int rho) { const int n = rho >> 4, i = rho & 15; return 8 * (i >> 2) + 4 * n + (i & 3); }

struct Unit { int pm, pn, pb, e; };
struct Gemm { const bf16_t* A; const bf16_t* Bt; int M, N, K; };

struct StaticOrder {
    int nM, nN, nwg, G, c;
    __device__ void init(int M, int N, int G_, int c_) { nM = M / BM; nN = N / BM; nwg = nM * nN; G = G_; c = c_; }
    __device__ bool next(int i, Unit& u) const {
        const long L = (long)i * G + c; if (L >= nwg) return false;
        int wgid = (int)L; { const int q = nwg / NXCD, r = nwg % NXCD, xcd = wgid % NXCD, off = wgid / NXCD; wgid = (xcd < r ? xcd * (q + 1) : r * (q + 1) + (xcd - r) * q) + off; }
        const int nig = WGM * nN, gid = wgid / nig, fm = gid * WGM, gsz = (nM - fm) < WGM ? (nM - fm) : WGM;
        u.pm = fm + ((wgid % nig) % gsz); u.pn = (wgid % nig) / gsz; u.pb = u.pn; u.e = 0; return true;
    }
};
struct GroupedOrder : StaticOrder {
    const PG8_LAS int* tile_e;
    __device__ bool next(int i, Unit& u) const {
        if (!StaticOrder::next(i, u)) return false;
        u.e = __builtin_amdgcn_readfirstlane(tile_e[u.pm]); u.pb = u.e * nN + u.pn; return true;
    }
};

__device__ __forceinline__ unsigned cvt_pk_bf16(float lo, float hi) { unsigned r; asm volatile("v_cvt_pk_bf16_f32 %0, %1, %2" : "=v"(r) : "v"(lo), "v"(hi)); return r; }
typedef float f32x2 __attribute__((ext_vector_type(2)));
__device__ __forceinline__ f32x2 gelu_pk(f32x2 v) {
    const f32x2 av = __builtin_elementwise_abs(v), d = av * 0.2316418882f + 1.0f;
    f32x2 t; t.x = __builtin_amdgcn_rcpf(d.x); t.y = __builtin_amdgcn_rcpf(d.y);
    f32x2 q = t * 0.5307027145f + (-0.7265760135f); q = q * t + 0.7107068705f; q = q * t + (-0.142248368f); q = q * t + 0.127414796f; q = q * t;
    const f32x2 s = (v * v) * (-0.72134752044f);
    f32x2 e; e.x = __builtin_amdgcn_exp2f(s.x); e.y = __builtin_amdgcn_exp2f(s.y);
    const f32x2 m = v * (q * e), r = v - m;
    f32x2 o; o.x = v.x < 0.f ? m.x : r.x; o.y = v.y < 0.f ? m.y : r.y; return o;
}

template <int ACT> struct EpiBf16 {
    static constexpr bool PERM = true;
    bf16_t* O; int ldc; const float* bias; int bias_estride;
    __device__ __forceinline__ void operator()(const f32x4 (&acc)[2][2][4][2], const Unit& u, int wr, int wc, int fr, int fq) const {
        const int row0 = u.pm * BM + wr * 64 + fr; const int col0 = u.pn * BM + wc * 32 + 8 * fq;
        const float* bp = bias ? bias + (size_t)u.e * bias_estride : nullptr;
        f32x4 bv[2][2];
#pragma unroll
        for (int bj = 0; bj < 2; ++bj)
#pragma unroll
            for (int n = 0; n < 2; ++n) bv[bj][n] = bp ? *(const f32x4*)(bp + col0 + bj * HALF + 4 * n) : (f32x4){0.f, 0.f, 0.f, 0.f};
#pragma unroll
        for (int ai = 0; ai < 2; ++ai)
#pragma unroll
            for (int m = 0; m < 4; ++m) { bf16_t* rowp = O + (size_t)(row0 + ai * HALF + m * 16) * ldc + col0;
#pragma unroll
                for (int bj = 0; bj < 2; ++bj) { f32x4 v0 = acc[ai][bj][m][0] + bv[bj][0], v1 = acc[ai][bj][m][1] + bv[bj][1];
                    if (ACT == 1) { f32x2 a = gelu_pk((f32x2){v0[0], v0[1]}), b = gelu_pk((f32x2){v0[2], v0[3]}), c = gelu_pk((f32x2){v1[0], v1[1]}), d = gelu_pk((f32x2){v1[2], v1[3]});
                        v0 = (f32x4){a.x, a.y, b.x, b.y}; v1 = (f32x4){c.x, c.y, d.x, d.y}; }
                    u32x4 w; w.x = cvt_pk_bf16(v0[0], v0[1]); w.y = cvt_pk_bf16(v0[2], v0[3]); w.z = cvt_pk_bf16(v1[0], v1[1]); w.w = cvt_pk_bf16(v1[2], v1[3]);
                    *(u32x4*)(rowp + bj * HALF) = w; } }
    }
};
struct EpiSwiglu {
    static constexpr bool PERM = true;
    bf16_t* O; int ldc; const float* bias; int bias_estride;
    __device__ __forceinline__ void operator()(const f32x4 (&acc)[2][2][4][2], const Unit& u, int wr, int wc, int fr, int fq) const {
        const int row0 = u.pm * BM + wr * 64 + fr; const int col0 = u.pn * HALF + wc * 32 + 8 * fq;
        const float* bp = bias + (size_t)u.e * bias_estride;
        f32x4 bg[2], bl[2];
#pragma unroll
        for (int n = 0; n < 2; ++n) { bg[n] = *(const f32x4*)(bp + col0 + 4 * n); bl[n] = *(const f32x4*)(bp + 1024 + col0 + 4 * n); }
#pragma unroll
        for (int ai = 0; ai < 2; ++ai)
#pragma unroll
            for (int m = 0; m < 4; ++m) { bf16_t* rowp = O + (size_t)(row0 + ai * HALF + m * 16) * ldc + col0;
                float o[8];
#pragma unroll
                for (int n = 0; n < 2; ++n) { const f32x4 g4 = acc[ai][0][m][n] + bg[n], l4 = acc[ai][1][m][n] + bl[n];
#pragma unroll
                    for (int i = 0; i < 4; ++i) { const float g = fminf(g4[i], 7.0f), l = fminf(fmaxf(l4[i], -7.0f), 7.0f);
                        const float sg = __builtin_amdgcn_rcpf(1.0f + __builtin_amdgcn_exp2f(-1.702f * 1.44269504089f * g));
                        o[4 * n + i] = g * sg * (l + 1.0f); } }
                u32x4 w; w.x = cvt_pk_bf16(o[0], o[1]); w.y = cvt_pk_bf16(o[2], o[3]); w.z = cvt_pk_bf16(o[4], o[5]); w.w = cvt_pk_bf16(o[6], o[7]);
                *(u32x4*)rowp = w; }
    }
};
struct EpiResid {
    static constexpr bool PERM = false;
    float* X; const float* gate; int gstride; int pm0;
    __device__ __forceinline__ void operator()(const f32x4 (&acc)[2][2][4][2], const Unit& u, int wr, int wc, int fr, int fq) const {
        const int t = u.pm + pm0; const int seg = t < 2 ? 0 : (t < 34 ? 1 : 2);
        const int row0 = u.pm * BM + wr * 64 + fr, col0 = u.pn * BM + wc * 32 + 4 * fq;
        const float* gp = gate + (size_t)seg * gstride;
        f32x4 gv[2][2];
#pragma unroll
        for (int bj = 0; bj < 2; ++bj)
#pragma unroll
            for (int n = 0; n < 2; ++n) gv[bj][n] = *(const f32x4*)(gp + col0 + bj * HALF + n * 16);
#pragma unroll
        for (int ai = 0; ai < 2; ++ai)
#pragma unroll
            for (int m = 0; m < 4; ++m) { float* rowp = X + (size_t)(row0 + ai * HALF + m * 16) * 1024 + col0;
#pragma unroll
                for (int bj = 0; bj < 2; ++bj)
#pragma unroll
                    for (int n = 0; n < 2; ++n) { f32x4* p = (f32x4*)(rowp + bj * HALF + n * 16); *p = *p + gv[bj][n] * acc[ai][bj][m][n]; } }
    }
};

template <class Epi, class Sched>
__device__ __forceinline__ void gemm_phase(PG8_LAS unsigned char* lds, const Gemm g, const Sched& S, const Epi& E) {
    const int tid = threadIdx.x, wid = __builtin_amdgcn_readfirstlane(tid >> 6), lane = tid & 63, wr = wid >> 2, wc = wid & 3, fr = lane & 15, fq = lane >> 4;
    const int K = g.K, nt = K / BK;
    unsigned voffA[2], voffB[2];
#pragma unroll
    for (int i = 0; i < 2; ++i) { int R, C; stage_rc(tid * 16 + i * 8192, R, C); const int Rb = Epi::PERM ? ((R & ~31) + perm32(R & 31)) : R;
        voffA[i] = (unsigned)(R * K + C) * 2u; voffB[i] = (unsigned)(Rb * K + C) * 2u; }
    const size_t kstep = (size_t)(BK * 2);
    const size_t hstep = (size_t)HALF * K * 2;
    const size_t tstep = 2 * hstep;
    const unsigned ldsw = (unsigned)wid * 1024u;
    const int aoff = lds_byte(wr * 64 + fr, fq * 8), boff = lds_byte(wc * 32 + fr, fq * 8);
#define PG8_SA(b, h) (((b) * 2 + (h)) * HTB)
#define PG8_SB(b, h) ((4 + (b) * 2 + (h)) * HTB)
#define PG8_STAGE(bufoff, gbase, voff) do { _Pragma("unroll") for (int _i = 0; _i < 2; ++_i) \
        __builtin_amdgcn_global_load_lds((const unsigned*)((const char*)(gbase) + (voff)[_i]), (PG8_LAS unsigned*)(lds + (bufoff) + ldsw + _i * 8192), 16, 0, 0); } while (0)
#define PG8_LDA(dst, b, h) do { _Pragma("unroll") for (int m = 0; m < 4; ++m) _Pragma("unroll") for (int k = 0; k < 2; ++k) dst[m][k] = *(const PG8_LAS bf16x8*)(lds + PG8_SA(b, h) + aoff + m * 2048 + k * 1024); } while (0)
#define PG8_LDB(dst, b, h) do { _Pragma("unroll") for (int n = 0; n < 2; ++n) _Pragma("unroll") for (int k = 0; k < 2; ++k) dst[n][k] = *(const PG8_LAS bf16x8*)(lds + PG8_SB(b, h) + boff + n * 2048 + k * 1024); } while (0)
#define PG8_MMA(ai, bj, At, Bt) do { __builtin_amdgcn_s_setprio(1); _Pragma("unroll") for (int m = 0; m < 4; ++m) _Pragma("unroll") for (int n = 0; n < 2; ++n) _Pragma("unroll") for (int k = 0; k < 2; ++k) \
        acc[ai][bj][m][n] = __builtin_amdgcn_mfma_f32_16x16x32_bf16(Bt[n][k], At[m][k], acc[ai][bj][m][n], 0, 0, 0); __builtin_amdgcn_s_setprio(0); } while (0)
#define PG8_WAIT_V(n) asm volatile("s_waitcnt vmcnt(" #n ")" ::: "memory")
#define PG8_WAIT_L(n) asm volatile("s_waitcnt lgkmcnt(" #n ")" ::: "memory")
#define PG8_BAR __builtin_amdgcn_s_barrier()
#define PG8_SCHED __builtin_amdgcn_sched_barrier(0)
    Unit cur, nxt; int ui = 0;
    if (!S.next(0, cur)) return;
    f32x4 acc[2][2][4][2];
#pragma unroll
    for (int a = 0; a < 2; ++a)
#pragma unroll
        for (int b = 0; b < 2; ++b)
#pragma unroll
            for (int m = 0; m < 4; ++m)
#pragma unroll
                for (int n = 0; n < 2; ++n) acc[a][b][m][n] = (f32x4){0.f, 0.f, 0.f, 0.f};
    bf16x8 At[4][2], B0[2][2], B1[2][2];
    const char* cA = (const char*)g.A + (size_t)cur.pm * tstep; const char* cB = (const char*)g.Bt + (size_t)cur.pb * tstep;
    PG8_STAGE(PG8_SB(0, 0), cB, voffB); PG8_STAGE(PG8_SB(0, 1), cB + hstep, voffB); PG8_STAGE(PG8_SA(0, 0), cA, voffA); PG8_STAGE(PG8_SA(0, 1), cA + hstep, voffA);
    if (wr == 1) PG8_BAR;
    PG8_WAIT_V(2); PG8_BAR;
    PG8_STAGE(PG8_SB(1, 0), cB + kstep, voffB); PG8_STAGE(PG8_SA(1, 0), cA + kstep, voffA); PG8_STAGE(PG8_SB(1, 1), cB + hstep + kstep, voffB);
    PG8_WAIT_V(6); PG8_BAR;
    for (;;) {
        const bool has_next = S.next(ui + 1, nxt);
        const char* nA = has_next ? (const char*)g.A + (size_t)nxt.pm * tstep : cA; const char* nB = has_next ? (const char*)g.Bt + (size_t)nxt.pb * tstep : cB;
        for (int t = 0; t < nt; t += 2) {
            const bool last = (t == nt - 2);
            const char* a1 = cA + (size_t)(t + 1) * kstep;
            const char* a2 = last ? nA : cA + (size_t)(t + 2) * kstep; const char* b2 = last ? nB : cB + (size_t)(t + 2) * kstep;
            const char* a3 = a2 + kstep; const char* b3 = b2 + kstep;
            PG8_LDB(B0, 0, 0); PG8_LDB(B1, 0, 1); PG8_SCHED; PG8_LDA(At, 0, 0); PG8_STAGE(PG8_SA(1, 1), a1 + hstep, voffA);
            PG8_WAIT_V(8); PG8_WAIT_L(0); PG8_BAR; PG8_MMA(0, 0, At, B0); PG8_MMA(0, 1, At, B1); PG8_BAR; PG8_SCHED;
            PG8_LDA(At, 0, 1); PG8_STAGE(PG8_SB(0, 0), b2, voffB); PG8_STAGE(PG8_SB(0, 1), b2 + hstep, voffB); PG8_STAGE(PG8_SA(0, 0), a2, voffA);
            PG8_WAIT_V(8); PG8_WAIT_L(0); PG8_BAR; PG8_MMA(1, 0, At, B0); PG8_MMA(1, 1, At, B1); PG8_BAR; PG8_SCHED;
            PG8_LDB(B0, 1, 0); PG8_LDB(B1, 1, 1); PG8_SCHED; PG8_LDA(At, 1, 0); PG8_STAGE(PG8_SA(0, 1), a2 + hstep, voffA);
            PG8_WAIT_V(8); PG8_WAIT_L(0); PG8_BAR; PG8_MMA(0, 0, At, B0); PG8_MMA(0, 1, At, B1); PG8_BAR; PG8_SCHED;
            PG8_LDA(At, 1, 1); PG8_STAGE(PG8_SB(1, 0), b3, voffB); PG8_STAGE(PG8_SB(1, 1), b3 + hstep, voffB); PG8_STAGE(PG8_SA(1, 0), a3, voffA);
            PG8_WAIT_V(8); PG8_WAIT_L(0); PG8_BAR; PG8_MMA(1, 0, At, B0); PG8_MMA(1, 1, At, B1); PG8_BAR; PG8_SCHED;
        }
        if (wr == 0) PG8_BAR;
        E(acc, cur, wr, wc, fr, fq);
        if (!has_next) break;
#pragma unroll
        for (int a = 0; a < 2; ++a)
#pragma unroll
            for (int b = 0; b < 2; ++b)
#pragma unroll
                for (int m = 0; m < 4; ++m)
#pragma unroll
                    for (int n = 0; n < 2; ++n) acc[a][b][m][n] = (f32x4){0.f, 0.f, 0.f, 0.f};
        cur = nxt; cA = nA; cB = nB; ++ui;
        if (wr == 1) PG8_BAR;
    }
    PG8_WAIT_V(0);
    PG8_BAR;
#undef PG8_SA
#undef PG8_SB
#undef PG8_STAGE
#undef PG8_LDA
#undef PG8_LDB
#undef PG8_MMA
#undef PG8_WAIT_V
#undef PG8_WAIT_L
#undef PG8_BAR
#undef PG8_SCHED
}
}

constexpr int NWAVES = 8, NTHREADS = 512;
constexpr int D = 1024, NCTX = 512, NLAT = 16384, NTOK = NCTX + NLAT, SEQ = 8192, CTXL = 256;
constexpr int NEXP = 32, MAXPADROWS = 75776, MAXPADTILES = 296;
constexpr int GLA_IN = 3104, GLA_INP = 3328;
constexpr float EPS = 1e-6f;

constexpr size_t MiB = 1u << 20;
constexpr size_t WS_CTL = 0, CTL_ZERO_BYTES = 1 * MiB;
constexpr size_t WS_ADA = 1 * MiB;
constexpr size_t WS_ROPE = 1 * MiB + 512 * 1024;
constexpr size_t WS_TOKI = 2 * MiB;
constexpr size_t WS_TOKG = 2 * MiB + 512 * 1024;
constexpr size_t WS_LIST = 3 * MiB;
constexpr size_t WS_WRH = 6 * MiB, WS_WRL = 6 * MiB + 256 * 1024;
constexpr size_t WS_WSB = 7 * MiB;
constexpr size_t WS_WAIN = 8 * MiB;
constexpr size_t WS_WAOUT = 16 * MiB;
constexpr size_t WS_WBIN = 20 * MiB;
constexpr size_t WS_WBOUT = 27 * MiB;
constexpr size_t WS_WCQKV = 29 * MiB;
constexpr size_t WS_WCOUT = 35 * MiB;
constexpr size_t WS_WGU = 64 * MiB;
constexpr size_t WS_WDN = 576 * MiB;
constexpr size_t WS_X = 832 * MiB;
constexpr size_t WS_H = 898 * MiB;
constexpr size_t WS_G = 931 * MiB;
constexpr size_t WS_BIG = 964 * MiB;
constexpr size_t WS_DS = 1072 * MiB;
constexpr size_t WS_SIN = 1204 * MiB;
constexpr size_t WS_DEC = 1336 * MiB;
constexpr size_t WS_AS = 1338 * MiB;
constexpr size_t WS_ACT = 1486 * MiB;
constexpr size_t WS_YB = 1634 * MiB;
constexpr size_t WS_END = 1782 * MiB;
constexpr int CW_TMO = 0;
constexpr int CW_BAR = 4096;
constexpr int CW_CNT = 8192;

constexpr int RING_OFF = 0, RING_BYTES = 131072;
constexpr int MISC_OFF = RING_BYTES;
constexpr int LDS_BYTES = 147456;

#define GAS __attribute__((address_space(1)))
#define LAS __attribute__((address_space(3)))
typedef unsigned short bf16;
typedef unsigned v4u __attribute__((ext_vector_type(4)));
typedef unsigned v2u __attribute__((ext_vector_type(2)));
typedef float f32x4 __attribute__((ext_vector_type(4)));
typedef short bf16x8 __attribute__((ext_vector_type(8)));
typedef short bf16x4 __attribute__((ext_vector_type(4)));
#define LDS_WAIT() asm volatile("s_waitcnt lgkmcnt(0)" ::: "memory")
#define VM_WAIT() asm volatile("s_waitcnt vmcnt(0)" ::: "memory")
__device__ __forceinline__ unsigned f2bf(float f) { unsigned u = __builtin_bit_cast(unsigned, f); return (u + 0x7fffu + ((u >> 16) & 1u)) >> 16; }
__device__ __forceinline__ unsigned pk2(float lo, float hi) { return f2bf(lo) | (f2bf(hi) << 16); }
__device__ __forceinline__ float bf2f(unsigned b) { return __builtin_bit_cast(float, b << 16); }
__device__ __forceinline__ float bflo(unsigned w) { return __builtin_bit_cast(float, w << 16); }
__device__ __forceinline__ float bfhi(unsigned w) { return __builtin_bit_cast(float, w & 0xffff0000u); }
#define MFMA16(a, b, c) __builtin_amdgcn_mfma_f32_16x16x32_bf16((a), (b), (c), 0, 0, 0)

#define XB_TMO      128
#define XB_XCNT(j)  (256  + 64 * (j))
#define XB_XSUB(j)  (1280 + 64 * (j))
#define XB_XGEN(j)  (2304 + 64 * (j))
#define XB_TOP      3328
#define XB_TOPGEN   3392
#define XCD_BAR_WORDS 3456
#define XB_SPIN_CAP (1u << 22)

__device__ __forceinline__ unsigned xb_ld(unsigned* p)              { return __hip_atomic_load(p, __ATOMIC_RELAXED, __HIP_MEMORY_SCOPE_AGENT); }
__device__ __forceinline__ unsigned xb_add(unsigned* p, unsigned v) { return __hip_atomic_fetch_add(p, v, __ATOMIC_RELAXED, __HIP_MEMORY_SCOPE_AGENT); }
__device__ __forceinline__ unsigned xb_xcc_id() { return (unsigned)__builtin_amdgcn_s_getreg((3 << 11) | 20) & 0xFu; }
#define XB_SPIN(cond, bar) do { unsigned _sp = 0; while (cond) { __builtin_amdgcn_s_sleep(1); \
    if ((++_sp & 255u) == 0u) { if (xb_ld(&(bar)[XB_TMO])) break; if (_sp > XB_SPIN_CAP) { atomicAdd(&(bar)[XB_TMO], 1u); break; } } } } while (0)

struct XcdBarrier { unsigned* bar; unsigned x; volatile LAS unsigned* st; };
__device__ __forceinline__ XcdBarrier xcd_barrier_post(unsigned* bar, volatile LAS unsigned* st) {
    XcdBarrier b; b.bar = bar; b.x = xb_xcc_id(); b.st = st;
    if (threadIdx.x == 0) (void)xb_add(&bar[XB_XCNT(b.x)], 1u);
    return b;
}
__device__ __forceinline__ void xcd_barrier_complete(unsigned* bar, unsigned x, unsigned& nloc, unsigned& nx) {
    const unsigned G = gridDim.x * gridDim.y * gridDim.z;
    unsigned sum, cnt, mine, sp = 0u;
    for (;;) {
        sum = 0u; cnt = 0u; mine = 0u;
#pragma unroll
        for (unsigned j = 0; j < 16; ++j) { const unsigned c = xb_ld(&bar[XB_XCNT(j)]); sum += c; cnt += (c > 0u) ? 1u : 0u; mine = (j == x) ? c : mine; }
        if (sum == G) break;
        __builtin_amdgcn_s_sleep(1);
        if ((++sp & 255u) == 0u) { if (xb_ld(&bar[XB_TMO])) break; if (sp > XB_SPIN_CAP) { atomicAdd(&bar[XB_TMO], 1u); break; } }
    }
    nloc = mine > 0u ? mine : 1u; nx = cnt > 0u ? cnt : 1u;
}
__device__ __forceinline__ void xcd_barrier(const XcdBarrier& b) {
    asm volatile("s_waitcnt vmcnt(0)" ::: "memory");
    __syncthreads();
    if (threadIdx.x == 0) {
        unsigned* bar = b.bar;
        __builtin_amdgcn_s_waitcnt(0);
        unsigned nloc = b.st[0], nx = b.st[1];
        if (nloc == 0u) { xcd_barrier_complete(bar, b.x, nloc, nx); b.st[0] = nloc; b.st[1] = nx; }
        const unsigned old = xb_add(&bar[XB_XSUB(b.x)], 1u);
        const unsigned gen = old / nloc;
        if (old + 1u == (gen + 1u) * nloc) {
            __builtin_amdgcn_fence(__ATOMIC_RELEASE, "agent");
            asm volatile("s_waitcnt vmcnt(0)" ::: "memory");
            const unsigned og = xb_add(&bar[XB_TOP], 1u);
            const unsigned tg = og / nx;
            if (og + 1u == (tg + 1u) * nx) xb_add(&bar[XB_TOPGEN], 1u);
            else XB_SPIN(xb_ld(&bar[XB_TOPGEN]) == tg, bar);
            __builtin_amdgcn_fence(__ATOMIC_ACQUIRE, "agent");
            xb_add(&bar[XB_XGEN(b.x)], 1u);
            asm volatile("s_waitcnt vmcnt(0)" ::: "memory");
        } else {
            XB_SPIN(xb_ld(&bar[XB_XGEN(b.x)]) == gen, bar);
            __builtin_amdgcn_fence(__ATOMIC_ACQUIRE, "agent");
            asm volatile("s_waitcnt vmcnt(0)" ::: "memory");
        }
    }
    __syncthreads();
}

struct Args { const float* in[28]; float* out; unsigned char* ws; int ph_lo, ph_hi; };
enum { I_X = 0, I_C, I_CTX, I_CCTX, I_ADAW, I_ADAB, I_NMIX, I_NFFN, I_NOUT, I_AWIN, I_AGV, I_AWS, I_ABS, I_AWOUT, I_BWIN, I_BWA2, I_BBA, I_BGO, I_BWOUT,
       I_CWQKV, I_CRPB, I_CWOUT, I_MWR, I_MBR, I_MWGU, I_MBGU, I_MWDN, I_MBDN };

struct Frame {
    LAS unsigned char* lds;
    unsigned* ctl;
    unsigned char* ws;
    int tid, lane, wave, vcu, G;
};

__device__ __forceinline__ float wave_sum(float v) {
#pragma unroll
    for (int o = 1; o < 64; o <<= 1) v += __shfl_xor(v, o);
    return v;
}
__device__ __forceinline__ int seg_of_row(int r) { return r < NCTX ? 0 : 1 + ((r - NCTX) >> 13); }

__device__ __forceinline__ void transpose_item64(const float* W, int N, int k0, int n0, bf16* WT, int K, int dst_row0, int ncols_valid, LAS float* scr, int lane) {
#pragma unroll 4
    for (int i = 0; i < 16; ++i) { const int row = 4 * i + (lane >> 4), c4 = (lane & 15) * 4;
        f32x4 v = (f32x4){0.f, 0.f, 0.f, 0.f};
        if (c4 < ncols_valid) v = *(const GAS f32x4*)(W + (size_t)(k0 + row) * N + n0 + c4);
        LAS float* s = scr + row * 65 + c4; s[0] = v.x; s[1] = v.y; s[2] = v.z; s[3] = v.w; }
    LDS_WAIT(); asm volatile("" ::: "memory");
    const int c = lane & 7;
#pragma unroll
    for (int j = 0; j < 8; ++j) { const int n = (lane >> 3) + 8 * j; const LAS float* s = scr + (8 * c) * 65 + n;
        v4u o; o.x = pk2(s[0 * 65], s[1 * 65]); o.y = pk2(s[2 * 65], s[3 * 65]); o.z = pk2(s[4 * 65], s[5 * 65]); o.w = pk2(s[6 * 65], s[7 * 65]);
        *(GAS v4u*)(WT + (size_t)(dst_row0 + n) * K + k0 + 8 * c) = o; }
    LDS_WAIT(); asm volatile("" ::: "memory");
}

__device__ __forceinline__ void p_prologue(Frame& F, const Args& a) {
    LAS float* scr = (LAS float*)(F.lds + F.wave * 16640);
    const int gw = F.vcu * NWAVES + F.wave, NGW = F.G * NWAVES;
    {
        constexpr int KB = 16;
        constexpr int I0 = 2 * KB * 32, I1 = 2 * KB * 16, I2 = KB * 52, I3 = KB * 16, I4 = KB * 48, I5 = KB * 16;
        constexpr int NI = I0 + I1 + I2 + I3 + I4 + I5;
        for (int it = gw; it < NI; it += NGW) {
            int r = it;
            if (r < I0) { const int j = r / (KB * 32), q = r % (KB * 32), kb = q / 32, nb = q % 32;
                transpose_item64(a.in[I_AWIN] + (size_t)j * 1024 * 2048, 2048, 64 * kb, 64 * nb, (bf16*)(F.ws + WS_WAIN) + (size_t)j * 2048 * 1024, 1024, 64 * nb, 64, scr, F.lane); continue; } r -= I0;
            if (r < I1) { const int j = r / (KB * 16), q = r % (KB * 16), kb = q / 16, nb = q % 16;
                transpose_item64(a.in[I_AWOUT] + (size_t)j * 1024 * 1024, 1024, 64 * kb, 64 * nb, (bf16*)(F.ws + WS_WAOUT) + (size_t)j * 1024 * 1024, 1024, 64 * nb, 64, scr, F.lane); continue; } r -= I1;
            if (r < I2) { const int kb = r / 52, nb = r % 52; const int nv = GLA_IN - 64 * nb;
                transpose_item64(a.in[I_BWIN], GLA_IN, 64 * kb, 64 * nb, (bf16*)(F.ws + WS_WBIN), 1024, 64 * nb, nv < 0 ? 0 : (nv > 64 ? 64 : nv), scr, F.lane); continue; } r -= I2;
            if (r < I3) { const int kb = r / 16, nb = r % 16;
                transpose_item64(a.in[I_BWOUT], 1024, 64 * kb, 64 * nb, (bf16*)(F.ws + WS_WBOUT), 1024, 64 * nb, 64, scr, F.lane); continue; } r -= I3;
            if (r < I4) { const int kb = r / 48, nb = r % 48;
                transpose_item64(a.in[I_CWQKV], 3072, 64 * kb, 64 * nb, (bf16*)(F.ws + WS_WCQKV), 1024, 64 * nb, 64, scr, F.lane); continue; } r -= I4;
            { const int kb = r / 16, nb = r % 16;
                transpose_item64(a.in[I_CWOUT], 1024, 64 * kb, 64 * nb, (bf16*)(F.ws + WS_WCOUT), 1024, 64 * nb, 64, scr, F.lane); }
        }
    }
    {
        constexpr int KB = 16, PER_GU = KB * 32, PER_DN = KB * 16, NGU = 128 * PER_GU, NDN = 128 * PER_DN;
        for (int it = gw; it < NGU + NDN; it += NGW) {
            if (it < NGU) { const int le = it / PER_GU, q = it % PER_GU, kb = q / 32, nb = q % 32;
                const int n0 = 64 * nb, half = n0 >> 10, jj = n0 & 1023, dst = (jj >> 7) * 256 + half * 128 + (jj & 127);
                transpose_item64(a.in[I_MWGU] + (size_t)le * 1024 * 2048, 2048, 64 * kb, n0, (bf16*)(F.ws + WS_WGU) + (size_t)le * 2048 * 1024, 1024, dst, 64, scr, F.lane); }
            else { const int r = it - NGU, le = r / PER_DN, q = r % PER_DN, kb = q / 16, nb = q % 16;
                transpose_item64(a.in[I_MWDN] + (size_t)le * 1024 * 1024, 1024, 64 * kb, 64 * nb, (bf16*)(F.ws + WS_WDN) + (size_t)le * 1024 * 1024, 1024, 64 * nb, 64, scr, F.lane); }
        }
    }
    const int gt = F.vcu * NTHREADS + F.tid, NGT = F.G * NTHREADS;
    for (int i = gt; i < 2 * 8 * 128 * 128; i += NGT) ((bf16*)(F.ws + WS_WSB))[i] = (bf16)f2bf(a.in[I_AWS][i]);
    for (int i = gt; i < 4 * 32 * 1024; i += NGT) { const int l = i >> 15, e = (i >> 10) & 31, k = i & 1023;
        const float w = a.in[I_MWR][((size_t)l * 1024 + k) * 32 + e]; const unsigned h = f2bf(w); const float rem = w - bf2f(h);
        ((bf16*)(F.ws + WS_WRH))[i] = (bf16)h; ((bf16*)(F.ws + WS_WRL))[i] = (bf16)f2bf(rem); }
    for (int i = gt; i < 128 * 32; i += NGT) { const int pos = i >> 5, f = i & 31;
        const float fr = powf(10000.0f, -(float)f / 32.0f); const float ang = (float)pos * fr; float sn, cs; sincosf(ang, &sn, &cs);
        ((float*)(F.ws + WS_ROPE))[2 * i] = cs; ((float*)(F.ws + WS_ROPE))[2 * i + 1] = sn; }
    {
        __syncthreads();
        LAS float* sv = (LAS float*)(F.lds);
        LAS float* red = sv + 3 * 1024;
        for (int i = F.tid; i < 3 * 1024; i += NTHREADS) { const int s = i >> 10, k = i & 1023;
            const float v = s == 0 ? a.in[I_CCTX][k] : a.in[I_C][(s - 1) * 1024 + k]; sv[i] = v / (1.0f + __expf(-v)); }
        __syncthreads();
        for (int u = F.vcu; u < 4 * 96; u += F.G) { const int l = u / 96, n0 = (u % 96) * 64;
            const float* w = a.in[I_ADAW] + (size_t)l * 1024 * 6144 + n0 + F.lane;
            float a0 = 0.f, a1 = 0.f, a2 = 0.f;
#pragma unroll 8
            for (int kk = 0; kk < 128; ++kk) { const int k = F.wave * 128 + kk; const float wv = w[(size_t)k * 6144];
                a0 += sv[k] * wv; a1 += sv[1024 + k] * wv; a2 += sv[2048 + k] * wv; }
            red[(F.wave * 3 + 0) * 64 + F.lane] = a0; red[(F.wave * 3 + 1) * 64 + F.lane] = a1; red[(F.wave * 3 + 2) * 64 + F.lane] = a2;
            __syncthreads();
            if (F.tid < 192) { const int s = F.tid >> 6, c = F.tid & 63; float t = a.in[I_ADAB][l * 6144 + n0 + c];
#pragma unroll
                for (int w8 = 0; w8 < 8; ++w8) t += red[(w8 * 3 + s) * 64 + c];
                ((float*)(F.ws + WS_ADA))[(size_t)(l * 3 + s) * 6144 + n0 + c] = t; }
            __syncthreads();
        }
    }
}

__device__ __forceinline__ void moe_tables(Frame& F, int layer) {
    LAS int* M = (LAS int*)(F.lds + MISC_OFF);
    __syncthreads();
    if (F.tid < 32) M[400 + F.tid] = (int)__hip_atomic_load(F.ctl + CW_CNT + (layer * 32 + F.tid) * 64, __ATOMIC_RELAXED, __HIP_MEMORY_SCOPE_AGENT);
    __syncthreads();
    if (F.tid == 0) { int off = 0; for (int e = 0; e < 32; ++e) { M[e] = off; const int nt = (M[400 + e] + 255) >> 8; for (int t = 0; t < nt; ++t) M[64 + (off >> 8) + t] = e; off += nt << 8; } M[32] = off; }
    __syncthreads();
}

__device__ __forceinline__ void p_prenorm(Frame& F, const Args& a, int layer, bool fin) {
    const int gw = F.vcu * NWAVES + F.wave, NGW = F.G * NWAVES;
    const int prev = layer - 1;
    const int row_lo = (layer >= 3) ? NCTX : 0;
    const bool combine = layer > 0;
    if (combine) moe_tables(F, prev);
    const LAS int* M = (const LAS int*)(F.lds + MISC_OFF);
    float* X = (float*)(F.ws + WS_X); bf16* H = (bf16*)(F.ws + WS_H);
    const bf16* YB = (const bf16*)(F.ws + WS_YB);
    const float* ada = (const float*)(F.ws + WS_ADA);
    const v4u* TOKI = (const v4u*)(F.ws + WS_TOKI); const f32x4* TOKG = (const f32x4*)(F.ws + WS_TOKG);
    for (int row = row_lo + gw; row < NTOK; row += NGW) {
        const int seg = seg_of_row(row);
        const float* src = layer == 0 ? (row < NCTX ? a.in[I_CTX] + (size_t)row * D : a.in[I_X] + (size_t)(row - NCTX) * D) : X + (size_t)row * D;
        f32x4 v[4];
#pragma unroll
        for (int j = 0; j < 4; ++j) v[j] = *(const GAS f32x4*)(src + 4 * F.lane + 256 * j);
        if (combine) {
            const v4u ti = TOKI[row]; const f32x4 tg = TOKG[row];
            f32x4 acc[4];
#pragma unroll
            for (int j = 0; j < 4; ++j) acc[j] = (f32x4){0.f, 0.f, 0.f, 0.f};
#pragma unroll
            for (int k = 0; k < 4; ++k) { const unsigned t = ti[k]; const int pos = M[t >> 16] + (int)(t & 0xffffu); const float g = tg[k];
                const bf16* yr = YB + (size_t)pos * D + 4 * F.lane;
#pragma unroll
                for (int j = 0; j < 4; ++j) { const v2u y = *(const GAS v2u*)(yr + 256 * j);
                    acc[j].x += g * bflo(y.x); acc[j].y += g * bfhi(y.x); acc[j].z += g * bflo(y.y); acc[j].w += g * bfhi(y.y); } }
            const float* g5 = ada + (size_t)((prev * 3 + seg) * 6 + 5) * D;
#pragma unroll
            for (int j = 0; j < 4; ++j) { const f32x4 gg = *(const GAS f32x4*)(g5 + 4 * F.lane + 256 * j); v[j] = v[j] + gg * acc[j]; }
        }
        if (!fin && (combine || layer == 0)) {
#pragma unroll
            for (int j = 0; j < 4; ++j) *(GAS f32x4*)(X + (size_t)row * D + 4 * F.lane + 256 * j) = v[j];
        }
        float ss = 0.f;
#pragma unroll
        for (int j = 0; j < 4; ++j) ss += (v[j].x * v[j].x + v[j].y * v[j].y) + (v[j].z * v[j].z + v[j].w * v[j].w);
        const float rstd = 1.0f / sqrtf(wave_sum(ss) * (1.0f / D) + EPS);
        if (fin) {
            float* o = a.out + (size_t)(row - NCTX) * D;
#pragma unroll
            for (int j = 0; j < 4; ++j) { const f32x4 g = *(const GAS f32x4*)(a.in[I_NOUT] + 4 * F.lane + 256 * j); *(GAS f32x4*)(o + 4 * F.lane + 256 * j) = v[j] * rstd * g; }
        } else {
            const float* sh = ada + (size_t)((layer * 3 + seg) * 6 + 0) * D; const float* sc = sh + D;
            const float* nw = a.in[I_NMIX] + (size_t)layer * D;
#pragma unroll
            for (int j = 0; j < 4; ++j) { const int c = 4 * F.lane + 256 * j;
                const f32x4 g = *(const GAS f32x4*)(nw + c), s1 = *(const GAS f32x4*)(sc + c), s0 = *(const GAS f32x4*)(sh + c);
                const f32x4 h = v[j] * rstd * g * (s1 + 1.0f) + s0;
                v2u o; o.x = pk2(h.x, h.y); o.y = pk2(h.z, h.w);
                *(GAS v2u*)(H + (size_t)row * D + c) = o; }
        }
    }
}

__device__ __forceinline__ void p_router(Frame& F, const Args& a, int layer) {
    const int row_lo = (layer >= 2) ? NCTX : 0;
    const int ntile = (NTOK - row_lo) / 16;
    float* X = (float*)(F.ws + WS_X); bf16* H = (bf16*)(F.ws + WS_H);
    const float* ada = (const float*)(F.ws + WS_ADA);
    constexpr int AST = 1032;
    LAS bf16* Ahi = (LAS bf16*)(F.lds); LAS bf16* Alo = Ahi + 16 * AST;
    LAS float* RED = (LAS float*)(F.lds + 2 * 16 * AST * 2);
    LAS float* LOG = RED + 8 * 16 * 32;
    const int fr = F.lane & 15, fq = F.lane >> 4;
    bf16x8 Bh[2][4], Bl[2][4];
    {
        const bf16* wh = (const bf16*)(F.ws + WS_WRH) + (size_t)layer * 32 * 1024; const bf16* wl = (const bf16*)(F.ws + WS_WRL) + (size_t)layer * 32 * 1024;
#pragma unroll
        for (int nt = 0; nt < 2; ++nt)
#pragma unroll
            for (int ks = 0; ks < 4; ++ks) { const size_t o = (size_t)(nt * 16 + fr) * 1024 + F.wave * 128 + ks * 32 + fq * 8;
                Bh[nt][ks] = *(const GAS bf16x8*)(wh + o); Bl[nt][ks] = *(const GAS bf16x8*)(wl + o); }
    }
    const float* nw = a.in[I_NFFN] + (size_t)layer * D;
    for (int tile = F.vcu; tile < ntile; tile += F.G) {
        const int r0 = row_lo + 16 * tile;
#pragma unroll
        for (int rr = 0; rr < 2; ++rr) {
            const int rl = 2 * F.wave + rr, row = r0 + rl, seg = seg_of_row(row);
            const float* sh = ada + (size_t)((layer * 3 + seg) * 6 + 3) * D; const float* sc = sh + D;
            f32x4 v[4]; float ss = 0.f;
#pragma unroll
            for (int j = 0; j < 4; ++j) { v[j] = *(const GAS f32x4*)(X + (size_t)row * D + 4 * F.lane + 256 * j); ss += (v[j].x * v[j].x + v[j].y * v[j].y) + (v[j].z * v[j].z + v[j].w * v[j].w); }
            const float rstd = 1.0f / sqrtf(wave_sum(ss) * (1.0f / D) + EPS);
#pragma unroll
            for (int j = 0; j < 4; ++j) { const int c = 4 * F.lane + 256 * j;
                const f32x4 g = *(const GAS f32x4*)(nw + c), s1 = *(const GAS f32x4*)(sc + c), s0 = *(const GAS f32x4*)(sh + c);
                const f32x4 h = v[j] * rstd * g * (s1 + 1.0f) + s0;
                const unsigned h0 = f2bf(h.x), h1 = f2bf(h.y), h2 = f2bf(h.z), h3 = f2bf(h.w);
                v2u o; o.x = h0 | (h1 << 16); o.y = h2 | (h3 << 16);
                *(GAS v2u*)(H + (size_t)row * D + c) = o;
                *(LAS v2u*)(Ahi + rl * AST + c) = o;
                v2u l; l.x = pk2(h.x - bf2f(h0), h.y - bf2f(h1)); l.y = pk2(h.z - bf2f(h2), h.w - bf2f(h3));
                *(LAS v2u*)(Alo + rl * AST + c) = l; }
        }
        __syncthreads();
        f32x4 acc[2] = {(f32x4){0.f, 0.f, 0.f, 0.f}, (f32x4){0.f, 0.f, 0.f, 0.f}};
#pragma unroll
        for (int ks = 0; ks < 4; ++ks) { const int o = fr * AST + F.wave * 128 + ks * 32 + fq * 8;
            const bf16x8 ah = *(const LAS bf16x8*)(Ahi + o), al = *(const LAS bf16x8*)(Alo + o);
#pragma unroll
            for (int nt = 0; nt < 2; ++nt) { acc[nt] = MFMA16(ah, Bh[nt][ks], acc[nt]); acc[nt] = MFMA16(ah, Bl[nt][ks], acc[nt]); acc[nt] = MFMA16(al, Bh[nt][ks], acc[nt]); } }
#pragma unroll
        for (int nt = 0; nt < 2; ++nt)
#pragma unroll
            for (int j = 0; j < 4; ++j) RED[(F.wave * 16 + fq * 4 + j) * 32 + nt * 16 + fr] = acc[nt][j];
        __syncthreads();
        {
            const int rl = F.tid >> 5, e = F.tid & 31, row = r0 + rl;
            float lg = a.in[I_MBR][layer * 32 + e];
#pragma unroll
            for (int w8 = 0; w8 < 8; ++w8) lg += RED[(w8 * 16 + rl) * 32 + e];
            float cur = lg; float tv[4]; int tix[4];
#pragma unroll
            for (int k = 0; k < 4; ++k) { float bv = cur; int bi = e;
#pragma unroll
                for (int o = 1; o < 32; o <<= 1) { const float ov = __shfl_xor(bv, o); const int oi = __shfl_xor(bi, o); if (ov > bv || (ov == bv && oi < bi)) { bv = ov; bi = oi; } }
                tv[k] = bv; tix[k] = bi; if (e == bi) cur = -3.0e38f; }
            const float e1 = __expf(tv[1] - tv[0]), e2 = __expf(tv[2] - tv[0]), e3 = __expf(tv[3] - tv[0]); const float inv = 1.0f / (1.0f + e1 + e2 + e3);
            if (e < 4) { const int k = e; const int ek = k == 0 ? tix[0] : (k == 1 ? tix[1] : (k == 2 ? tix[2] : tix[3])); const float gk = (k == 0 ? 1.0f : (k == 1 ? e1 : (k == 2 ? e2 : e3))) * inv;
                const unsigned rank = atomicAdd(F.ctl + CW_CNT + (layer * 32 + ek) * 64, 1u);
                ((unsigned*)(F.ws + WS_LIST))[(size_t)ek * NTOK + rank] = (unsigned)row;
                ((unsigned*)(F.ws + WS_TOKI))[(size_t)row * 4 + k] = ((unsigned)ek << 16) | rank;
                ((float*)(F.ws + WS_TOKG))[(size_t)row * 4 + k] = gk; }
        }
        __syncthreads();
    }
}

__device__ __forceinline__ void p_gather(Frame& F, int layer) {
    moe_tables(F, layer);
    const LAS int* M = (const LAS int*)(F.lds + MISC_OFF);
    const int total = M[32];
    const int gw = F.vcu * NWAVES + F.wave, NGW = F.G * NWAVES;
    const bf16* H = (const bf16*)(F.ws + WS_H); bf16* AS = (bf16*)(F.ws + WS_AS);
    const unsigned* LIST = (const unsigned*)(F.ws + WS_LIST);
    for (int p = gw; p < total; p += NGW) {
        const int e = M[64 + (p >> 8)]; const int rank = p - M[e];
        v4u x0 = (v4u){0u, 0u, 0u, 0u}, x1 = x0;
        if (rank < M[400 + e]) { const unsigned r = LIST[(size_t)e * NTOK + rank]; const GAS v4u* s = (const GAS v4u*)(H + (size_t)r * D); x0 = s[F.lane]; x1 = s[64 + F.lane]; }
        GAS v4u* d = (GAS v4u*)(AS + (size_t)p * D); d[F.lane] = x0; d[64 + F.lane] = x1;
    }
}

__device__ __forceinline__ void p_spatial(Frame& F, const Args& a, int layer) {
    const int jl = layer / 3;
    const int c_lo = (layer >= 3) ? 4 : 0;
    const int nunit = (132 - c_lo) * 8;
    const bf16* ZB = (const bf16*)(F.ws + WS_BIG); bf16* G = (bf16*)(F.ws + WS_G);
    constexpr int ST = 136;
    LAS bf16* As = (LAS bf16*)(F.lds); LAS bf16* Bs = As + 128 * ST; LAS float* rs = (LAS float*)(F.lds + 2 * 128 * ST * 2);
    const int fr = F.lane & 15, fq = F.lane >> 4;
    for (int u = F.vcu; u < nunit; u += F.G) {
        const int c = c_lo + (u >> 3), g = u & 7, r0 = 128 * c;
        for (int rr = 0; rr < 16; ++rr) { const int rl = F.wave * 16 + rr; const GAS v4u* p = (const GAS v4u*)(ZB + (size_t)(r0 + rl) * 2048 + 1024 + 16 * F.lane);
            const v4u x0 = p[0], x1 = p[1]; float ss = 0.f;
#pragma unroll
            for (int i = 0; i < 4; ++i) { const float l0 = bflo(x0[i]), h0 = bfhi(x0[i]), l1 = bflo(x1[i]), h1 = bfhi(x1[i]); ss += l0 * l0 + h0 * h0 + l1 * l1 + h1 * h1; }
            ss = wave_sum(ss); if (F.lane == 0) rs[rl] = 1.0f / sqrtf(ss * (1.0f / 1024.0f) + EPS); }
        __syncthreads();
        {
            const bf16* wsb = (const bf16*)(F.ws + WS_WSB) + (size_t)(jl * 8 + g) * 128 * 128;
            const float* gv = a.in[I_AGV] + (size_t)jl * 1024 + 128 * g;
#pragma unroll
            for (int i = 0; i < 4; ++i) { const int id = F.tid + 512 * i, p = id >> 4, qc = id & 15;
                *(LAS v4u*)(As + p * ST + qc * 8) = *(const GAS v4u*)(wsb + p * 128 + qc * 8);
                const int q = p, c8 = qc; const v4u x = *(const GAS v4u*)(ZB + (size_t)(r0 + q) * 2048 + 1024 + 128 * g + 8 * c8); const float rq = rs[q];
#pragma unroll
                for (int e = 0; e < 4; ++e) { const int cc = 8 * c8 + 2 * e;
                    Bs[cc * ST + q] = (bf16)f2bf(bflo(x[e]) * rq * gv[cc]); Bs[(cc + 1) * ST + q] = (bf16)f2bf(bfhi(x[e]) * rq * gv[cc + 1]); } }
        }
        __syncthreads();
        f32x4 acc[8];
#pragma unroll
        for (int nt = 0; nt < 8; ++nt) acc[nt] = (f32x4){0.f, 0.f, 0.f, 0.f};
#pragma unroll
        for (int ks = 0; ks < 4; ++ks) { const bf16x8 af = *(const LAS bf16x8*)(As + (16 * F.wave + fr) * ST + ks * 32 + fq * 8);
#pragma unroll
            for (int nt = 0; nt < 8; ++nt) { const bf16x8 bfr = *(const LAS bf16x8*)(Bs + (nt * 16 + fr) * ST + ks * 32 + fq * 8); acc[nt] = MFMA16(af, bfr, acc[nt]); } }
        const float* bs = a.in[I_ABS] + (size_t)(jl * 8 + g) * 128;
#pragma unroll
        for (int j = 0; j < 4; ++j) { const int p = 16 * F.wave + fq * 4 + j; const float bb = bs[p]; const size_t row = (size_t)(r0 + p);
#pragma unroll
            for (int nt = 0; nt < 8; ++nt) { const int cc = 128 * g + nt * 16 + fr; const float uu = bf2f(ZB[row * 2048 + cc]); G[row * D + cc] = (bf16)f2bf(uu * (acc[nt][j] + bb)); } }
        __syncthreads();
    }
}

constexpr int PST = GLA_INP;
__device__ __forceinline__ void gla_cum(Frame& F, const Args& a, int c, int h, int dir, LAS float* cum, LAS float* rt, LAS float* tot) {
    const bf16* P = (const bf16*)(F.ws + WS_BIG);
    for (int i = F.tid; i < 64 * 16; i += NTHREADS) { const int ii = i >> 4, j = i & 15; rt[i] = bf2f(P[(size_t)(64 * c + ii) * PST + 3072 + dir * 16 + j]); }
    const int kk = F.tid & 127, part = F.tid >> 7;
    float w[16];
#pragma unroll
    for (int j = 0; j < 16; ++j) w[j] = a.in[I_BWA2][(size_t)(dir * 16 + j) * 512 + h * 128 + kk];
    const float ba = a.in[I_BBA][dir * 512 + h * 128 + kk];
    __syncthreads();
    float la[16];
#pragma unroll
    for (int ii = 0; ii < 16; ++ii) { const int i = part * 16 + ii; float z = ba;
#pragma unroll
        for (int j = 0; j < 16; ++j) z += rt[i * 16 + j] * w[j];
        const float ls = fminf(z, 0.0f) - log1pf(expf(-fabsf(z)));
        la[ii] = ls * (1.0f / 16.0f); }
    float run = 0.f;
    if (dir == 0) {
#pragma unroll
        for (int ii = 0; ii < 16; ++ii) { run += la[ii]; la[ii] = run; } }
    else {
#pragma unroll
        for (int ii = 15; ii >= 0; --ii) { run += la[ii]; la[ii] = run; } }
    tot[part * 128 + kk] = run;
    __syncthreads();
    float off = 0.f;
#pragma unroll
    for (int p = 0; p < 4; ++p) { const float t = tot[p * 128 + kk]; if (dir == 0 ? (p < part) : (p > part)) off += t; }
#pragma unroll
    for (int ii = 0; ii < 16; ++ii) cum[(part * 16 + ii) * 128 + kk] = la[ii] + off;
    __syncthreads();
}
__device__ __forceinline__ float rope_elem(const bf16* x, int kk, int pr, int pc, const float* ROPE, bool lat) {
    const float xv = bf2f(x[kk]);
    if (!lat) return xv;
    const int half = kk >> 6, f = kk & 31, second = (kk >> 5) & 1;
    const float x1 = second ? bf2f(x[kk - 32]) : xv, x2 = second ? xv : bf2f(x[kk + 32]);
    const int pos = half ? pc : pr;
    const float cs = ROPE[(pos * 32 + f) * 2], sn = ROPE[(pos * 32 + f) * 2 + 1];
    return second ? (x1 * sn + x2 * cs) : (x1 * cs - x2 * sn);
}
__device__ __forceinline__ void p_gla_ds(Frame& F, const Args& a) {
    const bf16* P = (const bf16*)(F.ws + WS_BIG); const float* ROPE = (const float*)(F.ws + WS_ROPE);
    bf16* DS = (bf16*)(F.ws + WS_DS); float* DEC = (float*)(F.ws + WS_DEC);
    constexpr int ST = 72;
    LAS float* cum = (LAS float*)(F.lds); LAS float* rt = cum + 64 * 128; LAS float* tot = rt + 64 * 16;
    LAS bf16* KT = (LAS bf16*)(tot + 4 * 128); LAS bf16* VT = KT + 128 * ST;
    const int fr = F.lane & 15, fq = F.lane >> 4;
    for (int u = F.vcu; u < 264 * 8; u += F.G) {
        const int c = u >> 3, h = (u >> 1) & 3, dir = u & 1; const bool lat = c >= 8; const int pr = (c - 8) & 127;
        gla_cum(F, a, c, h, dir, cum, rt, tot);
        const int lastrow = dir == 0 ? 63 : 0;
        {
            const int i = F.tid & 63, grp = F.tid >> 6; const size_t row = (size_t)(64 * c + i);
            const bf16* kp = P + row * PST + 512 + h * 128;
#pragma unroll 4
            for (int e = 0; e < 16; ++e) { const int kk = grp * 16 + e; const float kv = rope_elem(kp, kk, pr, i, ROPE, lat);
                KT[kk * ST + i] = (bf16)f2bf(kv * __expf(cum[lastrow * 128 + kk] - cum[i * 128 + kk])); }
            const bf16* vp = P + row * PST + 1024 + h * 256 + grp * 32;
#pragma unroll
            for (int e = 0; e < 4; ++e) { const v4u x = *(const GAS v4u*)(vp + 8 * e);
#pragma unroll
                for (int q = 0; q < 4; ++q) { VT[(grp * 32 + 8 * e + 2 * q) * ST + i] = (bf16)(x[q] & 0xffffu); VT[(grp * 32 + 8 * e + 2 * q + 1) * ST + i] = (bf16)(x[q] >> 16); } }
            if (F.tid < 128) DEC[((size_t)(dir * 264 + c) * 4 + h) * 128 + F.tid] = __expf(cum[lastrow * 128 + F.tid]);
        }
        __syncthreads();
        f32x4 acc[16];
#pragma unroll
        for (int nt = 0; nt < 16; ++nt) acc[nt] = (f32x4){0.f, 0.f, 0.f, 0.f};
#pragma unroll
        for (int ks = 0; ks < 2; ++ks) { const bf16x8 af = *(const LAS bf16x8*)(KT + (16 * F.wave + fr) * ST + ks * 32 + fq * 8);
#pragma unroll
            for (int nt = 0; nt < 16; ++nt) { const bf16x8 bfr = *(const LAS bf16x8*)(VT + (nt * 16 + fr) * ST + ks * 32 + fq * 8); acc[nt] = MFMA16(af, bfr, acc[nt]); } }
        bf16* dsp = DS + ((size_t)(dir * 264 + c) * 4 + h) * 256 * 128;
#pragma unroll
        for (int nt = 0; nt < 16; ++nt) { v2u o; o.x = pk2(acc[nt][0], acc[nt][1]); o.y = pk2(acc[nt][2], acc[nt][3]);
            *(GAS v2u*)(dsp + (size_t)(nt * 16 + fr) * 128 + 16 * F.wave + fq * 4) = o; }
        __syncthreads();
    }
}
__device__ __forceinline__ void p_gla_scan(Frame& F) {
    const bf16* DS = (const bf16*)(F.ws + WS_DS); bf16* SIN = (bf16*)(F.ws + WS_SIN); const float* DEC = (const float*)(F.ws + WS_DEC);
    const int gt = F.vcu * NTHREADS + F.tid, NGT = F.G * NTHREADS;
    for (int id = gt; id < 2 * 2 * 4 * 256 * 32; id += NGT) {
        const int kq = id & 31, v = (id >> 5) & 255, h = (id >> 13) & 3, dir = (id >> 15) & 1, b = id >> 16;
        f32x4 S = (f32x4){0.f, 0.f, 0.f, 0.f};
        for (int s = 0; s < 132; ++s) {
            int c;
            if (dir == 0) c = s < 4 ? 4 * b + s : 8 + 128 * b + (s - 4);
            else c = s < 4 ? 4 * b + 3 - s : 8 + 128 * b + 127 - (s - 4);
            const size_t base = ((size_t)(dir * 264 + c) * 4 + h);
            const size_t o = (base * 256 + v) * 128 + 4 * kq;
            v2u so; so.x = pk2(S.x, S.y); so.y = pk2(S.z, S.w);
            *(GAS v2u*)(SIN + o) = so;
            const v2u d = *(const GAS v2u*)(DS + o); const f32x4 dc = *(const GAS f32x4*)(DEC + base * 128 + 4 * kq);
            S.x = S.x * dc.x + bflo(d.x); S.y = S.y * dc.y + bfhi(d.x); S.z = S.z * dc.z + bflo(d.y); S.w = S.w * dc.w + bfhi(d.y);
        }
    }
}
__device__ __forceinline__ void p_gla_out(Frame& F, const Args& a) {
    const bf16* P = (const bf16*)(F.ws + WS_BIG); const float* ROPE = (const float*)(F.ws + WS_ROPE);
    const bf16* SIN = (const bf16*)(F.ws + WS_SIN); bf16* G = (bf16*)(F.ws + WS_G);
    constexpr int ST = 72, QST = 136;
    LAS float* cum = (LAS float*)(F.lds); LAS float* rt = cum + 64 * 128; LAS float* tot = rt + 64 * 16; LAS float* ssq = tot + 4 * 128;
    LAS bf16* VT = (LAS bf16*)(ssq + 8 * 64); LAS bf16* QD = VT + 256 * ST; LAS bf16* KI = QD + 64 * QST; LAS bf16* PL = KI + 64 * QST;
    const int fr = F.lane & 15, fq = F.lane >> 4;
    for (int u = F.vcu; u < 264 * 4; u += F.G) {
        const int c = u >> 2, h = u & 3; const bool lat = c >= 8; const int pr = (c - 8) & 127;
        f32x4 acc[2][4];
#pragma unroll
        for (int mt = 0; mt < 2; ++mt)
#pragma unroll
            for (int nt = 0; nt < 4; ++nt) acc[mt][nt] = (f32x4){0.f, 0.f, 0.f, 0.f};
        {
            const int i = F.tid & 63, grp = F.tid >> 6; const bf16* vp = P + (size_t)(64 * c + i) * PST + 1024 + h * 256 + grp * 32;
#pragma unroll
            for (int e = 0; e < 4; ++e) { const v4u x = *(const GAS v4u*)(vp + 8 * e);
#pragma unroll
                for (int q = 0; q < 4; ++q) { VT[(grp * 32 + 8 * e + 2 * q) * ST + i] = (bf16)(x[q] & 0xffffu); VT[(grp * 32 + 8 * e + 2 * q + 1) * ST + i] = (bf16)(x[q] >> 16); } }
        }
        for (int dir = 0; dir < 2; ++dir) {
            gla_cum(F, a, c, h, dir, cum, rt, tot);
            {
                const int i = F.tid & 63, grp = F.tid >> 6; const size_t row = (size_t)(64 * c + i);
                const bf16* qp = P + row * PST + h * 128; const bf16* kp = P + row * PST + 512 + h * 128;
#pragma unroll 4
                for (int e = 0; e < 16; ++e) { const int kk = grp * 16 + e; const float cm = cum[i * 128 + kk];
                    const float qv = rope_elem(qp, kk, pr, i, ROPE, lat) * 0.08838834764831845f, kv = rope_elem(kp, kk, pr, i, ROPE, lat);
                    QD[i * QST + kk] = (bf16)f2bf(qv * __expf(cm)); KI[i * QST + kk] = (bf16)f2bf(kv * __expf(-cm)); }
            }
            __syncthreads();
            {
                const int jt = F.wave >> 1;
#pragma unroll
                for (int t2 = 0; t2 < 2; ++t2) { const int it = 2 * (F.wave & 1) + t2; f32x4 s = (f32x4){0.f, 0.f, 0.f, 0.f};
#pragma unroll
                    for (int ks = 0; ks < 4; ++ks) { const bf16x8 af = *(const LAS bf16x8*)(KI + (16 * jt + fr) * QST + ks * 32 + fq * 8), bfr = *(const LAS bf16x8*)(QD + (16 * it + fr) * QST + ks * 32 + fq * 8); s = MFMA16(af, bfr, s); }
                    const int i = 16 * it + fr, j0 = 16 * jt + fq * 4; float pv[4];
#pragma unroll
                    for (int r = 0; r < 4; ++r) { const int j = j0 + r; const bool keep = dir == 0 ? (j <= i) : (j >= i); pv[r] = keep ? s[r] : 0.0f; }
                    v2u o; o.x = pk2(pv[0], pv[1]); o.y = pk2(pv[2], pv[3]);
                    *(LAS v2u*)(PL + i * ST + j0) = o; }
            }
            __syncthreads();
#pragma unroll
            for (int ks = 0; ks < 2; ++ks) {
                bf16x8 bfr[4];
#pragma unroll
                for (int nt = 0; nt < 4; ++nt) bfr[nt] = *(const LAS bf16x8*)(PL + (16 * nt + fr) * ST + ks * 32 + fq * 8);
#pragma unroll
                for (int mt = 0; mt < 2; ++mt) { const bf16x8 af = *(const LAS bf16x8*)(VT + (32 * F.wave + 16 * mt + fr) * ST + ks * 32 + fq * 8);
#pragma unroll
                    for (int nt = 0; nt < 4; ++nt) acc[mt][nt] = MFMA16(af, bfr[nt], acc[mt][nt]); } }
            const bf16* sp = SIN + ((size_t)(dir * 264 + c) * 4 + h) * 256 * 128;
#pragma unroll
            for (int ks = 0; ks < 4; ++ks) {
                bf16x8 bfr[4];
#pragma unroll
                for (int nt = 0; nt < 4; ++nt) bfr[nt] = *(const LAS bf16x8*)(QD + (16 * nt + fr) * QST + ks * 32 + fq * 8);
#pragma unroll
                for (int mt = 0; mt < 2; ++mt) { const bf16x8 af = *(const GAS bf16x8*)(sp + (size_t)(32 * F.wave + 16 * mt + fr) * 128 + ks * 32 + fq * 8);
#pragma unroll
                    for (int nt = 0; nt < 4; ++nt) acc[mt][nt] = MFMA16(af, bfr[nt], acc[mt][nt]); } }
            __syncthreads();
        }
#pragma unroll
        for (int nt = 0; nt < 4; ++nt) { float s = 0.f;
#pragma unroll
            for (int mt = 0; mt < 2; ++mt)
#pragma unroll
                for (int j = 0; j < 4; ++j) s += acc[mt][nt][j] * acc[mt][nt][j];
            s += __shfl_xor(s, 16); s += __shfl_xor(s, 32);
            if (fq == 0) ssq[F.wave * 64 + 16 * nt + fr] = s; }
        __syncthreads();
#pragma unroll
        for (int nt = 0; nt < 4; ++nt) { const int i = 16 * nt + fr; float s = 0.f;
#pragma unroll
            for (int w8 = 0; w8 < 8; ++w8) s += ssq[w8 * 64 + i];
            const float rstd = 1.0f / sqrtf(s * (1.0f / 256.0f) + EPS); const size_t row = (size_t)(64 * c + i);
#pragma unroll
            for (int mt = 0; mt < 2; ++mt) { const int v0 = 32 * F.wave + 16 * mt + fq * 4;
                const v2u gg = *(const GAS v2u*)(P + row * PST + 2048 + h * 256 + v0); const f32x4 go = *(const GAS f32x4*)(a.in[I_BGO] + v0);
                const float g0 = bflo(gg.x), g1 = bfhi(gg.x), g2 = bflo(gg.y), g3 = bfhi(gg.y);
                const float o0 = acc[mt][nt][0] * rstd * go.x * (g0 / (1.0f + __expf(-g0))), o1 = acc[mt][nt][1] * rstd * go.y * (g1 / (1.0f + __expf(-g1)));
                const float o2 = acc[mt][nt][2] * rstd * go.z * (g2 / (1.0f + __expf(-g2))), o3 = acc[mt][nt][3] * rstd * go.w * (g3 / (1.0f + __expf(-g3)));
                v2u o; o.x = pk2(o0, o1); o.y = pk2(o2, o3);
                *(GAS v2u*)(G + row * D + h * 256 + v0) = o; } }
        __syncthreads();
    }
}

__device__ __forceinline__ void p_natten(Frame& F, const Args& a) {
    const bf16* QKV = (const bf16*)(F.ws + WS_BIG); bf16* G = (bf16*)(F.ws + WS_G);
    constexpr int QS = 3072, VLS = 520, VCS = 264;
    LAS bf16* VTl = (LAS bf16*)(F.lds); LAS bf16* VTc = VTl + 64 * VLS; LAS float* RPB = (LAS float*)(VTc + 64 * VCS); LAS float* MRG = RPB + 480;
    const int fr = F.lane & 15, fq = F.lane >> 4;
    const int jb = F.wave >> 1, role = F.wave & 1;
    const int u_lo = (int)(((long)F.vcu * 4096) / F.G), u_hi = (int)(((long)(F.vcu + 1) * 4096) / F.G);
    int cur_bh = -1;
    for (int u = u_lo; u < u_hi; ++u) {
        const int bh = u >> 7, r = u & 127, b = bh >> 4, h = bh & 15;
        const int r0 = r < 4 ? 0 : (r > 124 ? 120 : r - 4);
        const size_t lat0 = (size_t)NCTX + (size_t)b * SEQ;
        __syncthreads();
        if (bh != cur_bh) {
            cur_bh = bh;
            for (int i = F.tid; i < 465; i += NTHREADS) RPB[i] = a.in[I_CRPB][h * 465 + i];
#pragma unroll
            for (int i = 0; i < 4; ++i) { const int id = F.tid + 512 * i, key = id >> 3, d8 = id & 7;
                const v4u x = *(const GAS v4u*)(QKV + (size_t)(b * CTXL + key) * QS + 2048 + h * 64 + 8 * d8);
#pragma unroll
                for (int q = 0; q < 4; ++q) { VTc[(8 * d8 + 2 * q) * VCS + key] = (bf16)(x[q] & 0xffffu); VTc[(8 * d8 + 2 * q + 1) * VCS + key] = (bf16)(x[q] >> 16); } }
        }
#pragma unroll
        for (int i = 0; i < 8; ++i) { const int id = F.tid + 512 * i, key = id >> 3, d8 = id & 7;
            const v4u x = *(const GAS v4u*)(QKV + (lat0 + (size_t)r0 * 64 + key) * QS + 2048 + h * 64 + 8 * d8);
#pragma unroll
            for (int q = 0; q < 4; ++q) { VTl[(8 * d8 + 2 * q) * VLS + key] = (bf16)(x[q] & 0xffffu); VTl[(8 * d8 + 2 * q + 1) * VLS + key] = (bf16)(x[q] >> 16); } }
        __syncthreads();
        const int bstart = jb == 0 ? 0 : (jb == 1 ? 8 : (jb == 2 ? 24 : 32));
        const int qcol = 16 * jb + fr; const int cstart = qcol < 8 ? 0 : (qcol > 56 ? 48 : qcol - 8);
        bf16x8 qf[2];
#pragma unroll
        for (int ks = 0; ks < 2; ++ks) qf[ks] = *(const GAS bf16x8*)(QKV + (lat0 + (size_t)r * 64 + qcol) * QS + h * 64 + ks * 32 + fq * 8);
        f32x4 s[16];
#pragma unroll
        for (int kt = 0; kt < 16; ++kt) {
            const bf16* kp = role == 0 ? QKV + (lat0 + (size_t)(r0 + (kt >> 1)) * 64 + bstart + 16 * (kt & 1) + fr) * QS + 1024 + h * 64
                                       : QKV + (size_t)(b * CTXL + 16 * kt + fr) * QS + 1024 + h * 64;
            f32x4 t = (f32x4){0.f, 0.f, 0.f, 0.f};
#pragma unroll
            for (int ks = 0; ks < 2; ++ks) { const bf16x8 kf = *(const GAS bf16x8*)(kp + ks * 32 + fq * 8); t = MFMA16(kf, qf[ks], t); }
            s[kt] = t;
        }
        float mx = -3.0e38f;
#pragma unroll
        for (int kt = 0; kt < 16; ++kt)
#pragma unroll
            for (int j = 0; j < 4; ++j) { float v = s[kt][j] * 0.125f;
                if (role == 0) { const int kcol = bstart + 16 * (kt & 1) + fq * 4 + j, krow = r0 + (kt >> 1);
                    const bool ok = kcol >= cstart && kcol < cstart + 16;
                    v = ok ? v + RPB[(krow - r + 7) * 31 + (kcol - qcol + 15)] : -3.0e38f; }
                s[kt][j] = v; mx = fmaxf(mx, v); }
        mx = fmaxf(mx, __shfl_xor(mx, 16)); mx = fmaxf(mx, __shfl_xor(mx, 32));
        float l = 0.f;
#pragma unroll
        for (int kt = 0; kt < 16; ++kt)
#pragma unroll
            for (int j = 0; j < 4; ++j) { const float p = s[kt][j] > -1.0e38f ? __expf(s[kt][j] - mx) : 0.0f; s[kt][j] = p; l += p; }
        l += __shfl_xor(l, 16); l += __shfl_xor(l, 32);
        f32x4 o[4];
#pragma unroll
        for (int dt = 0; dt < 4; ++dt) o[dt] = (f32x4){0.f, 0.f, 0.f, 0.f};
#pragma unroll
        for (int st = 0; st < 8; ++st) {
            v4u pw; pw.x = pk2(s[2 * st][0], s[2 * st][1]); pw.y = pk2(s[2 * st][2], s[2 * st][3]); pw.z = pk2(s[2 * st + 1][0], s[2 * st + 1][1]); pw.w = pk2(s[2 * st + 1][2], s[2 * st + 1][3]);
            const bf16x8 pf = __builtin_bit_cast(bf16x8, pw);
            const LAS bf16* vb = role == 0 ? VTl + st * 64 + bstart : VTc + 32 * st;
            const int vst = role == 0 ? VLS : VCS;
#pragma unroll
            for (int dt = 0; dt < 4; ++dt) { const LAS bf16* vp = vb + (16 * dt + fr) * vst + fq * 4;
                const v2u lo = *(const LAS v2u*)vp, hi = *(const LAS v2u*)(vp + 16);
                v4u vw; vw.x = lo.x; vw.y = lo.y; vw.z = hi.x; vw.w = hi.y;
                o[dt] = MFMA16(__builtin_bit_cast(bf16x8, vw), pf, o[dt]); }
        }
        if (role == 1) { LAS float* m = MRG + jb * 18 * 64; m[F.lane] = mx; m[64 + F.lane] = l;
#pragma unroll
            for (int dt = 0; dt < 4; ++dt)
#pragma unroll
                for (int j = 0; j < 4; ++j) m[(2 + dt * 4 + j) * 64 + F.lane] = o[dt][j]; }
        __syncthreads();
        if (role == 0) { const LAS float* m = MRG + jb * 18 * 64; const float m1 = m[F.lane], l1 = m[64 + F.lane];
            const float mm = fmaxf(mx, m1), a0 = __expf(mx - mm), a1 = __expf(m1 - mm); const float inv = 1.0f / (l * a0 + l1 * a1);
            bf16* op = G + (lat0 + (size_t)r * 64 + qcol) * D + h * 64 + fq * 4;
#pragma unroll
            for (int dt = 0; dt < 4; ++dt) { float v[4];
#pragma unroll
                for (int j = 0; j < 4; ++j) v[j] = (o[dt][j] * a0 + m[(2 + dt * 4 + j) * 64 + F.lane] * a1) * inv;
                v2u w; w.x = pk2(v[0], v[1]); w.y = pk2(v[2], v[3]);
                *(GAS v2u*)(op + 16 * dt) = w; } }
    }
}

#define IN(k) (lo <= (k) && (k) < hi)
#define SEAM(k) do { if (IN(k) && IN((k) + 1)) xcd_barrier(bar); else __syncthreads(); } while (0)
template <int LAYER> __device__ __forceinline__ void run_layer(Frame& F, const Args& args, const XcdBarrier& bar, const int lo, const int hi) {
    {
        constexpr int layer = LAYER; constexpr int kind = layer % 3, base = 1 + 10 * layer;
        constexpr int mt0 = (layer >= 3) ? 2 : 0;
        constexpr int mo0 = (layer >= 2) ? 2 : 0;
        if (IN(base + 0)) { p_prenorm(F, args, layer, false); } SEAM(base + 0);
        if (IN(base + 1)) {
            const bf16* A = (const bf16*)(F.ws + WS_H) + (size_t)mt0 * 256 * D; const int M = (66 - mt0) * 256;
            if constexpr (kind == 0) {
                pg8::Gemm g{A, (const bf16*)(F.ws + WS_WAIN) + (size_t)(layer / 3) * 2048 * 1024, M, 2048, D}; pg8::StaticOrder S; S.init(M, 2048, F.G, (int)blockIdx.x);
                pg8::EpiBf16<1> E{(bf16*)(F.ws + WS_BIG) + (size_t)mt0 * 256 * 2048, 2048, nullptr, 0};
                pg8::gemm_phase<pg8::EpiBf16<1>, pg8::StaticOrder>(F.lds + RING_OFF, g, S, E);
            } else {
                const int N = kind == 1 ? GLA_INP : 3072;
                pg8::Gemm g{A, (const bf16*)(F.ws + (kind == 1 ? WS_WBIN : WS_WCQKV)), M, N, D}; pg8::StaticOrder S; S.init(M, N, F.G, (int)blockIdx.x);
                pg8::EpiBf16<0> E{(bf16*)(F.ws + WS_BIG), N, nullptr, 0};
                pg8::gemm_phase<pg8::EpiBf16<0>, pg8::StaticOrder>(F.lds + RING_OFF, g, S, E);
            }
        }
        SEAM(base + 1);
        if (IN(base + 2)) { if constexpr (kind == 0) p_spatial(F, args, layer); else if constexpr (kind == 1) p_gla_ds(F, args); else p_natten(F, args); } SEAM(base + 2);
        if constexpr (kind == 1) { if (IN(base + 3)) { p_gla_scan(F); } SEAM(base + 3); }
        if constexpr (kind == 1) { if (IN(base + 4)) { p_gla_out(F, args); } SEAM(base + 4); }
        if (IN(base + 5)) {
            const int M = (66 - mo0) * 256;
            const bf16* Bt = (const bf16*)(F.ws + (kind == 0 ? WS_WAOUT : (kind == 1 ? WS_WBOUT : WS_WCOUT))) + (kind == 0 ? (size_t)(layer / 3) * 1024 * 1024 : 0);
            pg8::Gemm g{(const bf16*)(F.ws + WS_G) + (size_t)mo0 * 256 * D, Bt, M, D, D}; pg8::StaticOrder S; S.init(M, D, F.G, (int)blockIdx.x);
            pg8::EpiResid E{(float*)(F.ws + WS_X) + (size_t)mo0 * 256 * D, (const float*)(F.ws + WS_ADA) + (size_t)(layer * 3 * 6 + 2) * D, 6 * D, mo0};
            pg8::gemm_phase<pg8::EpiResid, pg8::StaticOrder>(F.lds + RING_OFF, g, S, E);
        }
        SEAM(base + 5);
        if (IN(base + 6)) { p_router(F, args, layer); } SEAM(base + 6);
        if (IN(base + 7)) { p_gather(F, layer); } SEAM(base + 7);
        if (IN(base + 8)) {
            moe_tables(F, layer);
            const LAS int* Mt = (const LAS int*)(F.lds + MISC_OFF); const int total = Mt[32];
            pg8::Gemm g{(const bf16*)(F.ws + WS_AS), (const bf16*)(F.ws + WS_WGU) + (size_t)layer * 32 * 2048 * 1024, total, 2048, D};
            pg8::GroupedOrder S; S.init(total, 2048, F.G, (int)blockIdx.x); S.tile_e = Mt + 64;
            pg8::EpiSwiglu E{(bf16*)(F.ws + WS_ACT), D, args.in[I_MBGU] + (size_t)layer * 32 * 2048, 2048};
            pg8::gemm_phase<pg8::EpiSwiglu, pg8::GroupedOrder>(F.lds + RING_OFF, g, S, E);
        }
        SEAM(base + 8);
        if (IN(base + 9)) {
            moe_tables(F, layer);
            const LAS int* Mt = (const LAS int*)(F.lds + MISC_OFF); const int total = Mt[32];
            pg8::Gemm g{(const bf16*)(F.ws + WS_ACT), (const bf16*)(F.ws + WS_WDN) + (size_t)layer * 32 * 1024 * 1024, total, D, D};
            pg8::GroupedOrder S; S.init(total, D, F.G, (int)blockIdx.x); S.tile_e = Mt + 64;
            pg8::EpiBf16<0> E{(bf16*)(F.ws + WS_YB), D, args.in[I_MBDN] + (size_t)layer * 32 * 1024, 1024};
            pg8::gemm_phase<pg8::EpiBf16<0>, pg8::GroupedOrder>(F.lds + RING_OFF, g, S, E);
        }
        SEAM(base + 9);
    }
}

__global__ void __launch_bounds__(NTHREADS, 2) fwd(Args args) {
    extern __shared__ __attribute__((aligned(16))) unsigned char lds[];
    Frame F;
    F.lds = (LAS unsigned char*)lds;
    F.tid = threadIdx.x; F.lane = F.tid & 63; F.wave = __builtin_amdgcn_readfirstlane(F.tid >> 6);
    F.G = gridDim.x; { const int bx = blockIdx.x; F.vcu = (F.G % 8 == 0) ? (bx % 8) * (F.G / 8) + bx / 8 : bx; }
    F.ws = args.ws; F.ctl = (unsigned*)(args.ws + WS_CTL);
    volatile LAS unsigned* BST = (volatile LAS unsigned*)(F.lds + LDS_BYTES - 16);
    if (F.tid < 4) BST[F.tid] = 0u;
    __syncthreads();
    const int lo = args.ph_lo, hi = args.ph_hi;
    XcdBarrier bar; bar.bar = (unsigned*)(F.ctl + CW_BAR); bar.x = 0; bar.st = BST;
    if (hi - lo > 1) bar = xcd_barrier_post((unsigned*)(F.ctl + CW_BAR), BST);
    if (IN(0)) { p_prologue(F, args); } SEAM(0);

    run_layer<0>(F, args, bar, lo, hi);
    run_layer<1>(F, args, bar, lo, hi);
    run_layer<2>(F, args, bar, lo, hi);
    run_layer<3>(F, args, bar, lo, hi);
    if (IN(41)) { p_prenorm(F, args, 4, true); }
#undef IN
#undef SEAM
}

extern "C" void kernel_launch(void* const* d_in, const int* in_sizes, int n_in, void* d_out, int out_size, void* d_ws, size_t ws_size, hipStream_t stream) {
    static int grid = 0;
    if (grid == 0) {
        if (n_in != 28 || out_size != NLAT * D || ws_size < WS_END) { fprintf(stderr, "kernel_launch: unexpected problem (n_in %d, out %d, ws %zu < %zu)\n", n_in, out_size, ws_size, (size_t)WS_END); grid = -1; return; }
        int dev = 0, cus = 0, per_cu = 0;
        if (hipGetDevice(&dev) != hipSuccess || hipDeviceGetAttribute(&cus, hipDeviceAttributeMultiprocessorCount, dev) != hipSuccess) { grid = -1; return; }
        if (hipFuncSetAttribute((const void*)fwd, hipFuncAttributeMaxDynamicSharedMemorySize, LDS_BYTES) != hipSuccess) { fprintf(stderr, "kernel_launch: hipFuncSetAttribute failed\n"); grid = -1; return; }
        if (hipOccupancyMaxActiveBlocksPerMultiprocessor(&per_cu, (const void*)fwd, NTHREADS, LDS_BYTES) != hipSuccess || per_cu < 1) { fprintf(stderr, "kernel_launch: occupancy query reports %d\n", per_cu); }
        (void)hipGetLastError();
        grid = cus;
    }
    if (grid < 0) return;
    (void)hipMemsetAsync((char*)d_ws + WS_CTL, 0, CTL_ZERO_BYTES, stream);
    Args a{};
    for (int i = 0; i < 28; ++i) a.in[i] = (const float*)d_in[i];
    a.out = (float*)d_out; a.ws = (unsigned char*)d_ws;
#if MK_ONE_LAUNCH
    a.ph_lo = 0; a.ph_hi = 42;
    hipLaunchKernelGGL(fwd, dim3(grid), dim3(NTHREADS), LDS_BYTES, stream, a);
#else
    for (int p = 0; p < 42; ++p) {
        if (p >= 1 && p <= 40) { const int layer = (p - 1) / 10, loc = (p - 1) % 10; if ((loc == 3 || loc == 4) && (layer % 3) != 1) continue; }
        a.ph_lo = p; a.ph_hi = p + 1;
        hipLaunchKernelGGL(fwd, dim3(grid), dim3(NTHREADS), LDS_BYTES, stream, a);
    }
#endif
}
```

```cpp
#include <hip/hip_runtime.h>
#include <cstdio>
#include <cstdint>

#ifndef MK_ONE_LAUNCH
#define MK_ONE_LAUNCH 1
#endif

namespace pg8 {
#define PG8_LAS __attribute__((address_space(3)))
typedef unsigned short bf16_t;
typedef short bf16x8 __attribute__((ext_vector_type(8)));
typedef float f32x4 __attribute__((ext_vector_type(4)));
typedef unsigned u32x4 __attribute__((ext_vector_type(4)));
constexpr int BM = 256, BK = 64, HALF = 128, HTB = HALF * BK * 2, STAGE_BYTES = 8 * HTB, NXCD = 8, WGM = 8;

__host__ __device__ __forceinline__ int lds_byte(int r, int c) { const int st = (r >> 4) * 2 + (c >> 5), rr = r & 15, cc = c & 31, ob = rr * 64 + cc * 2; return st * 1024 + (ob ^ (((ob >> 9) & 1) << 5)); }
__host__ __device__ __forceinline__ void stage_rc(int b, int& R, int& C) { const int st = b / 1024, sb = b % 1024, swz = sb ^ (((sb >> 9) & 1) << 5); R = (st >> 1) * 16 + swz / 64; C = (st & 1) * 32 + (swz % 64) / 2; }
__host__ __device__ __forceinline__ int perm32(int rho) { const int n = rho >> 4, i = rho & 15; return 8 * (i >> 2) + 4 * n + (i & 3); }

struct Unit { int pm, pn, pb, e; };
struct Gemm { const bf16_t* A; const bf16_t* Bt; int M, N, K; };

struct StaticOrder {
    int nM, nN, nwg, G, c;
    __device__ void init(int M, int N, int G_, int c_) { nM = M / BM; nN = N / BM; nwg = nM * nN; G = G_; c = c_; }
    __device__ bool next(int i, Unit& u) const {
        const long L = (long)i * G + c; if (L >= nwg) return false;
        int wgid = (int)L; { const int q = nwg / NXCD, r = nwg % NXCD, xcd = wgid % NXCD, off = wgid / NXCD; wgid = (xcd < r ? xcd * (q + 1) : r * (q + 1) + (xcd - r) * q) + off; }
        const int nig = WGM * nN, gid = wgid / nig, fm = gid * WGM, gsz = (nM - fm) < WGM ? (nM - fm) : WGM;
        u.pm = fm + ((wgid % nig) % gsz); u.pn = (wgid % nig) / gsz; u.pb = u.pn; u.e = 0; return true;
    }
};
struct GroupedOrder : StaticOrder {
    const PG8_LAS int* tile_e;
    __device__ bool next(int i, Unit& u) const {
        if (!StaticOrder::next(i, u)) return false;
        u.e = __builtin_amdgcn_readfirstlane(tile_e[u.pm]); u.pb = u.e * nN + u.pn; return true;
    }
};

__device__ __forceinline__ unsigned cvt_pk_bf16(float lo, float hi) { unsigned r; asm volatile("v_cvt_pk_bf16_f32 %0, %1, %2" : "=v"(r) : "v"(lo), "v"(hi)); return r; }
typedef float f32x2 __attribute__((ext_vector_type(2)));
__device__ __forceinline__ f32x2 gelu_pk(f32x2 v) {
    const f32x2 av = __builtin_elementwise_abs(v), d = av * 0.2316418882f + 1.0f;
    f32x2 t; t.x = __builtin_amdgcn_rcpf(d.x); t.y = __builtin_amdgcn_rcpf(d.y);
    f32x2 q = t * 0.5307027145f + (-0.7265760135f); q = q * t + 0.7107068705f; q = q * t + (-0.142248368f); q = q * t + 0.127414796f; q = q * t;
    const f32x2 s = (v * v) * (-0.72134752044f);
    f32x2 e; e.x = __builtin_amdgcn_exp2f(s.x); e.y = __builtin_amdgcn_exp2f(s.y);
    const f32x2 m = v * (q * e), r = v - m;
    f32x2 o; o.x = v.x < 0.f ? m.x : r.x; o.y = v.y < 0.f ? m.y : r.y; return o;
}

template <int ACT> struct EpiBf16 {
    static constexpr bool PERM = true;
    bf16_t* O; int ldc; const float* bias; int bias_estride;
    __device__ __forceinline__ void operator()(const f32x4 (&acc)[2][2][4][2], const Unit& u, int wr, int wc, int fr, int fq) const {
        const int row0 = u.pm * BM + wr * 64 + fr; const int col0 = u.pn * BM + wc * 32 + 8 * fq;
        const float* bp = bias ? bias + (size_t)u.e * bias_estride : nullptr;
        f32x4 bv[2][2];
#pragma unroll
        for (int bj = 0; bj < 2; ++bj)
#pragma unroll
            for (int n = 0; n < 2; ++n) bv[bj][n] = bp ? *(const f32x4*)(bp + col0 + bj * HALF + 4 * n) : (f32x4){0.f, 0.f, 0.f, 0.f};
#pragma unroll
        for (int ai = 0; ai < 2; ++ai)
#pragma unroll
            for (int m = 0; m < 4; ++m) { bf16_t* rowp = O + (size_t)(row0 + ai * HALF + m * 16) * ldc + col0;
#pragma unroll
                for (int bj = 0; bj < 2; ++bj) { f32x4 v0 = acc[ai][bj][m][0] + bv[bj][0], v1 = acc[ai][bj][m][1] + bv[bj][1];
                    if (ACT == 1) { f32x2 a = gelu_pk((f32x2){v0[0], v0[1]}), b = gelu_pk((f32x2){v0[2], v0[3]}), c = gelu_pk((f32x2){v1[0], v1[1]}), d = gelu_pk((f32x2){v1[2], v1[3]});
                        v0 = (f32x4){a.x, a.y, b.x, b.y}; v1 = (f32x4){c.x, c.y, d.x, d.y}; }
                    u32x4 w; w.x = cvt_pk_bf16(v0[0], v0[1]); w.y = cvt_pk_bf16(v0[2], v0[3]); w.z = cvt_pk_bf16(v1[0], v1[1]); w.w = cvt_pk_bf16(v1[2], v1[3]);
                    *(u32x4*)(rowp + bj * HALF) = w; } }
    }
};
struct EpiSwiglu {
    static constexpr bool PERM = true;
    bf16_t* O; int ldc; const float* bias; int bias_estride;
    __device__ __forceinline__ void operator()(const f32x4 (&acc)[2][2][4][2], const Unit& u, int wr, int wc, int fr, int fq) const {
        const int row0 = u.pm * BM + wr * 64 + fr; const int col0 = u.pn * HALF + wc * 32 + 8 * fq;
        const float* bp = bias + (size_t)u.e * bias_estride;
        f32x4 bg[2], bl[2];
#pragma unroll
        for (int n = 0; n < 2; ++n) { bg[n] = *(const f32x4*)(bp + col0 + 4 * n); bl[n] = *(const f32x4*)(bp + 1024 + col0 + 4 * n); }
#pragma unroll
        for (int ai = 0; ai < 2; ++ai)
#pragma unroll
            for (int m = 0; m < 4; ++m) { bf16_t* rowp = O + (size_t)(row0 + ai * HALF + m * 16) * ldc + col0;
                float o[8];
#pragma unroll
                for (int n = 0; n < 2; ++n) { const f32x4 g4 = acc[ai][0][m][n] + bg[n], l4 = acc[ai][1][m][n] + bl[n];
#pragma unroll
                    for (int i = 0; i < 4; ++i) { const float g = fminf(g4[i], 7.0f), l = fminf(fmaxf(l4[i], -7.0f), 7.0f);
                        const float sg = __builtin_amdgcn_rcpf(1.0f + __builtin_amdgcn_exp2f(-1.702f * 1.44269504089f * g));
                        o[4 * n + i] = g * sg * (l + 1.0f); } }
                u32x4 w; w.x = cvt_pk_bf16(o[0], o[1]); w.y = cvt_pk_bf16(o[2], o[3]); w.z = cvt_pk_bf16(o[4], o[5]); w.w = cvt_pk_bf16(o[6], o[7]);
                *(u32x4*)rowp = w; }
    }
};
struct EpiResid {
    static constexpr bool PERM = false;
    float* X; const float* gate; int gstride; int pm0;
    __device__ __forceinline__ void operator()(const f32x4 (&acc)[2][2][4][2], const Unit& u, int wr, int wc, int fr, int fq) const {
        const int t = u.pm + pm0; const int seg = t < 2 ? 0 : (t < 34 ? 1 : 2);
        const int row0 = u.pm * BM + wr * 64 + fr, col0 = u.pn * BM + wc * 32 + 4 * fq;
        const float* gp = gate + (size_t)seg * gstride;
        f32x4 gv[2][2];
#pragma unroll
        for (int bj = 0; bj < 2; ++bj)
#pragma unroll
            for (int n = 0; n < 2; ++n) gv[bj][n] = *(const f32x4*)(gp + col0 + bj * HALF + n * 16);
#pragma unroll
        for (int ai = 0; ai < 2; ++ai)
#pragma unroll
            for (int m = 0; m < 4; ++m) { float* rowp = X + (size_t)(row0 + ai * HALF + m * 16) * 1024 + col0;
#pragma unroll
                for (int bj = 0; bj < 2; ++bj)
#pragma unroll
                    for (int n = 0; n < 2; ++n) { f32x4* p = (f32x4*)(rowp + bj * HALF + n * 16); *p = *p + gv[bj][n] * acc[ai][bj][m][n]; } }
    }
};

template <class Epi, class Sched>
__device__ __forceinline__ void gemm_phase(PG8_LAS unsigned char* lds, const Gemm g, const Sched& S, const Epi& E) {
    const int tid = threadIdx.x, wid = __builtin_amdgcn_readfirstlane(tid >> 6), lane = tid & 63, wr = wid >> 2, wc = wid & 3, fr = lane & 15, fq = lane >> 4;
    const int K = g.K, nt = K / BK;
    unsigned voffA[2], voffB[2];
#pragma unroll
    for (int i = 0; i < 2; ++i) { int R, C; stage_rc(tid * 16 + i * 8192, R, C); const int Rb = Epi::PERM ? ((R & ~31) + perm32(R & 31)) : R;
        voffA[i] = (unsigned)(R * K + C) * 2u; voffB[i] = (unsigned)(Rb * K + C) * 2u; }
    const size_t kstep = (size_t)(BK * 2);
    const size_t hstep = (size_t)HALF * K * 2;
    const size_t tstep = 2 * hstep;
    const unsigned ldsw = (unsigned)wid * 1024u;
    const int aoff = lds_byte(wr * 64 + fr, fq * 8), boff = lds_byte(wc * 32 + fr, fq * 8);
#define PG8_SA(b, h) (((b) * 2 + (h)) * HTB)
#define PG8_SB(b, h) ((4 + (b) * 2 + (h)) * HTB)
#define PG8_STAGE(bufoff, gbase, voff) do { _Pragma("unroll") for (int _i = 0; _i < 2; ++_i) \
        __builtin_amdgcn_global_load_lds((const unsigned*)((const char*)(gbase) + (voff)[_i]), (PG8_LAS unsigned*)(lds + (bufoff) + ldsw + _i * 8192), 16, 0, 0); } while (0)
#define PG8_LDA(dst, b, h) do { _Pragma("unroll") for (int m = 0; m < 4; ++m) _Pragma("unroll") for (int k = 0; k < 2; ++k) dst[m][k] = *(const PG8_LAS bf16x8*)(lds + PG8_SA(b, h) + aoff + m * 2048 + k * 1024); } while (0)
#define PG8_LDB(dst, b, h) do { _Pragma("unroll") for (int n = 0; n < 2; ++n) _Pragma("unroll") for (int k = 0; k < 2; ++k) dst[n][k] = *(const PG8_LAS bf16x8*)(lds + PG8_SB(b, h) + boff + n * 2048 + k * 1024); } while (0)
#define PG8_MMA(ai, bj, At, Bt) do { __builtin_amdgcn_s_setprio(1); _Pragma("unroll") for (int m = 0; m < 4; ++m) _Pragma("unroll") for (int n = 0; n < 2; ++n) _Pragma("unroll") for (int k = 0; k < 2; ++k) \
        acc[ai][bj][m][n] = __builtin_amdgcn_mfma_f32_16x16x32_bf16(Bt[n][k], At[m][k], acc[ai][bj][m][n], 0, 0, 0); __builtin_amdgcn_s_setprio(0); } while (0)
#define PG8_WAIT_V(n) asm volatile("s_waitcnt vmcnt(" #n ")" ::: "memory")
#define PG8_WAIT_L(n) asm volatile("s_waitcnt lgkmcnt(" #n ")" ::: "memory")
#define PG8_BAR __builtin_amdgcn_s_barrier()
#define PG8_SCHED __builtin_amdgcn_sched_barrier(0)
    Unit cur, nxt; int ui = 0;
    if (!S.next(0, cur)) return;
    f32x4 acc[2][2][4][2];
#pragma unroll
    for (int a = 0; a < 2; ++a)
#pragma unroll
        for (int b = 0; b < 2; ++b)
#pragma unroll
            for (int m = 0; m < 4; ++m)
#pragma unroll
                for (int n = 0; n < 2; ++n) acc[a][b][m][n] = (f32x4){0.f, 0.f, 0.f, 0.f};
    bf16x8 At[4][2], B0[2][2], B1[2][2];
    const char* cA = (const char*)g.A + (size_t)cur.pm * tstep; const char* cB = (const char*)g.Bt + (size_t)cur.pb * tstep;
    PG8_STAGE(PG8_SB(0, 0), cB, voffB); PG8_STAGE(PG8_SB(0, 1), cB + hstep, voffB); PG8_STAGE(PG8_SA(0, 0), cA, voffA); PG8_STAGE(PG8_SA(0, 1), cA + hstep, voffA);
    if (wr == 1) PG8_BAR;
    PG8_WAIT_V(2); PG8_BAR;
    PG8_STAGE(PG8_SB(1, 0), cB + kstep, voffB); PG8_STAGE(PG8_SA(1, 0), cA + kstep, voffA); PG8_STAGE(PG8_SB(1, 1), cB + hstep + kstep, voffB);
    PG8_WAIT_V(6); PG8_BAR;
    for (;;) {
        const bool has_next = S.next(ui + 1, nxt);
        const char* nA = has_next ? (const char*)g.A + (size_t)nxt.pm * tstep : cA; const char* nB = has_next ? (const char*)g.Bt + (size_t)nxt.pb * tstep : cB;
        for (int t = 0; t < nt; t += 2) {
            const bool last = (t == nt - 2);
            const char* a1 = cA + (size_t)(t + 1) * kstep;
            const char* a2 = last ? nA : cA + (size_t)(t + 2) * kstep; const char* b2 = last ? nB : cB + (size_t)(t + 2) * kstep;
            const char* a3 = a2 + kstep; const char* b3 = b2 + kstep;
            PG8_LDB(B0, 0, 0); PG8_LDB(B1, 0, 1); PG8_SCHED; PG8_LDA(At, 0, 0); PG8_STAGE(PG8_SA(1, 1), a1 + hstep, voffA);
            PG8_WAIT_V(8); PG8_WAIT_L(0); PG8_BAR; PG8_MMA(0, 0, At, B0); PG8_MMA(0, 1, At, B1); PG8_BAR; PG8_SCHED;
            PG8_LDA(At, 0, 1); PG8_STAGE(PG8_SB(0, 0), b2, voffB); PG8_STAGE(PG8_SB(0, 1), b2 + hstep, voffB); PG8_STAGE(PG8_SA(0, 0), a2, voffA);
            PG8_WAIT_V(8); PG8_WAIT_L(0); PG8_BAR; PG8_MMA(1, 0, At, B0); PG8_MMA(1, 1, At, B1); PG8_BAR; PG8_SCHED;
            PG8_LDB(B0, 1, 0); PG8_LDB(B1, 1, 1); PG8_SCHED; PG8_LDA(At, 1, 0); PG8_STAGE(PG8_SA(0, 1), a2 + hstep, voffA);
            PG8_WAIT_V(8); PG8_WAIT_L(0); PG8_BAR; PG8_MMA(0, 0, At, B0); PG8_MMA(0, 1, At, B1); PG8_BAR; PG8_SCHED;
            PG8_LDA(At, 1, 1); PG8_STAGE(PG8_SB(1, 0), b3, voffB); PG8_STAGE(PG8_SB(1, 1), b3 + hstep, voffB); PG8_STAGE(PG8_SA(1, 0), a3, voffA);
            PG8_WAIT_V(8); PG8_WAIT_L(0); PG8_BAR; PG8_MMA(1, 0, At, B0); PG8_MMA(1, 1, At, B1); PG8_BAR; PG8_SCHED;
        }
        if (wr == 0) PG8_BAR;
        E(acc, cur, wr, wc, fr, fq);
        if (!has_next) break;
#pragma unroll
        for (int a = 0; a < 2; ++a)
#pragma unroll
            for (int b = 0; b < 2; ++b)
#pragma unroll
                for (int m = 0; m < 4; ++m)
#pragma unroll
                    for (int n = 0; n < 2; ++n) acc[a][b][m][n] = (f32x4){0.f, 0.f, 0.f, 0.f};
        cur = nxt; cA = nA; cB = nB; ++ui;
        if (wr == 1) PG8_BAR;
    }
    PG8_WAIT_V(0);
    PG8_BAR;
#undef PG8_SA
#undef PG8_SB
#undef PG8_STAGE
#undef PG8_LDA
#undef PG8_LDB
#undef PG8_MMA
#undef PG8_WAIT_V
#undef PG8_WAIT_L
#undef PG8_BAR
#undef PG8_SCHED
}
}

constexpr int NWAVES = 8, NTHREADS = 512;
constexpr int D = 1024, NCTX = 512, NLAT = 16384, NTOK = NCTX + NLAT, SEQ = 8192, CTXL = 256;
constexpr int NEXP = 32, MAXPADROWS = 75776, MAXPADTILES = 296;
constexpr int GLA_IN = 3104, GLA_INP = 3328;
constexpr float EPS = 1e-6f;

constexpr size_t MiB = 1u << 20;
constexpr size_t WS_CTL = 0, CTL_ZERO_BYTES = 1 * MiB;
constexpr size_t WS_ADA = 1 * MiB;
constexpr size_t WS_ROPE = 1 * MiB + 512 * 1024;
constexpr size_t WS_TOKI = 2 * MiB;
constexpr size_t WS_TOKG = 2 * MiB + 512 * 1024;
constexpr size_t WS_LIST = 3 * MiB;
constexpr size_t WS_WRH = 6 * MiB, WS_WRL = 6 * MiB + 256 * 1024;
constexpr size_t WS_WSB = 7 * MiB;
constexpr size_t WS_WAIN = 8 * MiB;
constexpr size_t WS_WAOUT = 16 * MiB;
constexpr size_t WS_WBIN = 20 * MiB;
constexpr size_t WS_WBOUT = 27 * MiB;
constexpr size_t WS_WCQKV = 29 * MiB;
constexpr size_t WS_WCOUT = 35 * MiB;
constexpr size_t WS_WGU = 64 * MiB;
constexpr size_t WS_WDN = 576 * MiB;
constexpr size_t WS_X = 832 * MiB;
constexpr size_t WS_H = 898 * MiB;
constexpr size_t WS_G = 931 * MiB;
constexpr size_t WS_BIG = 964 * MiB;
constexpr size_t WS_DS = 1072 * MiB;
constexpr size_t WS_SIN = 1204 * MiB;
constexpr size_t WS_DEC = 1336 * MiB;
constexpr size_t WS_AS = 1338 * MiB;
constexpr size_t WS_ACT = 1486 * MiB;
constexpr size_t WS_YB = 1634 * MiB;
constexpr size_t WS_END = 1782 * MiB;
constexpr int CW_TMO = 0;
constexpr int CW_BAR = 4096;
constexpr int CW_CNT = 8192;

constexpr int RING_OFF = 0, RING_BYTES = 131072;
constexpr int MISC_OFF = RING_BYTES;
constexpr int LDS_BYTES = 147456;

#define GAS __attribute__((address_space(1)))
#define LAS __attribute__((address_space(3)))
typedef unsigned short bf16;
typedef unsigned v4u __attribute__((ext_vector_type(4)));
typedef unsigned v2u __attribute__((ext_vector_type(2)));
typedef float f32x4 __attribute__((ext_vector_type(4)));
typedef short bf16x8 __attribute__((ext_vector_type(8)));
typedef short bf16x4 __attribute__((ext_vector_type(4)));
#define LDS_WAIT() asm volatile("s_waitcnt lgkmcnt(0)" ::: "memory")
#define VM_WAIT() asm volatile("s_waitcnt vmcnt(0)" ::: "memory")
__device__ __forceinline__ unsigned f2bf(float f) { unsigned u = __builtin_bit_cast(unsigned, f); return (u + 0x7fffu + ((u >> 16) & 1u)) >> 16; }
__device__ __forceinline__ unsigned pk2(float lo, float hi) { return f2bf(lo) | (f2bf(hi) << 16); }
__device__ __forceinline__ float bf2f(unsigned b) { return __builtin_bit_cast(float, b << 16); }
__device__ __forceinline__ float bflo(unsigned w) { return __builtin_bit_cast(float, w << 16); }
__device__ __forceinline__ float bfhi(unsigned w) { return __builtin_bit_cast(float, w & 0xffff0000u); }
#define MFMA16(a, b, c) __builtin_amdgcn_mfma_f32_16x16x32_bf16((a), (b), (c), 0, 0, 0)

#define XB_TMO      128
#define XB_XCNT(j)  (256  + 64 * (j))
#define XB_XSUB(j)  (1280 + 64 * (j))
#define XB_XGEN(j)  (2304 + 64 * (j))
#define XB_TOP      3328
#define XB_TOPGEN   3392
#define XCD_BAR_WORDS 3456
#define XB_SPIN_CAP (1u << 22)

__device__ __forceinline__ unsigned xb_ld(unsigned* p)              { return __hip_atomic_load(p, __ATOMIC_RELAXED, __HIP_MEMORY_SCOPE_AGENT); }
__device__ __forceinline__ unsigned xb_add(unsigned* p, unsigned v) { return __hip_atomic_fetch_add(p, v, __ATOMIC_RELAXED, __HIP_MEMORY_SCOPE_AGENT); }
__device__ __forceinline__ unsigned xb_xcc_id() { return (unsigned)__builtin_amdgcn_s_getreg((3 << 11) | 20) & 0xFu; }
#define XB_SPIN(cond, bar) do { unsigned _sp = 0; while (cond) { __builtin_amdgcn_s_sleep(1); \
    if ((++_sp & 255u) == 0u) { if (xb_ld(&(bar)[XB_TMO])) break; if (_sp > XB_SPIN_CAP) { atomicAdd(&(bar)[XB_TMO], 1u); break; } } } } while (0)

struct XcdBarrier { unsigned* bar; unsigned x; volatile LAS unsigned* st; };
__device__ __forceinline__ XcdBarrier xcd_barrier_post(unsigned* bar, volatile LAS unsigned* st) {
    XcdBarrier b; b.bar = bar; b.x = xb_xcc_id(); b.st = st;
    if (threadIdx.x == 0) (void)xb_add(&bar[XB_XCNT(b.x)], 1u);
    return b;
}
__device__ __forceinline__ void xcd_barrier_complete(unsigned* bar, unsigned x, unsigned& nloc, unsigned& nx) {
    const unsigned G = gridDim.x * gridDim.y * gridDim.z;
    unsigned sum, cnt, mine, sp = 0u;
    for (;;) {
        sum = 0u; cnt = 0u; mine = 0u;
#pragma unroll
        for (unsigned j = 0; j < 16; ++j) { const unsigned c = xb_ld(&bar[XB_XCNT(j)]); sum += c; cnt += (c > 0u) ? 1u : 0u; mine = (j == x) ? c : mine; }
        if (sum == G) break;
        __builtin_amdgcn_s_sleep(1);
        if ((++sp & 255u) == 0u) { if (xb_ld(&bar[XB_TMO])) break; if (sp > XB_SPIN_CAP) { atomicAdd(&bar[XB_TMO], 1u); break; } }
    }
    nloc = mine > 0u ? mine : 1u; nx = cnt > 0u ? cnt : 1u;
}
__device__ __forceinline__ void xcd_barrier(const XcdBarrier& b) {
    asm volatile("s_waitcnt vmcnt(0)" ::: "memory");
    __syncthreads();
    if (threadIdx.x == 0) {
        unsigned* bar = b.bar;
        __builtin_amdgcn_s_waitcnt(0);
        unsigned nloc = b.st[0], nx = b.st[1];
        if (nloc == 0u) { xcd_barrier_complete(bar, b.x, nloc, nx); b.st[0] = nloc; b.st[1] = nx; }
        const unsigned old = xb_add(&bar[XB_XSUB(b.x)], 1u);
        const unsigned gen = old / nloc;
        if (old + 1u == (gen + 1u) * nloc) {
            __builtin_amdgcn_fence(__ATOMIC_RELEASE, "agent");
            asm volatile("s_waitcnt vmcnt(0)" ::: "memory");
            const unsigned og = xb_add(&bar[XB_TOP], 1u);
            const unsigned tg = og / nx;
            if (og + 1u == (tg + 1u) * nx) xb_add(&bar[XB_TOPGEN], 1u);
            else XB_SPIN(xb_ld(&bar[XB_TOPGEN]) == tg, bar);
            __builtin_amdgcn_fence(__ATOMIC_ACQUIRE, "agent");
            xb_add(&bar[XB_XGEN(b.x)], 1u);
            asm volatile("s_waitcnt vmcnt(0)" ::: "memory");
        } else {
            XB_SPIN(xb_ld(&bar[XB_XGEN(b.x)]) == gen, bar);
            __builtin_amdgcn_fence(__ATOMIC_ACQUIRE, "agent");
            asm volatile("s_waitcnt vmcnt(0)" ::: "memory");
        }
    }
    __syncthreads();
}

struct Args { const float* in[28]; float* out; unsigned char* ws; int ph_lo, ph_hi; };
enum { I_X = 0, I_C, I_CTX, I_CCTX, I_ADAW, I_ADAB, I_NMIX, I_NFFN, I_NOUT, I_AWIN, I_AGV, I_AWS, I_ABS, I_AWOUT, I_BWIN, I_BWA2, I_BBA, I_BGO, I_BWOUT,
       I_CWQKV, I_CRPB, I_CWOUT, I_MWR, I_MBR, I_MWGU, I_MBGU, I_MWDN, I_MBDN };

struct Frame {
    LAS unsigned char* lds;
    unsigned* ctl;
    unsigned char* ws;
    int tid, lane, wave, vcu, G;
};

__device__ __forceinline__ float wave_sum(float v) {
#pragma unroll
    for (int o = 1; o < 64; o <<= 1) v += __shfl_xor(v, o);
    return v;
}
__device__ __forceinline__ int seg_of_row(int r) { return r < NCTX ? 0 : 1 + ((r - NCTX) >> 13); }

__device__ __forceinline__ void transpose_item64(const float* W, int N, int k0, int n0, bf16* WT, int K, int dst_row0, int ncols_valid, LAS float* scr, int lane) {
#pragma unroll 4
    for (int i = 0; i < 16; ++i) { const int row = 4 * i + (lane >> 4), c4 = (lane & 15) * 4;
        f32x4 v = (f32x4){0.f, 0.f, 0.f, 0.f};
        if (c4 < ncols_valid) v = *(const GAS f32x4*)(W + (size_t)(k0 + row) * N + n0 + c4);
        LAS float* s = scr + row * 65 + c4; s[0] = v.x; s[1] = v.y; s[2] = v.z; s[3] = v.w; }
    LDS_WAIT(); asm volatile("" ::: "memory");
    const int c = lane & 7;
#pragma unroll
    for (int j = 0; j < 8; ++j) { const int n = (lane >> 3) + 8 * j; const LAS float* s = scr + (8 * c) * 65 + n;
        v4u o; o.x = pk2(s[0 * 65], s[1 * 65]); o.y = pk2(s[2 * 65], s[3 * 65]); o.z = pk2(s[4 * 65], s[5 * 65]); o.w = pk2(s[6 * 65], s[7 * 65]);
        *(GAS v4u*)(WT + (size_t)(dst_row0 + n) * K + k0 + 8 * c) = o; }
    LDS_WAIT(); asm volatile("" ::: "memory");
}

__device__ __forceinline__ void p_prologue(Frame& F, const Args& a) {
    LAS float* scr = (LAS float*)(F.lds + F.wave * 16640);
    const int gw = F.vcu * NWAVES + F.wave, NGW = F.G * NWAVES;
    {
        constexpr int KB = 16;
        constexpr int I0 = 2 * KB * 32, I1 = 2 * KB * 16, I2 = KB * 52, I3 = KB * 16, I4 = KB * 48, I5 = KB * 16;
        constexpr int NI = I0 + I1 + I2 + I3 + I4 + I5;
        for (int it = gw; it < NI; it += NGW) {
            int r = it;
            if (r < I0) { const int j = r / (KB * 32), q = r % (KB * 32), kb = q / 32, nb = q % 32;
                transpose_item64(a.in[I_AWIN] + (size_t)j * 1024 * 2048, 2048, 64 * kb, 64 * nb, (bf16*)(F.ws + WS_WAIN) + (size_t)j * 2048 * 1024, 1024, 64 * nb, 64, scr, F.lane); continue; } r -= I0;
            if (r < I1) { const int j = r / (KB * 16), q = r % (KB * 16), kb = q / 16, nb = q % 16;
                transpose_item64(a.in[I_AWOUT] + (size_t)j * 1024 * 1024, 1024, 64 * kb, 64 * nb, (bf16*)(F.ws + WS_WAOUT) + (size_t)j * 1024 * 1024, 1024, 64 * nb, 64, scr, F.lane); continue; } r -= I1;
            if (r < I2) { const int kb = r / 52, nb = r % 52; const int nv = GLA_IN - 64 * nb;
                transpose_item64(a.in[I_BWIN], GLA_IN, 64 * kb, 64 * nb, (bf16*)(F.ws + WS_WBIN), 1024, 64 * nb, nv < 0 ? 0 : (nv > 64 ? 64 : nv), scr, F.lane); continue; } r -= I2;
            if (r < I3) { const int kb = r / 16, nb = r % 16;
                transpose_item64(a.in[I_BWOUT], 1024, 64 * kb, 64 * nb, (bf16*)(F.ws + WS_WBOUT), 1024, 64 * nb, 64, scr, F.lane); continue; } r -= I3;
            if (r < I4) { const int kb = r / 48, nb = r % 48;
                transpose_item64(a.in[I_CWQKV], 3072, 64 * kb, 64 * nb, (bf16*)(F.ws + WS_WCQKV), 1024, 64 * nb, 64, scr, F.lane); continue; } r -= I4;
            { const int kb = r / 16, nb = r % 16;
                transpose_item64(a.in[I_CWOUT], 1024, 64 * kb, 64 * nb, (bf16*)(F.ws + WS_WCOUT), 1024, 64 * nb, 64, scr, F.lane); }
        }
    }
    {
        constexpr int KB = 16, PER_GU = KB * 32, PER_DN = KB * 16, NGU = 128 * PER_GU, NDN = 128 * PER_DN;
        for (int it = gw; it < NGU + NDN; it += NGW) {
            if (it < NGU) { const int le = it / PER_GU, q = it % PER_GU, kb = q / 32, nb = q % 32;
                const int n0 = 64 * nb, half = n0 >> 10, jj = n0 & 1023, dst = (jj >> 7) * 256 + half * 128 + (jj & 127);
                transpose_item64(a.in[I_MWGU] + (size_t)le * 1024 * 2048, 2048, 64 * kb, n0, (bf16*)(F.ws + WS_WGU) + (size_t)le * 2048 * 1024, 1024, dst, 64, scr, F.lane); }
            else { const int r = it - NGU, le = r / PER_DN, q = r % PER_DN, kb = q / 16, nb = q % 16;
                transpose_item64(a.in[I_MWDN] + (size_t)le * 1024 * 1024, 1024, 64 * kb, 64 * nb, (bf16*)(F.ws + WS_WDN) + (size_t)le * 1024 * 1024, 1024, 64 * nb, 64, scr, F.lane); }
        }
    }
    const int gt = F.vcu * NTHREADS + F.tid, NGT = F.G * NTHREADS;
    for (int i = gt; i < 2 * 8 * 128 * 128; i += NGT) ((bf16*)(F.ws + WS_WSB))[i] = (bf16)f2bf(a.in[I_AWS][i]);
    for (int i = gt; i < 4 * 32 * 1024; i += NGT) { const int l = i >> 15, e = (i >> 10) & 31, k = i & 1023;
        const float w = a.in[I_MWR][((size_t)l * 1024 + k) * 32 + e]; const unsigned h = f2bf(w); const float rem = w - bf2f(h);
        ((bf16*)(F.ws + WS_WRH))[i] = (bf16)h; ((bf16*)(F.ws + WS_WRL))[i] = (bf16)f2bf(rem); }
    for (int i = gt; i < 128 * 32; i += NGT) { const int pos = i >> 5, f = i & 31;
        const float fr = powf(10000.0f, -(float)f / 32.0f); const float ang = (float)pos * fr; float sn, cs; sincosf(ang, &sn, &cs);
        ((float*)(F.ws + WS_ROPE))[2 * i] = cs; ((float*)(F.ws + WS_ROPE))[2 * i + 1] = sn; }
    {
        __syncthreads();
        LAS float* sv = (LAS float*)(F.lds);
        LAS float* red = sv + 3 * 1024;
        for (int i = F.tid; i < 3 * 1024; i += NTHREADS) { const int s = i >> 10, k = i & 1023;
            const float v = s == 0 ? a.in[I_CCTX][k] : a.in[I_C][(s - 1) * 1024 + k]; sv[i] = v / (1.0f + __expf(-v)); }
        __syncthreads();
        for (int u = F.vcu; u < 4 * 96; u += F.G) { const int l = u / 96, n0 = (u % 96) * 64;
            const float* w = a.in[I_ADAW] + (size_t)l * 1024 * 6144 + n0 + F.lane;
            float a0 = 0.f, a1 = 0.f, a2 = 0.f;
#pragma unroll 8
            for (int kk = 0; kk < 128; ++kk) { const int k = F.wave * 128 + kk; const float wv = w[(size_t)k * 6144];
                a0 += sv[k] * wv; a1 += sv[1024 + k] * wv; a2 += sv[2048 + k] * wv; }
            red[(F.wave * 3 + 0) * 64 + F.lane] = a0; red[(F.wave * 3 + 1) * 64 + F.lane] = a1; red[(F.wave * 3 + 2) * 64 + F.lane] = a2;
            __syncthreads();
            if (F.tid < 192) { const int s = F.tid >> 6, c = F.tid & 63; float t = a.in[I_ADAB][l * 6144 + n0 + c];
#pragma unroll
                for (int w8 = 0; w8 < 8; ++w8) t += red[(w8 * 3 + s) * 64 + c];
                ((float*)(F.ws + WS_ADA))[(size_t)(l * 3 + s) * 6144 + n0 + c] = t; }
            __syncthreads();
        }
    }
}

__device__ __forceinline__ void moe_tables(Frame& F, int layer) {
    LAS int* M = (LAS int*)(F.lds + MISC_OFF);
    __syncthreads();
    if (F.tid < 32) M[400 + F.tid] = (int)__hip_atomic_load(F.ctl + CW_CNT + (layer * 32 + F.tid) * 64, __ATOMIC_RELAXED, __HIP_MEMORY_SCOPE_AGENT);
    __syncthreads();
    if (F.tid == 0) { int off = 0; for (int e = 0; e < 32; ++e) { M[e] = off; const int nt = (M[400 + e] + 255) >> 8; for (int t = 0; t < nt; ++t) M[64 + (off >> 8) + t] = e; off += nt << 8; } M[32] = off; }
    __syncthreads();
}

__device__ __forceinline__ void p_prenorm(Frame& F, const Args& a, int layer, bool fin) {
    const int gw = F.vcu * NWAVES + F.wave, NGW = F.G * NWAVES;
    const int prev = layer - 1;
    const int row_lo = (layer >= 3) ? NCTX : 0;
    const bool combine = layer > 0;
    if (combine) moe_tables(F, prev);
    const LAS int* M = (const LAS int*)(F.lds + MISC_OFF);
    float* X = (float*)(F.ws + WS_X); bf16* H = (bf16*)(F.ws + WS_H);
    const bf16* YB = (const bf16*)(F.ws + WS_YB);
    const float* ada = (const float*)(F.ws + WS_ADA);
    const v4u* TOKI = (const v4u*)(F.ws + WS_TOKI); const f32x4* TOKG = (const f32x4*)(F.ws + WS_TOKG);
    for (int row = row_lo + gw; row < NTOK; row += NGW) {
        const int seg = seg_of_row(row);
        const float* src = layer == 0 ? (row < NCTX ? a.in[I_CTX] + (size_t)row * D : a.in[I_X] + (size_t)(row - NCTX) * D) : X + (size_t)row * D;
        f32x4 v[4];
#pragma unroll
        for (int j = 0; j < 4; ++j) v[j] = *(const GAS f32x4*)(src + 4 * F.lane + 256 * j);
        if (combine) {
            const v4u ti = TOKI[row]; const f32x4 tg = TOKG[row];
            f32x4 acc[4];
#pragma unroll
            for (int j = 0; j < 4; ++j) acc[j] = (f32x4){0.f, 0.f, 0.f, 0.f};
#pragma unroll
            for (int k = 0; k < 4; ++k) { const unsigned t = ti[k]; const int pos = M[t >> 16] + (int)(t & 0xffffu); const float g = tg[k];
                const bf16* yr = YB + (size_t)pos * D + 4 * F.lane;
#pragma unroll
                for (int j = 0; j < 4; ++j) { const v2u y = *(const GAS v2u*)(yr + 256 * j);
                    acc[j].x += g * bflo(y.x); acc[j].y += g * bfhi(y.x); acc[j].z += g * bflo(y.y); acc[j].w += g * bfhi(y.y); } }
            const float* g5 = ada + (size_t)((prev * 3 + seg) * 6 + 5) * D;
#pragma unroll
            for (int j = 0; j < 4; ++j) { const f32x4 gg = *(const GAS f32x4*)(g5 + 4 * F.lane + 256 * j); v[j] = v[j] + gg * acc[j]; }
        }
        if (!fin && (combine || layer == 0)) {
#pragma unroll
            for (int j = 0; j < 4; ++j) *(GAS f32x4*)(X + (size_t)row * D + 4 * F.lane + 256 * j) = v[j];
        }
        float ss = 0.f;
#pragma unroll
        for (int j = 0; j < 4; ++j) ss += (v[j].x * v[j].x + v[j].y * v[j].y) + (v[j].z * v[j].z + v[j].w * v[j].w);
        const float rstd = 1.0f / sqrtf(wave_sum(ss) * (1.0f / D) + EPS);
        if (fin) {
            float* o = a.out + (size_t)(row - NCTX) * D;
#pragma unroll
            for (int j = 0; j < 4; ++j) { const f32x4 g = *(const GAS f32x4*)(a.in[I_NOUT] + 4 * F.lane + 256 * j); *(GAS f32x4*)(o + 4 * F.lane + 256 * j) = v[j] * rstd * g; }
        } else {
            const float* sh = ada + (size_t)((layer * 3 + seg) * 6 + 0) * D; const float* sc = sh + D;
            const float* nw = a.in[I_NMIX] + (size_t)layer * D;
#pragma unroll
            for (int j = 0; j < 4; ++j) { const int c = 4 * F.lane + 256 * j;
                const f32x4 g = *(const GAS f32x4*)(nw + c), s1 = *(const GAS f32x4*)(sc + c), s0 = *(const GAS f32x4*)(sh + c);
                const f32x4 h = v[j] * rstd * g * (s1 + 1.0f) + s0;
                v2u o; o.x = pk2(h.x, h.y); o.y = pk2(h.z, h.w);
                *(GAS v2u*)(H + (size_t)row * D + c) = o; }
        }
    }
}

__device__ __forceinline__ void p_router(Frame& F, const Args& a, int layer) {
    const int row_lo = (layer >= 2) ? NCTX : 0;
    const int ntile = (NTOK - row_lo) / 16;
    float* X = (float*)(F.ws + WS_X); bf16* H = (bf16*)(F.ws + WS_H);
    const float* ada = (const float*)(F.ws + WS_ADA);
    constexpr int AST = 1032;
    LAS bf16* Ahi = (LAS bf16*)(F.lds); LAS bf16* Alo = Ahi + 16 * AST;
    LAS float* RED = (LAS float*)(F.lds + 2 * 16 * AST * 2);
    LAS float* LOG = RED + 8 * 16 * 32;
    const int fr = F.lane & 15, fq = F.lane >> 4;
    bf16x8 Bh[2][4], Bl[2][4];
    {
        const bf16* wh = (const bf16*)(F.ws + WS_WRH) + (size_t)layer * 32 * 1024; const bf16* wl = (const bf16*)(F.ws + WS_WRL) + (size_t)layer * 32 * 1024;
#pragma unroll
        for (int nt = 0; nt < 2; ++nt)
#pragma unroll
            for (int ks = 0; ks < 4; ++ks) { const size_t o = (size_t)(nt * 16 + fr) * 1024 + F.wave * 128 + ks * 32 + fq * 8;
                Bh[nt][ks] = *(const GAS bf16x8*)(wh + o); Bl[nt][ks] = *(const GAS bf16x8*)(wl + o); }
    }
    const float* nw = a.in[I_NFFN] + (size_t)layer * D;
    for (int tile = F.vcu; tile < ntile; tile += F.G) {
        const int r0 = row_lo + 16 * tile;
#pragma unroll
        for (int rr = 0; rr < 2; ++rr) {
            const int rl = 2 * F.wave + rr, row = r0 + rl, seg = seg_of_row(row);
            const float* sh = ada + (size_t)((layer * 3 + seg) * 6 + 3) * D; const float* sc = sh + D;
            f32x4 v[4]; float ss = 0.f;
#pragma unroll
            for (int j = 0; j < 4; ++j) { v[j] = *(const GAS f32x4*)(X + (size_t)row * D + 4 * F.lane + 256 * j); ss += (v[j].x * v[j].x + v[j].y * v[j].y) + (v[j].z * v[j].z + v[j].w * v[j].w); }
            const float rstd = 1.0f / sqrtf(wave_sum(ss) * (1.0f / D) + EPS);
#pragma unroll
            for (int j = 0; j < 4; ++j) { const int c = 4 * F.lane + 256 * j;
                const f32x4 g = *(const GAS f32x4*)(nw + c), s1 = *(const GAS f32x4*)(sc + c), s0 = *(const GAS f32x4*)(sh + c);
                const f32x4 h = v[j] * rstd * g * (s1 + 1.0f) + s0;
                const unsigned h0 = f2bf(h.x), h1 = f2bf(h.y), h2 = f2bf(h.z), h3 = f2bf(h.w);
                v2u o; o.x = h0 | (h1 << 16); o.y = h2 | (h3 << 16);
                *(GAS v2u*)(H + (size_t)row * D + c) = o;
                *(LAS v2u*)(Ahi + rl * AST + c) = o;
                v2u l; l.x = pk2(h.x - bf2f(h0), h.y - bf2f(h1)); l.y = pk2(h.z - bf2f(h2), h.w - bf2f(h3));
                *(LAS v2u*)(Alo + rl * AST + c) = l; }
        }
        __syncthreads();
        f32x4 acc[2] = {(f32x4){0.f, 0.f, 0.f, 0.f}, (f32x4){0.f, 0.f, 0.f, 0.f}};
#pragma unroll
        for (int ks = 0; ks < 4; ++ks) { const int o = fr * AST + F.wave * 128 + ks * 32 + fq * 8;
            const bf16x8 ah = *(const LAS bf16x8*)(Ahi + o), al = *(const LAS bf16x8*)(Alo + o);
#pragma unroll
            for (int nt = 0; nt < 2; ++nt) { acc[nt] = MFMA16(ah, Bh[nt][ks], acc[nt]); acc[nt] = MFMA16(ah, Bl[nt][ks], acc[nt]); acc[nt] = MFMA16(al, Bh[nt][ks], acc[nt]); } }
#pragma unroll
        for (int nt = 0; nt < 2; ++nt)
#pragma unroll
            for (int j = 0; j < 4; ++j) RED[(F.wave * 16 + fq * 4 + j) * 32 + nt * 16 + fr] = acc[nt][j];
        __syncthreads();
        {
            const int rl = F.tid >> 5, e = F.tid & 31, row = r0 + rl;
            float lg = a.in[I_MBR][layer * 32 + e];
#pragma unroll
            for (int w8 = 0; w8 < 8; ++w8) lg += RED[(w8 * 16 + rl) * 32 + e];
            float cur = lg; float tv[4]; int tix[4];
#pragma unroll
            for (int k = 0; k < 4; ++k) { float bv = cur; int bi = e;
#pragma unroll
                for (int o = 1; o < 32; o <<= 1) { const float ov = __shfl_xor(bv, o); const int oi = __shfl_xor(bi, o); if (ov > bv || (ov == bv && oi < bi)) { bv = ov; bi = oi; } }
                tv[k] = bv; tix[k] = bi; if (e == bi) cur = -3.0e38f; }
            const float e1 = __expf(tv[1] - tv[0]), e2 = __expf(tv[2] - tv[0]), e3 = __expf(tv[3] - tv[0]); const float inv = 1.0f / (1.0f + e1 + e2 + e3);
            if (e < 4) { const int k = e; const int ek = k == 0 ? tix[0] : (k == 1 ? tix[1] : (k == 2 ? tix[2] : tix[3])); const float gk = (k == 0 ? 1.0f : (k == 1 ? e1 : (k == 2 ? e2 : e3))) * inv;
                const unsigned rank = atomicAdd(F.ctl + CW_CNT + (layer * 32 + ek) * 64, 1u);
                ((unsigned*)(F.ws + WS_LIST))[(size_t)ek * NTOK + rank] = (unsigned)row;
                ((unsigned*)(F.ws + WS_TOKI))[(size_t)row * 4 + k] = ((unsigned)ek << 16) | rank;
                ((float*)(F.ws + WS_TOKG))[(size_t)row * 4 + k] = gk; }
        }
        __syncthreads();
    }
}

__device__ __forceinline__ void p_gather(Frame& F, int layer) {
    moe_tables(F, layer);
    const LAS int* M = (const LAS int*)(F.lds + MISC_OFF);
    const int total = M[32];
    const int gw = F.vcu * NWAVES + F.wave, NGW = F.G * NWAVES;
    const bf16* H = (const bf16*)(F.ws + WS_H); bf16* AS = (bf16*)(F.ws + WS_AS);
    const unsigned* LIST = (const unsigned*)(F.ws + WS_LIST);
    for (int p = gw; p < total; p += NGW) {
        const int e = M[64 + (p >> 8)]; const int rank = p - M[e];
        v4u x0 = (v4u){0u, 0u, 0u, 0u}, x1 = x0;
        if (rank < M[400 + e]) { const unsigned r = LIST[(size_t)e * NTOK + rank]; const GAS v4u* s = (const GAS v4u*)(H + (size_t)r * D); x0 = s[F.lane]; x1 = s[64 + F.lane]; }
        GAS v4u* d = (GAS v4u*)(AS + (size_t)p * D); d[F.lane] = x0; d[64 + F.lane] = x1;
    }
}

__device__ __forceinline__ void p_spatial(Frame& F, const Args& a, int layer) {
    const int jl = layer / 3;
    const int c_lo = (layer >= 3) ? 4 : 0;
    const int nunit = (132 - c_lo) * 8;
    const bf16* ZB = (const bf16*)(F.ws + WS_BIG); bf16* G = (bf16*)(F.ws + WS_G);
    constexpr int ST = 136;
    LAS bf16* As = (LAS bf16*)(F.lds); LAS bf16* Bs = As + 128 * ST; LAS float* rs = (LAS float*)(F.lds + 2 * 128 * ST * 2);
    const int fr = F.lane & 15, fq = F.lane >> 4;
    for (int u = F.vcu; u < nunit; u += F.G) {
        const int c = c_lo + (u >> 3), g = u & 7, r0 = 128 * c;
        for (int rr = 0; rr < 16; ++rr) { const int rl = F.wave * 16 + rr; const GAS v4u* p = (const GAS v4u*)(ZB + (size_t)(r0 + rl) * 2048 + 1024 + 16 * F.lane);
            const v4u x0 = p[0], x1 = p[1]; float ss = 0.f;
#pragma unroll
            for (int i = 0; i < 4; ++i) { const float l0 = bflo(x0[i]), h0 = bfhi(x0[i]), l1 = bflo(x1[i]), h1 = bfhi(x1[i]); ss += l0 * l0 + h0 * h0 + l1 * l1 + h1 * h1; }
            ss = wave_sum(ss); if (F.lane == 0) rs[rl] = 1.0f / sqrtf(ss * (1.0f / 1024.0f) + EPS); }
        __syncthreads();
        {
            const bf16* wsb = (const bf16*)(F.ws + WS_WSB) + (size_t)(jl * 8 + g) * 128 * 128;
            const float* gv = a.in[I_AGV] + (size_t)jl * 1024 + 128 * g;
#pragma unroll
            for (int i = 0; i < 4; ++i) { const int id = F.tid + 512 * i, p = id >> 4, qc = id & 15;
                *(LAS v4u*)(As + p * ST + qc * 8) = *(const GAS v4u*)(wsb + p * 128 + qc * 8);
                const int q = p, c8 = qc; const v4u x = *(const GAS v4u*)(ZB + (size_t)(r0 + q) * 2048 + 1024 + 128 * g + 8 * c8); const float rq = rs[q];
#pragma unroll
                for (int e = 0; e < 4; ++e) { const int cc = 8 * c8 + 2 * e;
                    Bs[cc * ST + q] = (bf16)f2bf(bflo(x[e]) * rq * gv[cc]); Bs[(cc + 1) * ST + q] = (bf16)f2bf(bfhi(x[e]) * rq * gv[cc + 1]); } }
        }
        __syncthreads();
        f32x4 acc[8];
#pragma unroll
        for (int nt = 0; nt < 8; ++nt) acc[nt] = (f32x4){0.f, 0.f, 0.f, 0.f};
#pragma unroll
        for (int ks = 0; ks < 4; ++ks) { const bf16x8 af = *(const LAS bf16x8*)(As + (16 * F.wave + fr) * ST + ks * 32 + fq * 8);
#pragma unroll
            for (int nt = 0; nt < 8; ++nt) { const bf16x8 bfr = *(const LAS bf16x8*)(Bs + (nt * 16 + fr) * ST + ks * 32 + fq * 8); acc[nt] = MFMA16(af, bfr, acc[nt]); } }
        const float* bs = a.in[I_ABS] + (size_t)(jl * 8 + g) * 128;
#pragma unroll
        for (int j = 0; j < 4; ++j) { const int p = 16 * F.wave + fq * 4 + j; const float bb = bs[p]; const size_t row = (size_t)(r0 + p);
#pragma unroll
            for (int nt = 0; nt < 8; ++nt) { const int cc = 128 * g + nt * 16 + fr; const float uu = bf2f(ZB[row * 2048 + cc]); G[row * D + cc] = (bf16)f2bf(uu * (acc[nt][j] + bb)); } }
        __syncthreads();
    }
}

constexpr int PST = GLA_INP;
__device__ __forceinline__ void gla_cum(Frame& F, const Args& a, int c, int h, int dir, LAS float* cum, LAS float* rt, LAS float* tot) {
    const bf16* P = (const bf16*)(F.ws + WS_BIG);
    for (int i = F.tid; i < 64 * 16; i += NTHREADS) { const int ii = i >> 4, j = i & 15; rt[i] = bf2f(P[(size_t)(64 * c + ii) * PST + 3072 + dir * 16 + j]); }
    const int kk = F.tid & 127, part = F.tid >> 7;
    float w[16];
#pragma unroll
    for (int j = 0; j < 16; ++j) w[j] = a.in[I_BWA2][(size_t)(dir * 16 + j) * 512 + h * 128 + kk];
    const float ba = a.in[I_BBA][dir * 512 + h * 128 + kk];
    __syncthreads();
    float la[16];
#pragma unroll
    for (int ii = 0; ii < 16; ++ii) { const int i = part * 16 + ii; float z = ba;
#pragma unroll
        for (int j = 0; j < 16; ++j) z += rt[i * 16 + j] * w[j];
        const float ls = fminf(z, 0.0f) - log1pf(expf(-fabsf(z)));
        la[ii] = ls * (1.0f / 16.0f); }
    float run = 0.f;
    if (dir == 0) {
#pragma unroll
        for (int ii = 0; ii < 16; ++ii) { run += la[ii]; la[ii] = run; } }
    else {
#pragma unroll
        for (int ii = 15; ii >= 0; --ii) { run += la[ii]; la[ii] = run; } }
    tot[part * 128 + kk] = run;
    __syncthreads();
    float off = 0.f;
#pragma unroll
    for (int p = 0; p < 4; ++p) { const float t = tot[p * 128 + kk]; if (dir == 0 ? (p < part) : (p > part)) off += t; }
#pragma unroll
    for (int ii = 0; ii < 16; ++ii) cum[(part * 16 + ii) * 128 + kk] = la[ii] + off;
    __syncthreads();
}
__device__ __forceinline__ float rope_elem(const bf16* x, int kk, int pr, int pc, const float* ROPE, bool lat) {
    const float xv = bf2f(x[kk]);
    if (!lat) return xv;
    const int half = kk >> 6, f = kk & 31, second = (kk >> 5) & 1;
    const float x1 = second ? bf2f(x[kk - 32]) : xv, x2 = second ? xv : bf2f(x[kk + 32]);
    const int pos = half ? pc : pr;
    const float cs = ROPE[(pos * 32 + f) * 2], sn = ROPE[(pos * 32 + f) * 2 + 1];
    return second ? (x1 * sn + x2 * cs) : (x1 * cs - x2 * sn);
}
__device__ __forceinline__ void p_gla_ds(Frame& F, const Args& a) {
    const bf16* P = (const bf16*)(F.ws + WS_BIG); const float* ROPE = (const float*)(F.ws + WS_ROPE);
    bf16* DS = (bf16*)(F.ws + WS_DS); float* DEC = (float*)(F.ws + WS_DEC);
    constexpr int ST = 72;
    LAS float* cum = (LAS float*)(F.lds); LAS float* rt = cum + 64 * 128; LAS float* tot = rt + 64 * 16;
    LAS bf16* KT = (LAS bf16*)(tot + 4 * 128); LAS bf16* VT = KT + 128 * ST;
    const int fr = F.lane & 15, fq = F.lane >> 4;
    for (int u = F.vcu; u < 264 * 8; u += F.G) {
        const int c = u >> 3, h = (u >> 1) & 3, dir = u & 1; const bool lat = c >= 8; const int pr = (c - 8) & 127;
        gla_cum(F, a, c, h, dir, cum, rt, tot);
        const int lastrow = dir == 0 ? 63 : 0;
        {
            const int i = F.tid & 63, grp = F.tid >> 6; const size_t row = (size_t)(64 * c + i);
            const bf16* kp = P + row * PST + 512 + h * 128;
#pragma unroll 4
            for (int e = 0; e < 16; ++e) { const int kk = grp * 16 + e; const float kv = rope_elem(kp, kk, pr, i, ROPE, lat);
                KT[kk * ST + i] = (bf16)f2bf(kv * __expf(cum[lastrow * 128 + kk] - cum[i * 128 + kk])); }
            const bf16* vp = P + row * PST + 1024 + h * 256 + grp * 32;
#pragma unroll
            for (int e = 0; e < 4; ++e) { const v4u x = *(const GAS v4u*)(vp + 8 * e);
#pragma unroll
                for (int q = 0; q < 4; ++q) { VT[(grp * 32 + 8 * e + 2 * q) * ST + i] = (bf16)(x[q] & 0xffffu); VT[(grp * 32 + 8 * e + 2 * q + 1) * ST + i] = (bf16)(x[q] >> 16); } }
            if (F.tid < 128) DEC[((size_t)(dir * 264 + c) * 4 + h) * 128 + F.tid] = __expf(cum[lastrow * 128 + F.tid]);
        }
        __syncthreads();
        f32x4 acc[16];
#pragma unroll
        for (int nt = 0; nt < 16; ++nt) acc[nt] = (f32x4){0.f, 0.f, 0.f, 0.f};
#pragma unroll
        for (int ks = 0; ks < 2; ++ks) { const bf16x8 af = *(const LAS bf16x8*)(KT + (16 * F.wave + fr) * ST + ks * 32 + fq * 8);
#pragma unroll
            for (int nt = 0; nt < 16; ++nt) { const bf16x8 bfr = *(const LAS bf16x8*)(VT + (nt * 16 + fr) * ST + ks * 32 + fq * 8); acc[nt] = MFMA16(af, bfr, acc[nt]); } }
        bf16* dsp = DS + ((size_t)(dir * 264 + c) * 4 + h) * 256 * 128;
#pragma unroll
        for (int nt = 0; nt < 16; ++nt) { v2u o; o.x = pk2(acc[nt][0], acc[nt][1]); o.y = pk2(acc[nt][2], acc[nt][3]);
            *(GAS v2u*)(dsp + (size_t)(nt * 16 + fr) * 128 + 16 * F.wave + fq * 4) = o; }
        __syncthreads();
    }
}
__device__ __forceinline__ void p_gla_scan(Frame& F) {
    const bf16* DS = (const bf16*)(F.ws + WS_DS); bf16* SIN = (bf16*)(F.ws + WS_SIN); const float* DEC = (const float*)(F.ws + WS_DEC);
    const int gt = F.vcu * NTHREADS + F.tid, NGT = F.G * NTHREADS;
    for (int id = gt; id < 2 * 2 * 4 * 256 * 32; id += NGT) {
        const int kq = id & 31, v = (id >> 5) & 255, h = (id >> 13) & 3, dir = (id >> 15) & 1, b = id >> 16;
        f32x4 S = (f32x4){0.f, 0.f, 0.f, 0.f};
        for (int s = 0; s < 132; ++s) {
            int c;
            if (dir == 0) c = s < 4 ? 4 * b + s : 8 + 128 * b + (s - 4);
            else c = s < 4 ? 4 * b + 3 - s : 8 + 128 * b + 127 - (s - 4);
            const size_t base = ((size_t)(dir * 264 + c) * 4 + h);
            const size_t o = (base * 256 + v) * 128 + 4 * kq;
            v2u so; so.x = pk2(S.x, S.y); so.y = pk2(S.z, S.w);
            *(GAS v2u*)(SIN + o) = so;
            const v2u d = *(const GAS v2u*)(DS + o); const f32x4 dc = *(const GAS f32x4*)(DEC + base * 128 + 4 * kq);
            S.x = S.x * dc.x + bflo(d.x); S.y = S.y * dc.y + bfhi(d.x); S.z = S.z * dc.z + bflo(d.y); S.w = S.w * dc.w + bfhi(d.y);
        }
    }
}
__device__ __forceinline__ void p_gla_out(Frame& F, const Args& a) {
    const bf16* P = (const bf16*)(F.ws + WS_BIG); const float* ROPE = (const float*)(F.ws + WS_ROPE);
    const bf16* SIN = (const bf16*)(F.ws + WS_SIN); bf16* G = (bf16*)(F.ws + WS_G);
    constexpr int ST = 72, QST = 136;
    LAS float* cum = (LAS float*)(F.lds); LAS float* rt = cum + 64 * 128; LAS float* tot = rt + 64 * 16; LAS float* ssq = tot + 4 * 128;
    LAS bf16* VT = (LAS bf16*)(ssq + 8 * 64); LAS bf16* QD = VT + 256 * ST; LAS bf16* KI = QD + 64 * QST; LAS bf16* PL = KI + 64 * QST;
    const int fr = F.lane & 15, fq = F.lane >> 4;
    for (int u = F.vcu; u < 264 * 4; u += F.G) {
        const int c = u >> 2, h = u & 3; const bool lat = c >= 8; const int pr = (c - 8) & 127;
        f32x4 acc[2][4];
#pragma unroll
        for (int mt = 0; mt < 2; ++mt)
#pragma unroll
            for (int nt = 0; nt < 4; ++nt) acc[mt][nt] = (f32x4){0.f, 0.f, 0.f, 0.f};
        {
            const int i = F.tid & 63, grp = F.tid >> 6; const bf16* vp = P + (size_t)(64 * c + i) * PST + 1024 + h * 256 + grp * 32;
#pragma unroll
            for (int e = 0; e < 4; ++e) { const v4u x = *(const GAS v4u*)(vp + 8 * e);
#pragma unroll
                for (int q = 0; q < 4; ++q) { VT[(grp * 32 + 8 * e + 2 * q) * ST + i] = (bf16)(x[q] & 0xffffu); VT[(grp * 32 + 8 * e + 2 * q + 1) * ST + i] = (bf16)(x[q] >> 16); } }
        }
        for (int dir = 0; dir < 2; ++dir) {
            gla_cum(F, a, c, h, dir, cum, rt, tot);
            {
                const int i = F.tid & 63, grp = F.tid >> 6; const size_t row = (size_t)(64 * c + i);
                const bf16* qp = P + row * PST + h * 128; const bf16* kp = P + row * PST + 512 + h * 128;
#pragma unroll 4
                for (int e = 0; e < 16; ++e) { const int kk = grp * 16 + e; const float cm = cum[i * 128 + kk];
                    const float qv = rope_elem(qp, kk, pr, i, ROPE, lat) * 0.08838834764831845f, kv = rope_elem(kp, kk, pr, i, ROPE, lat);
                    QD[i * QST + kk] = (bf16)f2bf(qv * __expf(cm)); KI[i * QST + kk] = (bf16)f2bf(kv * __expf(-cm)); }
            }
            __syncthreads();
            {
                const int jt = F.wave >> 1;
#pragma unroll
                for (int t2 = 0; t2 < 2; ++t2) { const int it = 2 * (F.wave & 1) + t2; f32x4 s = (f32x4){0.f, 0.f, 0.f, 0.f};
#pragma unroll
                    for (int ks = 0; ks < 4; ++ks) { const bf16x8 af = *(const LAS bf16x8*)(KI + (16 * jt + fr) * QST + ks * 32 + fq * 8), bfr = *(const LAS bf16x8*)(QD + (16 * it + fr) * QST + ks * 32 + fq * 8); s = MFMA16(af, bfr, s); }
                    const int i = 16 * it + fr, j0 = 16 * jt + fq * 4; float pv[4];
#pragma unroll
                    for (int r = 0; r < 4; ++r) { const int j = j0 + r; const bool keep = dir == 0 ? (j <= i) : (j >= i); pv[r] = keep ? s[r] : 0.0f; }
                    v2u o; o.x = pk2(pv[0], pv[1]); o.y = pk2(pv[2], pv[3]);
                    *(LAS v2u*)(PL + i * ST + j0) = o; }
            }
            __syncthreads();
#pragma unroll
            for (int ks = 0; ks < 2; ++ks) {
                bf16x8 bfr[4];
#pragma unroll
                for (int nt = 0; nt < 4; ++nt) bfr[nt] = *(const LAS bf16x8*)(PL + (16 * nt + fr) * ST + ks * 32 + fq * 8);
#pragma unroll
                for (int mt = 0; mt < 2; ++mt) { const bf16x8 af = *(const LAS bf16x8*)(VT + (32 * F.wave + 16 * mt + fr) * ST + ks * 32 + fq * 8);
#pragma unroll
                    for (int nt = 0; nt < 4; ++nt) acc[mt][nt] = MFMA16(af, bfr[nt], acc[mt][nt]); } }
            const bf16* sp = SIN + ((size_t)(dir * 264 + c) * 4 + h) * 256 * 128;
#pragma unroll
            for (int ks = 0; ks < 4; ++ks) {
                bf16x8 bfr[4];
#pragma unroll
                for (int nt = 0; nt < 4; ++nt) bfr[nt] = *(const LAS bf16x8*)(QD + (16 * nt + fr) * QST + ks * 32 + fq * 8);
#pragma unroll
                for (int mt = 0; mt < 2; ++mt) { const bf16x8 af = *(const GAS bf16x8*)(sp + (size_t)(32 * F.wave + 16 * mt + fr) * 128 + ks * 32 + fq * 8);
#pragma unroll
                    for (int nt = 0; nt < 4; ++nt) acc[mt][nt] = MFMA16(af, bfr[nt], acc[mt][nt]); } }
            __syncthreads();
        }
#pragma unroll
        for (int nt = 0; nt < 4; ++nt) { float s = 0.f;
#pragma unroll
            for (int mt = 0; mt < 2; ++mt)
#pragma unroll
                for (int j = 0; j < 4; ++j) s += acc[mt][nt][j] * acc[mt][nt][j];
            s += __shfl_xor(s, 16); s += __shfl_xor(s, 32);
            if (fq == 0) ssq[F.wave * 64 + 16 * nt + fr] = s; }
        __syncthreads();
#pragma unroll
        for (int nt = 0; nt < 4; ++nt) { const int i = 16 * nt + fr; float s = 0.f;
#pragma unroll
            for (int w8 = 0; w8 < 8; ++w8) s += ssq[w8 * 64 + i];
            const float rstd = 1.0f / sqrtf(s * (1.0f / 256.0f) + EPS); const size_t row = (size_t)(64 * c + i);
#pragma unroll
            for (int mt = 0; mt < 2; ++mt) { const int v0 = 32 * F.wave + 16 * mt + fq * 4;
                const v2u gg = *(const GAS v2u*)(P + row * PST + 2048 + h * 256 + v0); const f32x4 go = *(const GAS f32x4*)(a.in[I_BGO] + v0);
                const float g0 = bflo(gg.x), g1 = bfhi(gg.x), g2 = bflo(gg.y), g3 = bfhi(gg.y);
                const float o0 = acc[mt][nt][0] * rstd * go.x * (g0 / (1.0f + __expf(-g0))), o1 = acc[mt][nt][1] * rstd * go.y * (g1 / (1.0f + __expf(-g1)));
                const float o2 = acc[mt][nt][2] * rstd * go.z * (g2 / (1.0f + __expf(-g2))), o3 = acc[mt][nt][3] * rstd * go.w * (g3 / (1.0f + __expf(-g3)));
                v2u o; o.x = pk2(o0, o1); o.y = pk2(o2, o3);
                *(GAS v2u*)(G + row * D + h * 256 + v0) = o; } }
        __syncthreads();
    }
}

__device__ __forceinline__ void p_natten(Frame& F, const Args& a) {
    const bf16* QKV = (const bf16*)(F.ws + WS_BIG); bf16* G = (bf16*)(F.ws + WS_G);
    constexpr int QS = 3072, VLS = 520, VCS = 264;
    LAS bf16* VTl = (LAS bf16*)(F.lds); LAS bf16* VTc = VTl + 64 * VLS; LAS float* RPB = (LAS float*)(VTc + 64 * VCS); LAS float* MRG = RPB + 480;
    const int fr = F.lane & 15, fq = F.lane >> 4;
    const int jb = F.wave >> 1, role = F.wave & 1;
    const int u_lo = (int)(((long)F.vcu * 4096) / F.G), u_hi = (int)(((long)(F.vcu + 1) * 4096) / F.G);
    int cur_bh = -1;
    for (int u = u_lo; u < u_hi; ++u) {
        const int bh = u >> 7, r = u & 127, b = bh >> 4, h = bh & 15;
        const int r0 = r < 4 ? 0 : (r > 124 ? 120 : r - 4);
        const size_t lat0 = (size_t)NCTX + (size_t)b * SEQ;
        __syncthreads();
        if (bh != cur_bh) {
            cur_bh = bh;
            for (int i = F.tid; i < 465; i += NTHREADS) RPB[i] = a.in[I_CRPB][h * 465 + i];
#pragma unroll
            for (int i = 0; i < 4; ++i) { const int id = F.tid + 512 * i, key = id >> 3, d8 = id & 7;
                const v4u x = *(const GAS v4u*)(QKV + (size_t)(b * CTXL + key) * QS + 2048 + h * 64 + 8 * d8);
#pragma unroll
                for (int q = 0; q < 4; ++q) { VTc[(8 * d8 + 2 * q) * VCS + key] = (bf16)(x[q] & 0xffffu); VTc[(8 * d8 + 2 * q + 1) * VCS + key] = (bf16)(x[q] >> 16); } }
        }
#pragma unroll
        for (int i = 0; i < 8; ++i) { const int id = F.tid + 512 * i, key = id >> 3, d8 = id & 7;
            const v4u x = *(const GAS v4u*)(QKV + (lat0 + (size_t)r0 * 64 + key) * QS + 2048 + h * 64 + 8 * d8);
#pragma unroll
            for (int q = 0; q < 4; ++q) { VTl[(8 * d8 + 2 * q) * VLS + key] = (bf16)(x[q] & 0xffffu); VTl[(8 * d8 + 2 * q + 1) * VLS + key] = (bf16)(x[q] >> 16); } }
        __syncthreads();
        const int bstart = jb == 0 ? 0 : (jb == 1 ? 8 : (jb == 2 ? 24 : 32));
        const int qcol = 16 * jb + fr; const int cstart = qcol < 8 ? 0 : (qcol > 56 ? 48 : qcol - 8);
        bf16x8 qf[2];
#pragma unroll
        for (int ks = 0; ks < 2; ++ks) qf[ks] = *(const GAS bf16x8*)(QKV + (lat0 + (size_t)r * 64 + qcol) * QS + h * 64 + ks * 32 + fq * 8);
        f32x4 s[16];
#pragma unroll
        for (int kt = 0; kt < 16; ++kt) {
            const bf16* kp = role == 0 ? QKV + (lat0 + (size_t)(r0 + (kt >> 1)) * 64 + bstart + 16 * (kt & 1) + fr) * QS + 1024 + h * 64
                                       : QKV + (size_t)(b * CTXL + 16 * kt + fr) * QS + 1024 + h * 64;
            f32x4 t = (f32x4){0.f, 0.f, 0.f, 0.f};
#pragma unroll
            for (int ks = 0; ks < 2; ++ks) { const bf16x8 kf = *(const GAS bf16x8*)(kp + ks * 32 + fq * 8); t = MFMA16(kf, qf[ks], t); }
            s[kt] = t;
        }
        float mx = -3.0e38f;
#pragma unroll
        for (int kt = 0; kt < 16; ++kt)
#pragma unroll
            for (int j = 0; j < 4; ++j) { float v = s[kt][j] * 0.125f;
                if (role == 0) { const int kcol = bstart + 16 * (kt & 1) + fq * 4 + j, krow = r0 + (kt >> 1);
                    const bool ok = kcol >= cstart && kcol < cstart + 16;
                    v = ok ? v + RPB[(krow - r + 7) * 31 + (kcol - qcol + 15)] : -3.0e38f; }
                s[kt][j] = v; mx = fmaxf(mx, v); }
        mx = fmaxf(mx, __shfl_xor(mx, 16)); mx = fmaxf(mx, __shfl_xor(mx, 32));
        float l = 0.f;
#pragma unroll
        for (int kt = 0; kt < 16; ++kt)
#pragma unroll
            for (int j = 0; j < 4; ++j) { const float p = s[kt][j] > -1.0e38f ? __expf(s[kt][j] - mx) : 0.0f; s[kt][j] = p; l += p; }
        l += __shfl_xor(l, 16); l += __shfl_xor(l, 32);
        f32x4 o[4];
#pragma unroll
        for (int dt = 0; dt < 4; ++dt) o[dt] = (f32x4){0.f, 0.f, 0.f, 0.f};
#pragma unroll
        for (int st = 0; st < 8; ++st) {
            v4u pw; pw.x = pk2(s[2 * st][0], s[2 * st][1]); pw.y = pk2(s[2 * st][2], s[2 * st][3]); pw.z = pk2(s[2 * st + 1][0], s[2 * st + 1][1]); pw.w = pk2(s[2 * st + 1][2], s[2 * st + 1][3]);
            const bf16x8 pf = __builtin_bit_cast(bf16x8, pw);
            const LAS bf16* vb = role == 0 ? VTl + st * 64 + bstart : VTc + 32 * st;
            const int vst = role == 0 ? VLS : VCS;
#pragma unroll
            for (int dt = 0; dt < 4; ++dt) { const LAS bf16* vp = vb + (16 * dt + fr) * vst + fq * 4;
                const v2u lo = *(const LAS v2u*)vp, hi = *(const LAS v2u*)(vp + 16);
                v4u vw; vw.x = lo.x; vw.y = lo.y; vw.z = hi.x; vw.w = hi.y;
                o[dt] = MFMA16(__builtin_bit_cast(bf16x8, vw), pf, o[dt]); }
        }
        if (role == 1) { LAS float* m = MRG + jb * 18 * 64; m[F.lane] = mx; m[64 + F.lane] = l;
#pragma unroll
            for (int dt = 0; dt < 4; ++dt)
#pragma unroll
                for (int j = 0; j < 4; ++j) m[(2 + dt * 4 + j) * 64 + F.lane] = o[dt][j]; }
        __syncthreads();
        if (role == 0) { const LAS float* m = MRG + jb * 18 * 64; const float m1 = m[F.lane], l1 = m[64 + F.lane];
            const float mm = fmaxf(mx, m1), a0 = __expf(mx - mm), a1 = __expf(m1 - mm); const float inv = 1.0f / (l * a0 + l1 * a1);
            bf16* op = G + (lat0 + (size_t)r * 64 + qcol) * D + h * 64 + fq * 4;
#pragma unroll
            for (int dt = 0; dt < 4; ++dt) { float v[4];
#pragma unroll
                for (int j = 0; j < 4; ++j) v[j] = (o[dt][j] * a0 + m[(2 + dt * 4 + j) * 64 + F.lane] * a1) * inv;
                v2u w; w.x = pk2(v[0], v[1]); w.y = pk2(v[2], v[3]);
                *(GAS v2u*)(op + 16 * dt) = w; } }
    }
}

#define IN(k) (lo <= (k) && (k) < hi)
#define SEAM(k) do { if (IN(k) && IN((k) + 1)) xcd_barrier(bar); else __syncthreads(); } while (0)
template <int LAYER> __device__ __forceinline__ void run_layer(Frame& F, const Args& args, const XcdBarrier& bar, const int lo, const int hi) {
    {
        constexpr int layer = LAYER; constexpr int kind = layer % 3, base = 1 + 10 * layer;
        constexpr int mt0 = (layer >= 3) ? 2 : 0;
        constexpr int mo0 = (layer >= 2) ? 2 : 0;
        if (IN(base + 0)) { p_prenorm(F, args, layer, false); } SEAM(base + 0);
        if (IN(base + 1)) {
            const bf16* A = (const bf16*)(F.ws + WS_H) + (size_t)mt0 * 256 * D; const int M = (66 - mt0) * 256;
            if constexpr (kind == 0) {
                pg8::Gemm g{A, (const bf16*)(F.ws + WS_WAIN) + (size_t)(layer / 3) * 2048 * 1024, M, 2048, D}; pg8::StaticOrder S; S.init(M, 2048, F.G, (int)blockIdx.x);
                pg8::EpiBf16<1> E{(bf16*)(F.ws + WS_BIG) + (size_t)mt0 * 256 * 2048, 2048, nullptr, 0};
                pg8::gemm_phase<pg8::EpiBf16<1>, pg8::StaticOrder>(F.lds + RING_OFF, g, S, E);
            } else {
                const int N = kind == 1 ? GLA_INP : 3072;
                pg8::Gemm g{A, (const bf16*)(F.ws + (kind == 1 ? WS_WBIN : WS_WCQKV)), M, N, D}; pg8::StaticOrder S; S.init(M, N, F.G, (int)blockIdx.x);
                pg8::EpiBf16<0> E{(bf16*)(F.ws + WS_BIG), N, nullptr, 0};
                pg8::gemm_phase<pg8::EpiBf16<0>, pg8::StaticOrder>(F.lds + RING_OFF, g, S, E);
            }
        }
        SEAM(base + 1);
        if (IN(base + 2)) { if constexpr (kind == 0) p_spatial(F, args, layer); else if constexpr (kind == 1) p_gla_ds(F, args); else p_natten(F, args); } SEAM(base + 2);
        if constexpr (kind == 1) { if (IN(base + 3)) { p_gla_scan(F); } SEAM(base + 3); }
        if constexpr (kind == 1) { if (IN(base + 4)) { p_gla_out(F, args); } SEAM(base + 4); }
        if (IN(base + 5)) {
            const int M = (66 - mo0) * 256;
            const bf16* Bt = (const bf16*)(F.ws + (kind == 0 ? WS_WAOUT : (kind == 1 ? WS_WBOUT : WS_WCOUT))) + (kind == 0 ? (size_t)(layer / 3) * 1024 * 1024 : 0);
            pg8::Gemm g{(const bf16*)(F.ws + WS_G) + (size_t)mo0 * 256 * D, Bt, M, D, D}; pg8::StaticOrder S; S.init(M, D, F.G, (int)blockIdx.x);
            pg8::EpiResid E{(float*)(F.ws + WS_X) + (size_t)mo0 * 256 * D, (const float*)(F.ws + WS_ADA) + (size_t)(layer * 3 * 6 + 2) * D, 6 * D, mo0};
            pg8::gemm_phase<pg8::EpiResid, pg8::StaticOrder>(F.lds + RING_OFF, g, S, E);
        }
        SEAM(base + 5);
        if (IN(base + 6)) { p_router(F, args, layer); } SEAM(base + 6);
        if (IN(base + 7)) { p_gather(F, layer); } SEAM(base + 7);
        if (IN(base + 8)) {
            moe_tables(F, layer);
            const LAS int* Mt = (const LAS int*)(F.lds + MISC_OFF); const int total = Mt[32];
            pg8::Gemm g{(const bf16*)(F.ws + WS_AS), (const bf16*)(F.ws + WS_WGU) + (size_t)layer * 32 * 2048 * 1024, total, 2048, D};
            pg8::GroupedOrder S; S.init(total, 2048, F.G, (int)blockIdx.x); S.tile_e = Mt + 64;
            pg8::EpiSwiglu E{(bf16*)(F.ws + WS_ACT), D, args.in[I_MBGU] + (size_t)layer * 32 * 2048, 2048};
            pg8::gemm_phase<pg8::EpiSwiglu, pg8::GroupedOrder>(F.lds + RING_OFF, g, S, E);
        }
        SEAM(base + 8);
        if (IN(base + 9)) {
            moe_tables(F, layer);
            const LAS int* Mt = (const LAS int*)(F.lds + MISC_OFF); const int total = Mt[32];
            pg8::Gemm g{(const bf16*)(F.ws + WS_ACT), (const bf16*)(F.ws + WS_WDN) + (size_t)layer * 32 * 1024 * 1024, total, D, D};
            pg8::GroupedOrder S; S.init(total, D, F.G, (int)blockIdx.x); S.tile_e = Mt + 64;
            pg8::EpiBf16<0> E{(bf16*)(F.ws + WS_YB), D, args.in[I_MBDN] + (size_t)layer * 32 * 1024, 1024};
            pg8::gemm_phase<pg8::EpiBf16<0>, pg8::GroupedOrder>(F.lds + RING_OFF, g, S, E);
        }
        SEAM(base + 9);
    }
}

__global__ void __launch_bounds__(NTHREADS, 2) fwd(Args args) {
    extern __shared__ __attribute__((aligned(16))) unsigned char lds[];
    Frame F;
    F.lds = (LAS unsigned char*)lds;
    F.tid = threadIdx.x; F.lane = F.tid & 63; F.wave = __builtin_amdgcn_readfirstlane(F.tid >> 6);
    F.G = gridDim.x; { const int bx = blockIdx.x; F.vcu = (F.G % 8 == 0) ? (bx % 8) * (F.G / 8) + bx / 8 : bx; }
    F.ws = args.ws; F.ctl = (unsigned*)(args.ws + WS_CTL);
    volatile LAS unsigned* BST = (volatile LAS unsigned*)(F.lds + LDS_BYTES - 16);
    if (F.tid < 4) BST[F.tid] = 0u;
    __syncthreads();
    const int lo = args.ph_lo, hi = args.ph_hi;
    XcdBarrier bar; bar.bar = (unsigned*)(F.ctl + CW_BAR); bar.x = 0; bar.st = BST;
    if (hi - lo > 1) bar = xcd_barrier_post((unsigned*)(F.ctl + CW_BAR), BST);
    if (IN(0)) { p_prologue(F, args); } SEAM(0);

    run_layer<0>(F, args, bar, lo, hi);
    run_layer<1>(F, args, bar, lo, hi);
    run_layer<2>(F, args, bar, lo, hi);
    run_layer<3>(F, args, bar, lo, hi);
    if (IN(41)) { p_prenorm(F, args, 4, true); }
#undef IN
#undef SEAM
}

extern "C" void kernel_launch(void* const* d_in, const int* in_sizes, int n_in, void* d_out, int out_size, void* d_ws, size_t ws_size, hipStream_t stream) {
    static int grid = 0;
    if (grid == 0) {
        if (n_in != 28 || out_size != NLAT * D || ws_size < WS_END) { fprintf(stderr, "kernel_launch: unexpected problem (n_in %d, out %d, ws %zu < %zu)\n", n_in, out_size, ws_size, (size_t)WS_END); grid = -1; return; }
        int dev = 0, cus = 0, per_cu = 0;
        if (hipGetDevice(&dev) != hipSuccess || hipDeviceGetAttribute(&cus, hipDeviceAttributeMultiprocessorCount, dev) != hipSuccess) { grid = -1; return; }
        if (hipFuncSetAttribute((const void*)fwd, hipFuncAttributeMaxDynamicSharedMemorySize, LDS_BYTES) != hipSuccess) { fprintf(stderr, "kernel_launch: hipFuncSetAttribute failed\n"); grid = -1; return; }
        if (hipOccupancyMaxActiveBlocksPerMultiprocessor(&per_cu, (const void*)fwd, NTHREADS, LDS_BYTES) != hipSuccess || per_cu < 1) { fprintf(stderr, "kernel_launch: occupancy query reports %d\n", per_cu); }
        (void)hipGetLastError();
        grid = cus;
    }
    if (grid < 0) return;
    (void)hipMemsetAsync((char*)d_ws + WS_CTL, 0, CTL_ZERO_BYTES, stream);
    Args a{};
    for (int i = 0; i < 28; ++i) a.in[i] = (const float*)d_in[i];
    a.out = (float*)d_out; a.ws = (unsigned char*)d_ws;
#if MK_ONE_LAUNCH
    a.ph_lo = 0; a.ph_hi = 42;
    hipLaunchKernelGGL(fwd, dim3(grid), dim3(NTHREADS), LDS_BYTES, stream, a);
#else
    for (int p = 0; p < 42; ++p) {
        if (p >= 1 && p <= 40) { const int layer = (p - 1) / 10, loc = (p - 1) % 10; if ((loc == 3 || loc == 4) && (layer % 3) != 1) continue; }
        a.ph_lo = p; a.ph_hi = p + 1;
        hipLaunchKernelGGL(fwd, dim3(grid), dim3(NTHREADS), LDS_BYTES, stream, a);
    }
#endif
}
```

```cpp
#include <hip/hip_runtime.h>
#include <cstdio>
#include <cstdint>

#ifndef MK_ONE_LAUNCH
#define MK_ONE_LAUNCH 1
#endif
#ifndef PROBE_PRO
#define PROBE_PRO 0
#endif
#ifndef PROBE_MOE
#define PROBE_MOE 0
#endif
#ifndef PROBE_ING
#define PROBE_ING 0
#endif
#ifndef PROBE_MIX
#define PROBE_MIX 0
#endif
#ifndef PROBE_GLA
#define PROBE_GLA 0
#endif
#ifndef PROBE_GATHER
#define PROBE_GATHER 0
#endif

namespace pg8 {
#define PG8_LAS __attribute__((address_space(3)))
typedef unsigned short bf16_t;
typedef short bf16x8 __attribute__((ext_vector_type(8)));
typedef float f32x4 __attribute__((ext_vector_type(4)));
typedef unsigned u32x4 __attribute__((ext_vector_type(4)));
constexpr int BM = 256, BK = 64, HALF = 128, HTB = HALF * BK * 2, STAGE_BYTES = 8 * HTB, NXCD = 8, WGM = 8;

__host__ __device__ __forceinline__ int lds_byte(int r, int c) { const int st = (r >> 4) * 2 + (c >> 5), rr = r & 15, cc = c & 31, ob = rr * 64 + cc * 2; return st * 1024 + (ob ^ (((ob >> 9) & 1) << 5)); }
__host__ __device__ __forceinline__ void stage_rc(int b, int& R, int& C) { const int st = b / 1024, sb = b % 1024, swz = sb ^ (((sb >> 9) & 1) << 5); R = (st >> 1) * 16 + swz / 64; C = (st & 1) * 32 + (swz % 64) / 2; }
__host__ __device__ __forceinline__ int perm32(int rho) { const int n = rho >> 4, i = rho & 15; return 8 * (i >> 2) + 4 * n + (i & 3); }

struct Unit { int pm, pn, pb, e; };
struct Gemm { const bf16_t* A; const bf16_t* Bt; int M, N, K; };

struct StaticOrder {
    int nM, nN, nwg, G, c;
    __device__ void init(int M, int N, int G_, int c_) { nM = M / BM; nN = N / BM; nwg = nM * nN; G = G_; c = c_; }
    __device__ bool next(int i, Unit& u) const {
        const long L = (long)i * G + c; if (L >= nwg) return false;
        int wgid = (int)L; { const int q = nwg / NXCD, r = nwg % NXCD, xcd = wgid % NXCD, off = wgid / NXCD; wgid = (xcd < r ? xcd * (q + 1) : r * (q + 1) + (xcd - r) * q) + off; }
        const int nig = WGM * nN, gid = wgid / nig, fm = gid * WGM, gsz = (nM - fm) < WGM ? (nM - fm) : WGM;
        u.pm = fm + ((wgid % nig) % gsz); u.pn = (wgid % nig) / gsz; u.pb = u.pn; u.e = 0; return true;
    }
};
struct GroupedOrder : StaticOrder {
    const PG8_LAS int* tile_e;
    __device__ bool next(int i, Unit& u) const {
        if (!StaticOrder::next(i, u)) return false;
        u.e = __builtin_amdgcn_readfirstlane(tile_e[u.pm]); u.pb = u.e * nN + u.pn; return true;
    }
};

__device__ __forceinline__ unsigned cvt_pk_bf16(float lo, float hi) { unsigned r; asm volatile("v_cvt_pk_bf16_f32 %0, %1, %2" : "=v"(r) : "v"(lo), "v"(hi)); return r; }
typedef float f32x2 __attribute__((ext_vector_type(2)));
__device__ __forceinline__ f32x2 gelu_pk(f32x2 v) {
    const f32x2 av = __builtin_elementwise_abs(v), d = av * 0.2316418882f + 1.0f;
    f32x2 t; t.x = __builtin_amdgcn_rcpf(d.x); t.y = __builtin_amdgcn_rcpf(d.y);
    f32x2 q = t * 0.5307027145f + (-0.7265760135f); q = q * t + 0.7107068705f; q = q * t + (-0.142248368f); q = q * t + 0.127414796f; q = q * t;
    const f32x2 s = (v * v) * (-0.72134752044f);
    f32x2 e; e.x = __builtin_amdgcn_exp2f(s.x); e.y = __builtin_amdgcn_exp2f(s.y);
    const f32x2 m = v * (q * e), r = v - m;
    f32x2 o; o.x = v.x < 0.f ? m.x : r.x; o.y = v.y < 0.f ? m.y : r.y; return o;
}

template <int ACT> struct EpiBf16 {
    static constexpr bool PERM = true;
    bf16_t* O; int ldc; const float* bias; int bias_estride;
    __device__ __forceinline__ void operator()(const f32x4 (&acc)[2][2][4][2], const Unit& u, int wr, int wc, int fr, int fq) const {
        const int row0 = u.pm * BM + wr * 64 + fr; const int col0 = u.pn * BM + wc * 32 + 8 * fq;
        const float* bp = bias ? bias + (size_t)u.e * bias_estride : nullptr;
        f32x4 bv[2][2];
#pragma unroll
        for (int bj = 0; bj < 2; ++bj)
#pragma unroll
            for (int n = 0; n < 2; ++n) bv[bj][n] = bp ? *(const f32x4*)(bp + col0 + bj * HALF + 4 * n) : (f32x4){0.f, 0.f, 0.f, 0.f};
#pragma unroll
        for (int ai = 0; ai < 2; ++ai)
#pragma unroll
            for (int m = 0; m < 4; ++m) { bf16_t* rowp = O + (size_t)(row0 + ai * HALF + m * 16) * ldc + col0;
#pragma unroll
                for (int bj = 0; bj < 2; ++bj) { f32x4 v0 = acc[ai][bj][m][0] + bv[bj][0], v1 = acc[ai][bj][m][1] + bv[bj][1];
                    if (ACT == 1) { f32x2 a = gelu_pk((f32x2){v0[0], v0[1]}), b = gelu_pk((f32x2){v0[2], v0[3]}), c = gelu_pk((f32x2){v1[0], v1[1]}), d = gelu_pk((f32x2){v1[2], v1[3]});
                        v0 = (f32x4){a.x, a.y, b.x, b.y}; v1 = (f32x4){c.x, c.y, d.x, d.y}; }
                    u32x4 w; w.x = cvt_pk_bf16(v0[0], v0[1]); w.y = cvt_pk_bf16(v0[2], v0[3]); w.z = cvt_pk_bf16(v1[0], v1[1]); w.w = cvt_pk_bf16(v1[2], v1[3]);
                    *(u32x4*)(rowp + bj * HALF) = w; } }
    }
};
struct EpiSwiglu {
    static constexpr bool PERM = true;
    bf16_t* O; int ldc; const float* bias; int bias_estride;
    __device__ __forceinline__ void operator()(const f32x4 (&acc)[2][2][4][2], const Unit& u, int wr, int wc, int fr, int fq) const {
        const int row0 = u.pm * BM + wr * 64 + fr; const int col0 = u.pn * HALF + wc * 32 + 8 * fq;
        const float* bp = bias + (size_t)u.e * bias_estride;
        f32x4 bg[2], bl[2];
#pragma unroll
        for (int n = 0; n < 2; ++n) { bg[n] = *(const f32x4*)(bp + col0 + 4 * n); bl[n] = *(const f32x4*)(bp + 1024 + col0 + 4 * n); }
#pragma unroll
        for (int ai = 0; ai < 2; ++ai)
#pragma unroll
            for (int m = 0; m < 4; ++m) { bf16_t* rowp = O + (size_t)(row0 + ai * HALF + m * 16) * ldc + col0;
                float o[8];
#pragma unroll
                for (int n = 0; n < 2; ++n) { const f32x4 g4 = acc[ai][0][m][n] + bg[n], l4 = acc[ai][1][m][n] + bl[n];
#pragma unroll
                    for (int i = 0; i < 4; ++i) { const float g = fminf(g4[i], 7.0f), l = fminf(fmaxf(l4[i], -7.0f), 7.0f);
                        const float sg = __builtin_amdgcn_rcpf(1.0f + __builtin_amdgcn_exp2f(-1.702f * 1.44269504089f * g));
                        o[4 * n + i] = g * sg * (l + 1.0f); } }
                u32x4 w; w.x = cvt_pk_bf16(o[0], o[1]); w.y = cvt_pk_bf16(o[2], o[3]); w.z = cvt_pk_bf16(o[4], o[5]); w.w = cvt_pk_bf16(o[6], o[7]);
                *(u32x4*)rowp = w; }
    }
};
struct EpiResid {
    static constexpr bool PERM = false;
    float* X; const float* gate; int gstride; int pm0;
    __device__ __forceinline__ void operator()(const f32x4 (&acc)[2][2][4][2], const Unit& u, int wr, int wc, int fr, int fq) const {
        const int t = u.pm + pm0; const int seg = t < 2 ? 0 : (t < 34 ? 1 : 2);
        const int row0 = u.pm * BM + wr * 64 + fr, col0 = u.pn * BM + wc * 32 + 4 * fq;
        const float* gp = gate + (size_t)seg * gstride;
        f32x4 gv[2][2];
#pragma unroll
        for (int bj = 0; bj < 2; ++bj)
#pragma unroll
            for (int n = 0; n < 2; ++n) gv[bj][n] = *(const f32x4*)(gp + col0 + bj * HALF + n * 16);
#pragma unroll
        for (int ai = 0; ai < 2; ++ai)
#pragma unroll
            for (int m = 0; m < 4; ++m) { float* rowp = X + (size_t)(row0 + ai * HALF + m * 16) * 1024 + col0;
#pragma unroll
                for (int bj = 0; bj < 2; ++bj)
#pragma unroll
                    for (int n = 0; n < 2; ++n) { f32x4* p = (f32x4*)(rowp + bj * HALF + n * 16); *p = *p + gv[bj][n] * acc[ai][bj][m][n]; } }
    }
};

template <class Epi, class Sched, bool GATHER = false>
__device__ __forceinline__ void gemm_phase(PG8_LAS unsigned char* lds, const Gemm g, const Sched& S, const Epi& E, const unsigned* glist = nullptr, const PG8_LAS int* gM = nullptr, int gstride = 0) {
    const int tid = threadIdx.x, wid = __builtin_amdgcn_readfirstlane(tid >> 6), lane = tid & 63, wr = wid >> 2, wc = wid & 3, fr = lane & 15, fq = lane >> 4;
    const int K = g.K, nt = K / BK;
    unsigned voffB[2], va[2][2], vn[2][2]; int aR[2], aC[2];
#pragma unroll
    for (int i = 0; i < 2; ++i) { int R, C; stage_rc(tid * 16 + i * 8192, R, C); const int Rb = Epi::PERM ? ((R & ~31) + perm32(R & 31)) : R;
        aR[i] = R; aC[i] = C; voffB[i] = (unsigned)(Rb * K + C) * 2u;
#pragma unroll
        for (int h = 0; h < 2; ++h) { va[h][i] = (unsigned)((HALF * h + R) * K + C) * 2u; vn[h][i] = va[h][i]; } }
#define PG8_GOFF(u, dst) do { if constexpr (GATHER) { const int _e = (u).e, _p0 = (u).pm * BM - gM[_e], _c1 = gM[400 + _e] - 1; _Pragma("unroll") for (int _h = 0; _h < 2; ++_h) _Pragma("unroll") for (int _i = 0; _i < 2; ++_i) { \
        int _rk = _p0 + HALF * _h + aR[_i]; _rk = _rk < _c1 ? _rk : _c1; const unsigned _tok = glist[(size_t)_e * gstride + _rk]; dst[_h][_i] = (_tok * (unsigned)K + (unsigned)aC[_i]) * 2u; } } } while (0)
    const size_t kstep = (size_t)(BK * 2);
    const size_t hstep = (size_t)HALF * K * 2;
    const size_t tstep = 2 * hstep;
    const unsigned ldsw = (unsigned)wid * 1024u;
    const int aoff = lds_byte(wr * 64 + fr, fq * 8), boff = lds_byte(wc * 32 + fr, fq * 8);
#define PG8_SA(b, h) (((b) * 2 + (h)) * HTB)
#define PG8_SB(b, h) ((4 + (b) * 2 + (h)) * HTB)
#define PG8_STAGE(bufoff, gbase, voff) do { _Pragma("unroll") for (int _i = 0; _i < 2; ++_i) \
        __builtin_amdgcn_global_load_lds((const unsigned*)((const char*)(gbase) + (voff)[_i]), (PG8_LAS unsigned*)(lds + (bufoff) + ldsw + _i * 8192), 16, 0, 0); } while (0)
#define PG8_LDA(dst, b, h) do { _Pragma("unroll") for (int m = 0; m < 4; ++m) _Pragma("unroll") for (int k = 0; k < 2; ++k) dst[m][k] = *(const PG8_LAS bf16x8*)(lds + PG8_SA(b, h) + aoff + m * 2048 + k * 1024); } while (0)
#define PG8_LDB(dst, b, h) do { _Pragma("unroll") for (int n = 0; n < 2; ++n) _Pragma("unroll") for (int k = 0; k < 2; ++k) dst[n][k] = *(const PG8_LAS bf16x8*)(lds + PG8_SB(b, h) + boff + n * 2048 + k * 1024); } while (0)
#define PG8_MMA(ai, bj, At, Bt) do { __builtin_amdgcn_s_setprio(1); _Pragma("unroll") for (int m = 0; m < 4; ++m) _Pragma("unroll") for (int n = 0; n < 2; ++n) _Pragma("unroll") for (int k = 0; k < 2; ++k) \
        acc[ai][bj][m][n] = __builtin_amdgcn_mfma_f32_16x16x32_bf16(Bt[n][k], At[m][k], acc[ai][bj][m][n], 0, 0, 0); __builtin_amdgcn_s_setprio(0); } while (0)
#define PG8_WAIT_V(n) asm volatile("s_waitcnt vmcnt(" #n ")" ::: "memory")
#define PG8_WAIT_L(n) asm volatile("s_waitcnt lgkmcnt(" #n ")" ::: "memory")
#define PG8_BAR __builtin_amdgcn_s_barrier()
#define PG8_SCHED __builtin_amdgcn_sched_barrier(0)
    Unit cur, nxt; int ui = 0;
    if (!S.next(0, cur)) return;
    f32x4 acc[2][2][4][2];
#pragma unroll
    for (int a = 0; a < 2; ++a)
#pragma unroll
        for (int b = 0; b < 2; ++b)
#pragma unroll
            for (int m = 0; m < 4; ++m)
#pragma unroll
                for (int n = 0; n < 2; ++n) acc[a][b][m][n] = (f32x4){0.f, 0.f, 0.f, 0.f};
    bf16x8 At[4][2], B0[2][2], B1[2][2];
    const char* cA = (const char*)g.A + (GATHER ? (size_t)0 : (size_t)cur.pm * tstep); const char* cB = (const char*)g.Bt + (size_t)cur.pb * tstep;
    PG8_GOFF(cur, va);
    PG8_STAGE(PG8_SB(0, 0), cB, voffB); PG8_STAGE(PG8_SB(0, 1), cB + hstep, voffB); PG8_STAGE(PG8_SA(0, 0), cA, va[0]); PG8_STAGE(PG8_SA(0, 1), cA, va[1]);
    if (wr == 1) PG8_BAR;
    PG8_WAIT_V(2); PG8_BAR;
    PG8_STAGE(PG8_SB(1, 0), cB + kstep, voffB); PG8_STAGE(PG8_SA(1, 0), cA + kstep, va[0]); PG8_STAGE(PG8_SB(1, 1), cB + hstep + kstep, voffB);
    PG8_WAIT_V(6); PG8_BAR;
    for (;;) {
        const bool has_next = S.next(ui + 1, nxt);
        const char* nA = (has_next && !GATHER) ? (const char*)g.A + (size_t)nxt.pm * tstep : cA; const char* nB = has_next ? (const char*)g.Bt + (size_t)nxt.pb * tstep : cB;
        if constexpr (GATHER) { if (has_next) PG8_GOFF(nxt, vn); else { vn[0][0] = va[0][0]; vn[0][1] = va[0][1]; vn[1][0] = va[1][0]; vn[1][1] = va[1][1]; } }
        for (int t = 0; t < nt; t += 2) {
            const bool last = (t == nt - 2);
            const char* a1 = cA + (size_t)(t + 1) * kstep;
            const char* a2 = last ? nA : cA + (size_t)(t + 2) * kstep; const char* b2 = last ? nB : cB + (size_t)(t + 2) * kstep;
            const char* a3 = a2 + kstep; const char* b3 = b2 + kstep;
            unsigned v2[2][2];
#pragma unroll
            for (int _h = 0; _h < 2; ++_h)
#pragma unroll
                for (int _i = 0; _i < 2; ++_i) v2[_h][_i] = (GATHER && last) ? vn[_h][_i] : va[_h][_i];
            PG8_LDB(B0, 0, 0); PG8_LDB(B1, 0, 1); PG8_SCHED; PG8_LDA(At, 0, 0); PG8_STAGE(PG8_SA(1, 1), a1, va[1]);
            PG8_WAIT_V(8); PG8_WAIT_L(0); PG8_BAR; PG8_MMA(0, 0, At, B0); PG8_MMA(0, 1, At, B1); PG8_BAR; PG8_SCHED;
            PG8_LDA(At, 0, 1); PG8_STAGE(PG8_SB(0, 0), b2, voffB); PG8_STAGE(PG8_SB(0, 1), b2 + hstep, voffB); PG8_STAGE(PG8_SA(0, 0), a2, v2[0]);
            PG8_WAIT_V(8); PG8_WAIT_L(0); PG8_BAR; PG8_MMA(1, 0, At, B0); PG8_MMA(1, 1, At, B1); PG8_BAR; PG8_SCHED;
            PG8_LDB(B0, 1, 0); PG8_LDB(B1, 1, 1); PG8_SCHED; PG8_LDA(At, 1, 0); PG8_STAGE(PG8_SA(0, 1), a2, v2[1]);
            PG8_WAIT_V(8); PG8_WAIT_L(0); PG8_BAR; PG8_MMA(0, 0, At, B0); PG8_MMA(0, 1, At, B1); PG8_BAR; PG8_SCHED;
            PG8_LDA(At, 1, 1); PG8_STAGE(PG8_SB(1, 0), b3, voffB); PG8_STAGE(PG8_SB(1, 1), b3 + hstep, voffB); PG8_STAGE(PG8_SA(1, 0), a3, v2[0]);
            PG8_WAIT_V(8); PG8_WAIT_L(0); PG8_BAR; PG8_MMA(1, 0, At, B0); PG8_MMA(1, 1, At, B1); PG8_BAR; PG8_SCHED;
        }
        if (wr == 0) PG8_BAR;
        E(acc, cur, wr, wc, fr, fq);
        if (!has_next) break;
#pragma unroll
        for (int a = 0; a < 2; ++a)
#pragma unroll
            for (int b = 0; b < 2; ++b)
#pragma unroll
                for (int m = 0; m < 4; ++m)
#pragma unroll
                    for (int n = 0; n < 2; ++n) acc[a][b][m][n] = (f32x4){0.f, 0.f, 0.f, 0.f};
        cur = nxt; cA = nA; cB = nB; ++ui;
        if constexpr (GATHER) { va[0][0] = vn[0][0]; va[0][1] = vn[0][1]; va[1][0] = vn[1][0]; va[1][1] = vn[1][1]; }
        if (wr == 1) PG8_BAR;
    }
    PG8_WAIT_V(0);
    PG8_BAR;
#undef PG8_SA
#undef PG8_SB
#undef PG8_STAGE
#undef PG8_GOFF
#undef PG8_LDA
#undef PG8_LDB
#undef PG8_MMA
#undef PG8_WAIT_V
#undef PG8_WAIT_L
#undef PG8_BAR
#undef PG8_SCHED
}
}

constexpr int NWAVES = 8, NTHREADS = 512;
constexpr int D = 1024, NCTX = 512, NLAT = 16384, NTOK = NCTX + NLAT, SEQ = 8192, CTXL = 256;
constexpr int NEXP = 32, MAXPADROWS = 75776, MAXPADTILES = 296;
constexpr int GLA_IN = 3104, GLA_INP = 3328;
constexpr float EPS = 1e-6f;

constexpr size_t MiB = 1u << 20;
constexpr size_t WS_CTL = 0, CTL_ZERO_BYTES = 1 * MiB;
constexpr size_t WS_ADA = 1 * MiB;
constexpr size_t WS_ROPE = 1 * MiB + 512 * 1024;
constexpr size_t WS_TOKI = 2 * MiB;
constexpr size_t WS_TOKG = 2 * MiB + 512 * 1024;
constexpr size_t WS_LIST = 3 * MiB;
constexpr size_t WS_WRH = 6 * MiB, WS_WRL = 6 * MiB + 256 * 1024;
constexpr size_t WS_WSB = 7 * MiB;
constexpr size_t WS_WAIN = 8 * MiB;
constexpr size_t WS_WAOUT = 16 * MiB;
constexpr size_t WS_WBIN = 20 * MiB;
constexpr size_t WS_WBOUT = 27 * MiB;
constexpr size_t WS_WCQKV = 29 * MiB;
constexpr size_t WS_WCOUT = 35 * MiB;
constexpr size_t WS_WGU = 64 * MiB;
constexpr size_t WS_WDN = 576 * MiB;
constexpr size_t WS_X = 832 * MiB;
constexpr size_t WS_H = 898 * MiB;
constexpr size_t WS_G = 931 * MiB;
constexpr size_t WS_BIG = 964 * MiB;
constexpr size_t WS_DS = 1072 * MiB;
constexpr size_t WS_SIN = 1204 * MiB;
constexpr size_t WS_DEC = 1336 * MiB;
constexpr size_t WS_AS = 1338 * MiB;
constexpr size_t WS_ACT = 1486 * MiB;
constexpr size_t WS_YB = 1634 * MiB;
constexpr size_t WS_END = 1782 * MiB;
constexpr int CW_TMO = 0;
constexpr int CW_BAR = 4096;
constexpr int CW_CNT = 8192;

constexpr int RING_OFF = 0, RING_BYTES = 131072;
constexpr int MISC_OFF = RING_BYTES;
constexpr int LDS_BYTES = 147456;

#define GAS __attribute__((address_space(1)))
#define LAS __attribute__((address_space(3)))
typedef unsigned short bf16;
typedef unsigned v4u __attribute__((ext_vector_type(4)));
typedef unsigned v2u __attribute__((ext_vector_type(2)));
typedef float f32x4 __attribute__((ext_vector_type(4)));
typedef short bf16x8 __attribute__((ext_vector_type(8)));
typedef short bf16x4 __attribute__((ext_vector_type(4)));
#define LDS_WAIT() asm volatile("s_waitcnt lgkmcnt(0)" ::: "memory")
#define VM_WAIT() asm volatile("s_waitcnt vmcnt(0)" ::: "memory")
__device__ __forceinline__ unsigned f2bf(float f) { unsigned u = __builtin_bit_cast(unsigned, f); return (u + 0x7fffu + ((u >> 16) & 1u)) >> 16; }
__device__ __forceinline__ unsigned pk2(float lo, float hi) { return f2bf(lo) | (f2bf(hi) << 16); }
__device__ __forceinline__ float bf2f(unsigned b) { return __builtin_bit_cast(float, b << 16); }
__device__ __forceinline__ float bflo(unsigned w) { return __builtin_bit_cast(float, w << 16); }
__device__ __forceinline__ float bfhi(unsigned w) { return __builtin_bit_cast(float, w & 0xffff0000u); }
#define MFMA16(a, b, c) __builtin_amdgcn_mfma_f32_16x16x32_bf16((a), (b), (c), 0, 0, 0)

#define XB_TMO      128
#define XB_XCNT(j)  (256  + 64 * (j))
#define XB_XSUB(j)  (1280 + 64 * (j))
#define XB_XGEN(j)  (2304 + 64 * (j))
#define XB_TOP      3328
#define XB_TOPGEN   3392
#define XCD_BAR_WORDS 3456
#define XB_SPIN_CAP (1u << 22)

__device__ __forceinline__ unsigned xb_ld(unsigned* p)              { return __hip_atomic_load(p, __ATOMIC_RELAXED, __HIP_MEMORY_SCOPE_AGENT); }
__device__ __forceinline__ unsigned xb_add(unsigned* p, unsigned v) { return __hip_atomic_fetch_add(p, v, __ATOMIC_RELAXED, __HIP_MEMORY_SCOPE_AGENT); }
__device__ __forceinline__ unsigned xb_xcc_id() { return (unsigned)__builtin_amdgcn_s_getreg((3 << 11) | 20) & 0xFu; }
#define XB_SPIN(cond, bar) do { unsigned _sp = 0; while (cond) { __builtin_amdgcn_s_sleep(1); \
    if ((++_sp & 255u) == 0u) { if (xb_ld(&(bar)[XB_TMO])) break; if (_sp > XB_SPIN_CAP) { atomicAdd(&(bar)[XB_TMO], 1u); break; } } } } while (0)

struct XcdBarrier { unsigned* bar; unsigned x; volatile LAS unsigned* st; };
__device__ __forceinline__ XcdBarrier xcd_barrier_post(unsigned* bar, volatile LAS unsigned* st) {
    XcdBarrier b; b.bar = bar; b.x = xb_xcc_id(); b.st = st;
    if (threadIdx.x == 0) (void)xb_add(&bar[XB_XCNT(b.x)], 1u);
    return b;
}
__device__ __forceinline__ void xcd_barrier_complete(unsigned* bar, unsigned x, unsigned& nloc, unsigned& nx) {
    const unsigned G = gridDim.x * gridDim.y * gridDim.z;
    unsigned sum, cnt, mine, sp = 0u;
    for (;;) {
        sum = 0u; cnt = 0u; mine = 0u;
#pragma unroll
        for (unsigned j = 0; j < 16; ++j) { const unsigned c = xb_ld(&bar[XB_XCNT(j)]); sum += c; cnt += (c > 0u) ? 1u : 0u; mine = (j == x) ? c : mine; }
        if (sum == G) break;
        __builtin_amdgcn_s_sleep(1);
        if ((++sp & 255u) == 0u) { if (xb_ld(&bar[XB_TMO])) break; if (sp > XB_SPIN_CAP) { atomicAdd(&bar[XB_TMO], 1u); break; } }
    }
    nloc = mine > 0u ? mine : 1u; nx = cnt > 0u ? cnt : 1u;
}
__device__ __forceinline__ void xcd_barrier(const XcdBarrier& b) {
    asm volatile("s_waitcnt vmcnt(0)" ::: "memory");
    __syncthreads();
    if (threadIdx.x == 0) {
        unsigned* bar = b.bar;
        __builtin_amdgcn_s_waitcnt(0);
        unsigned nloc = b.st[0], nx = b.st[1];
        if (nloc == 0u) { xcd_barrier_complete(bar, b.x, nloc, nx); b.st[0] = nloc; b.st[1] = nx; }
        const unsigned old = xb_add(&bar[XB_XSUB(b.x)], 1u);
        const unsigned gen = old / nloc;
        if (old + 1u == (gen + 1u) * nloc) {
            __builtin_amdgcn_fence(__ATOMIC_RELEASE, "agent");
            asm volatile("s_waitcnt vmcnt(0)" ::: "memory");
            const unsigned og = xb_add(&bar[XB_TOP], 1u);
            const unsigned tg = og / nx;
            if (og + 1u == (tg + 1u) * nx) xb_add(&bar[XB_TOPGEN], 1u);
            else XB_SPIN(xb_ld(&bar[XB_TOPGEN]) == tg, bar);
            __builtin_amdgcn_fence(__ATOMIC_ACQUIRE, "agent");
            xb_add(&bar[XB_XGEN(b.x)], 1u);
            asm volatile("s_waitcnt vmcnt(0)" ::: "memory");
        } else {
            XB_SPIN(xb_ld(&bar[XB_XGEN(b.x)]) == gen, bar);
            __builtin_amdgcn_fence(__ATOMIC_ACQUIRE, "agent");
            asm volatile("s_waitcnt vmcnt(0)" ::: "memory");
        }
    }
    __syncthreads();
}

struct Args { const float* in[28]; float* out; unsigned char* ws; int ph_lo, ph_hi; };
enum { I_X = 0, I_C, I_CTX, I_CCTX, I_ADAW, I_ADAB, I_NMIX, I_NFFN, I_NOUT, I_AWIN, I_AGV, I_AWS, I_ABS, I_AWOUT, I_BWIN, I_BWA2, I_BBA, I_BGO, I_BWOUT,
       I_CWQKV, I_CRPB, I_CWOUT, I_MWR, I_MBR, I_MWGU, I_MBGU, I_MWDN, I_MBDN };

struct Frame {
    LAS unsigned char* lds;
    unsigned* ctl;
    unsigned char* ws;
    int tid, lane, wave, vcu, G;
};

__device__ __forceinline__ float wave_sum(float v) {
#pragma unroll
    for (int o = 1; o < 64; o <<= 1) v += __shfl_xor(v, o);
    return v;
}
__device__ __forceinline__ int seg_of_row(int r) { return r < NCTX ? 0 : 1 + ((r - NCTX) >> 13); }

__device__ __forceinline__ void transpose_item64(const float* W, int N, int k0, int n0, bf16* WT, int K, int dst_row0, int ncols_valid, LAS float* scr, int lane) {
#pragma unroll 4
    for (int i = 0; i < 16; ++i) { const int row = 4 * i + (lane >> 4), c4 = (lane & 15) * 4;
        f32x4 v = (f32x4){0.f, 0.f, 0.f, 0.f};
        if (c4 < ncols_valid) v = *(const GAS f32x4*)(W + (size_t)(k0 + row) * N + n0 + c4);
        LAS float* s = scr + row * 65 + c4; s[0] = v.x; s[1] = v.y; s[2] = v.z; s[3] = v.w; }
    LDS_WAIT(); asm volatile("" ::: "memory");
    const int c = lane & 7;
#pragma unroll
    for (int j = 0; j < 8; ++j) { const int n = (lane >> 3) + 8 * j; const LAS float* s = scr + (8 * c) * 65 + n;
        v4u o; o.x = pk2(s[0 * 65], s[1 * 65]); o.y = pk2(s[2 * 65], s[3 * 65]); o.z = pk2(s[4 * 65], s[5 * 65]); o.w = pk2(s[6 * 65], s[7 * 65]);
        *(GAS v4u*)(WT + (size_t)(dst_row0 + n) * K + k0 + 8 * c) = o; }
    LDS_WAIT(); asm volatile("" ::: "memory");
}

__device__ __forceinline__ void p_prologue(Frame& F, const Args& a) {
    LAS float* scr = (LAS float*)(F.lds + F.wave * 16640);
    const int gw = F.vcu * NWAVES + F.wave, NGW = F.G * NWAVES;
    {
        constexpr int KB = 16;
        constexpr int I0 = 2 * KB * 32, I1 = 2 * KB * 16, I2 = KB * 52, I3 = KB * 16, I4 = KB * 48, I5 = KB * 16;
        constexpr int NI = I0 + I1 + I2 + I3 + I4 + I5;
        for (int it = gw; it < NI; it += NGW) {
            int r = it;
            if (r < I0) { const int j = r / (KB * 32), q = r % (KB * 32), kb = q / 32, nb = q % 32;
                transpose_item64(a.in[I_AWIN] + (size_t)j * 1024 * 2048, 2048, 64 * kb, 64 * nb, (bf16*)(F.ws + WS_WAIN) + (size_t)j * 2048 * 1024, 1024, 64 * nb, 64, scr, F.lane); continue; } r -= I0;
            if (r < I1) { const int j = r / (KB * 16), q = r % (KB * 16), kb = q / 16, nb = q % 16;
                transpose_item64(a.in[I_AWOUT] + (size_t)j * 1024 * 1024, 1024, 64 * kb, 64 * nb, (bf16*)(F.ws + WS_WAOUT) + (size_t)j * 1024 * 1024, 1024, 64 * nb, 64, scr, F.lane); continue; } r -= I1;
            if (r < I2) { const int kb = r / 52, nb = r % 52; const int nv = GLA_IN - 64 * nb;
                transpose_item64(a.in[I_BWIN], GLA_IN, 64 * kb, 64 * nb, (bf16*)(F.ws + WS_WBIN), 1024, 64 * nb, nv < 0 ? 0 : (nv > 64 ? 64 : nv), scr, F.lane); continue; } r -= I2;
            if (r < I3) { const int kb = r / 16, nb = r % 16;
                transpose_item64(a.in[I_BWOUT], 1024, 64 * kb, 64 * nb, (bf16*)(F.ws + WS_WBOUT), 1024, 64 * nb, 64, scr, F.lane); continue; } r -= I3;
            if (r < I4) { const int kb = r / 48, nb = r % 48;
                transpose_item64(a.in[I_CWQKV], 3072, 64 * kb, 64 * nb, (bf16*)(F.ws + WS_WCQKV), 1024, 64 * nb, 64, scr, F.lane); continue; } r -= I4;
            { const int kb = r / 16, nb = r % 16;
                transpose_item64(a.in[I_CWOUT], 1024, 64 * kb, 64 * nb, (bf16*)(F.ws + WS_WCOUT), 1024, 64 * nb, 64, scr, F.lane); }
        }
    }
    {
        constexpr int KB = 16, PER_GU = KB * 32, PER_DN = KB * 16, NGU = 128 * PER_GU, NDN = 128 * PER_DN;
        for (int it = gw; it < NGU + NDN; it += NGW) {
            if (it < NGU) { const int le = it / PER_GU, q = it % PER_GU, kb = q / 32, nb = q % 32;
                const int n0 = 64 * nb, half = n0 >> 10, jj = n0 & 1023, dst = (jj >> 7) * 256 + half * 128 + (jj & 127);
                transpose_item64(a.in[I_MWGU] + (size_t)le * 1024 * 2048, 2048, 64 * kb, n0, (bf16*)(F.ws + WS_WGU) + (size_t)le * 2048 * 1024, 1024, dst, 64, scr, F.lane); }
            else { const int r = it - NGU, le = r / PER_DN, q = r % PER_DN, kb = q / 16, nb = q % 16;
                transpose_item64(a.in[I_MWDN] + (size_t)le * 1024 * 1024, 1024, 64 * kb, 64 * nb, (bf16*)(F.ws + WS_WDN) + (size_t)le * 1024 * 1024, 1024, 64 * nb, 64, scr, F.lane); }
        }
    }
    const int gt = F.vcu * NTHREADS + F.tid, NGT = F.G * NTHREADS;
    for (int i = gt; i < 2 * 8 * 128 * 128; i += NGT) ((bf16*)(F.ws + WS_WSB))[i] = (bf16)f2bf(a.in[I_AWS][i]);
    for (int i = gt; i < 4 * 32 * 1024; i += NGT) { const int l = i >> 15, e = (i >> 10) & 31, k = i & 1023;
        const float w = a.in[I_MWR][((size_t)l * 1024 + k) * 32 + e]; const unsigned h = f2bf(w); const float rem = w - bf2f(h);
        ((bf16*)(F.ws + WS_WRH))[i] = (bf16)h; ((bf16*)(F.ws + WS_WRL))[i] = (bf16)f2bf(rem); }
    for (int i = gt; i < 128 * 32; i += NGT) { const int pos = i >> 5, f = i & 31;
        const float fr = powf(10000.0f, -(float)f / 32.0f); const float ang = (float)pos * fr; float sn, cs; sincosf(ang, &sn, &cs);
        ((float*)(F.ws + WS_ROPE))[2 * i] = cs; ((float*)(F.ws + WS_ROPE))[2 * i + 1] = sn; }
    {
        __syncthreads();
        LAS float* sv = (LAS float*)(F.lds);
        LAS float* red = sv + 3 * 1024;
        for (int i = F.tid; i < 3 * 1024; i += NTHREADS) { const int s = i >> 10, k = i & 1023;
            const float v = s == 0 ? a.in[I_CCTX][k] : a.in[I_C][(s - 1) * 1024 + k]; sv[i] = v / (1.0f + __expf(-v)); }
        __syncthreads();
        for (int u = F.vcu; u < 4 * 96; u += F.G) { const int l = u / 96, n0 = (u % 96) * 64;
            const float* w = a.in[I_ADAW] + (size_t)l * 1024 * 6144 + n0 + F.lane;
            float a0 = 0.f, a1 = 0.f, a2 = 0.f;
#pragma unroll 8
            for (int kk = 0; kk < 128; ++kk) { const int k = F.wave * 128 + kk; const float wv = w[(size_t)k * 6144];
                a0 += sv[k] * wv; a1 += sv[1024 + k] * wv; a2 += sv[2048 + k] * wv; }
            red[(F.wave * 3 + 0) * 64 + F.lane] = a0; red[(F.wave * 3 + 1) * 64 + F.lane] = a1; red[(F.wave * 3 + 2) * 64 + F.lane] = a2;
            __syncthreads();
            if (F.tid < 192) { const int s = F.tid >> 6, c = F.tid & 63; float t = a.in[I_ADAB][l * 6144 + n0 + c];
#pragma unroll
                for (int w8 = 0; w8 < 8; ++w8) t += red[(w8 * 3 + s) * 64 + c];
                ((float*)(F.ws + WS_ADA))[(size_t)(l * 3 + s) * 6144 + n0 + c] = t; }
            __syncthreads();
        }
    }
}

__device__ __forceinline__ void moe_tables(Frame& F, int layer) {
    LAS int* M = (LAS int*)(F.lds + MISC_OFF);
    __syncthreads();
    if (F.tid < 32) M[400 + F.tid] = (int)__hip_atomic_load(F.ctl + CW_CNT + (layer * 32 + F.tid) * 64, __ATOMIC_RELAXED, __HIP_MEMORY_SCOPE_AGENT);
    __syncthreads();
    if (F.tid == 0) { int off = 0; for (int e = 0; e < 32; ++e) { M[e] = off; const int nt = (M[400 + e] + 255) >> 8; for (int t = 0; t < nt; ++t) M[64 + (off >> 8) + t] = e; off += nt << 8; } M[32] = off; }
    __syncthreads();
}

__device__ __forceinline__ void p_prenorm(Frame& F, const Args& a, int layer, bool fin) {
    const int gw = F.vcu * NWAVES + F.wave, NGW = F.G * NWAVES;
    const int prev = layer - 1;
    const int row_lo = (layer >= 3) ? NCTX : 0;
    const bool combine = layer > 0;
    if (combine) moe_tables(F, prev);
    const LAS int* M = (const LAS int*)(F.lds + MISC_OFF);
    float* X = (float*)(F.ws + WS_X); bf16* H = (bf16*)(F.ws + WS_H);
    const bf16* YB = (const bf16*)(F.ws + WS_YB);
    const float* ada = (const float*)(F.ws + WS_ADA);
    const v4u* TOKI = (const v4u*)(F.ws + WS_TOKI); const f32x4* TOKG = (const f32x4*)(F.ws + WS_TOKG);
    for (int row = row_lo + gw; row < NTOK; row += NGW) {
        const int seg = seg_of_row(row);
        const float* src = layer == 0 ? (row < NCTX ? a.in[I_CTX] + (size_t)row * D : a.in[I_X] + (size_t)(row - NCTX) * D) : X + (size_t)row * D;
        f32x4 v[4];
#pragma unroll
        for (int j = 0; j < 4; ++j) v[j] = *(const GAS f32x4*)(src + 4 * F.lane + 256 * j);
        if (combine) {
            const v4u ti = TOKI[row]; const f32x4 tg = TOKG[row];
            f32x4 acc[4];
#pragma unroll
            for (int j = 0; j < 4; ++j) acc[j] = (f32x4){0.f, 0.f, 0.f, 0.f};
#pragma unroll
            for (int k = 0; k < 4; ++k) { const unsigned t = ti[k]; const int pos = M[t >> 16] + (int)(t & 0xffffu); const float g = tg[k];
                const bf16* yr = YB + (size_t)pos * D + 4 * F.lane;
#pragma unroll
                for (int j = 0; j < 4; ++j) { const v2u y = *(const GAS v2u*)(yr + 256 * j);
                    acc[j].x += g * bflo(y.x); acc[j].y += g * bfhi(y.x); acc[j].z += g * bflo(y.y); acc[j].w += g * bfhi(y.y); } }
            const float* g5 = ada + (size_t)((prev * 3 + seg) * 6 + 5) * D;
#pragma unroll
            for (int j = 0; j < 4; ++j) { const f32x4 gg = *(const GAS f32x4*)(g5 + 4 * F.lane + 256 * j); v[j] = v[j] + gg * acc[j]; }
        }
        if (!fin && (combine || layer == 0)) {
#pragma unroll
            for (int j = 0; j < 4; ++j) *(GAS f32x4*)(X + (size_t)row * D + 4 * F.lane + 256 * j) = v[j];
        }
        float ss = 0.f;
#pragma unroll
        for (int j = 0; j < 4; ++j) ss += (v[j].x * v[j].x + v[j].y * v[j].y) + (v[j].z * v[j].z + v[j].w * v[j].w);
        const float rstd = 1.0f / sqrtf(wave_sum(ss) * (1.0f / D) + EPS);
        if (fin) {
            float* o = a.out + (size_t)(row - NCTX) * D;
#pragma unroll
            for (int j = 0; j < 4; ++j) { const f32x4 g = *(const GAS f32x4*)(a.in[I_NOUT] + 4 * F.lane + 256 * j); *(GAS f32x4*)(o + 4 * F.lane + 256 * j) = v[j] * rstd * g; }
        } else {
            const float* sh = ada + (size_t)((layer * 3 + seg) * 6 + 0) * D; const float* sc = sh + D;
            const float* nw = a.in[I_NMIX] + (size_t)layer * D;
#pragma unroll
            for (int j = 0; j < 4; ++j) { const int c = 4 * F.lane + 256 * j;
                const f32x4 g = *(const GAS f32x4*)(nw + c), s1 = *(const GAS f32x4*)(sc + c), s0 = *(const GAS f32x4*)(sh + c);
                const f32x4 h = v[j] * rstd * g * (s1 + 1.0f) + s0;
                v2u o; o.x = pk2(h.x, h.y); o.y = pk2(h.z, h.w);
                *(GAS v2u*)(H + (size_t)row * D + c) = o; }
        }
    }
}

__device__ __forceinline__ void p_router(Frame& F, const Args& a, int layer) {
    const int row_lo = (layer >= 2) ? NCTX : 0;
    const int ntile = (NTOK - row_lo) / 16;
    float* X = (float*)(F.ws + WS_X); bf16* H = (bf16*)(F.ws + WS_H);
    const float* ada = (const float*)(F.ws + WS_ADA);
    constexpr int AST = 1032;
    LAS bf16* Ahi = (LAS bf16*)(F.lds); LAS bf16* Alo = Ahi + 16 * AST;
    LAS float* RED = (LAS float*)(F.lds + 2 * 16 * AST * 2);
    LAS float* LOG = RED + 8 * 16 * 32;
    const int fr = F.lane & 15, fq = F.lane >> 4;
    bf16x8 Bh[2][4], Bl[2][4];
    {
        const bf16* wh = (const bf16*)(F.ws + WS_WRH) + (size_t)layer * 32 * 1024; const bf16* wl = (const bf16*)(F.ws + WS_WRL) + (size_t)layer * 32 * 1024;
#pragma unroll
        for (int nt = 0; nt < 2; ++nt)
#pragma unroll
            for (int ks = 0; ks < 4; ++ks) { const size_t o = (size_t)(nt * 16 + fr) * 1024 + F.wave * 128 + ks * 32 + fq * 8;
                Bh[nt][ks] = *(const GAS bf16x8*)(wh + o); Bl[nt][ks] = *(const GAS bf16x8*)(wl + o); }
    }
    const float* nw = a.in[I_NFFN] + (size_t)layer * D;
    for (int tile = F.vcu; tile < ntile; tile += F.G) {
        const int r0 = row_lo + 16 * tile;
#pragma unroll
        for (int rr = 0; rr < 2; ++rr) {
            const int rl = 2 * F.wave + rr, row = r0 + rl, seg = seg_of_row(row);
            const float* sh = ada + (size_t)((layer * 3 + seg) * 6 + 3) * D; const float* sc = sh + D;
            f32x4 v[4]; float ss = 0.f;
#pragma unroll
            for (int j = 0; j < 4; ++j) { v[j] = *(const GAS f32x4*)(X + (size_t)row * D + 4 * F.lane + 256 * j); ss += (v[j].x * v[j].x + v[j].y * v[j].y) + (v[j].z * v[j].z + v[j].w * v[j].w); }
            const float rstd = 1.0f / sqrtf(wave_sum(ss) * (1.0f / D) + EPS);
#pragma unroll
            for (int j = 0; j < 4; ++j) { const int c = 4 * F.lane + 256 * j;
                const f32x4 g = *(const GAS f32x4*)(nw + c), s1 = *(const GAS f32x4*)(sc + c), s0 = *(const GAS f32x4*)(sh + c);
                const f32x4 h = v[j] * rstd * g * (s1 + 1.0f) + s0;
                const unsigned h0 = f2bf(h.x), h1 = f2bf(h.y), h2 = f2bf(h.z), h3 = f2bf(h.w);
                v2u o; o.x = h0 | (h1 << 16); o.y = h2 | (h3 << 16);
                *(GAS v2u*)(H + (size_t)row * D + c) = o;
                *(LAS v2u*)(Ahi + rl * AST + c) = o;
                v2u l; l.x = pk2(h.x - bf2f(h0), h.y - bf2f(h1)); l.y = pk2(h.z - bf2f(h2), h.w - bf2f(h3));
                *(LAS v2u*)(Alo + rl * AST + c) = l; }
        }
        __syncthreads();
        f32x4 acc[2] = {(f32x4){0.f, 0.f, 0.f, 0.f}, (f32x4){0.f, 0.f, 0.f, 0.f}};
#pragma unroll
        for (int ks = 0; ks < 4; ++ks) { const int o = fr * AST + F.wave * 128 + ks * 32 + fq * 8;
            const bf16x8 ah = *(const LAS bf16x8*)(Ahi + o), al = *(const LAS bf16x8*)(Alo + o);
#pragma unroll
            for (int nt = 0; nt < 2; ++nt) { acc[nt] = MFMA16(ah, Bh[nt][ks], acc[nt]); acc[nt] = MFMA16(ah, Bl[nt][ks], acc[nt]); acc[nt] = MFMA16(al, Bh[nt][ks], acc[nt]); } }
#pragma unroll
        for (int nt = 0; nt < 2; ++nt)
#pragma unroll
            for (int j = 0; j < 4; ++j) RED[(F.wave * 16 + fq * 4 + j) * 32 + nt * 16 + fr] = acc[nt][j];
        __syncthreads();
        {
            const int rl = F.tid >> 5, e = F.tid & 31, row = r0 + rl;
            float lg = a.in[I_MBR][layer * 32 + e];
#pragma unroll
            for (int w8 = 0; w8 < 8; ++w8) lg += RED[(w8 * 16 + rl) * 32 + e];
            float cur = lg; float tv[4]; int tix[4];
#pragma unroll
            for (int k = 0; k < 4; ++k) { float bv = cur; int bi = e;
#pragma unroll
                for (int o = 1; o < 32; o <<= 1) { const float ov = __shfl_xor(bv, o); const int oi = __shfl_xor(bi, o); if (ov > bv || (ov == bv && oi < bi)) { bv = ov; bi = oi; } }
                tv[k] = bv; tix[k] = bi; if (e == bi) cur = -3.0e38f; }
            const float e1 = __expf(tv[1] - tv[0]), e2 = __expf(tv[2] - tv[0]), e3 = __expf(tv[3] - tv[0]); const float inv = 1.0f / (1.0f + e1 + e2 + e3);
            if (e < 4) { const int k = e; const int ek = k == 0 ? tix[0] : (k == 1 ? tix[1] : (k == 2 ? tix[2] : tix[3])); const float gk = (k == 0 ? 1.0f : (k == 1 ? e1 : (k == 2 ? e2 : e3))) * inv;
                const unsigned rank = atomicAdd(F.ctl + CW_CNT + (layer * 32 + ek) * 64, 1u);
                ((unsigned*)(F.ws + WS_LIST))[(size_t)ek * NTOK + rank] = (unsigned)row;
                ((unsigned*)(F.ws + WS_TOKI))[(size_t)row * 4 + k] = ((unsigned)ek << 16) | rank;
                ((float*)(F.ws + WS_TOKG))[(size_t)row * 4 + k] = gk; }
        }
        __syncthreads();
    }
}

__device__ __forceinline__ void p_gather(Frame& F, int layer) {
    moe_tables(F, layer);
    const LAS int* M = (const LAS int*)(F.lds + MISC_OFF);
    const int total = M[32];
    const int gw = F.vcu * NWAVES + F.wave, NGW = F.G * NWAVES;
    const bf16* H = (const bf16*)(F.ws + WS_H); bf16* AS = (bf16*)(F.ws + WS_AS);
    const unsigned* LIST = (const unsigned*)(F.ws + WS_LIST);
    for (int p = gw; p < total; p += NGW) {
        const int e = M[64 + (p >> 8)]; const int rank = p - M[e];
        v4u x0 = (v4u){0u, 0u, 0u, 0u}, x1 = x0;
        if (rank < M[400 + e]) { const unsigned r = LIST[(size_t)e * NTOK + rank]; const GAS v4u* s = (const GAS v4u*)(H + (size_t)r * D); x0 = s[F.lane]; x1 = s[64 + F.lane]; }
        GAS v4u* d = (GAS v4u*)(AS + (size_t)p * D); d[F.lane] = x0; d[64 + F.lane] = x1;
    }
}

__device__ __forceinline__ void p_spatial(Frame& F, const Args& a, int layer) {
    const int jl = layer / 3;
    const int c_lo = (layer >= 3) ? 4 : 0;
    const int nunit = (132 - c_lo) * 8;
    const bf16* ZB = (const bf16*)(F.ws + WS_BIG); bf16* G = (bf16*)(F.ws + WS_G);
    constexpr int ST = 136;
    LAS bf16* As = (LAS bf16*)(F.lds); LAS bf16* Bs = As + 128 * ST; LAS float* rs = (LAS float*)(F.lds + 2 * 128 * ST * 2);
    const int fr = F.lane & 15, fq = F.lane >> 4;
    for (int u = F.vcu; u < nunit; u += F.G) {
        const int c = c_lo + (u >> 3), g = u & 7, r0 = 128 * c;
        for (int rr = 0; rr < 16; ++rr) { const int rl = F.wave * 16 + rr; const GAS v4u* p = (const GAS v4u*)(ZB + (size_t)(r0 + rl) * 2048 + 1024 + 16 * F.lane);
            const v4u x0 = p[0], x1 = p[1]; float ss = 0.f;
#pragma unroll
            for (int i = 0; i < 4; ++i) { const float l0 = bflo(x0[i]), h0 = bfhi(x0[i]), l1 = bflo(x1[i]), h1 = bfhi(x1[i]); ss += l0 * l0 + h0 * h0 + l1 * l1 + h1 * h1; }
            ss = wave_sum(ss); if (F.lane == 0) rs[rl] = 1.0f / sqrtf(ss * (1.0f / 1024.0f) + EPS); }
        __syncthreads();
        {
            const bf16* wsb = (const bf16*)(F.ws + WS_WSB) + (size_t)(jl * 8 + g) * 128 * 128;
            const float* gv = a.in[I_AGV] + (size_t)jl * 1024 + 128 * g;
#pragma unroll
            for (int i = 0; i < 4; ++i) { const int id = F.tid + 512 * i, p = id >> 4, qc = id & 15;
                *(LAS v4u*)(As + p * ST + qc * 8) = *(const GAS v4u*)(wsb + p * 128 + qc * 8);
                const int q = p, c8 = qc; const v4u x = *(const GAS v4u*)(ZB + (size_t)(r0 + q) * 2048 + 1024 + 128 * g + 8 * c8); const float rq = rs[q];
#pragma unroll
                for (int e = 0; e < 4; ++e) { const int cc = 8 * c8 + 2 * e;
                    Bs[cc * ST + q] = (bf16)f2bf(bflo(x[e]) * rq * gv[cc]); Bs[(cc + 1) * ST + q] = (bf16)f2bf(bfhi(x[e]) * rq * gv[cc + 1]); } }
        }
        __syncthreads();
        f32x4 acc[8];
#pragma unroll
        for (int nt = 0; nt < 8; ++nt) acc[nt] = (f32x4){0.f, 0.f, 0.f, 0.f};
#pragma unroll
        for (int ks = 0; ks < 4; ++ks) { const bf16x8 af = *(const LAS bf16x8*)(As + (16 * F.wave + fr) * ST + ks * 32 + fq * 8);
#pragma unroll
            for (int nt = 0; nt < 8; ++nt) { const bf16x8 bfr = *(const LAS bf16x8*)(Bs + (nt * 16 + fr) * ST + ks * 32 + fq * 8); acc[nt] = MFMA16(af, bfr, acc[nt]); } }
        const float* bs = a.in[I_ABS] + (size_t)(jl * 8 + g) * 128;
#pragma unroll
        for (int j = 0; j < 4; ++j) { const int p = 16 * F.wave + fq * 4 + j; const float bb = bs[p]; const size_t row = (size_t)(r0 + p);
#pragma unroll
            for (int nt = 0; nt < 8; ++nt) { const int cc = 128 * g + nt * 16 + fr; const float uu = bf2f(ZB[row * 2048 + cc]); G[row * D + cc] = (bf16)f2bf(uu * (acc[nt][j] + bb)); } }
        __syncthreads();
    }
}

constexpr int PST = GLA_INP;
__device__ __forceinline__ void gla_cum(Frame& F, const Args& a, int c, int h, int dir, LAS float* cum, LAS float* rt, LAS float* tot) {
    const bf16* P = (const bf16*)(F.ws + WS_BIG);
    for (int i = F.tid; i < 64 * 16; i += NTHREADS) { const int ii = i >> 4, j = i & 15; rt[i] = bf2f(P[(size_t)(64 * c + ii) * PST + 3072 + dir * 16 + j]); }
    const int kk = F.tid & 127, part = F.tid >> 7;
    float w[16];
#pragma unroll
    for (int j = 0; j < 16; ++j) w[j] = a.in[I_BWA2][(size_t)(dir * 16 + j) * 512 + h * 128 + kk];
    const float ba = a.in[I_BBA][dir * 512 + h * 128 + kk];
    __syncthreads();
    float la[16];
#pragma unroll
    for (int ii = 0; ii < 16; ++ii) { const int i = part * 16 + ii; float z = ba;
#pragma unroll
        for (int j = 0; j < 16; ++j) z += rt[i * 16 + j] * w[j];
        const float ls = fminf(z, 0.0f) - log1pf(expf(-fabsf(z)));
        la[ii] = ls * (1.0f / 16.0f); }
    float run = 0.f;
    if (dir == 0) {
#pragma unroll
        for (int ii = 0; ii < 16; ++ii) { run += la[ii]; la[ii] = run; } }
    else {
#pragma unroll
        for (int ii = 15; ii >= 0; --ii) { run += la[ii]; la[ii] = run; } }
    tot[part * 128 + kk] = run;
    __syncthreads();
    float off = 0.f;
#pragma unroll
    for (int p = 0; p < 4; ++p) { const float t = tot[p * 128 + kk]; if (dir == 0 ? (p < part) : (p > part)) off += t; }
#pragma unroll
    for (int ii = 0; ii < 16; ++ii) cum[(part * 16 + ii) * 128 + kk] = la[ii] + off;
    __syncthreads();
}
__device__ __forceinline__ float rope_elem(const bf16* x, int kk, int pr, int pc, const float* ROPE, bool lat) {
    const float xv = bf2f(x[kk]);
    if (!lat) return xv;
    const int half = kk >> 6, f = kk & 31, second = (kk >> 5) & 1;
    const float x1 = second ? bf2f(x[kk - 32]) : xv, x2 = second ? xv : bf2f(x[kk + 32]);
    const int pos = half ? pc : pr;
    const float cs = ROPE[(pos * 32 + f) * 2], sn = ROPE[(pos * 32 + f) * 2 + 1];
    return second ? (x1 * sn + x2 * cs) : (x1 * cs - x2 * sn);
}
__device__ __forceinline__ void p_gla_ds(Frame& F, const Args& a) {
    const bf16* P = (const bf16*)(F.ws + WS_BIG); const float* ROPE = (const float*)(F.ws + WS_ROPE);
    bf16* DS = (bf16*)(F.ws + WS_DS); float* DEC = (float*)(F.ws + WS_DEC);
    constexpr int ST = 72;
    LAS float* cum = (LAS float*)(F.lds); LAS float* rt = cum + 64 * 128; LAS float* tot = rt + 64 * 16;
    LAS bf16* KT = (LAS bf16*)(tot + 4 * 128); LAS bf16* VT = KT + 128 * ST;
    const int fr = F.lane & 15, fq = F.lane >> 4;
    for (int u = F.vcu; u < 264 * 8; u += F.G) {
        const int c = u >> 3, h = (u >> 1) & 3, dir = u & 1; const bool lat = c >= 8; const int pr = (c - 8) & 127;
        gla_cum(F, a, c, h, dir, cum, rt, tot);
        const int lastrow = dir == 0 ? 63 : 0;
        {
            const int i = F.tid & 63, grp = F.tid >> 6; const size_t row = (size_t)(64 * c + i);
            const bf16* kp = P + row * PST + 512 + h * 128;
#pragma unroll 4
            for (int e = 0; e < 16; ++e) { const int kk = grp * 16 + e; const float kv = rope_elem(kp, kk, pr, i, ROPE, lat);
                KT[kk * ST + i] = (bf16)f2bf(kv * __expf(cum[lastrow * 128 + kk] - cum[i * 128 + kk])); }
            const bf16* vp = P + row * PST + 1024 + h * 256 + grp * 32;
#pragma unroll
            for (int e = 0; e < 4; ++e) { const v4u x = *(const GAS v4u*)(vp + 8 * e);
#pragma unroll
                for (int q = 0; q < 4; ++q) { VT[(grp * 32 + 8 * e + 2 * q) * ST + i] = (bf16)(x[q] & 0xffffu); VT[(grp * 32 + 8 * e + 2 * q + 1) * ST + i] = (bf16)(x[q] >> 16); } }
            if (F.tid < 128) DEC[((size_t)(dir * 264 + c) * 4 + h) * 128 + F.tid] = __expf(cum[lastrow * 128 + F.tid]);
        }
        __syncthreads();
        f32x4 acc[16];
#pragma unroll
        for (int nt = 0; nt < 16; ++nt) acc[nt] = (f32x4){0.f, 0.f, 0.f, 0.f};
#pragma unroll
        for (int ks = 0; ks < 2; ++ks) { const bf16x8 af = *(const LAS bf16x8*)(KT + (16 * F.wave + fr) * ST + ks * 32 + fq * 8);
#pragma unroll
            for (int nt = 0; nt < 16; ++nt) { const bf16x8 bfr = *(const LAS bf16x8*)(VT + (nt * 16 + fr) * ST + ks * 32 + fq * 8); acc[nt] = MFMA16(af, bfr, acc[nt]); } }
        bf16* dsp = DS + ((size_t)(dir * 264 + c) * 4 + h) * 256 * 128;
#pragma unroll
        for (int nt = 0; nt < 16; ++nt) { v2u o; o.x = pk2(acc[nt][0], acc[nt][1]); o.y = pk2(acc[nt][2], acc[nt][3]);
            *(GAS v2u*)(dsp + (size_t)(nt * 16 + fr) * 128 + 16 * F.wave + fq * 4) = o; }
        __syncthreads();
    }
}
__device__ __forceinline__ void p_gla_scan(Frame& F) {
    const bf16* DS = (const bf16*)(F.ws + WS_DS); bf16* SIN = (bf16*)(F.ws + WS_SIN); const float* DEC = (const float*)(F.ws + WS_DEC);
    const int gt = F.vcu * NTHREADS + F.tid, NGT = F.G * NTHREADS;
    for (int id = gt; id < 2 * 2 * 4 * 256 * 32; id += NGT) {
        const int kq = id & 31, v = (id >> 5) & 255, h = (id >> 13) & 3, dir = (id >> 15) & 1, b = id >> 16;
        f32x4 S = (f32x4){0.f, 0.f, 0.f, 0.f};
        for (int s0 = 0; s0 < 132; s0 += 4) {
            size_t o[4]; v2u d[4]; f32x4 dc[4];
#pragma unroll
            for (int q = 0; q < 4; ++q) { const int s = s0 + q; int c;
                if (dir == 0) c = s < 4 ? 4 * b + s : 8 + 128 * b + (s - 4);
                else c = s < 4 ? 4 * b + 3 - s : 8 + 128 * b + 127 - (s - 4);
                const size_t base = ((size_t)(dir * 264 + c) * 4 + h);
                o[q] = (base * 256 + v) * 128 + 4 * kq;
                d[q] = __builtin_nontemporal_load((const GAS v2u*)(DS + o[q])); dc[q] = *(const GAS f32x4*)(DEC + base * 128 + 4 * kq); }
#pragma unroll
            for (int q = 0; q < 4; ++q) {
                v2u so; so.x = pk2(S.x, S.y); so.y = pk2(S.z, S.w);
                *(GAS v2u*)(SIN + o[q]) = so;
                S.x = S.x * dc[q].x + bflo(d[q].x); S.y = S.y * dc[q].y + bfhi(d[q].x); S.z = S.z * dc[q].z + bflo(d[q].y); S.w = S.w * dc[q].w + bfhi(d[q].y); }
        }
    }
}
__device__ __forceinline__ void p_gla_out(Frame& F, const Args& a) {
    const bf16* P = (const bf16*)(F.ws + WS_BIG); const float* ROPE = (const float*)(F.ws + WS_ROPE);
    const bf16* SIN = (const bf16*)(F.ws + WS_SIN); bf16* G = (bf16*)(F.ws + WS_G);
    constexpr int ST = 72, QST = 136;
    LAS float* cum = (LAS float*)(F.lds); LAS float* rt = cum + 64 * 128; LAS float* tot = rt + 64 * 16; LAS float* ssq = tot + 4 * 128;
    LAS bf16* VT = (LAS bf16*)(ssq + 8 * 64); LAS bf16* QD = VT + 256 * ST; LAS bf16* KI = QD + 64 * QST; LAS bf16* PL = KI + 64 * QST;
    const int fr = F.lane & 15, fq = F.lane >> 4;
    for (int u = F.vcu; u < 264 * 4; u += F.G) {
        const int c = u >> 2, h = u & 3; const bool lat = c >= 8; const int pr = (c - 8) & 127;
        f32x4 acc[2][4];
#pragma unroll
        for (int mt = 0; mt < 2; ++mt)
#pragma unroll
            for (int nt = 0; nt < 4; ++nt) acc[mt][nt] = (f32x4){0.f, 0.f, 0.f, 0.f};
        {
            const int i = F.tid & 63, grp = F.tid >> 6; const bf16* vp = P + (size_t)(64 * c + i) * PST + 1024 + h * 256 + grp * 32;
#pragma unroll
            for (int e = 0; e < 4; ++e) { const v4u x = *(const GAS v4u*)(vp + 8 * e);
#pragma unroll
                for (int q = 0; q < 4; ++q) { VT[(grp * 32 + 8 * e + 2 * q) * ST + i] = (bf16)(x[q] & 0xffffu); VT[(grp * 32 + 8 * e + 2 * q + 1) * ST + i] = (bf16)(x[q] >> 16); } }
        }
        for (int dir = 0; dir < 2; ++dir) {
            gla_cum(F, a, c, h, dir, cum, rt, tot);
            {
                const int i = F.tid & 63, grp = F.tid >> 6; const size_t row = (size_t)(64 * c + i);
                const bf16* qp = P + row * PST + h * 128; const bf16* kp = P + row * PST + 512 + h * 128;
#pragma unroll 4
                for (int e = 0; e < 16; ++e) { const int kk = grp * 16 + e; const float cm = cum[i * 128 + kk];
                    const float qv = rope_elem(qp, kk, pr, i, ROPE, lat) * 0.08838834764831845f, kv = rope_elem(kp, kk, pr, i, ROPE, lat);
                    QD[i * QST + kk] = (bf16)f2bf(qv * __expf(cm)); KI[i * QST + kk] = (bf16)f2bf(kv * __expf(-cm)); }
            }
            __syncthreads();
            {
                const int jt = F.wave >> 1;
#pragma unroll
                for (int t2 = 0; t2 < 2; ++t2) { const int it = 2 * (F.wave & 1) + t2; f32x4 s = (f32x4){0.f, 0.f, 0.f, 0.f};
#pragma unroll
                    for (int ks = 0; ks < 4; ++ks) { const bf16x8 af = *(const LAS bf16x8*)(KI + (16 * jt + fr) * QST + ks * 32 + fq * 8), bfr = *(const LAS bf16x8*)(QD + (16 * it + fr) * QST + ks * 32 + fq * 8); s = MFMA16(af, bfr, s); }
                    const int i = 16 * it + fr, j0 = 16 * jt + fq * 4; float pv[4];
#pragma unroll
                    for (int r = 0; r < 4; ++r) { const int j = j0 + r; const bool keep = dir == 0 ? (j <= i) : (j >= i); pv[r] = keep ? s[r] : 0.0f; }
                    v2u o; o.x = pk2(pv[0], pv[1]); o.y = pk2(pv[2], pv[3]);
                    *(LAS v2u*)(PL + i * ST + j0) = o; }
            }
            __syncthreads();
#pragma unroll
            for (int ks = 0; ks < 2; ++ks) {
                bf16x8 bfr[4];
#pragma unroll
                for (int nt = 0; nt < 4; ++nt) bfr[nt] = *(const LAS bf16x8*)(PL + (16 * nt + fr) * ST + ks * 32 + fq * 8);
#pragma unroll
                for (int mt = 0; mt < 2; ++mt) { const bf16x8 af = *(const LAS bf16x8*)(VT + (32 * F.wave + 16 * mt + fr) * ST + ks * 32 + fq * 8);
#pragma unroll
                    for (int nt = 0; nt < 4; ++nt) acc[mt][nt] = MFMA16(af, bfr[nt], acc[mt][nt]); } }
            const bf16* sp = SIN + ((size_t)(dir * 264 + c) * 4 + h) * 256 * 128;
#pragma unroll
            for (int ks = 0; ks < 4; ++ks) {
                bf16x8 bfr[4];
#pragma unroll
                for (int nt = 0; nt < 4; ++nt) bfr[nt] = *(const LAS bf16x8*)(QD + (16 * nt + fr) * QST + ks * 32 + fq * 8);
#pragma unroll
                for (int mt = 0; mt < 2; ++mt) { const bf16x8 af = *(const GAS bf16x8*)(sp + (size_t)(32 * F.wave + 16 * mt + fr) * 128 + ks * 32 + fq * 8);
#pragma unroll
                    for (int nt = 0; nt < 4; ++nt) acc[mt][nt] = MFMA16(af, bfr[nt], acc[mt][nt]); } }
            __syncthreads();
        }
#pragma unroll
        for (int nt = 0; nt < 4; ++nt) { float s = 0.f;
#pragma unroll
            for (int mt = 0; mt < 2; ++mt)
#pragma unroll
                for (int j = 0; j < 4; ++j) s += acc[mt][nt][j] * acc[mt][nt][j];
            s += __shfl_xor(s, 16); s += __shfl_xor(s, 32);
            if (fq == 0) ssq[F.wave * 64 + 16 * nt + fr] = s; }
        __syncthreads();
#pragma unroll
        for (int nt = 0; nt < 4; ++nt) { const int i = 16 * nt + fr; float s = 0.f;
#pragma unroll
            for (int w8 = 0; w8 < 8; ++w8) s += ssq[w8 * 64 + i];
            const float rstd = 1.0f / sqrtf(s * (1.0f / 256.0f) + EPS); const size_t row = (size_t)(64 * c + i);
#pragma unroll
            for (int mt = 0; mt < 2; ++mt) { const int v0 = 32 * F.wave + 16 * mt + fq * 4;
                const v2u gg = *(const GAS v2u*)(P + row * PST + 2048 + h * 256 + v0); const f32x4 go = *(const GAS f32x4*)(a.in[I_BGO] + v0);
                const float g0 = bflo(gg.x), g1 = bfhi(gg.x), g2 = bflo(gg.y), g3 = bfhi(gg.y);
                const float o0 = acc[mt][nt][0] * rstd * go.x * (g0 / (1.0f + __expf(-g0))), o1 = acc[mt][nt][1] * rstd * go.y * (g1 / (1.0f + __expf(-g1)));
                const float o2 = acc[mt][nt][2] * rstd * go.z * (g2 / (1.0f + __expf(-g2))), o3 = acc[mt][nt][3] * rstd * go.w * (g3 / (1.0f + __expf(-g3)));
                v2u o; o.x = pk2(o0, o1); o.y = pk2(o2, o3);
                *(GAS v2u*)(G + row * D + h * 256 + v0) = o; } }
        __syncthreads();
    }
}

__device__ __forceinline__ void p_natten(Frame& F, const Args& a) {
    const bf16* QKV = (const bf16*)(F.ws + WS_BIG); bf16* G = (bf16*)(F.ws + WS_G);
    constexpr int QS = 3072, VLS = 520, VCS = 264;
    LAS bf16* VTl = (LAS bf16*)(F.lds); LAS bf16* VTc = VTl + 64 * VLS; LAS float* RPB = (LAS float*)(VTc + 64 * VCS); LAS float* MRG = RPB + 480;
    const int fr = F.lane & 15, fq = F.lane >> 4;
    const int jb = F.wave >> 1, role = F.wave & 1;
    const int u_lo = (int)(((long)F.vcu * 4096) / F.G), u_hi = (int)(((long)(F.vcu + 1) * 4096) / F.G);
    int cur_bh = -1;
    for (int u = u_lo; u < u_hi; ++u) {
        const int bh = u >> 7, r = u & 127, b = bh >> 4, h = bh & 15;
        const int r0 = r < 4 ? 0 : (r > 124 ? 120 : r - 4);
        const size_t lat0 = (size_t)NCTX + (size_t)b * SEQ;
        __syncthreads();
        if (bh != cur_bh) {
            cur_bh = bh;
            for (int i = F.tid; i < 465; i += NTHREADS) RPB[i] = a.in[I_CRPB][h * 465 + i];
#pragma unroll
            for (int i = 0; i < 4; ++i) { const int id = F.tid + 512 * i, key = id >> 3, d8 = id & 7;
                const v4u x = *(const GAS v4u*)(QKV + (size_t)(b * CTXL + key) * QS + 2048 + h * 64 + 8 * d8);
#pragma unroll
                for (int q = 0; q < 4; ++q) { VTc[(8 * d8 + 2 * q) * VCS + key] = (bf16)(x[q] & 0xffffu); VTc[(8 * d8 + 2 * q + 1) * VCS + key] = (bf16)(x[q] >> 16); } }
        }
#pragma unroll
        for (int i = 0; i < 8; ++i) { const int id = F.tid + 512 * i, key = id >> 3, d8 = id & 7;
            const v4u x = *(const GAS v4u*)(QKV + (lat0 + (size_t)r0 * 64 + key) * QS + 2048 + h * 64 + 8 * d8);
#pragma unroll
            for (int q = 0; q < 4; ++q) { VTl[(8 * d8 + 2 * q) * VLS + key] = (bf16)(x[q] & 0xffffu); VTl[(8 * d8 + 2 * q + 1) * VLS + key] = (bf16)(x[q] >> 16); } }
        __syncthreads();
        const int bstart = jb == 0 ? 0 : (jb == 1 ? 8 : (jb == 2 ? 24 : 32));
        const int qcol = 16 * jb + fr; const int cstart = qcol < 8 ? 0 : (qcol > 56 ? 48 : qcol - 8);
        bf16x8 qf[2];
#pragma unroll
        for (int ks = 0; ks < 2; ++ks) qf[ks] = *(const GAS bf16x8*)(QKV + (lat0 + (size_t)r * 64 + qcol) * QS + h * 64 + ks * 32 + fq * 8);
        f32x4 s[16];
#pragma unroll
        for (int kt = 0; kt < 16; ++kt) {
            const bf16* kp = role == 0 ? QKV + (lat0 + (size_t)(r0 + (kt >> 1)) * 64 + bstart + 16 * (kt & 1) + fr) * QS + 1024 + h * 64
                                       : QKV + (size_t)(b * CTXL + 16 * kt + fr) * QS + 1024 + h * 64;
            f32x4 t = (f32x4){0.f, 0.f, 0.f, 0.f};
#pragma unroll
            for (int ks = 0; ks < 2; ++ks) { const bf16x8 kf = *(const GAS bf16x8*)(kp + ks * 32 + fq * 8); t = MFMA16(kf, qf[ks], t); }
            s[kt] = t;
        }
        float mx = -3.0e38f;
#pragma unroll
        for (int kt = 0; kt < 16; ++kt)
#pragma unroll
            for (int j = 0; j < 4; ++j) { float v = s[kt][j] * 0.125f;
                if (role == 0) { const int kcol = bstart + 16 * (kt & 1) + fq * 4 + j, krow = r0 + (kt >> 1);
                    const bool ok = kcol >= cstart && kcol < cstart + 16;
                    v = ok ? v + RPB[(krow - r + 7) * 31 + (kcol - qcol + 15)] : -3.0e38f; }
                s[kt][j] = v; mx = fmaxf(mx, v); }
        mx = fmaxf(mx, __shfl_xor(mx, 16)); mx = fmaxf(mx, __shfl_xor(mx, 32));
        float l = 0.f;
#pragma unroll
        for (int kt = 0; kt < 16; ++kt)
#pragma unroll
            for (int j = 0; j < 4; ++j) { const float p = s[kt][j] > -1.0e38f ? __expf(s[kt][j] - mx) : 0.0f; s[kt][j] = p; l += p; }
        l += __shfl_xor(l, 16); l += __shfl_xor(l, 32);
        f32x4 o[4];
#pragma unroll
        for (int dt = 0; dt < 4; ++dt) o[dt] = (f32x4){0.f, 0.f, 0.f, 0.f};
#pragma unroll
        for (int st = 0; st < 8; ++st) {
            v4u pw; pw.x = pk2(s[2 * st][0], s[2 * st][1]); pw.y = pk2(s[2 * st][2], s[2 * st][3]); pw.z = pk2(s[2 * st + 1][0], s[2 * st + 1][1]); pw.w = pk2(s[2 * st + 1][2], s[2 * st + 1][3]);
            const bf16x8 pf = __builtin_bit_cast(bf16x8, pw);
            const LAS bf16* vb = role == 0 ? VTl + st * 64 + bstart : VTc + 32 * st;
            const int vst = role == 0 ? VLS : VCS;
#pragma unroll
            for (int dt = 0; dt < 4; ++dt) { const LAS bf16* vp = vb + (16 * dt + fr) * vst + fq * 4;
                const v2u lo = *(const LAS v2u*)vp, hi = *(const LAS v2u*)(vp + 16);
                v4u vw; vw.x = lo.x; vw.y = lo.y; vw.z = hi.x; vw.w = hi.y;
                o[dt] = MFMA16(__builtin_bit_cast(bf16x8, vw), pf, o[dt]); }
        }
        if (role == 1) { LAS float* m = MRG + jb * 18 * 64; m[F.lane] = mx; m[64 + F.lane] = l;
#pragma unroll
            for (int dt = 0; dt < 4; ++dt)
#pragma unroll
                for (int j = 0; j < 4; ++j) m[(2 + dt * 4 + j) * 64 + F.lane] = o[dt][j]; }
        __syncthreads();
        if (role == 0) { const LAS float* m = MRG + jb * 18 * 64; const float m1 = m[F.lane], l1 = m[64 + F.lane];
            const float mm = fmaxf(mx, m1), a0 = __expf(mx - mm), a1 = __expf(m1 - mm); const float inv = 1.0f / (l * a0 + l1 * a1);
            bf16* op = G + (lat0 + (size_t)r * 64 + qcol) * D + h * 64 + fq * 4;
#pragma unroll
            for (int dt = 0; dt < 4; ++dt) { float v[4];
#pragma unroll
                for (int j = 0; j < 4; ++j) v[j] = (o[dt][j] * a0 + m[(2 + dt * 4 + j) * 64 + F.lane] * a1) * inv;
                v2u w; w.x = pk2(v[0], v[1]); w.y = pk2(v[2], v[3]);
                *(GAS v2u*)(op + 16 * dt) = w; } }
    }
}


__device__ __forceinline__ void ph_moe_gu(Frame& F, const Args& args, const int layer) {
    moe_tables(F, layer);
    const LAS int* Mt = (const LAS int*)(F.lds + MISC_OFF); const int total = Mt[32];
    pg8::Gemm g{(const bf16*)(F.ws + WS_H), (const bf16*)(F.ws + WS_WGU) + (size_t)layer * 32 * 2048 * 1024, total, 2048, D};
    pg8::GroupedOrder S; S.init(total, 2048, F.G, (int)blockIdx.x); S.tile_e = Mt + 64;
    pg8::EpiSwiglu E{(bf16*)(F.ws + WS_ACT), D, args.in[I_MBGU] + (size_t)layer * 32 * 2048, 2048};
    pg8::gemm_phase<pg8::EpiSwiglu, pg8::GroupedOrder, true>(F.lds + RING_OFF, g, S, E, (const unsigned*)(F.ws + WS_LIST), Mt, NTOK);
}
__device__ __forceinline__ void ph_moe_dn(Frame& F, const Args& args, const int layer) {
    moe_tables(F, layer);
    const LAS int* Mt = (const LAS int*)(F.lds + MISC_OFF); const int total = Mt[32];
    pg8::Gemm g{(const bf16*)(F.ws + WS_ACT), (const bf16*)(F.ws + WS_WDN) + (size_t)layer * 32 * 1024 * 1024, total, D, D};
    pg8::GroupedOrder S; S.init(total, D, F.G, (int)blockIdx.x); S.tile_e = Mt + 64;
    pg8::EpiBf16<0> E{(bf16*)(F.ws + WS_YB), D, args.in[I_MBDN] + (size_t)layer * 32 * 1024, 1024};
    pg8::gemm_phase<pg8::EpiBf16<0>, pg8::GroupedOrder>(F.lds + RING_OFF, g, S, E);
}
template <int LAYER> __device__ __forceinline__ void ph_ingemm(Frame& F) {
    constexpr int layer = LAYER, kind = layer % 3, mt0 = (layer >= 3) ? 2 : 0;
    const bf16* A = (const bf16*)(F.ws + WS_H) + (size_t)mt0 * 256 * D; const int M = (66 - mt0) * 256;
    if constexpr (kind == 0) {
        pg8::Gemm g{A, (const bf16*)(F.ws + WS_WAIN) + (size_t)(layer / 3) * 2048 * 1024, M, 2048, D}; pg8::StaticOrder S; S.init(M, 2048, F.G, (int)blockIdx.x);
        pg8::EpiBf16<1> E{(bf16*)(F.ws + WS_BIG) + (size_t)mt0 * 256 * 2048, 2048, nullptr, 0};
        pg8::gemm_phase<pg8::EpiBf16<1>, pg8::StaticOrder>(F.lds + RING_OFF, g, S, E);
    } else {
        const int N = kind == 1 ? GLA_INP : 3072;
        pg8::Gemm g{A, (const bf16*)(F.ws + (kind == 1 ? WS_WBIN : WS_WCQKV)), M, N, D}; pg8::StaticOrder S; S.init(M, N, F.G, (int)blockIdx.x);
        pg8::EpiBf16<0> E{(bf16*)(F.ws + WS_BIG), N, nullptr, 0};
        pg8::gemm_phase<pg8::EpiBf16<0>, pg8::StaticOrder>(F.lds + RING_OFF, g, S, E);
    }
}

#define IN(k) (lo <= (k) && (k) < hi)
#define SEAM(k) do { if (IN(k) && IN((k) + 1)) xcd_barrier(bar); else __syncthreads(); } while (0)
template <int LAYER> __device__ __forceinline__ void run_layer(Frame& F, const Args& args, const XcdBarrier& bar, const int lo, const int hi) {
    {
        constexpr int layer = LAYER; constexpr int kind = layer % 3, base = 1 + 10 * layer;
        constexpr int mt0 = (layer >= 3) ? 2 : 0;
        constexpr int mo0 = (layer >= 2) ? 2 : 0;
        if (IN(base + 0)) { p_prenorm(F, args, layer, false); } SEAM(base + 0);
        if (IN(base + 1)) { ph_ingemm<LAYER>(F);
#if PROBE_ING
            __syncthreads(); ph_ingemm<LAYER>(F);
#endif
        }
        SEAM(base + 1);
        if (IN(base + 2)) for (int rep = 0; rep < 1 + (kind == 1 ? PROBE_GLA : PROBE_MIX); ++rep) { if (rep) __syncthreads(); if constexpr (kind == 0) p_spatial(F, args, layer); else if constexpr (kind == 1) p_gla_ds(F, args); else p_natten(F, args); } SEAM(base + 2);
        if constexpr (kind == 1) { if (IN(base + 3)) for (int rep = 0; rep < 1 + PROBE_GLA; ++rep) { p_gla_scan(F); } SEAM(base + 3); }
        if constexpr (kind == 1) { if (IN(base + 4)) for (int rep = 0; rep < 1 + PROBE_GLA; ++rep) { if (rep) __syncthreads(); p_gla_out(F, args); } SEAM(base + 4); }
        if (IN(base + 5)) {
            const int M = (66 - mo0) * 256;
            const bf16* Bt = (const bf16*)(F.ws + (kind == 0 ? WS_WAOUT : (kind == 1 ? WS_WBOUT : WS_WCOUT))) + (kind == 0 ? (size_t)(layer / 3) * 1024 * 1024 : 0);
            pg8::Gemm g{(const bf16*)(F.ws + WS_G) + (size_t)mo0 * 256 * D, Bt, M, D, D}; pg8::StaticOrder S; S.init(M, D, F.G, (int)blockIdx.x);
            pg8::EpiResid E{(float*)(F.ws + WS_X) + (size_t)mo0 * 256 * D, (const float*)(F.ws + WS_ADA) + (size_t)(layer * 3 * 6 + 2) * D, 6 * D, mo0};
            pg8::gemm_phase<pg8::EpiResid, pg8::StaticOrder>(F.lds + RING_OFF, g, S, E);
        }
        SEAM(base + 5);
        if (IN(base + 6)) { p_router(F, args, layer); } SEAM(base + 6);
        if (IN(base + 8)) { ph_moe_gu(F, args, layer);
#if PROBE_MOE
            __syncthreads(); ph_moe_gu(F, args, layer);
#endif
        }
        SEAM(base + 8);
        if (IN(base + 9)) { ph_moe_dn(F, args, layer);
#if PROBE_MOE
            __syncthreads(); ph_moe_dn(F, args, layer);
#endif
        }
        SEAM(base + 9);
    }
}

__global__ void __launch_bounds__(NTHREADS, 2) fwd(Args args) {
    extern __shared__ __attribute__((aligned(16))) unsigned char lds[];
    Frame F;
    F.lds = (LAS unsigned char*)lds;
    F.tid = threadIdx.x; F.lane = F.tid & 63; F.wave = __builtin_amdgcn_readfirstlane(F.tid >> 6);
    F.G = gridDim.x; { const int bx = blockIdx.x; F.vcu = (F.G % 8 == 0) ? (bx % 8) * (F.G / 8) + bx / 8 : bx; }
    F.ws = args.ws; F.ctl = (unsigned*)(args.ws + WS_CTL);
    volatile LAS unsigned* BST = (volatile LAS unsigned*)(F.lds + LDS_BYTES - 16);
    if (F.tid < 4) BST[F.tid] = 0u;
    __syncthreads();
    const int lo = args.ph_lo, hi = args.ph_hi;
    XcdBarrier bar; bar.bar = (unsigned*)(F.ctl + CW_BAR); bar.x = 0; bar.st = BST;
    if (hi - lo > 1) bar = xcd_barrier_post((unsigned*)(F.ctl + CW_BAR), BST);
    if (IN(0)) { p_prologue(F, args);
#if PROBE_PRO
        __syncthreads(); p_prologue(F, args);
#endif
    } SEAM(0);

    run_layer<0>(F, args, bar, lo, hi);
    run_layer<1>(F, args, bar, lo, hi);
    run_layer<2>(F, args, bar, lo, hi);
    run_layer<3>(F, args, bar, lo, hi);
    if (IN(41)) { p_prenorm(F, args, 4, true); }
#undef IN
#undef SEAM
}

extern "C" void kernel_launch(void* const* d_in, const int* in_sizes, int n_in, void* d_out, int out_size, void* d_ws, size_t ws_size, hipStream_t stream) {
    static int grid = 0;
    if (grid == 0) {
        if (n_in != 28 || out_size != NLAT * D || ws_size < WS_END) { fprintf(stderr, "kernel_launch: unexpected problem (n_in %d, out %d, ws %zu < %zu)\n", n_in, out_size, ws_size, (size_t)WS_END); grid = -1; return; }
        int dev = 0, cus = 0, per_cu = 0;
        if (hipGetDevice(&dev) != hipSuccess || hipDeviceGetAttribute(&cus, hipDeviceAttributeMultiprocessorCount, dev) != hipSuccess) { grid = -1; return; }
        if (hipFuncSetAttribute((const void*)fwd, hipFuncAttributeMaxDynamicSharedMemorySize, LDS_BYTES) != hipSuccess) { fprintf(stderr, "kernel_launch: hipFuncSetAttribute failed\n"); grid = -1; return; }
        if (hipOccupancyMaxActiveBlocksPerMultiprocessor(&per_cu, (const void*)fwd, NTHREADS, LDS_BYTES) != hipSuccess || per_cu < 1) { fprintf(stderr, "kernel_launch: occupancy query reports %d\n", per_cu); }
        (void)hipGetLastError();
        grid = cus;
    }
    if (grid < 0) return;
    (void)hipMemsetAsync((char*)d_ws + WS_CTL, 0, CTL_ZERO_BYTES, stream);
    Args a{};
    for (int i = 0; i < 28; ++i) a.in[i] = (const float*)d_in[i];
    a.out = (float*)d_out; a.ws = (unsigned char*)d_ws;
#if MK_ONE_LAUNCH
    a.ph_lo = 0; a.ph_hi = 42;
    hipLaunchKernelGGL(fwd, dim3(grid), dim3(NTHREADS), LDS_BYTES, stream, a);
#else
    for (int p = 0; p < 42; ++p) {
        if (p >= 1 && p <= 40) { const int layer = (p - 1) / 10, loc = (p - 1) % 10; if (((loc == 3 || loc == 4) && (layer % 3) != 1) || loc == 7) continue; }
        a.ph_lo = p; a.ph_hi = p + 1;
        hipLaunchKernelGGL(fwd, dim3(grid), dim3(NTHREADS), LDS_BYTES, stream, a);
    }
#endif
}
```

```cpp
#include <hip/hip_runtime.h>
#include <cstdio>
#include <cstdint>

#ifndef MK_ONE_LAUNCH
#define MK_ONE_LAUNCH 1
#endif
#ifndef PROBE_PRO
#define PROBE_PRO 0
#endif
#ifndef PROBE_MOE
#define PROBE_MOE 0
#endif
#ifndef PROBE_ING
#define PROBE_ING 0
#endif
#ifndef PROBE_MIX
#define PROBE_MIX 0
#endif
#ifndef PROBE_GLA
#define PROBE_GLA 0
#endif
#ifndef PROBE_TOK
#define PROBE_TOK 0
#endif
#ifndef PROBE_BAR
#define PROBE_BAR 0
#endif
#ifndef PROBE_NAT
#define PROBE_NAT 0
#endif
#ifndef PROBE_GATHER
#define PROBE_GATHER 0
#endif

namespace pg8 {
#define PG8_LAS __attribute__((address_space(3)))
typedef unsigned short bf16_t;
typedef short bf16x8 __attribute__((ext_vector_type(8)));
typedef float f32x4 __attribute__((ext_vector_type(4)));
typedef unsigned u32x4 __attribute__((ext_vector_type(4)));
constexpr int BM = 256, BK = 64, HALF = 128, HTB = HALF * BK * 2, STAGE_BYTES = 8 * HTB, NXCD = 8, WGM = 8;

__host__ __device__ __forceinline__ int lds_byte(int r, int c) { const int st = (r >> 4) * 2 + (c >> 5), rr = r & 15, cc = c & 31, ob = rr * 64 + cc * 2; return st * 1024 + (ob ^ (((ob >> 9) & 1) << 5)); }
__host__ __device__ __forceinline__ void stage_rc(int b, int& R, int& C) { const int st = b / 1024, sb = b % 1024, swz = sb ^ (((sb >> 9) & 1) << 5); R = (st >> 1) * 16 + swz / 64; C = (st & 1) * 32 + (swz % 64) / 2; }
__host__ __device__ __forceinline__ int perm32(int rho) { const int n = rho >> 4, i = rho & 15; return 8 * (i >> 2) + 4 * n + (i & 3); }

struct Unit { int pm, pn, pb, e; };
struct Gemm { const bf16_t* A; const bf16_t* Bt; int M, N, K; };

struct StaticOrder {
    int nM, nN, nwg, G, c;
    __device__ void init(int M, int N, int G_, int c_) { nM = M / BM; nN = N / BM; nwg = nM * nN; G = G_; c = c_; }
    __device__ bool next(int i, Unit& u) const {
        const long L = (long)i * G + c; if (L >= nwg) return false;
        int wgid = (int)L; { const int q = nwg / NXCD, r = nwg % NXCD, xcd = wgid % NXCD, off = wgid / NXCD; wgid = (xcd < r ? xcd * (q + 1) : r * (q + 1) + (xcd - r) * q) + off; }
        const int nig = WGM * nN, gid = wgid / nig, fm = gid * WGM, gsz = (nM - fm) < WGM ? (nM - fm) : WGM;
        u.pm = fm + ((wgid % nig) % gsz); u.pn = (wgid % nig) / gsz; u.pb = u.pn; u.e = 0; return true;
    }
};
struct GroupedOrder : StaticOrder {
    const PG8_LAS int* tile_e;
    __device__ bool next(int i, Unit& u) const {
        if (!StaticOrder::next(i, u)) return false;
        u.e = __builtin_amdgcn_readfirstlane(tile_e[u.pm]); u.pb = u.e * nN + u.pn; return true;
    }
};

__device__ __forceinline__ unsigned cvt_pk_bf16(float lo, float hi) { unsigned r; asm volatile("v_cvt_pk_bf16_f32 %0, %1, %2" : "=v"(r) : "v"(lo), "v"(hi)); return r; }
typedef float f32x2 __attribute__((ext_vector_type(2)));
__device__ __forceinline__ f32x2 gelu_pk(f32x2 v) {
    const f32x2 av = __builtin_elementwise_abs(v), d = av * 0.2316418882f + 1.0f;
    f32x2 t; t.x = __builtin_amdgcn_rcpf(d.x); t.y = __builtin_amdgcn_rcpf(d.y);
    f32x2 q = t * 0.5307027145f + (-0.7265760135f); q = q * t + 0.7107068705f; q = q * t + (-0.142248368f); q = q * t + 0.127414796f; q = q * t;
    const f32x2 s = (v * v) * (-0.72134752044f);
    f32x2 e; e.x = __builtin_amdgcn_exp2f(s.x); e.y = __builtin_amdgcn_exp2f(s.y);
    const f32x2 m = v * (q * e), r = v - m;
    f32x2 o; o.x = v.x < 0.f ? m.x : r.x; o.y = v.y < 0.f ? m.y : r.y; return o;
}

template <int ACT> struct EpiBf16 {
    static constexpr bool PERM = true;
    bf16_t* O; int ldc; const float* bias; int bias_estride;
    __device__ __forceinline__ void operator()(const f32x4 (&acc)[2][2][4][2], const Unit& u, int wr, int wc, int fr, int fq) const {
        const int row0 = u.pm * BM + wr * 64 + fr; const int col0 = u.pn * BM + wc * 32 + 8 * fq;
        const float* bp = bias ? bias + (size_t)u.e * bias_estride : nullptr;
        f32x4 bv[2][2];
#pragma unroll
        for (int bj = 0; bj < 2; ++bj)
#pragma unroll
            for (int n = 0; n < 2; ++n) bv[bj][n] = bp ? *(const f32x4*)(bp + col0 + bj * HALF + 4 * n) : (f32x4){0.f, 0.f, 0.f, 0.f};
#pragma unroll
        for (int ai = 0; ai < 2; ++ai)
#pragma unroll
            for (int m = 0; m < 4; ++m) { bf16_t* rowp = O + (size_t)(row0 + ai * HALF + m * 16) * ldc + col0;
#pragma unroll
                for (int bj = 0; bj < 2; ++bj) { f32x4 v0 = acc[ai][bj][m][0] + bv[bj][0], v1 = acc[ai][bj][m][1] + bv[bj][1];
                    if (ACT == 1) { f32x2 a = gelu_pk((f32x2){v0[0], v0[1]}), b = gelu_pk((f32x2){v0[2], v0[3]}), c = gelu_pk((f32x2){v1[0], v1[1]}), d = gelu_pk((f32x2){v1[2], v1[3]});
                        v0 = (f32x4){a.x, a.y, b.x, b.y}; v1 = (f32x4){c.x, c.y, d.x, d.y}; }
                    u32x4 w; w.x = cvt_pk_bf16(v0[0], v0[1]); w.y = cvt_pk_bf16(v0[2], v0[3]); w.z = cvt_pk_bf16(v1[0], v1[1]); w.w = cvt_pk_bf16(v1[2], v1[3]);
                    *(u32x4*)(rowp + bj * HALF) = w; } }
    }
};
struct EpiSwiglu {
    static constexpr bool PERM = true;
    bf16_t* O; int ldc; const float* bias; int bias_estride;
    __device__ __forceinline__ void operator()(const f32x4 (&acc)[2][2][4][2], const Unit& u, int wr, int wc, int fr, int fq) const {
        const int row0 = u.pm * BM + wr * 64 + fr; const int col0 = u.pn * HALF + wc * 32 + 8 * fq;
        const float* bp = bias + (size_t)u.e * bias_estride;
        f32x4 bg[2], bl[2];
#pragma unroll
        for (int n = 0; n < 2; ++n) { bg[n] = *(const f32x4*)(bp + col0 + 4 * n); bl[n] = *(const f32x4*)(bp + 1024 + col0 + 4 * n); }
#pragma unroll
        for (int ai = 0; ai < 2; ++ai)
#pragma unroll
            for (int m = 0; m < 4; ++m) { bf16_t* rowp = O + (size_t)(row0 + ai * HALF + m * 16) * ldc + col0;
                float o[8];
#pragma unroll
                for (int n = 0; n < 2; ++n) { const f32x4 g4 = acc[ai][0][m][n] + bg[n], l4 = acc[ai][1][m][n] + bl[n];
#pragma unroll
                    for (int i = 0; i < 4; ++i) { const float g = fminf(g4[i], 7.0f), l = fminf(fmaxf(l4[i], -7.0f), 7.0f);
                        const float sg = __builtin_amdgcn_rcpf(1.0f + __builtin_amdgcn_exp2f(-1.702f * 1.44269504089f * g));
                        o[4 * n + i] = g * sg * (l + 1.0f); } }
                u32x4 w; w.x = cvt_pk_bf16(o[0], o[1]); w.y = cvt_pk_bf16(o[2], o[3]); w.z = cvt_pk_bf16(o[4], o[5]); w.w = cvt_pk_bf16(o[6], o[7]);
                *(u32x4*)rowp = w; }
    }
};
struct EpiResid {
    static constexpr bool PERM = false;
    float* X; const float* gate; int gstride; int pm0;
    __device__ __forceinline__ void operator()(const f32x4 (&acc)[2][2][4][2], const Unit& u, int wr, int wc, int fr, int fq) const {
        const int t = u.pm + pm0; const int seg = t < 2 ? 0 : (t < 34 ? 1 : 2);
        const int row0 = u.pm * BM + wr * 64 + fr, col0 = u.pn * BM + wc * 32 + 4 * fq;
        const float* gp = gate + (size_t)seg * gstride;
        f32x4 gv[2][2];
#pragma unroll
        for (int bj = 0; bj < 2; ++bj)
#pragma unroll
            for (int n = 0; n < 2; ++n) gv[bj][n] = *(const f32x4*)(gp + col0 + bj * HALF + n * 16);
#pragma unroll
        for (int ai = 0; ai < 2; ++ai)
#pragma unroll
            for (int m = 0; m < 4; ++m) { float* rowp = X + (size_t)(row0 + ai * HALF + m * 16) * 1024 + col0;
#pragma unroll
                for (int bj = 0; bj < 2; ++bj)
#pragma unroll
                    for (int n = 0; n < 2; ++n) { f32x4* p = (f32x4*)(rowp + bj * HALF + n * 16); *p = *p + gv[bj][n] * acc[ai][bj][m][n]; } }
    }
};

template <class Epi, class Sched, bool GATHER = false>
__device__ __forceinline__ void gemm_phase(PG8_LAS unsigned char* lds, const Gemm g, const Sched& S, const Epi& E, const unsigned* glist = nullptr, const PG8_LAS int* gM = nullptr, int gstride = 0) {
    const int tid = threadIdx.x, wid = __builtin_amdgcn_readfirstlane(tid >> 6), lane = tid & 63, wr = wid >> 2, wc = wid & 3, fr = lane & 15, fq = lane >> 4;
    const int K = g.K, nt = K / BK;
    unsigned voffB[2], va[2][2], vn[2][2]; int aR[2], aC[2];
#pragma unroll
    for (int i = 0; i < 2; ++i) { int R, C; stage_rc(tid * 16 + i * 8192, R, C); const int Rb = Epi::PERM ? ((R & ~31) + perm32(R & 31)) : R;
        aR[i] = R; aC[i] = C; voffB[i] = (unsigned)(Rb * K + C) * 2u;
#pragma unroll
        for (int h = 0; h < 2; ++h) { va[h][i] = (unsigned)((HALF * h + R) * K + C) * 2u; vn[h][i] = va[h][i]; } }
#define PG8_GOFF(u, dst) do { if constexpr (GATHER) { const int _e = (u).e, _p0 = (u).pm * BM - gM[_e], _c1 = gM[400 + _e] - 1; _Pragma("unroll") for (int _h = 0; _h < 2; ++_h) _Pragma("unroll") for (int _i = 0; _i < 2; ++_i) { \
        int _rk = _p0 + HALF * _h + aR[_i]; _rk = _rk < _c1 ? _rk : _c1; const unsigned _tok = glist[(size_t)_e * gstride + _rk]; dst[_h][_i] = (_tok * (unsigned)K + (unsigned)aC[_i]) * 2u; } } } while (0)
    const size_t kstep = (size_t)(BK * 2);
    const size_t hstep = (size_t)HALF * K * 2;
    const size_t tstep = 2 * hstep;
    const unsigned ldsw = (unsigned)wid * 1024u;
    const int aoff = lds_byte(wr * 64 + fr, fq * 8), boff = lds_byte(wc * 32 + fr, fq * 8);
#define PG8_SA(b, h) (((b) * 2 + (h)) * HTB)
#define PG8_SB(b, h) ((4 + (b) * 2 + (h)) * HTB)
#define PG8_STAGE(bufoff, gbase, voff) do { _Pragma("unroll") for (int _i = 0; _i < 2; ++_i) \
        __builtin_amdgcn_global_load_lds((const unsigned*)((const char*)(gbase) + (voff)[_i]), (PG8_LAS unsigned*)(lds + (bufoff) + ldsw + _i * 8192), 16, 0, 0); } while (0)
#define PG8_LDA(dst, b, h) do { _Pragma("unroll") for (int m = 0; m < 4; ++m) _Pragma("unroll") for (int k = 0; k < 2; ++k) dst[m][k] = *(const PG8_LAS bf16x8*)(lds + PG8_SA(b, h) + aoff + m * 2048 + k * 1024); } while (0)
#define PG8_LDB(dst, b, h) do { _Pragma("unroll") for (int n = 0; n < 2; ++n) _Pragma("unroll") for (int k = 0; k < 2; ++k) dst[n][k] = *(const PG8_LAS bf16x8*)(lds + PG8_SB(b, h) + boff + n * 2048 + k * 1024); } while (0)
#define PG8_MMA(ai, bj, At, Bt) do { __builtin_amdgcn_s_setprio(1); _Pragma("unroll") for (int m = 0; m < 4; ++m) _Pragma("unroll") for (int n = 0; n < 2; ++n) _Pragma("unroll") for (int k = 0; k < 2; ++k) \
        acc[ai][bj][m][n] = __builtin_amdgcn_mfma_f32_16x16x32_bf16(Bt[n][k], At[m][k], acc[ai][bj][m][n], 0, 0, 0); __builtin_amdgcn_s_setprio(0); } while (0)
#define PG8_WAIT_V(n) asm volatile("s_waitcnt vmcnt(" #n ")" ::: "memory")
#define PG8_WAIT_L(n) asm volatile("s_waitcnt lgkmcnt(" #n ")" ::: "memory")
#define PG8_BAR __builtin_amdgcn_s_barrier()
#define PG8_SCHED __builtin_amdgcn_sched_barrier(0)
    Unit cur, nxt; int ui = 0;
    if (!S.next(0, cur)) return;
    f32x4 acc[2][2][4][2];
#pragma unroll
    for (int a = 0; a < 2; ++a)
#pragma unroll
        for (int b = 0; b < 2; ++b)
#pragma unroll
            for (int m = 0; m < 4; ++m)
#pragma unroll
                for (int n = 0; n < 2; ++n) acc[a][b][m][n] = (f32x4){0.f, 0.f, 0.f, 0.f};
    bf16x8 At[4][2], B0[2][2], B1[2][2];
    const char* cA = (const char*)g.A + (GATHER ? (size_t)0 : (size_t)cur.pm * tstep); const char* cB = (const char*)g.Bt + (size_t)cur.pb * tstep;
    PG8_GOFF(cur, va);
    PG8_STAGE(PG8_SB(0, 0), cB, voffB); PG8_STAGE(PG8_SB(0, 1), cB + hstep, voffB); PG8_STAGE(PG8_SA(0, 0), cA, va[0]); PG8_STAGE(PG8_SA(0, 1), cA, va[1]);
    if (wr == 1) PG8_BAR;
    PG8_WAIT_V(2); PG8_BAR;
    PG8_STAGE(PG8_SB(1, 0), cB + kstep, voffB); PG8_STAGE(PG8_SA(1, 0), cA + kstep, va[0]); PG8_STAGE(PG8_SB(1, 1), cB + hstep + kstep, voffB);
    PG8_WAIT_V(6); PG8_BAR;
    for (;;) {
        const bool has_next = S.next(ui + 1, nxt);
        const char* nA = (has_next && !GATHER) ? (const char*)g.A + (size_t)nxt.pm * tstep : cA; const char* nB = has_next ? (const char*)g.Bt + (size_t)nxt.pb * tstep : cB;
        if constexpr (GATHER) { if (has_next) PG8_GOFF(nxt, vn); else { vn[0][0] = va[0][0]; vn[0][1] = va[0][1]; vn[1][0] = va[1][0]; vn[1][1] = va[1][1]; } }
        for (int t = 0; t < nt; t += 2) {
            const bool last = (t == nt - 2);
            const char* a1 = cA + (size_t)(t + 1) * kstep;
            const char* a2 = last ? nA : cA + (size_t)(t + 2) * kstep; const char* b2 = last ? nB : cB + (size_t)(t + 2) * kstep;
            const char* a3 = a2 + kstep; const char* b3 = b2 + kstep;
            unsigned v2[2][2];
#pragma unroll
            for (int _h = 0; _h < 2; ++_h)
#pragma unroll
                for (int _i = 0; _i < 2; ++_i) v2[_h][_i] = (GATHER && last) ? vn[_h][_i] : va[_h][_i];
            PG8_LDB(B0, 0, 0); PG8_LDB(B1, 0, 1); PG8_SCHED; PG8_LDA(At, 0, 0); PG8_STAGE(PG8_SA(1, 1), a1, va[1]);
            PG8_WAIT_V(8); PG8_WAIT_L(0); PG8_BAR; PG8_MMA(0, 0, At, B0); PG8_MMA(0, 1, At, B1); PG8_BAR; PG8_SCHED;
            PG8_LDA(At, 0, 1); PG8_STAGE(PG8_SB(0, 0), b2, voffB); PG8_STAGE(PG8_SB(0, 1), b2 + hstep, voffB); PG8_STAGE(PG8_SA(0, 0), a2, v2[0]);
            PG8_WAIT_V(8); PG8_WAIT_L(0); PG8_BAR; PG8_MMA(1, 0, At, B0); PG8_MMA(1, 1, At, B1); PG8_BAR; PG8_SCHED;
            PG8_LDB(B0, 1, 0); PG8_LDB(B1, 1, 1); PG8_SCHED; PG8_LDA(At, 1, 0); PG8_STAGE(PG8_SA(0, 1), a2, v2[1]);
            PG8_WAIT_V(8); PG8_WAIT_L(0); PG8_BAR; PG8_MMA(0, 0, At, B0); PG8_MMA(0, 1, At, B1); PG8_BAR; PG8_SCHED;
            PG8_LDA(At, 1, 1); PG8_STAGE(PG8_SB(1, 0), b3, voffB); PG8_STAGE(PG8_SB(1, 1), b3 + hstep, voffB); PG8_STAGE(PG8_SA(1, 0), a3, v2[0]);
            PG8_WAIT_V(8); PG8_WAIT_L(0); PG8_BAR; PG8_MMA(1, 0, At, B0); PG8_MMA(1, 1, At, B1); PG8_BAR; PG8_SCHED;
        }
        if (wr == 0) PG8_BAR;
        E(acc, cur, wr, wc, fr, fq);
        if (!has_next) break;
#pragma unroll
        for (int a = 0; a < 2; ++a)
#pragma unroll
            for (int b = 0; b < 2; ++b)
#pragma unroll
                for (int m = 0; m < 4; ++m)
#pragma unroll
                    for (int n = 0; n < 2; ++n) acc[a][b][m][n] = (f32x4){0.f, 0.f, 0.f, 0.f};
        cur = nxt; cA = nA; cB = nB; ++ui;
        if constexpr (GATHER) { va[0][0] = vn[0][0]; va[0][1] = vn[0][1]; va[1][0] = vn[1][0]; va[1][1] = vn[1][1]; }
        if (wr == 1) PG8_BAR;
    }
    PG8_WAIT_V(0);
    PG8_BAR;
#undef PG8_SA
#undef PG8_SB
#undef PG8_STAGE
#undef PG8_GOFF
#undef PG8_LDA
#undef PG8_LDB
#undef PG8_MMA
#undef PG8_WAIT_V
#undef PG8_WAIT_L
#undef PG8_BAR
#undef PG8_SCHED
}
}

constexpr int NWAVES = 8, NTHREADS = 512;
constexpr int D = 1024, NCTX = 512, NLAT = 16384, NTOK = NCTX + NLAT, SEQ = 8192, CTXL = 256;
constexpr int NEXP = 32, MAXPADROWS = 75776, MAXPADTILES = 296;
constexpr int GLA_IN = 3104, GLA_INP = 3328;
constexpr float EPS = 1e-6f;

constexpr size_t MiB = 1u << 20;
constexpr size_t WS_CTL = 0, CTL_ZERO_BYTES = 1 * MiB;
constexpr size_t WS_ADA = 1 * MiB;
constexpr size_t WS_ROPE = 1 * MiB + 512 * 1024;
constexpr size_t WS_TOKI = 2 * MiB;
constexpr size_t WS_TOKG = 2 * MiB + 512 * 1024;
constexpr size_t WS_LIST = 3 * MiB;
constexpr size_t WS_WRH = 6 * MiB, WS_WRL = 6 * MiB + 256 * 1024;
constexpr size_t WS_WSB = 7 * MiB;
constexpr size_t WS_WAIN = 8 * MiB;
constexpr size_t WS_WAOUT = 16 * MiB;
constexpr size_t WS_WBIN = 20 * MiB;
constexpr size_t WS_WBOUT = 27 * MiB;
constexpr size_t WS_WCQKV = 29 * MiB;
constexpr size_t WS_WCOUT = 35 * MiB;
constexpr size_t WS_WGU = 64 * MiB;
constexpr size_t WS_WDN = 576 * MiB;
constexpr size_t WS_X = 832 * MiB;
constexpr size_t WS_H = 898 * MiB;
constexpr size_t WS_G = 931 * MiB;
constexpr size_t WS_BIG = 964 * MiB;
constexpr size_t WS_DS = 1072 * MiB;
constexpr size_t WS_SIN = 1204 * MiB;
constexpr size_t WS_DEC = 1336 * MiB;
constexpr size_t WS_AS = 1338 * MiB;
constexpr size_t WS_ACT = 1486 * MiB;
constexpr size_t WS_YB = 1634 * MiB;
constexpr size_t WS_END = 1782 * MiB;
constexpr int CW_TMO = 0;
constexpr int CW_BAR = 4096;
constexpr int CW_CNT = 8192;

constexpr int RING_OFF = 0, RING_BYTES = 131072;
constexpr int MISC_OFF = RING_BYTES;
constexpr int LDS_BYTES = 147456;

#define GAS __attribute__((address_space(1)))
#define LAS __attribute__((address_space(3)))
typedef unsigned short bf16;
typedef unsigned v4u __attribute__((ext_vector_type(4)));
typedef unsigned v2u __attribute__((ext_vector_type(2)));
typedef float f32x4 __attribute__((ext_vector_type(4)));
typedef short bf16x8 __attribute__((ext_vector_type(8)));
typedef short bf16x4 __attribute__((ext_vector_type(4)));
#define LDS_WAIT() asm volatile("s_waitcnt lgkmcnt(0)" ::: "memory")
#define VM_WAIT() asm volatile("s_waitcnt vmcnt(0)" ::: "memory")
__device__ __forceinline__ unsigned f2bf(float f) { unsigned u = __builtin_bit_cast(unsigned, f); return (u + 0x7fffu + ((u >> 16) & 1u)) >> 16; }
__device__ __forceinline__ unsigned pk2(float lo, float hi) { return f2bf(lo) | (f2bf(hi) << 16); }
__device__ __forceinline__ float bf2f(unsigned b) { return __builtin_bit_cast(float, b << 16); }
__device__ __forceinline__ float bflo(unsigned w) { return __builtin_bit_cast(float, w << 16); }
__device__ __forceinline__ float bfhi(unsigned w) { return __builtin_bit_cast(float, w & 0xffff0000u); }
#define MFMA16(a, b, c) __builtin_amdgcn_mfma_f32_16x16x32_bf16((a), (b), (c), 0, 0, 0)

#define XB_TMO      128
#define XB_XCNT(j)  (256  + 64 * (j))
#define XB_XSUB(j)  (1280 + 64 * (j))
#define XB_XGEN(j)  (2304 + 64 * (j))
#define XB_TOP      3328
#define XB_TOPGEN   3392
#define XCD_BAR_WORDS 3456
#define XB_SPIN_CAP (1u << 22)

__device__ __forceinline__ unsigned xb_ld(unsigned* p)              { return __hip_atomic_load(p, __ATOMIC_RELAXED, __HIP_MEMORY_SCOPE_AGENT); }
__device__ __forceinline__ unsigned xb_add(unsigned* p, unsigned v) { return __hip_atomic_fetch_add(p, v, __ATOMIC_RELAXED, __HIP_MEMORY_SCOPE_AGENT); }
__device__ __forceinline__ unsigned xb_xcc_id() { return (unsigned)__builtin_amdgcn_s_getreg((3 << 11) | 20) & 0xFu; }
#define XB_SPIN(cond, bar) do { unsigned _sp = 0; while (cond) { __builtin_amdgcn_s_sleep(1); \
    if ((++_sp & 255u) == 0u) { if (xb_ld(&(bar)[XB_TMO])) break; if (_sp > XB_SPIN_CAP) { atomicAdd(&(bar)[XB_TMO], 1u); break; } } } } while (0)

struct XcdBarrier { unsigned* bar; unsigned x; volatile LAS unsigned* st; };
__device__ __forceinline__ XcdBarrier xcd_barrier_post(unsigned* bar, volatile LAS unsigned* st) {
    XcdBarrier b; b.bar = bar; b.x = xb_xcc_id(); b.st = st;
    if (threadIdx.x == 0) (void)xb_add(&bar[XB_XCNT(b.x)], 1u);
    return b;
}
__device__ __forceinline__ void xcd_barrier_complete(unsigned* bar, unsigned x, unsigned& nloc, unsigned& nx) {
    const unsigned G = gridDim.x * gridDim.y * gridDim.z;
    unsigned sum, cnt, mine, sp = 0u;
    for (;;) {
        sum = 0u; cnt = 0u; mine = 0u;
#pragma unroll
        for (unsigned j = 0; j < 16; ++j) { const unsigned c = xb_ld(&bar[XB_XCNT(j)]); sum += c; cnt += (c > 0u) ? 1u : 0u; mine = (j == x) ? c : mine; }
        if (sum == G) break;
        __builtin_amdgcn_s_sleep(1);
        if ((++sp & 255u) == 0u) { if (xb_ld(&bar[XB_TMO])) break; if (sp > XB_SPIN_CAP) { atomicAdd(&bar[XB_TMO], 1u); break; } }
    }
    nloc = mine > 0u ? mine : 1u; nx = cnt > 0u ? cnt : 1u;
}
__device__ __forceinline__ void xcd_barrier(const XcdBarrier& b) {
    asm volatile("s_waitcnt vmcnt(0)" ::: "memory");
    __syncthreads();
    if (threadIdx.x == 0) {
        unsigned* bar = b.bar;
        __builtin_amdgcn_s_waitcnt(0);
        unsigned nloc = b.st[0], nx = b.st[1];
        if (nloc == 0u) { xcd_barrier_complete(bar, b.x, nloc, nx); b.st[0] = nloc; b.st[1] = nx; }
        const unsigned old = xb_add(&bar[XB_XSUB(b.x)], 1u);
        const unsigned gen = old / nloc;
        if (old + 1u == (gen + 1u) * nloc) {
            __builtin_amdgcn_fence(__ATOMIC_RELEASE, "agent");
            asm volatile("s_waitcnt vmcnt(0)" ::: "memory");
            const unsigned og = xb_add(&bar[XB_TOP], 1u);
            const unsigned tg = og / nx;
            if (og + 1u == (tg + 1u) * nx) xb_add(&bar[XB_TOPGEN], 1u);
            else XB_SPIN(xb_ld(&bar[XB_TOPGEN]) == tg, bar);
            __builtin_amdgcn_fence(__ATOMIC_ACQUIRE, "agent");
            xb_add(&bar[XB_XGEN(b.x)], 1u);
            asm volatile("s_waitcnt vmcnt(0)" ::: "memory");
        } else {
            XB_SPIN(xb_ld(&bar[XB_XGEN(b.x)]) == gen, bar);
            __builtin_amdgcn_fence(__ATOMIC_ACQUIRE, "agent");
            asm volatile("s_waitcnt vmcnt(0)" ::: "memory");
        }
    }
    __syncthreads();
}

struct Args { const float* in[28]; float* out; unsigned char* ws; int ph_lo, ph_hi; };
enum { I_X = 0, I_C, I_CTX, I_CCTX, I_ADAW, I_ADAB, I_NMIX, I_NFFN, I_NOUT, I_AWIN, I_AGV, I_AWS, I_ABS, I_AWOUT, I_BWIN, I_BWA2, I_BBA, I_BGO, I_BWOUT,
       I_CWQKV, I_CRPB, I_CWOUT, I_MWR, I_MBR, I_MWGU, I_MBGU, I_MWDN, I_MBDN };

struct Frame {
    LAS unsigned char* lds;
    unsigned* ctl;
    unsigned char* ws;
    int tid, lane, wave, vcu, G;
};

__device__ __forceinline__ float wave_sum(float v) {
#pragma unroll
    for (int o = 1; o < 64; o <<= 1) v += __shfl_xor(v, o);
    return v;
}
__device__ __forceinline__ int seg_of_row(int r) { return r < NCTX ? 0 : 1 + ((r - NCTX) >> 13); }

__device__ __forceinline__ void transpose_item64(const float* W, int N, int k0, int n0, bf16* WT, int K, int dst_row0, int ncols_valid, LAS float* scr, int lane) {
#pragma unroll 4
    for (int i = 0; i < 16; ++i) { const int row = 4 * i + (lane >> 4), c4 = (lane & 15) * 4;
        f32x4 v = (f32x4){0.f, 0.f, 0.f, 0.f};
        if (c4 < ncols_valid) v = *(const GAS f32x4*)(W + (size_t)(k0 + row) * N + n0 + c4);
        LAS float* s = scr + row * 65 + c4; s[0] = v.x; s[1] = v.y; s[2] = v.z; s[3] = v.w; }
    LDS_WAIT(); asm volatile("" ::: "memory");
    const int c = lane & 7;
#pragma unroll
    for (int j = 0; j < 8; ++j) { const int n = (lane >> 3) + 8 * j; const LAS float* s = scr + (8 * c) * 65 + n;
        v4u o; o.x = pk2(s[0 * 65], s[1 * 65]); o.y = pk2(s[2 * 65], s[3 * 65]); o.z = pk2(s[4 * 65], s[5 * 65]); o.w = pk2(s[6 * 65], s[7 * 65]);
        *(GAS v4u*)(WT + (size_t)(dst_row0 + n) * K + k0 + 8 * c) = o; }
    LDS_WAIT(); asm volatile("" ::: "memory");
}

__device__ __forceinline__ void p_prologue(Frame& F, const Args& a) {
    LAS float* scr = (LAS float*)(F.lds + F.wave * 16640);
    const int gw = F.vcu * NWAVES + F.wave, NGW = F.G * NWAVES;
    {
        constexpr int KB = 16;
        constexpr int I0 = 2 * KB * 32, I1 = 2 * KB * 16, I2 = KB * 52, I3 = KB * 16, I4 = KB * 48, I5 = KB * 16;
        constexpr int NI = I0 + I1 + I2 + I3 + I4 + I5;
        for (int it = gw; it < NI; it += NGW) {
            int r = it;
            if (r < I0) { const int j = r / (KB * 32), q = r % (KB * 32), kb = q / 32, nb = q % 32;
                transpose_item64(a.in[I_AWIN] + (size_t)j * 1024 * 2048, 2048, 64 * kb, 64 * nb, (bf16*)(F.ws + WS_WAIN) + (size_t)j * 2048 * 1024, 1024, 64 * nb, 64, scr, F.lane); continue; } r -= I0;
            if (r < I1) { const int j = r / (KB * 16), q = r % (KB * 16), kb = q / 16, nb = q % 16;
                transpose_item64(a.in[I_AWOUT] + (size_t)j * 1024 * 1024, 1024, 64 * kb, 64 * nb, (bf16*)(F.ws + WS_WAOUT) + (size_t)j * 1024 * 1024, 1024, 64 * nb, 64, scr, F.lane); continue; } r -= I1;
            if (r < I2) { const int kb = r / 52, nb = r % 52; const int nv = GLA_IN - 64 * nb;
                transpose_item64(a.in[I_BWIN], GLA_IN, 64 * kb, 64 * nb, (bf16*)(F.ws + WS_WBIN), 1024, 64 * nb, nv < 0 ? 0 : (nv > 64 ? 64 : nv), scr, F.lane); continue; } r -= I2;
            if (r < I3) { const int kb = r / 16, nb = r % 16;
                transpose_item64(a.in[I_BWOUT], 1024, 64 * kb, 64 * nb, (bf16*)(F.ws + WS_WBOUT), 1024, 64 * nb, 64, scr, F.lane); continue; } r -= I3;
            if (r < I4) { const int kb = r / 48, nb = r % 48;
                transpose_item64(a.in[I_CWQKV], 3072, 64 * kb, 64 * nb, (bf16*)(F.ws + WS_WCQKV), 1024, 64 * nb, 64, scr, F.lane); continue; } r -= I4;
            { const int kb = r / 16, nb = r % 16;
                transpose_item64(a.in[I_CWOUT], 1024, 64 * kb, 64 * nb, (bf16*)(F.ws + WS_WCOUT), 1024, 64 * nb, 64, scr, F.lane); }
        }
    }
    {
        constexpr int KB = 16, PER_GU = KB * 32, PER_DN = KB * 16, NGU = 128 * PER_GU, NDN = 128 * PER_DN;
        for (int it = gw; it < NGU + NDN; it += NGW) {
            if (it < NGU) { const int le = it / PER_GU, q = it % PER_GU, kb = q / 32, nb = q % 32;
                const int n0 = 64 * nb, half = n0 >> 10, jj = n0 & 1023, dst = (jj >> 7) * 256 + half * 128 + (jj & 127);
                transpose_item64(a.in[I_MWGU] + (size_t)le * 1024 * 2048, 2048, 64 * kb, n0, (bf16*)(F.ws + WS_WGU) + (size_t)le * 2048 * 1024, 1024, dst, 64, scr, F.lane); }
            else { const int r = it - NGU, le = r / PER_DN, q = r % PER_DN, kb = q / 16, nb = q % 16;
                transpose_item64(a.in[I_MWDN] + (size_t)le * 1024 * 1024, 1024, 64 * kb, 64 * nb, (bf16*)(F.ws + WS_WDN) + (size_t)le * 1024 * 1024, 1024, 64 * nb, 64, scr, F.lane); }
        }
    }
    const int gt = F.vcu * NTHREADS + F.tid, NGT = F.G * NTHREADS;
    for (int i = gt; i < 2 * 8 * 128 * 128; i += NGT) ((bf16*)(F.ws + WS_WSB))[i] = (bf16)f2bf(a.in[I_AWS][i]);
    for (int i = gt; i < 4 * 32 * 1024; i += NGT) { const int l = i >> 15, e = (i >> 10) & 31, k = i & 1023;
        const float w = a.in[I_MWR][((size_t)l * 1024 + k) * 32 + e]; const unsigned h = f2bf(w); const float rem = w - bf2f(h);
        ((bf16*)(F.ws + WS_WRH))[i] = (bf16)h; ((bf16*)(F.ws + WS_WRL))[i] = (bf16)f2bf(rem); }
    for (int i = gt; i < 128 * 32; i += NGT) { const int pos = i >> 5, f = i & 31;
        const float fr = powf(10000.0f, -(float)f / 32.0f); const float ang = (float)pos * fr; float sn, cs; sincosf(ang, &sn, &cs);
        ((float*)(F.ws + WS_ROPE))[2 * i] = cs; ((float*)(F.ws + WS_ROPE))[2 * i + 1] = sn; }
    {
        __syncthreads();
        LAS float* sv = (LAS float*)(F.lds);
        LAS float* red = sv + 3 * 1024;
        for (int i = F.tid; i < 3 * 1024; i += NTHREADS) { const int s = i >> 10, k = i & 1023;
            const float v = s == 0 ? a.in[I_CCTX][k] : a.in[I_C][(s - 1) * 1024 + k]; sv[i] = v / (1.0f + __expf(-v)); }
        __syncthreads();
        for (int u = F.vcu; u < 4 * 96; u += F.G) { const int l = u / 96, n0 = (u % 96) * 64;
            const float* w = a.in[I_ADAW] + (size_t)l * 1024 * 6144 + n0 + F.lane;
            float a0 = 0.f, a1 = 0.f, a2 = 0.f;
#pragma unroll 8
            for (int kk = 0; kk < 128; ++kk) { const int k = F.wave * 128 + kk; const float wv = w[(size_t)k * 6144];
                a0 += sv[k] * wv; a1 += sv[1024 + k] * wv; a2 += sv[2048 + k] * wv; }
            red[(F.wave * 3 + 0) * 64 + F.lane] = a0; red[(F.wave * 3 + 1) * 64 + F.lane] = a1; red[(F.wave * 3 + 2) * 64 + F.lane] = a2;
            __syncthreads();
            if (F.tid < 192) { const int s = F.tid >> 6, c = F.tid & 63; float t = a.in[I_ADAB][l * 6144 + n0 + c];
#pragma unroll
                for (int w8 = 0; w8 < 8; ++w8) t += red[(w8 * 3 + s) * 64 + c];
                ((float*)(F.ws + WS_ADA))[(size_t)(l * 3 + s) * 6144 + n0 + c] = t; }
            __syncthreads();
        }
    }
}

__device__ __forceinline__ void moe_tables(Frame& F, int layer) {
    LAS int* M = (LAS int*)(F.lds + MISC_OFF);
    __syncthreads();
    if (F.tid < 32) M[400 + F.tid] = (int)__hip_atomic_load(F.ctl + CW_CNT + (layer * 32 + F.tid) * 64, __ATOMIC_RELAXED, __HIP_MEMORY_SCOPE_AGENT);
    __syncthreads();
    if (F.tid == 0) { int off = 0; for (int e = 0; e < 32; ++e) { M[e] = off; const int nt = (M[400 + e] + 255) >> 8; for (int t = 0; t < nt; ++t) M[64 + (off >> 8) + t] = e; off += nt << 8; } M[32] = off; }
    __syncthreads();
}

__device__ __forceinline__ void p_prenorm(Frame& F, const Args& a, int layer, bool fin, bool dry = false) {
    const int gw = F.vcu * NWAVES + F.wave, NGW = F.G * NWAVES;
    const int prev = layer - 1;
    const int row_lo = (layer >= 3) ? NCTX : 0;
    const bool combine = layer > 0;
    if (combine) moe_tables(F, prev);
    const LAS int* M = (const LAS int*)(F.lds + MISC_OFF);
    float* X = (float*)(F.ws + WS_X); bf16* H = (bf16*)(F.ws + (dry ? WS_AS : WS_H));
    const bf16* YB = (const bf16*)(F.ws + WS_YB);
    const float* ada = (const float*)(F.ws + WS_ADA);
    const v4u* TOKI = (const v4u*)(F.ws + WS_TOKI); const f32x4* TOKG = (const f32x4*)(F.ws + WS_TOKG);
    for (int row = row_lo + gw; row < NTOK; row += NGW) {
        const int seg = seg_of_row(row);
        const float* src = layer == 0 ? (row < NCTX ? a.in[I_CTX] + (size_t)row * D : a.in[I_X] + (size_t)(row - NCTX) * D) : X + (size_t)row * D;
        f32x4 v[4];
#pragma unroll
        for (int j = 0; j < 4; ++j) v[j] = *(const GAS f32x4*)(src + 4 * F.lane + 256 * j);
        if (combine) {
            const v4u ti = TOKI[row]; const f32x4 tg = TOKG[row];
            f32x4 acc[4];
#pragma unroll
            for (int j = 0; j < 4; ++j) acc[j] = (f32x4){0.f, 0.f, 0.f, 0.f};
#pragma unroll
            for (int k = 0; k < 4; ++k) { const unsigned t = ti[k]; const int pos = M[t >> 16] + (int)(t & 0xffffu); const float g = tg[k];
                const bf16* yr = YB + (size_t)pos * D + 4 * F.lane;
#pragma unroll
                for (int j = 0; j < 4; ++j) { const v2u y = *(const GAS v2u*)(yr + 256 * j);
                    acc[j].x += g * bflo(y.x); acc[j].y += g * bfhi(y.x); acc[j].z += g * bflo(y.y); acc[j].w += g * bfhi(y.y); } }
            const float* g5 = ada + (size_t)((prev * 3 + seg) * 6 + 5) * D;
#pragma unroll
            for (int j = 0; j < 4; ++j) { const f32x4 gg = *(const GAS f32x4*)(g5 + 4 * F.lane + 256 * j); v[j] = v[j] + gg * acc[j]; }
        }
        if (!fin && !dry && (combine || layer == 0)) {
#pragma unroll
            for (int j = 0; j < 4; ++j) *(GAS f32x4*)(X + (size_t)row * D + 4 * F.lane + 256 * j) = v[j];
        }
        float ss = 0.f;
#pragma unroll
        for (int j = 0; j < 4; ++j) ss += (v[j].x * v[j].x + v[j].y * v[j].y) + (v[j].z * v[j].z + v[j].w * v[j].w);
        const float rstd = 1.0f / sqrtf(wave_sum(ss) * (1.0f / D) + EPS);
        if (fin) {
            float* o = a.out + (size_t)(row - NCTX) * D;
#pragma unroll
            for (int j = 0; j < 4; ++j) { const f32x4 g = *(const GAS f32x4*)(a.in[I_NOUT] + 4 * F.lane + 256 * j); *(GAS f32x4*)(o + 4 * F.lane + 256 * j) = v[j] * rstd * g; }
        } else {
            const float* sh = ada + (size_t)((layer * 3 + seg) * 6 + 0) * D; const float* sc = sh + D;
            const float* nw = a.in[I_NMIX] + (size_t)layer * D;
#pragma unroll
            for (int j = 0; j < 4; ++j) { const int c = 4 * F.lane + 256 * j;
                const f32x4 g = *(const GAS f32x4*)(nw + c), s1 = *(const GAS f32x4*)(sc + c), s0 = *(const GAS f32x4*)(sh + c);
                const f32x4 h = v[j] * rstd * g * (s1 + 1.0f) + s0;
                v2u o; o.x = pk2(h.x, h.y); o.y = pk2(h.z, h.w);
                *(GAS v2u*)(H + (size_t)row * D + c) = o; }
        }
    }
}

__device__ __forceinline__ void p_router(Frame& F, const Args& a, int layer, bool dry = false) {
    const int row_lo = (layer >= 2) ? NCTX : 0;
    const int ntile = (NTOK - row_lo) / 16;
    float* X = (float*)(F.ws + WS_X); bf16* H = (bf16*)(F.ws + WS_H);
    const float* ada = (const float*)(F.ws + WS_ADA);
    constexpr int AST = 1032;
    LAS bf16* Ahi = (LAS bf16*)(F.lds); LAS bf16* Alo = Ahi + 16 * AST;
    LAS float* RED = (LAS float*)(F.lds + 2 * 16 * AST * 2);
    LAS float* LOG = RED + 8 * 16 * 32;
    const int fr = F.lane & 15, fq = F.lane >> 4;
    bf16x8 Bh[2][4], Bl[2][4];
    {
        const bf16* wh = (const bf16*)(F.ws + WS_WRH) + (size_t)layer * 32 * 1024; const bf16* wl = (const bf16*)(F.ws + WS_WRL) + (size_t)layer * 32 * 1024;
#pragma unroll
        for (int nt = 0; nt < 2; ++nt)
#pragma unroll
            for (int ks = 0; ks < 4; ++ks) { const size_t o = (size_t)(nt * 16 + fr) * 1024 + F.wave * 128 + ks * 32 + fq * 8;
                Bh[nt][ks] = *(const GAS bf16x8*)(wh + o); Bl[nt][ks] = *(const GAS bf16x8*)(wl + o); }
    }
    const float* nw = a.in[I_NFFN] + (size_t)layer * D;
    for (int tile = F.vcu; tile < ntile; tile += F.G) {
        const int r0 = row_lo + 16 * tile;
#pragma unroll
        for (int rr = 0; rr < 2; ++rr) {
            const int rl = 2 * F.wave + rr, row = r0 + rl, seg = seg_of_row(row);
            const float* sh = ada + (size_t)((layer * 3 + seg) * 6 + 3) * D; const float* sc = sh + D;
            f32x4 v[4]; float ss = 0.f;
#pragma unroll
            for (int j = 0; j < 4; ++j) { v[j] = *(const GAS f32x4*)(X + (size_t)row * D + 4 * F.lane + 256 * j); ss += (v[j].x * v[j].x + v[j].y * v[j].y) + (v[j].z * v[j].z + v[j].w * v[j].w); }
            const float rstd = 1.0f / sqrtf(wave_sum(ss) * (1.0f / D) + EPS);
#pragma unroll
            for (int j = 0; j < 4; ++j) { const int c = 4 * F.lane + 256 * j;
                const f32x4 g = *(const GAS f32x4*)(nw + c), s1 = *(const GAS f32x4*)(sc + c), s0 = *(const GAS f32x4*)(sh + c);
                const f32x4 h = v[j] * rstd * g * (s1 + 1.0f) + s0;
                const unsigned h0 = f2bf(h.x), h1 = f2bf(h.y), h2 = f2bf(h.z), h3 = f2bf(h.w);
                v2u o; o.x = h0 | (h1 << 16); o.y = h2 | (h3 << 16);
                *(GAS v2u*)(H + (size_t)row * D + c) = o;
                *(LAS v2u*)(Ahi + rl * AST + c) = o;
                v2u l; l.x = pk2(h.x - bf2f(h0), h.y - bf2f(h1)); l.y = pk2(h.z - bf2f(h2), h.w - bf2f(h3));
                *(LAS v2u*)(Alo + rl * AST + c) = l; }
        }
        __syncthreads();
        f32x4 acc[2] = {(f32x4){0.f, 0.f, 0.f, 0.f}, (f32x4){0.f, 0.f, 0.f, 0.f}};
#pragma unroll
        for (int ks = 0; ks < 4; ++ks) { const int o = fr * AST + F.wave * 128 + ks * 32 + fq * 8;
            const bf16x8 ah = *(const LAS bf16x8*)(Ahi + o), al = *(const LAS bf16x8*)(Alo + o);
#pragma unroll
            for (int nt = 0; nt < 2; ++nt) { acc[nt] = MFMA16(ah, Bh[nt][ks], acc[nt]); acc[nt] = MFMA16(ah, Bl[nt][ks], acc[nt]); acc[nt] = MFMA16(al, Bh[nt][ks], acc[nt]); } }
#pragma unroll
        for (int nt = 0; nt < 2; ++nt)
#pragma unroll
            for (int j = 0; j < 4; ++j) RED[(F.wave * 16 + fq * 4 + j) * 32 + nt * 16 + fr] = acc[nt][j];
        __syncthreads();
        {
            const int rl = F.tid >> 5, e = F.tid & 31, row = r0 + rl;
            float lg = a.in[I_MBR][layer * 32 + e];
#pragma unroll
            for (int w8 = 0; w8 < 8; ++w8) lg += RED[(w8 * 16 + rl) * 32 + e];
            float cur = lg; float tv[4]; int tix[4];
#pragma unroll
            for (int k = 0; k < 4; ++k) { float bv = cur; int bi = e;
#pragma unroll
                for (int o = 1; o < 32; o <<= 1) { const float ov = __shfl_xor(bv, o); const int oi = __shfl_xor(bi, o); if (ov > bv || (ov == bv && oi < bi)) { bv = ov; bi = oi; } }
                tv[k] = bv; tix[k] = bi; if (e == bi) cur = -3.0e38f; }
            const float e1 = __expf(tv[1] - tv[0]), e2 = __expf(tv[2] - tv[0]), e3 = __expf(tv[3] - tv[0]); const float inv = 1.0f / (1.0f + e1 + e2 + e3);
            if (e < 4 && !dry) { const int k = e; const int ek = k == 0 ? tix[0] : (k == 1 ? tix[1] : (k == 2 ? tix[2] : tix[3])); const float gk = (k == 0 ? 1.0f : (k == 1 ? e1 : (k == 2 ? e2 : e3))) * inv;
                const unsigned rank = atomicAdd(F.ctl + CW_CNT + (layer * 32 + ek) * 64, 1u);
                ((unsigned*)(F.ws + WS_LIST))[(size_t)ek * NTOK + rank] = (unsigned)row;
                ((unsigned*)(F.ws + WS_TOKI))[(size_t)row * 4 + k] = ((unsigned)ek << 16) | rank;
                ((float*)(F.ws + WS_TOKG))[(size_t)row * 4 + k] = gk; }
        }
        __syncthreads();
    }
}

__device__ __forceinline__ void p_gather(Frame& F, int layer) {
    moe_tables(F, layer);
    const LAS int* M = (const LAS int*)(F.lds + MISC_OFF);
    const int total = M[32];
    const int gw = F.vcu * NWAVES + F.wave, NGW = F.G * NWAVES;
    const bf16* H = (const bf16*)(F.ws + WS_H); bf16* AS = (bf16*)(F.ws + WS_AS);
    const unsigned* LIST = (const unsigned*)(F.ws + WS_LIST);
    for (int p = gw; p < total; p += NGW) {
        const int e = M[64 + (p >> 8)]; const int rank = p - M[e];
        v4u x0 = (v4u){0u, 0u, 0u, 0u}, x1 = x0;
        if (rank < M[400 + e]) { const unsigned r = LIST[(size_t)e * NTOK + rank]; const GAS v4u* s = (const GAS v4u*)(H + (size_t)r * D); x0 = s[F.lane]; x1 = s[64 + F.lane]; }
        GAS v4u* d = (GAS v4u*)(AS + (size_t)p * D); d[F.lane] = x0; d[64 + F.lane] = x1;
    }
}

typedef short s16x4 __attribute__((ext_vector_type(4)));
__device__ __forceinline__ bf16x8 tr_frag(const LAS bf16* T, int stride, int kb, int c0, int lane) {
    const int g = lane >> 4, w = lane & 15, q = w >> 2, p = w & 3;
    const LAS bf16* a0 = T + (kb + 4 * g + q) * stride + c0 + 4 * p;
    const s16x4 lo = __builtin_amdgcn_ds_read_tr16_b64_v4i16((LAS s16x4*)a0);
    const s16x4 hi = __builtin_amdgcn_ds_read_tr16_b64_v4i16((LAS s16x4*)(a0 + 16 * stride));
    return (bf16x8){lo[0], lo[1], lo[2], lo[3], hi[0], hi[1], hi[2], hi[3]};
}
__device__ __forceinline__ bf16x8 perm_frag(const LAS bf16* rowp, int kb, int quad) {
    const v2u lo = *(const LAS v2u*)(rowp + kb + 4 * quad), hi = *(const LAS v2u*)(rowp + kb + 16 + 4 * quad);
    v4u w; w.x = lo.x; w.y = lo.y; w.z = hi.x; w.w = hi.y; return __builtin_bit_cast(bf16x8, w);
}
__device__ __forceinline__ void p_spatial(Frame& F, const Args& a, int layer) {
    const int jl = layer / 3;
    const int c_lo = (layer >= 3) ? 4 : 0;
    const int nunit = (132 - c_lo) * 8;
    const bf16* ZB = (const bf16*)(F.ws + WS_BIG); bf16* G = (bf16*)(F.ws + WS_G);
    constexpr int ST = 144;
    LAS bf16* As = (LAS bf16*)(F.lds); LAS bf16* Bs = As + 128 * ST; LAS float* rs = (LAS float*)(F.lds + 2 * 128 * ST * 2);
    const int fr = F.lane & 15, fq = F.lane >> 4;
    for (int u = F.vcu; u < nunit; u += F.G) {
        const int c = c_lo + (u >> 3), g = u & 7, r0 = 128 * c;
        for (int rr = 0; rr < 16; ++rr) { const int rl = F.wave * 16 + rr; const GAS v4u* p = (const GAS v4u*)(ZB + (size_t)(r0 + rl) * 2048 + 1024 + 16 * F.lane);
            const v4u x0 = p[0], x1 = p[1]; float ss = 0.f;
#pragma unroll
            for (int i = 0; i < 4; ++i) { const float l0 = bflo(x0[i]), h0 = bfhi(x0[i]), l1 = bflo(x1[i]), h1 = bfhi(x1[i]); ss += l0 * l0 + h0 * h0 + l1 * l1 + h1 * h1; }
            ss = wave_sum(ss); if (F.lane == 0) rs[rl] = 1.0f / sqrtf(ss * (1.0f / 1024.0f) + EPS); }
        __syncthreads();
        {
            const bf16* wsb = (const bf16*)(F.ws + WS_WSB) + (size_t)(jl * 8 + g) * 128 * 128;
            const float* gv = a.in[I_AGV] + (size_t)jl * 1024 + 128 * g;
#pragma unroll
            for (int i = 0; i < 4; ++i) { const int id = F.tid + 512 * i, p = id >> 4, qc = id & 15;
                *(LAS v4u*)(As + p * ST + qc * 8) = *(const GAS v4u*)(wsb + p * 128 + qc * 8);
                const v4u x = *(const GAS v4u*)(ZB + (size_t)(r0 + p) * 2048 + 1024 + 128 * g + 8 * qc); const float rq = rs[p];
                const f32x4 g0 = *(const GAS f32x4*)(gv + 8 * qc), g1 = *(const GAS f32x4*)(gv + 8 * qc + 4);
                v4u o; o.x = pk2(bflo(x.x) * rq * g0.x, bfhi(x.x) * rq * g0.y); o.y = pk2(bflo(x.y) * rq * g0.z, bfhi(x.y) * rq * g0.w);
                o.z = pk2(bflo(x.z) * rq * g1.x, bfhi(x.z) * rq * g1.y); o.w = pk2(bflo(x.w) * rq * g1.z, bfhi(x.w) * rq * g1.w);
                *(LAS v4u*)(Bs + p * ST + qc * 8) = o; }
        }
        __syncthreads();
        f32x4 acc[8];
#pragma unroll
        for (int nt = 0; nt < 8; ++nt) acc[nt] = (f32x4){0.f, 0.f, 0.f, 0.f};
#pragma unroll
        for (int ks = 0; ks < 4; ++ks) { const bf16x8 af = tr_frag(Bs, ST, 32 * ks, 16 * F.wave, F.lane);
#pragma unroll
            for (int nt = 0; nt < 8; ++nt) { const bf16x8 bfr = perm_frag(As + (16 * nt + fr) * ST, 32 * ks, fq); acc[nt] = MFMA16(af, bfr, acc[nt]); } }
        const float* bs = a.in[I_ABS] + (size_t)(jl * 8 + g) * 128;
#pragma unroll
        for (int nt = 0; nt < 8; ++nt) { const int p = 16 * nt + fr; const float bb = bs[p]; const size_t row = (size_t)(r0 + p); const int cc = 128 * g + 16 * F.wave + 4 * fq;
            const v2u uu = *(const GAS v2u*)(ZB + row * 2048 + cc);
            v2u o; o.x = pk2(bflo(uu.x) * (acc[nt][0] + bb), bfhi(uu.x) * (acc[nt][1] + bb)); o.y = pk2(bflo(uu.y) * (acc[nt][2] + bb), bfhi(uu.y) * (acc[nt][3] + bb));
            *(GAS v2u*)(G + row * D + cc) = o; }
        __syncthreads();
    }
}

constexpr int PST = GLA_INP;
constexpr int CST = 132;
constexpr int KST = 144;
constexpr int VST = 272;
__device__ __forceinline__ void gla_cum(Frame& F, const Args& a, int c, int h, int dir, LAS float* cum, LAS float* rt, LAS float* tot) {
    const bf16* P = (const bf16*)(F.ws + WS_BIG);
    for (int i = F.tid; i < 64 * 8; i += NTHREADS) { const int ii = i >> 3, j2 = i & 7; const unsigned x = *(const GAS unsigned*)(P + (size_t)(64 * c + ii) * PST + 3072 + dir * 16 + 2 * j2);
        rt[ii * 16 + 2 * j2] = bflo(x); rt[ii * 16 + 2 * j2 + 1] = bfhi(x); }
    const int kk = F.tid & 127, part = F.tid >> 7;
    float w[16];
#pragma unroll
    for (int j = 0; j < 16; ++j) w[j] = a.in[I_BWA2][(size_t)(dir * 16 + j) * 512 + h * 128 + kk];
    const float ba = a.in[I_BBA][dir * 512 + h * 128 + kk];
    __syncthreads();
    float la[16];
#pragma unroll
    for (int ii = 0; ii < 16; ++ii) { const int i = part * 16 + ii; float z = ba;
        const f32x4 r0 = *(const LAS f32x4*)(rt + i * 16), r1 = *(const LAS f32x4*)(rt + i * 16 + 4), r2 = *(const LAS f32x4*)(rt + i * 16 + 8), r3 = *(const LAS f32x4*)(rt + i * 16 + 12);
        z += r0.x * w[0] + r0.y * w[1] + r0.z * w[2] + r0.w * w[3]; z += r1.x * w[4] + r1.y * w[5] + r1.z * w[6] + r1.w * w[7];
        z += r2.x * w[8] + r2.y * w[9] + r2.z * w[10] + r2.w * w[11]; z += r3.x * w[12] + r3.y * w[13] + r3.z * w[14] + r3.w * w[15];
        const float ls = fminf(z, 0.0f) - __logf(1.0f + __expf(-fabsf(z)));
        la[ii] = ls * (1.0f / 16.0f); }
    float run = 0.f;
    if (dir == 0) {
#pragma unroll
        for (int ii = 0; ii < 16; ++ii) { run += la[ii]; la[ii] = run; } }
    else {
#pragma unroll
        for (int ii = 15; ii >= 0; --ii) { run += la[ii]; la[ii] = run; } }
    tot[part * 128 + kk] = run;
    __syncthreads();
    float off = 0.f;
#pragma unroll
    for (int p = 0; p < 4; ++p) { const float t = tot[p * 128 + kk]; if (dir == 0 ? (p < part) : (p > part)) off += t; }
#pragma unroll
    for (int ii = 0; ii < 16; ++ii) cum[(part * 16 + ii) * CST + kk] = la[ii] + off;
    __syncthreads();
}
__device__ __forceinline__ void rope16(const bf16* x, int grp, int pr, int pc, const float* ROPE, bool lat, float (&out)[16]) {
    const v4u o0 = *(const GAS v4u*)(x + 16 * grp), o1 = *(const GAS v4u*)(x + 16 * grp + 8);
    float own[16];
#pragma unroll
    for (int e = 0; e < 4; ++e) { own[2 * e] = bflo(o0[e]); own[2 * e + 1] = bfhi(o0[e]); own[8 + 2 * e] = bflo(o1[e]); own[8 + 2 * e + 1] = bfhi(o1[e]); }
    if (!lat) {
#pragma unroll
        for (int e = 0; e < 16; ++e) out[e] = own[e];
        return; }
    const v4u p0 = *(const GAS v4u*)(x + 16 * (grp ^ 2)), p1 = *(const GAS v4u*)(x + 16 * (grp ^ 2) + 8);
    float par[16];
#pragma unroll
    for (int e = 0; e < 4; ++e) { par[2 * e] = bflo(p0[e]); par[2 * e + 1] = bfhi(p0[e]); par[8 + 2 * e] = bflo(p1[e]); par[8 + 2 * e + 1] = bfhi(p1[e]); }
    const int pos = (grp >> 2) ? pc : pr; const bool second = (grp >> 1) & 1;
    const float* tb = ROPE + (size_t)(pos * 32 + 16 * (grp & 1)) * 2;
#pragma unroll
    for (int e2 = 0; e2 < 8; ++e2) { const f32x4 t = *(const GAS f32x4*)(tb + 4 * e2);
        { const int e = 2 * e2; const float x1 = second ? par[e] : own[e], x2 = second ? own[e] : par[e]; out[e] = second ? (x1 * t.y + x2 * t.x) : (x1 * t.x - x2 * t.y); }
        { const int e = 2 * e2 + 1; const float x1 = second ? par[e] : own[e], x2 = second ? own[e] : par[e]; out[e] = second ? (x1 * t.w + x2 * t.z) : (x1 * t.z - x2 * t.w); } }
}
__device__ __forceinline__ void st16bf(LAS bf16* dst, const float (&v)[16]) {
    v4u a, b; a.x = pk2(v[0], v[1]); a.y = pk2(v[2], v[3]); a.z = pk2(v[4], v[5]); a.w = pk2(v[6], v[7]); b.x = pk2(v[8], v[9]); b.y = pk2(v[10], v[11]); b.z = pk2(v[12], v[13]); b.w = pk2(v[14], v[15]);
    *(LAS v4u*)dst = a; *(LAS v4u*)(dst + 8) = b;
}
__device__ __forceinline__ void ld16cum(const LAS float* p, float (&v)[16]) {
#pragma unroll
    for (int e = 0; e < 4; ++e) { const f32x4 t = *(const LAS f32x4*)(p + 4 * e); v[4 * e] = t.x; v[4 * e + 1] = t.y; v[4 * e + 2] = t.z; v[4 * e + 3] = t.w; }
}
__device__ __forceinline__ void gla_stage_v(Frame& F, int c, int h, LAS bf16* VL) {
    const bf16* P = (const bf16*)(F.ws + WS_BIG);
    const int i = F.tid & 63, grp = F.tid >> 6; const bf16* vp = P + (size_t)(64 * c + i) * PST + 1024 + h * 256 + grp * 32;
#pragma unroll
    for (int e = 0; e < 4; ++e) *(LAS v4u*)(VL + i * VST + grp * 32 + 8 * e) = *(const GAS v4u*)(vp + 8 * e);
}
__device__ __forceinline__ void p_gla_ds(Frame& F, const Args& a) {
    const bf16* P = (const bf16*)(F.ws + WS_BIG); const float* ROPE = (const float*)(F.ws + WS_ROPE);
    bf16* DS = (bf16*)(F.ws + WS_DS); float* DEC = (float*)(F.ws + WS_DEC);
    LAS float* cum = (LAS float*)(F.lds); LAS float* rt = cum + 64 * CST; LAS float* tot = rt + 64 * 16;
    LAS bf16* KE = (LAS bf16*)(tot + 4 * 128); LAS bf16* VL = KE + 64 * KST;
    const int fr = F.lane & 15, fq = F.lane >> 4;
    for (int u = F.vcu; u < 264 * 8; u += F.G) {
        const int c = u >> 3, h = (u >> 1) & 3, dir = u & 1; const bool lat = c >= 8; const int pr = (c - 8) & 127;
        gla_cum(F, a, c, h, dir, cum, rt, tot);
        const int lastrow = dir == 0 ? 63 : 0;
        {
            const int i = F.tid & 63, grp = F.tid >> 6;
            float kv[16], cl[16], ci[16];
            rope16(P + (size_t)(64 * c + i) * PST + 512 + h * 128, grp, pr, i, ROPE, lat, kv);
            ld16cum(cum + lastrow * CST + 16 * grp, cl); ld16cum(cum + i * CST + 16 * grp, ci);
#pragma unroll
            for (int e = 0; e < 16; ++e) kv[e] *= __expf(cl[e] - ci[e]);
            st16bf(KE + i * KST + 16 * grp, kv);
            gla_stage_v(F, c, h, VL);
            if (F.tid < 128) DEC[((size_t)(dir * 264 + c) * 4 + h) * 128 + F.tid] = __expf(cum[lastrow * CST + F.tid]);
        }
        __syncthreads();
        f32x4 acc[16];
#pragma unroll
        for (int nt = 0; nt < 16; ++nt) acc[nt] = (f32x4){0.f, 0.f, 0.f, 0.f};
#pragma unroll
        for (int ks = 0; ks < 2; ++ks) { const bf16x8 af = tr_frag(KE, KST, 32 * ks, 16 * F.wave, F.lane);
#pragma unroll
            for (int nt = 0; nt < 16; ++nt) { const bf16x8 bfr = tr_frag(VL, VST, 32 * ks, 16 * nt, F.lane); acc[nt] = MFMA16(af, bfr, acc[nt]); } }
        bf16* dsp = DS + ((size_t)(dir * 264 + c) * 4 + h) * 256 * 128;
#pragma unroll
        for (int nt = 0; nt < 16; ++nt) { v2u o; o.x = pk2(acc[nt][0], acc[nt][1]); o.y = pk2(acc[nt][2], acc[nt][3]);
            *(GAS v2u*)(dsp + (size_t)(nt * 16 + fr) * 128 + 16 * F.wave + fq * 4) = o; }
        __syncthreads();
    }
}
__device__ __forceinline__ void p_gla_scan(Frame& F) {
    const bf16* DS = (const bf16*)(F.ws + WS_DS); bf16* SIN = (bf16*)(F.ws + WS_SIN); const float* DEC = (const float*)(F.ws + WS_DEC);
    const int gt = F.vcu * NTHREADS + F.tid, NGT = F.G * NTHREADS;
    for (int id = gt; id < 2 * 2 * 4 * 256 * 32; id += NGT) {
        const int kq = id & 31, v = (id >> 5) & 255, h = (id >> 13) & 3, dir = (id >> 15) & 1, b = id >> 16;
        f32x4 S = (f32x4){0.f, 0.f, 0.f, 0.f};
        for (int s0 = 0; s0 < 132; s0 += 4) {
            size_t o[4]; v2u d[4]; f32x4 dc[4];
#pragma unroll
            for (int q = 0; q < 4; ++q) { const int s = s0 + q; int c;
                if (dir == 0) c = s < 4 ? 4 * b + s : 8 + 128 * b + (s - 4);
                else c = s < 4 ? 4 * b + 3 - s : 8 + 128 * b + 127 - (s - 4);
                const size_t base = ((size_t)(dir * 264 + c) * 4 + h);
                o[q] = (base * 256 + v) * 128 + 4 * kq;
                d[q] = __builtin_nontemporal_load((const GAS v2u*)(DS + o[q])); dc[q] = *(const GAS f32x4*)(DEC + base * 128 + 4 * kq); }
#pragma unroll
            for (int q = 0; q < 4; ++q) {
                v2u so; so.x = pk2(S.x, S.y); so.y = pk2(S.z, S.w);
                *(GAS v2u*)(SIN + o[q]) = so;
                S.x = S.x * dc[q].x + bflo(d[q].x); S.y = S.y * dc[q].y + bfhi(d[q].x); S.z = S.z * dc[q].z + bflo(d[q].y); S.w = S.w * dc[q].w + bfhi(d[q].y); }
        }
    }
}
__device__ __forceinline__ void p_gla_out(Frame& F, const Args& a) {
    const bf16* P = (const bf16*)(F.ws + WS_BIG); const float* ROPE = (const float*)(F.ws + WS_ROPE);
    const bf16* SIN = (const bf16*)(F.ws + WS_SIN); bf16* G = (bf16*)(F.ws + WS_G);
    constexpr int ST = 72;
    LAS float* cum = (LAS float*)(F.lds); LAS float* rt = cum + 64 * CST; LAS float* tot = rt + 64 * 16; LAS float* ssq = tot + 4 * 128;
    LAS bf16* VL = (LAS bf16*)(ssq + 8 * 64); LAS bf16* QD = VL + 64 * VST; LAS bf16* KI = QD + 64 * KST; LAS bf16* PL = KI + 64 * KST;
    const int fr = F.lane & 15, fq = F.lane >> 4;
    for (int u = F.vcu; u < 264 * 4; u += F.G) {
        const int c = u >> 2, h = u & 3; const bool lat = c >= 8; const int pr = (c - 8) & 127;
        f32x4 acc[2][4];
#pragma unroll
        for (int mt = 0; mt < 2; ++mt)
#pragma unroll
            for (int nt = 0; nt < 4; ++nt) acc[mt][nt] = (f32x4){0.f, 0.f, 0.f, 0.f};
        gla_stage_v(F, c, h, VL);
        for (int dir = 0; dir < 2; ++dir) {
            gla_cum(F, a, c, h, dir, cum, rt, tot);
            {
                const int i = F.tid & 63, grp = F.tid >> 6; const size_t row = (size_t)(64 * c + i);
                float qv[16], kv[16], ci[16];
                rope16(P + row * PST + h * 128, grp, pr, i, ROPE, lat, qv); rope16(P + row * PST + 512 + h * 128, grp, pr, i, ROPE, lat, kv);
                ld16cum(cum + i * CST + 16 * grp, ci);
#pragma unroll
                for (int e = 0; e < 16; ++e) { const float ex = __expf(ci[e]); qv[e] *= 0.08838834764831845f * ex; kv[e] *= __builtin_amdgcn_rcpf(ex); }
                st16bf(QD + i * KST + 16 * grp, qv); st16bf(KI + i * KST + 16 * grp, kv);
            }
            __syncthreads();
            {
                const int jt = F.wave >> 1;
#pragma unroll
                for (int t2 = 0; t2 < 2; ++t2) { const int it = 2 * (F.wave & 1) + t2; f32x4 s = (f32x4){0.f, 0.f, 0.f, 0.f};
#pragma unroll
                    for (int ks = 0; ks < 4; ++ks) { const bf16x8 af = *(const LAS bf16x8*)(KI + (16 * jt + fr) * KST + ks * 32 + fq * 8), bfr = *(const LAS bf16x8*)(QD + (16 * it + fr) * KST + ks * 32 + fq * 8); s = MFMA16(af, bfr, s); }
                    const int i = 16 * it + fr, j0 = 16 * jt + fq * 4; float pv[4];
#pragma unroll
                    for (int r = 0; r < 4; ++r) { const int j = j0 + r; const bool keep = dir == 0 ? (j <= i) : (j >= i); pv[r] = keep ? s[r] : 0.0f; }
                    v2u o; o.x = pk2(pv[0], pv[1]); o.y = pk2(pv[2], pv[3]);
                    *(LAS v2u*)(PL + i * ST + j0) = o; }
            }
            __syncthreads();
#pragma unroll
            for (int ks = 0; ks < 2; ++ks) {
                bf16x8 bfr[4];
#pragma unroll
                for (int nt = 0; nt < 4; ++nt) bfr[nt] = perm_frag(PL + (16 * nt + fr) * ST, 32 * ks, fq);
#pragma unroll
                for (int mt = 0; mt < 2; ++mt) { const bf16x8 af = tr_frag(VL, VST, 32 * ks, 32 * F.wave + 16 * mt, F.lane);
#pragma unroll
                    for (int nt = 0; nt < 4; ++nt) acc[mt][nt] = MFMA16(af, bfr[nt], acc[mt][nt]); } }
            const bf16* sp = SIN + ((size_t)(dir * 264 + c) * 4 + h) * 256 * 128;
#pragma unroll
            for (int ks = 0; ks < 4; ++ks) {
                bf16x8 bfr[4];
#pragma unroll
                for (int nt = 0; nt < 4; ++nt) bfr[nt] = *(const LAS bf16x8*)(QD + (16 * nt + fr) * KST + ks * 32 + fq * 8);
#pragma unroll
                for (int mt = 0; mt < 2; ++mt) { const bf16x8 af = *(const GAS bf16x8*)(sp + (size_t)(32 * F.wave + 16 * mt + fr) * 128 + ks * 32 + fq * 8);
#pragma unroll
                    for (int nt = 0; nt < 4; ++nt) acc[mt][nt] = MFMA16(af, bfr[nt], acc[mt][nt]); } }
            __syncthreads();
        }
#pragma unroll
        for (int nt = 0; nt < 4; ++nt) { float s = 0.f;
#pragma unroll
            for (int mt = 0; mt < 2; ++mt)
#pragma unroll
                for (int j = 0; j < 4; ++j) s += acc[mt][nt][j] * acc[mt][nt][j];
            s += __shfl_xor(s, 16); s += __shfl_xor(s, 32);
            if (fq == 0) ssq[F.wave * 64 + 16 * nt + fr] = s; }
        __syncthreads();
#pragma unroll
        for (int nt = 0; nt < 4; ++nt) { const int i = 16 * nt + fr; float s = 0.f;
#pragma unroll
            for (int w8 = 0; w8 < 8; ++w8) s += ssq[w8 * 64 + i];
            const float rstd = 1.0f / sqrtf(s * (1.0f / 256.0f) + EPS); const size_t row = (size_t)(64 * c + i);
#pragma unroll
            for (int mt = 0; mt < 2; ++mt) { const int v0 = 32 * F.wave + 16 * mt + fq * 4;
                const v2u gg = *(const GAS v2u*)(P + row * PST + 2048 + h * 256 + v0); const f32x4 go = *(const GAS f32x4*)(a.in[I_BGO] + v0);
                const float g0 = bflo(gg.x), g1 = bfhi(gg.x), g2 = bflo(gg.y), g3 = bfhi(gg.y);
                const float o0 = acc[mt][nt][0] * rstd * go.x * (g0 / (1.0f + __expf(-g0))), o1 = acc[mt][nt][1] * rstd * go.y * (g1 / (1.0f + __expf(-g1)));
                const float o2 = acc[mt][nt][2] * rstd * go.z * (g2 / (1.0f + __expf(-g2))), o3 = acc[mt][nt][3] * rstd * go.w * (g3 / (1.0f + __expf(-g3)));
                v2u o; o.x = pk2(o0, o1); o.y = pk2(o2, o3);
                *(GAS v2u*)(G + row * D + h * 256 + v0) = o; } }
        __syncthreads();
    }
}

__device__ __forceinline__ int na_koff(int key, int c16) { return key * 128 + ((c16 ^ ((key >> 1) & 7)) << 4); }
__device__ __forceinline__ int na_voff(int key, int c16) { return key * 128 + (((((c16 >> 1) ^ ((key >> 1) & 3)) << 1) | (c16 & 1)) << 4); }
__device__ __forceinline__ bf16x8 na_vfrag(const LAS unsigned char* V, int kb, int dt, int lane) {
    const int g = lane >> 4, w = lane & 15, q = w >> 2, p = w & 3; const int r0 = kb + 4 * g + q, r1 = r0 + 16;
    const s16x4 lo = __builtin_amdgcn_ds_read_tr16_b64_v4i16((LAS s16x4*)(V + r0 * 128 + ((dt ^ ((r0 >> 1) & 3)) << 5) + 8 * p));
    const s16x4 hi = __builtin_amdgcn_ds_read_tr16_b64_v4i16((LAS s16x4*)(V + r1 * 128 + ((dt ^ ((r1 >> 1) & 3)) << 5) + 8 * p));
    return (bf16x8){lo[0], lo[1], lo[2], lo[3], hi[0], hi[1], hi[2], hi[3]};
}
#define LBAR() do { asm volatile("s_waitcnt lgkmcnt(0)" ::: "memory"); __builtin_amdgcn_s_barrier(); asm volatile("" ::: "memory"); } while (0)
struct NaState { bf16x8 qf[2], qn[2]; f32x4 o[4]; float m_run, l_run; int cur_bh; };
__device__ __forceinline__ int na_r0(int r) { return r < 4 ? 0 : (r > 124 ? 120 : r - 4); }
__device__ __forceinline__ void na_load(Frame& F, int u_lo, int st, v4u (&kr)[4], v4u (&vr)[4]) {
    const bf16* QKV = (const bf16*)(F.ws + WS_BIG);
    const int u = u_lo + (st >> 1), bh = u >> 7, r = u & 127, b = bh >> 4, h = bh & 15;
    const size_t t0 = (size_t)NCTX + (size_t)b * SEQ + (size_t)(na_r0(r) + 4 * (st & 1)) * 64;
#pragma unroll
    for (int i = 0; i < 4; ++i) { const int id = F.tid + 512 * i, key = id >> 3, c = id & 7;
        const bf16* p = QKV + (t0 + key) * 3072 + 1024 + h * 64 + 8 * c; kr[i] = *(const GAS v4u*)p; vr[i] = *(const GAS v4u*)(p + 1024); }
}
__device__ __forceinline__ void na_loadq(Frame& F, int u, int qcol, int fq, bf16x8 (&q)[2]) {
    const bf16* QKV = (const bf16*)(F.ws + WS_BIG);
    const int bh = u >> 7, r = u & 127, b = bh >> 4, h = bh & 15;
#pragma unroll
    for (int ks = 0; ks < 2; ++ks) q[ks] = *(const GAS bf16x8*)(QKV + ((size_t)NCTX + (size_t)b * SEQ + (size_t)r * 64 + qcol) * 3072 + h * 64 + ks * 32 + fq * 8);
}
__device__ __forceinline__ void na_stage(Frame& F, const Args& a, const int u_lo, const int nstage, const int stage, v4u (&kr)[4], v4u (&vr)[4], NaState& S) {
    const bf16* QKV = (const bf16*)(F.ws + WS_BIG); bf16* G = (bf16*)(F.ws + WS_G);
    constexpr int QS = 3072;
    LAS unsigned char* KC = F.lds; LAS unsigned char* VC = F.lds + 32768; LAS unsigned char* KL = F.lds + 65536; LAS unsigned char* VL = F.lds + 98304;
    LAS float* RPB = (LAS float*)(F.lds + 131072); LAS float* MRG = RPB + 480;
    const int fr = F.lane & 15, fq = F.lane >> 4;
    const int jb = F.wave >> 1, role = F.wave & 1;
    const int bstart = jb == 0 ? 0 : (jb == 1 ? 8 : (jb == 2 ? 24 : 32));
    const int qcol = 16 * jb + fr; const int cstart = qcol < 8 ? 0 : (qcol > 56 ? 48 : qcol - 8);
    const int u = u_lo + (stage >> 1), pass = stage & 1;
    const int bh = u >> 7, r = u & 127, b = bh >> 4, h = bh & 15;
    const int r0 = na_r0(r);
    const size_t lat0 = (size_t)NCTX + (size_t)b * SEQ;
    LBAR();
    if (bh != S.cur_bh) {
        S.cur_bh = bh;
        for (int i = F.tid; i < 465; i += NTHREADS) RPB[i] = a.in[I_CRPB][h * 465 + i];
#pragma unroll
        for (int i = 0; i < 4; ++i) { const int id = F.tid + 512 * i, key = id >> 3, c = id & 7;
            const bf16* p = QKV + (size_t)(b * CTXL + key) * QS + 1024 + h * 64 + 8 * c;
            *(LAS v4u*)(KC + na_koff(key, c)) = *(const GAS v4u*)p; *(LAS v4u*)(VC + na_voff(key, c)) = *(const GAS v4u*)(p + 1024); }
    }
#pragma unroll
    for (int i = 0; i < 4; ++i) { const int id = F.tid + 512 * i, key = id >> 3, c = id & 7;
        *(LAS v4u*)(KL + na_koff(key, c)) = kr[i]; *(LAS v4u*)(VL + na_voff(key, c)) = vr[i]; }
    if (pass == 0) {
        S.qf[0] = S.qn[0]; S.qf[1] = S.qn[1];
#pragma unroll
        for (int dt = 0; dt < 4; ++dt) S.o[dt] = (f32x4){0.f, 0.f, 0.f, 0.f};
        S.m_run = -3.0e38f; S.l_run = 0.f;
        if (stage + 2 < nstage) na_loadq(F, u + 1, qcol, fq, S.qn);
    }
    if (stage + 1 < nstage) na_load(F, u_lo, stage + 1, kr, vr);
    LBAR();
    const LAS unsigned char* KB = role == 0 ? KL : KC; const LAS unsigned char* VB = role == 0 ? VL : VC;
    f32x4 s[8];
#pragma unroll
    for (int t = 0; t < 8; ++t) { const int kidx = role == 0 ? (t >> 1) * 64 + bstart + 16 * (t & 1) + fr : 128 * pass + 16 * t + fr;
        const bf16x8 k0 = *(const LAS bf16x8*)(KB + na_koff(kidx, fq)), k1 = *(const LAS bf16x8*)(KB + na_koff(kidx, 4 + fq));
        f32x4 tt = (f32x4){0.f, 0.f, 0.f, 0.f}; tt = MFMA16(k0, S.qf[0], tt); tt = MFMA16(k1, S.qf[1], tt); s[t] = tt; }
    float mx = S.m_run;
    if (role == 0) {
#pragma unroll
        for (int t4 = 0; t4 < 2; ++t4) {
            float bias[16];
#pragma unroll
            for (int q = 0; q < 16; ++q) { const int t = 4 * t4 + (q >> 2), j = q & 3; const int krow = r0 + 4 * pass + (t >> 1), kcol = bstart + 16 * (t & 1) + fq * 4 + j;
                int ci = kcol - qcol + 15; ci = ci < 0 ? 0 : (ci > 30 ? 30 : ci); bias[q] = RPB[(krow - r + 7) * 31 + ci]; }
            asm volatile("" : "+v"(bias[0]), "+v"(bias[1]), "+v"(bias[2]), "+v"(bias[3]), "+v"(bias[4]), "+v"(bias[5]), "+v"(bias[6]), "+v"(bias[7]),
                              "+v"(bias[8]), "+v"(bias[9]), "+v"(bias[10]), "+v"(bias[11]), "+v"(bias[12]), "+v"(bias[13]), "+v"(bias[14]), "+v"(bias[15]));
#pragma unroll
            for (int q = 0; q < 16; ++q) { const int t = 4 * t4 + (q >> 2), j = q & 3; const int kcol = bstart + 16 * (t & 1) + fq * 4 + j;
                const bool ok = kcol >= cstart && kcol < cstart + 16;
                const float v = ok ? s[t][j] * 0.125f + bias[q] : -3.0e38f;
                s[t][j] = v; mx = fmaxf(mx, v); } }
    } else {
#pragma unroll
        for (int t = 0; t < 8; ++t)
#pragma unroll
            for (int j = 0; j < 4; ++j) { const float v = s[t][j] * 0.125f; s[t][j] = v; mx = fmaxf(mx, v); }
    }
    mx = fmaxf(mx, __shfl_xor(mx, 16)); mx = fmaxf(mx, __shfl_xor(mx, 32));
    const float alpha = __expf(S.m_run - mx); S.m_run = mx;
    float l = 0.f;
#pragma unroll
    for (int t = 0; t < 8; ++t)
#pragma unroll
        for (int j = 0; j < 4; ++j) { const float p = s[t][j] > -1.0e38f ? __expf(s[t][j] - mx) : 0.0f; s[t][j] = p; l += p; }
    S.l_run = S.l_run * alpha + l;
#pragma unroll
    for (int dt = 0; dt < 4; ++dt) S.o[dt] = S.o[dt] * alpha;
#pragma unroll
    for (int st = 0; st < 4; ++st) {
        v4u pw; pw.x = pk2(s[2 * st][0], s[2 * st][1]); pw.y = pk2(s[2 * st][2], s[2 * st][3]); pw.z = pk2(s[2 * st + 1][0], s[2 * st + 1][1]); pw.w = pk2(s[2 * st + 1][2], s[2 * st + 1][3]);
        const bf16x8 pf = __builtin_bit_cast(bf16x8, pw);
        const int kb = role == 0 ? st * 64 + bstart : 128 * pass + 32 * st;
#pragma unroll
        for (int dt = 0; dt < 4; ++dt) S.o[dt] = MFMA16(na_vfrag(VB, kb, dt, F.lane), pf, S.o[dt]);
    }
    if (pass == 1) {
        float lt = S.l_run; lt += __shfl_xor(lt, 16); lt += __shfl_xor(lt, 32);
        if (role == 1) { LAS float* mg = MRG + jb * 10 * 64; mg[F.lane] = S.m_run; mg[64 + F.lane] = lt;
#pragma unroll
            for (int dt = 0; dt < 4; ++dt) { ((LAS unsigned*)mg)[(2 + 2 * dt) * 64 + F.lane] = pk2(S.o[dt][0], S.o[dt][1]); ((LAS unsigned*)mg)[(3 + 2 * dt) * 64 + F.lane] = pk2(S.o[dt][2], S.o[dt][3]); } }
        LBAR();
        if (role == 0) { const LAS float* mg = MRG + jb * 10 * 64; const float m1 = mg[F.lane], l1 = mg[64 + F.lane];
            const float mm = fmaxf(S.m_run, m1), a0 = __expf(S.m_run - mm), a1 = __expf(m1 - mm); const float inv = 1.0f / (lt * a0 + l1 * a1);
            bf16* op = G + (lat0 + (size_t)r * 64 + qcol) * D + h * 64 + fq * 4;
#pragma unroll
            for (int dt = 0; dt < 4; ++dt) { const unsigned w0 = ((const LAS unsigned*)mg)[(2 + 2 * dt) * 64 + F.lane], w1 = ((const LAS unsigned*)mg)[(3 + 2 * dt) * 64 + F.lane];
                v2u w; w.x = pk2((S.o[dt][0] * a0 + bflo(w0) * a1) * inv, (S.o[dt][1] * a0 + bfhi(w0) * a1) * inv); w.y = pk2((S.o[dt][2] * a0 + bflo(w1) * a1) * inv, (S.o[dt][3] * a0 + bfhi(w1) * a1) * inv);
                *(GAS v2u*)(op + 16 * dt) = w; } }
    }
}
__device__ __forceinline__ void p_natten(Frame& F, const Args& a) {
    const int u_lo = (int)(((long)F.vcu * 4096) / F.G), u_hi = (int)(((long)(F.vcu + 1) * 4096) / F.G);
    const int nstage = 2 * (u_hi - u_lo);
    if (nstage <= 0) return;
    const int fr = F.lane & 15, fq = F.lane >> 4, qcol = 16 * (F.wave >> 1) + fr;
    v4u kA[4], vA[4];
    NaState S; S.cur_bh = -1; S.m_run = -3.0e38f; S.l_run = 0.f;
#pragma unroll
    for (int dt = 0; dt < 4; ++dt) S.o[dt] = (f32x4){0.f, 0.f, 0.f, 0.f};
    na_loadq(F, u_lo, qcol, fq, S.qn); S.qf[0] = S.qn[0]; S.qf[1] = S.qn[1];
    na_load(F, u_lo, 0, kA, vA);
    for (int stage = 0; stage < nstage; ++stage) na_stage(F, a, u_lo, nstage, stage, kA, vA, S);
}

template <int MODE>
__device__ __forceinline__ void sgemm_region(Frame& F, const bf16* A, const bf16* Bt, int R0, int nrb, int C0, int ncb, bf16* O, int ldo, float* X, const float* gate, int u_first, int u_stride) {
    constexpr int ST = 264;
    LAS bf16* As = (LAS bf16*)(F.lds); LAS bf16* Bs = As + 64 * ST;
    const int fr = F.lane & 15, fq = F.lane >> 4, mt = F.wave >> 1, nt0 = 2 * (F.wave & 1);
    for (int u = u_first; u < nrb * ncb; u += u_stride) {
        const int rb = u % nrb, cb = u / nrb; const int r0 = R0 + 64 * rb, c0 = C0 + 64 * cb;
        pg8::f32x4 acc[2] = {(pg8::f32x4){0.f, 0.f, 0.f, 0.f}, (pg8::f32x4){0.f, 0.f, 0.f, 0.f}};
        v4u ra[4], rbv[4];
#pragma unroll
        for (int i = 0; i < 4; ++i) { const int id = F.tid + 512 * i, row = id >> 5, c = id & 31;
            ra[i] = *(const GAS v4u*)(A + (size_t)(r0 + row) * 1024 + 8 * c); rbv[i] = *(const GAS v4u*)(Bt + (size_t)(c0 + row) * 1024 + 8 * c); }
        for (int kc = 0; kc < 4; ++kc) {
            __syncthreads();
#pragma unroll
            for (int i = 0; i < 4; ++i) { const int id = F.tid + 512 * i, row = id >> 5, c = id & 31;
                *(LAS v4u*)(As + row * ST + 8 * c) = ra[i]; *(LAS v4u*)(Bs + row * ST + 8 * c) = rbv[i]; }
            if (kc < 3) {
#pragma unroll
                for (int i = 0; i < 4; ++i) { const int id = F.tid + 512 * i, row = id >> 5, c = id & 31;
                    ra[i] = *(const GAS v4u*)(A + (size_t)(r0 + row) * 1024 + 256 * (kc + 1) + 8 * c); rbv[i] = *(const GAS v4u*)(Bt + (size_t)(c0 + row) * 1024 + 256 * (kc + 1) + 8 * c); } }
            __syncthreads();
#pragma unroll
            for (int ks = 0; ks < 8; ++ks) { const bf16x8 af = *(const LAS bf16x8*)(As + (16 * mt + fr) * ST + ks * 32 + fq * 8);
#pragma unroll
                for (int n = 0; n < 2; ++n) { const bf16x8 bfr = *(const LAS bf16x8*)(Bs + (16 * (nt0 + n) + fr) * ST + ks * 32 + fq * 8); acc[n] = MFMA16(bfr, af, acc[n]); } }
        }
        const size_t row = (size_t)(r0 + 16 * mt + fr);
#pragma unroll
        for (int n = 0; n < 2; ++n) { const int col = c0 + 16 * (nt0 + n) + 4 * fq;
            if (MODE == 2) { f32x4* p = (f32x4*)(X + row * 1024 + col); const f32x4 g = *(const f32x4*)(gate + col); *p = *p + g * acc[n]; }
            else { f32x4 v = acc[n];
                if (MODE == 1) { const pg8::f32x2 a2 = pg8::gelu_pk((pg8::f32x2){v[0], v[1]}), b2 = pg8::gelu_pk((pg8::f32x2){v[2], v[3]}); v = (f32x4){a2.x, a2.y, b2.x, b2.y}; }
                v2u o; o.x = pk2(v[0], v[1]); o.y = pk2(v[2], v[3]); *(GAS v2u*)(O + row * ldo + col) = o; } }
    }
    __syncthreads();
}

__device__ __forceinline__ void ph_moe_gu(Frame& F, const Args& args, const int layer) {
    moe_tables(F, layer);
    const LAS int* Mt = (const LAS int*)(F.lds + MISC_OFF); const int total = Mt[32];
    pg8::Gemm g{(const bf16*)(F.ws + WS_H), (const bf16*)(F.ws + WS_WGU) + (size_t)layer * 32 * 2048 * 1024, total, 2048, D};
    pg8::GroupedOrder S; S.init(total, 2048, F.G, (int)blockIdx.x); S.tile_e = Mt + 64;
    pg8::EpiSwiglu E{(bf16*)(F.ws + WS_ACT), D, args.in[I_MBGU] + (size_t)layer * 32 * 2048, 2048};
    pg8::gemm_phase<pg8::EpiSwiglu, pg8::GroupedOrder, true>(F.lds + RING_OFF, g, S, E, (const unsigned*)(F.ws + WS_LIST), Mt, NTOK);
}
__device__ __forceinline__ void ph_moe_dn(Frame& F, const Args& args, const int layer) {
    moe_tables(F, layer);
    const LAS int* Mt = (const LAS int*)(F.lds + MISC_OFF); const int total = Mt[32];
    pg8::Gemm g{(const bf16*)(F.ws + WS_ACT), (const bf16*)(F.ws + WS_WDN) + (size_t)layer * 32 * 1024 * 1024, total, D, D};
    pg8::GroupedOrder S; S.init(total, D, F.G, (int)blockIdx.x); S.tile_e = Mt + 64;
    pg8::EpiBf16<0> E{(bf16*)(F.ws + WS_YB), D, args.in[I_MBDN] + (size_t)layer * 32 * 1024, 1024};
    pg8::gemm_phase<pg8::EpiBf16<0>, pg8::GroupedOrder>(F.lds + RING_OFF, g, S, E);
}
template <int LAYER> __device__ __forceinline__ void ph_ingemm(Frame& F) {
    constexpr int layer = LAYER, kind = layer % 3;
    const bf16* H = (const bf16*)(F.ws + WS_H);
    const bf16* A = H + (size_t)2 * 256 * D; constexpr int M = 64 * 256;
    if constexpr (kind == 0) {
        const bf16* Bt = (const bf16*)(F.ws + WS_WAIN) + (size_t)(layer / 3) * 2048 * 1024;
        pg8::Gemm g{A, Bt, M, 2048, D}; pg8::StaticOrder S; S.init(M, 2048, F.G, (int)blockIdx.x);
        pg8::EpiBf16<1> E{(bf16*)(F.ws + WS_BIG) + (size_t)2 * 256 * 2048, 2048, nullptr, 0};
        pg8::gemm_phase<pg8::EpiBf16<1>, pg8::StaticOrder>(F.lds + RING_OFF, g, S, E);
        if constexpr (layer < 3) sgemm_region<1>(F, H, Bt, 0, 8, 0, 32, (bf16*)(F.ws + WS_BIG), 2048, nullptr, nullptr, F.vcu, F.G);
    } else if constexpr (kind == 1) {
        const bf16* Bt = (const bf16*)(F.ws + WS_WBIN);
        pg8::Gemm g{A, Bt, M, 3072, D}; pg8::StaticOrder S; S.init(M, 3072, F.G, (int)blockIdx.x);
        pg8::EpiBf16<0> E{(bf16*)(F.ws + WS_BIG) + (size_t)2 * 256 * GLA_INP, GLA_INP, nullptr, 0};
        pg8::gemm_phase<pg8::EpiBf16<0>, pg8::StaticOrder>(F.lds + RING_OFF, g, S, E);
        sgemm_region<0>(F, H, Bt, 0, 8, 0, 48, (bf16*)(F.ws + WS_BIG), GLA_INP, nullptr, nullptr, F.vcu, F.G);
        sgemm_region<0>(F, H, Bt, 0, 264, 3072, 1, (bf16*)(F.ws + WS_BIG), GLA_INP, nullptr, nullptr, (F.vcu + 128) % F.G, F.G);
    } else {
        const bf16* Bt = (const bf16*)(F.ws + WS_WCQKV);
        pg8::Gemm g{A, Bt, M, 3072, D}; pg8::StaticOrder S; S.init(M, 3072, F.G, (int)blockIdx.x);
        pg8::EpiBf16<0> E{(bf16*)(F.ws + WS_BIG) + (size_t)2 * 256 * 3072, 3072, nullptr, 0};
        pg8::gemm_phase<pg8::EpiBf16<0>, pg8::StaticOrder>(F.lds + RING_OFF, g, S, E);
        sgemm_region<0>(F, H, Bt, 0, 8, 1024, 32, (bf16*)(F.ws + WS_BIG), 3072, nullptr, nullptr, F.vcu, F.G);
    }
}

#define IN(k) (lo <= (k) && (k) < hi)
#define SEAM(k) do { if (IN(k) && IN((k) + 1)) { xcd_barrier(bar); if (PROBE_BAR) xcd_barrier(bar); } else __syncthreads(); } while (0)
template <int LAYER> __device__ __forceinline__ void run_layer(Frame& F, const Args& args, const XcdBarrier& bar, const int lo, const int hi) {
    {
        constexpr int layer = LAYER; constexpr int kind = layer % 3, base = 1 + 10 * layer;
        constexpr int mt0 = (layer >= 3) ? 2 : 0;
        constexpr int mo0 = (layer >= 2) ? 2 : 0;
        if (IN(base + 0)) { p_prenorm(F, args, layer, false);
#if PROBE_TOK
            __syncthreads(); p_prenorm(F, args, layer, false, true);
#endif
        } SEAM(base + 0);
        if (IN(base + 1)) { ph_ingemm<LAYER>(F);
#if PROBE_ING
            __syncthreads(); ph_ingemm<LAYER>(F);
#endif
        }
        SEAM(base + 1);
        if (IN(base + 2)) for (int rep = 0; rep < 1 + (kind == 1 ? PROBE_GLA : (kind == 0 ? PROBE_MIX : PROBE_NAT)); ++rep) { if (rep) __syncthreads(); if constexpr (kind == 0) p_spatial(F, args, layer); else if constexpr (kind == 1) p_gla_ds(F, args); else p_natten(F, args); } SEAM(base + 2);
        if constexpr (kind == 1) { if (IN(base + 3)) for (int rep = 0; rep < 1 + PROBE_GLA; ++rep) { p_gla_scan(F); } SEAM(base + 3); }
        if constexpr (kind == 1) { if (IN(base + 4)) for (int rep = 0; rep < 1 + PROBE_GLA; ++rep) { if (rep) __syncthreads(); p_gla_out(F, args); } SEAM(base + 4); }
        if (IN(base + 5)) {
            constexpr int M = 64 * 256;
            const bf16* Bt = (const bf16*)(F.ws + (kind == 0 ? WS_WAOUT : (kind == 1 ? WS_WBOUT : WS_WCOUT))) + (kind == 0 ? (size_t)(layer / 3) * 1024 * 1024 : 0);
            const float* gate = (const float*)(F.ws + WS_ADA) + (size_t)(layer * 3 * 6 + 2) * D;
            pg8::Gemm g{(const bf16*)(F.ws + WS_G) + (size_t)2 * 256 * D, Bt, M, D, D}; pg8::StaticOrder S; S.init(M, D, F.G, (int)blockIdx.x);
            pg8::EpiResid E{(float*)(F.ws + WS_X) + (size_t)2 * 256 * D, gate, 6 * D, 2};
            pg8::gemm_phase<pg8::EpiResid, pg8::StaticOrder>(F.lds + RING_OFF, g, S, E);
            if constexpr (layer < 2) sgemm_region<2>(F, (const bf16*)(F.ws + WS_G), Bt, 0, 8, 0, 16, nullptr, 0, (float*)(F.ws + WS_X), gate, F.vcu, F.G);
        }
        SEAM(base + 5);
        if (IN(base + 6)) { p_router(F, args, layer);
#if PROBE_TOK
            __syncthreads(); p_router(F, args, layer, true);
#endif
        } SEAM(base + 6);
        if (IN(base + 8)) { ph_moe_gu(F, args, layer);
#if PROBE_MOE
            __syncthreads(); ph_moe_gu(F, args, layer);
#endif
        }
        SEAM(base + 8);
        if (IN(base + 9)) { ph_moe_dn(F, args, layer);
#if PROBE_MOE
            __syncthreads(); ph_moe_dn(F, args, layer);
#endif
        }
        SEAM(base + 9);
    }
}

__global__ void __launch_bounds__(NTHREADS, 2) fwd(Args args) {
    extern __shared__ __attribute__((aligned(16))) unsigned char lds[];
    Frame F;
    F.lds = (LAS unsigned char*)lds;
    F.tid = threadIdx.x; F.lane = F.tid & 63; F.wave = __builtin_amdgcn_readfirstlane(F.tid >> 6);
    F.G = gridDim.x; { const int bx = blockIdx.x; F.vcu = (F.G % 8 == 0) ? (bx % 8) * (F.G / 8) + bx / 8 : bx; }
    F.ws = args.ws; F.ctl = (unsigned*)(args.ws + WS_CTL);
    volatile LAS unsigned* BST = (volatile LAS unsigned*)(F.lds + LDS_BYTES - 16);
    if (F.tid < 4) BST[F.tid] = 0u;
    __syncthreads();
    const int lo = args.ph_lo, hi = args.ph_hi;
    XcdBarrier bar; bar.bar = (unsigned*)(F.ctl + CW_BAR); bar.x = 0; bar.st = BST;
    if (hi - lo > 1) bar = xcd_barrier_post((unsigned*)(F.ctl + CW_BAR), BST);
    if (IN(0)) { p_prologue(F, args);
#if PROBE_PRO
        __syncthreads(); p_prologue(F, args);
#endif
    } SEAM(0);

    run_layer<0>(F, args, bar, lo, hi);
    run_layer<1>(F, args, bar, lo, hi);
    run_layer<2>(F, args, bar, lo, hi);
    run_layer<3>(F, args, bar, lo, hi);
    if (IN(41)) { p_prenorm(F, args, 4, true); }
#undef IN
#undef SEAM
}

extern "C" void kernel_launch(void* const* d_in, const int* in_sizes, int n_in, void* d_out, int out_size, void* d_ws, size_t ws_size, hipStream_t stream) {
    static int grid = 0;
    if (grid == 0) {
        if (n_in != 28 || out_size != NLAT * D || ws_size < WS_END) { fprintf(stderr, "kernel_launch: unexpected problem (n_in %d, out %d, ws %zu < %zu)\n", n_in, out_size, ws_size, (size_t)WS_END); grid = -1; return; }
        int dev = 0, cus = 0, per_cu = 0;
        if (hipGetDevice(&dev) != hipSuccess || hipDeviceGetAttribute(&cus, hipDeviceAttributeMultiprocessorCount, dev) != hipSuccess) { grid = -1; return; }
        if (hipFuncSetAttribute((const void*)fwd, hipFuncAttributeMaxDynamicSharedMemorySize, LDS_BYTES) != hipSuccess) { fprintf(stderr, "kernel_launch: hipFuncSetAttribute failed\n"); grid = -1; return; }
        if (hipOccupancyMaxActiveBlocksPerMultiprocessor(&per_cu, (const void*)fwd, NTHREADS, LDS_BYTES) != hipSuccess || per_cu < 1) { fprintf(stderr, "kernel_launch: occupancy query reports %d\n", per_cu); }
        (void)hipGetLastError();
        grid = cus;
    }
    if (grid < 0) return;
    (void)hipMemsetAsync((char*)d_ws + WS_CTL, 0, CTL_ZERO_BYTES, stream);
    Args a{};
    for (int i = 0; i < 28; ++i) a.in[i] = (const float*)d_in[i];
    a.out = (float*)d_out; a.ws = (unsigned char*)d_ws;
#if MK_ONE_LAUNCH
    a.ph_lo = 0; a.ph_hi = 42;
    hipLaunchKernelGGL(fwd, dim3(grid), dim3(NTHREADS), LDS_BYTES, stream, a);
#else
    for (int p = 0; p < 42; ++p) {
        if (p >= 1 && p <= 40) { const int layer = (p - 1) / 10, loc = (p - 1) % 10; if (((loc == 3 || loc == 4) && (layer % 3) != 1) || loc == 7) continue; }
        a.ph_lo = p; a.ph_hi = p + 1;
        hipLaunchKernelGGL(fwd, dim3(grid), dim3(NTHREADS), LDS_BYTES, stream, a);
    }
#endif
}
```

```cpp
#include <hip/hip_runtime.h>
#include <cstdio>
#include <cstdint>

#ifndef MK_ONE_LAUNCH
#define MK_ONE_LAUNCH 1
#endif
#ifndef PROBE_PRO
#define PROBE_PRO 0
#endif
#ifndef PROBE_MOE
#define PROBE_MOE 0
#endif
#ifndef PROBE_ING
#define PROBE_ING 0
#endif
#ifndef PROBE_MIX
#define PROBE_MIX 0
#endif
#ifndef PROBE_GLA
#define PROBE_GLA 0
#endif
#ifndef PROBE_TOK
#define PROBE_TOK 0
#endif
#ifndef PROBE_BAR
#define PROBE_BAR 0
#endif
#ifndef PROBE_OUTG
#define PROBE_OUTG 0
#endif
#ifndef PROBE_NAT
#define PROBE_NAT 0
#endif
#ifndef PROBE_GATHER
#define PROBE_GATHER 0
#endif

namespace pg8 {
#define PG8_LAS __attribute__((address_space(3)))
typedef unsigned short bf16_t;
typedef short bf16x8 __attribute__((ext_vector_type(8)));
typedef float f32x4 __attribute__((ext_vector_type(4)));
typedef unsigned u32x4 __attribute__((ext_vector_type(4)));
constexpr int BM = 256, BK = 64, HALF = 128, HTB = HALF * BK * 2, STAGE_BYTES = 8 * HTB, NXCD = 8, WGM = 8;

__host__ __device__ __forceinline__ int lds_byte(int r, int c) { const int st = (r >> 4) * 2 + (c >> 5), rr = r & 15, cc = c & 31, ob = rr * 64 + cc * 2; return st * 1024 + (ob ^ (((ob >> 9) & 1) << 5)); }
__host__ __device__ __forceinline__ void stage_rc(int b, int& R, int& C) { const int st = b / 1024, sb = b % 1024, swz = sb ^ (((sb >> 9) & 1) << 5); R = (st >> 1) * 16 + swz / 64; C = (st & 1) * 32 + (swz % 64) / 2; }
__host__ __device__ __forceinline__ int perm32(int rho) { const int n = rho >> 4, i = rho & 15; return 8 * (i >> 2) + 4 * n + (i & 3); }

struct Unit { int pm, pn, pb, e; };
struct Gemm { const bf16_t* A; const bf16_t* Bt; int M, N, K; };

struct StaticOrder {
    int nM, nN, nwg, G, c;
    __device__ void init(int M, int N, int G_, int c_) { nM = M / BM; nN = N / BM; nwg = nM * nN; G = G_; c = c_; }
    __device__ bool next(int i, Unit& u) const {
        const long L = (long)i * G + c; if (L >= nwg) return false;
        int wgid = (int)L; { const int q = nwg / NXCD, r = nwg % NXCD, xcd = wgid % NXCD, off = wgid / NXCD; wgid = (xcd < r ? xcd * (q + 1) : r * (q + 1) + (xcd - r) * q) + off; }
        const int nig = WGM * nN, gid = wgid / nig, fm = gid * WGM, gsz = (nM - fm) < WGM ? (nM - fm) : WGM;
        u.pm = fm + ((wgid % nig) % gsz); u.pn = (wgid % nig) / gsz; u.pb = u.pn; u.e = 0; return true;
    }
};
struct GroupedOrder : StaticOrder {
    const PG8_LAS int* tile_e;
    __device__ bool next(int i, Unit& u) const {
        if (!StaticOrder::next(i, u)) return false;
        u.e = __builtin_amdgcn_readfirstlane(tile_e[u.pm]); u.pb = u.e * nN + u.pn; return true;
    }
};

__device__ __forceinline__ unsigned cvt_pk_bf16(float lo, float hi) { unsigned r; asm volatile("v_cvt_pk_bf16_f32 %0, %1, %2" : "=v"(r) : "v"(lo), "v"(hi)); return r; }
typedef float f32x2 __attribute__((ext_vector_type(2)));
__device__ __forceinline__ f32x2 gelu_pk(f32x2 v) {
    const f32x2 av = __builtin_elementwise_abs(v), d = av * 0.2316418882f + 1.0f;
    f32x2 t; t.x = __builtin_amdgcn_rcpf(d.x); t.y = __builtin_amdgcn_rcpf(d.y);
    f32x2 q = t * 0.5307027145f + (-0.7265760135f); q = q * t + 0.7107068705f; q = q * t + (-0.142248368f); q = q * t + 0.127414796f; q = q * t;
    const f32x2 s = (v * v) * (-0.72134752044f);
    f32x2 e; e.x = __builtin_amdgcn_exp2f(s.x); e.y = __builtin_amdgcn_exp2f(s.y);
    const f32x2 m = v * (q * e), r = v - m;
    f32x2 o; o.x = v.x < 0.f ? m.x : r.x; o.y = v.y < 0.f ? m.y : r.y; return o;
}

template <int ACT> struct EpiBf16 {
    static constexpr bool PERM = true;
    bf16_t* O; int ldc; const float* bias; int bias_estride;
    __device__ __forceinline__ void operator()(const f32x4 (&acc)[2][2][4][2], const Unit& u, int wr, int wc, int fr, int fq) const {
        const int row0 = u.pm * BM + wr * 64 + fr; const int col0 = u.pn * BM + wc * 32 + 8 * fq;
        const float* bp = bias ? bias + (size_t)u.e * bias_estride : nullptr;
        f32x4 bv[2][2];
#pragma unroll
        for (int bj = 0; bj < 2; ++bj)
#pragma unroll
            for (int n = 0; n < 2; ++n) bv[bj][n] = bp ? *(const f32x4*)(bp + col0 + bj * HALF + 4 * n) : (f32x4){0.f, 0.f, 0.f, 0.f};
#pragma unroll
        for (int ai = 0; ai < 2; ++ai)
#pragma unroll
            for (int m = 0; m < 4; ++m) { bf16_t* rowp = O + (size_t)(row0 + ai * HALF + m * 16) * ldc + col0;
#pragma unroll
                for (int bj = 0; bj < 2; ++bj) { f32x4 v0 = acc[ai][bj][m][0] + bv[bj][0], v1 = acc[ai][bj][m][1] + bv[bj][1];
                    if (ACT == 1) { f32x2 a = gelu_pk((f32x2){v0[0], v0[1]}), b = gelu_pk((f32x2){v0[2], v0[3]}), c = gelu_pk((f32x2){v1[0], v1[1]}), d = gelu_pk((f32x2){v1[2], v1[3]});
                        v0 = (f32x4){a.x, a.y, b.x, b.y}; v1 = (f32x4){c.x, c.y, d.x, d.y}; }
                    u32x4 w; w.x = cvt_pk_bf16(v0[0], v0[1]); w.y = cvt_pk_bf16(v0[2], v0[3]); w.z = cvt_pk_bf16(v1[0], v1[1]); w.w = cvt_pk_bf16(v1[2], v1[3]);
                    *(u32x4*)(rowp + bj * HALF) = w; } }
    }
};
struct EpiSwiglu {
    static constexpr bool PERM = true;
    bf16_t* O; int ldc; const float* bias; int bias_estride;
    __device__ __forceinline__ void operator()(const f32x4 (&acc)[2][2][4][2], const Unit& u, int wr, int wc, int fr, int fq) const {
        const int row0 = u.pm * BM + wr * 64 + fr; const int col0 = u.pn * HALF + wc * 32 + 8 * fq;
        const float* bp = bias + (size_t)u.e * bias_estride;
        f32x4 bg[2], bl[2];
#pragma unroll
        for (int n = 0; n < 2; ++n) { bg[n] = *(const f32x4*)(bp + col0 + 4 * n); bl[n] = *(const f32x4*)(bp + 1024 + col0 + 4 * n); }
#pragma unroll
        for (int ai = 0; ai < 2; ++ai)
#pragma unroll
            for (int m = 0; m < 4; ++m) { bf16_t* rowp = O + (size_t)(row0 + ai * HALF + m * 16) * ldc + col0;
                float o[8];
#pragma unroll
                for (int n = 0; n < 2; ++n) { const f32x4 g4 = acc[ai][0][m][n] + bg[n], l4 = acc[ai][1][m][n] + bl[n];
#pragma unroll
                    for (int i = 0; i < 4; ++i) { const float g = fminf(g4[i], 7.0f), l = fminf(fmaxf(l4[i], -7.0f), 7.0f);
                        const float sg = __builtin_amdgcn_rcpf(1.0f + __builtin_amdgcn_exp2f(-1.702f * 1.44269504089f * g));
                        o[4 * n + i] = g * sg * (l + 1.0f); } }
                u32x4 w; w.x = cvt_pk_bf16(o[0], o[1]); w.y = cvt_pk_bf16(o[2], o[3]); w.z = cvt_pk_bf16(o[4], o[5]); w.w = cvt_pk_bf16(o[6], o[7]);
                *(u32x4*)rowp = w; }
    }
};
struct EpiResid {
    static constexpr bool PERM = false;
    float* X; const float* gate; int gstride; int pm0; bool dry;
    __device__ __forceinline__ void operator()(const f32x4 (&acc)[2][2][4][2], const Unit& u, int wr, int wc, int fr, int fq) const {
        const int t = u.pm + pm0; const int seg = t < 2 ? 0 : (t < 34 ? 1 : 2);
        const int row0 = u.pm * BM + wr * 64 + fr, col0 = u.pn * BM + wc * 32 + 4 * fq;
        const float* gp = gate + (size_t)seg * gstride;
        f32x4 gv[2][2];
#pragma unroll
        for (int bj = 0; bj < 2; ++bj)
#pragma unroll
            for (int n = 0; n < 2; ++n) gv[bj][n] = *(const f32x4*)(gp + col0 + bj * HALF + n * 16);
#pragma unroll
        for (int ai = 0; ai < 2; ++ai)
#pragma unroll
            for (int m = 0; m < 4; ++m) { float* rowp = X + (size_t)(row0 + ai * HALF + m * 16) * 1024 + col0;
#pragma unroll
                for (int bj = 0; bj < 2; ++bj)
#pragma unroll
                    for (int n = 0; n < 2; ++n) { f32x4* p = (f32x4*)(rowp + bj * HALF + n * 16); const f32x4 nv = *p + gv[bj][n] * acc[ai][bj][m][n]; if (!dry) *p = nv; else if (nv[0] == 1.2345e30f) *p = nv; } }
    }
};

template <class Epi, class Sched, bool GATHER = false>
__device__ __forceinline__ void gemm_phase(PG8_LAS unsigned char* lds, const Gemm g, const Sched& S, const Epi& E, const unsigned* glist = nullptr, const PG8_LAS int* gM = nullptr, int gstride = 0) {
    const int tid = threadIdx.x, wid = __builtin_amdgcn_readfirstlane(tid >> 6), lane = tid & 63, wr = wid >> 2, wc = wid & 3, fr = lane & 15, fq = lane >> 4;
    const int K = g.K, nt = K / BK;
    unsigned voffB[2], va[2][2], vn[2][2]; int aR[2], aC[2];
#pragma unroll
    for (int i = 0; i < 2; ++i) { int R, C; stage_rc(tid * 16 + i * 8192, R, C); const int Rb = Epi::PERM ? ((R & ~31) + perm32(R & 31)) : R;
        aR[i] = R; aC[i] = C; voffB[i] = (unsigned)(Rb * K + C) * 2u;
#pragma unroll
        for (int h = 0; h < 2; ++h) { va[h][i] = (unsigned)((HALF * h + R) * K + C) * 2u; vn[h][i] = va[h][i]; } }
#define PG8_GOFF(u, dst) do { if constexpr (GATHER) { const int _e = (u).e, _p0 = (u).pm * BM - gM[_e], _c1 = gM[400 + _e] - 1; _Pragma("unroll") for (int _h = 0; _h < 2; ++_h) _Pragma("unroll") for (int _i = 0; _i < 2; ++_i) { \
        int _rk = _p0 + HALF * _h + aR[_i]; _rk = _rk < _c1 ? _rk : _c1; const unsigned _tok = glist[(size_t)_e * gstride + _rk]; dst[_h][_i] = (_tok * (unsigned)K + (unsigned)aC[_i]) * 2u; } } } while (0)
#define PG8_GTOK(u, dst) do { const int _e = (u).e, _p0 = (u).pm * BM - gM[_e], _c1 = gM[400 + _e] - 1; _Pragma("unroll") for (int _h = 0; _h < 2; ++_h) _Pragma("unroll") for (int _i = 0; _i < 2; ++_i) { \
        int _rk = _p0 + HALF * _h + aR[_i]; _rk = _rk < _c1 ? _rk : _c1; dst[_h][_i] = glist[(size_t)_e * gstride + _rk]; } } while (0)
    const size_t kstep = (size_t)(BK * 2);
    const size_t hstep = (size_t)HALF * K * 2;
    const size_t tstep = 2 * hstep;
    const unsigned ldsw = (unsigned)wid * 1024u;
    const int aoff = lds_byte(wr * 64 + fr, fq * 8), boff = lds_byte(wc * 32 + fr, fq * 8);
#define PG8_SA(b, h) (((b) * 2 + (h)) * HTB)
#define PG8_SB(b, h) ((4 + (b) * 2 + (h)) * HTB)
#define PG8_STAGE(bufoff, gbase, voff) do { _Pragma("unroll") for (int _i = 0; _i < 2; ++_i) \
        __builtin_amdgcn_global_load_lds((const unsigned*)((const char*)(gbase) + (voff)[_i]), (PG8_LAS unsigned*)(lds + (bufoff) + ldsw + _i * 8192), 16, 0, 0); } while (0)
#define PG8_LDA(dst, b, h) do { _Pragma("unroll") for (int m = 0; m < 4; ++m) _Pragma("unroll") for (int k = 0; k < 2; ++k) dst[m][k] = *(const PG8_LAS bf16x8*)(lds + PG8_SA(b, h) + aoff + m * 2048 + k * 1024); } while (0)
#define PG8_LDB(dst, b, h) do { _Pragma("unroll") for (int n = 0; n < 2; ++n) _Pragma("unroll") for (int k = 0; k < 2; ++k) dst[n][k] = *(const PG8_LAS bf16x8*)(lds + PG8_SB(b, h) + boff + n * 2048 + k * 1024); } while (0)
#define PG8_MMA(ai, bj, At, Bt) do { __builtin_amdgcn_s_setprio(1); _Pragma("unroll") for (int m = 0; m < 4; ++m) _Pragma("unroll") for (int n = 0; n < 2; ++n) _Pragma("unroll") for (int k = 0; k < 2; ++k) \
        acc[ai][bj][m][n] = __builtin_amdgcn_mfma_f32_16x16x32_bf16(Bt[n][k], At[m][k], acc[ai][bj][m][n], 0, 0, 0); __builtin_amdgcn_s_setprio(0); } while (0)
#define PG8_WAIT_V(n) asm volatile("s_waitcnt vmcnt(" #n ")" ::: "memory")
#define PG8_WAIT_L(n) asm volatile("s_waitcnt lgkmcnt(" #n ")" ::: "memory")
#define PG8_BAR __builtin_amdgcn_s_barrier()
#define PG8_SCHED __builtin_amdgcn_sched_barrier(0)
    Unit cur, nxt, nx2; int ui = 0; bool has_next = false, has_nx2 = false;
    if (!S.next(0, cur)) return;
    f32x4 acc[2][2][4][2];
#pragma unroll
    for (int a = 0; a < 2; ++a)
#pragma unroll
        for (int b = 0; b < 2; ++b)
#pragma unroll
            for (int m = 0; m < 4; ++m)
#pragma unroll
                for (int n = 0; n < 2; ++n) acc[a][b][m][n] = (f32x4){0.f, 0.f, 0.f, 0.f};
    bf16x8 At[4][2], B0[2][2], B1[2][2];
    const char* cA = (const char*)g.A + (GATHER ? (size_t)0 : (size_t)cur.pm * tstep); const char* cB = (const char*)g.Bt + (size_t)cur.pb * tstep;
    PG8_GOFF(cur, va);
    if constexpr (GATHER) { has_next = S.next(1, nxt); if (has_next) PG8_GOFF(nxt, vn); }
    PG8_STAGE(PG8_SB(0, 0), cB, voffB); PG8_STAGE(PG8_SB(0, 1), cB + hstep, voffB); PG8_STAGE(PG8_SA(0, 0), cA, va[0]); PG8_STAGE(PG8_SA(0, 1), cA, va[1]);
    if (wr == 1) PG8_BAR;
    PG8_WAIT_V(2); PG8_BAR;
    PG8_STAGE(PG8_SB(1, 0), cB + kstep, voffB); PG8_STAGE(PG8_SA(1, 0), cA + kstep, va[0]); PG8_STAGE(PG8_SB(1, 1), cB + hstep + kstep, voffB);
    PG8_WAIT_V(6); PG8_BAR;
    for (;;) {
        if constexpr (!GATHER) has_next = S.next(ui + 1, nxt);
        const char* nA = (has_next && !GATHER) ? (const char*)g.A + (size_t)nxt.pm * tstep : cA; const char* nB = has_next ? (const char*)g.Bt + (size_t)nxt.pb * tstep : cB;
        for (int t = 0; t < nt; t += 2) {
            const bool last = (t == nt - 2);
            const char* a1 = cA + (size_t)(t + 1) * kstep;
            const char* a2 = last ? nA : cA + (size_t)(t + 2) * kstep; const char* b2 = last ? nB : cB + (size_t)(t + 2) * kstep;
            const char* a3 = a2 + kstep; const char* b3 = b2 + kstep;
            unsigned v2[2][2];
#pragma unroll
            for (int _h = 0; _h < 2; ++_h)
#pragma unroll
                for (int _i = 0; _i < 2; ++_i) v2[_h][_i] = (GATHER && last) ? vn[_h][_i] : va[_h][_i];
            PG8_LDB(B0, 0, 0); PG8_LDB(B1, 0, 1); PG8_SCHED; PG8_LDA(At, 0, 0); PG8_STAGE(PG8_SA(1, 1), a1, va[1]);
            PG8_WAIT_V(8); PG8_WAIT_L(0); PG8_BAR; PG8_MMA(0, 0, At, B0); PG8_MMA(0, 1, At, B1); PG8_BAR; PG8_SCHED;
            PG8_LDA(At, 0, 1); PG8_STAGE(PG8_SB(0, 0), b2, voffB); PG8_STAGE(PG8_SB(0, 1), b2 + hstep, voffB); PG8_STAGE(PG8_SA(0, 0), a2, v2[0]);
            PG8_WAIT_V(8); PG8_WAIT_L(0); PG8_BAR; PG8_MMA(1, 0, At, B0); PG8_MMA(1, 1, At, B1); PG8_BAR; PG8_SCHED;
            PG8_LDB(B0, 1, 0); PG8_LDB(B1, 1, 1); PG8_SCHED; PG8_LDA(At, 1, 0); PG8_STAGE(PG8_SA(0, 1), a2, v2[1]);
            PG8_WAIT_V(8); PG8_WAIT_L(0); PG8_BAR; PG8_MMA(0, 0, At, B0); PG8_MMA(0, 1, At, B1); PG8_BAR; PG8_SCHED;
            PG8_LDA(At, 1, 1); PG8_STAGE(PG8_SB(1, 0), b3, voffB); PG8_STAGE(PG8_SB(1, 1), b3 + hstep, voffB); PG8_STAGE(PG8_SA(1, 0), a3, v2[0]);
            PG8_WAIT_V(8); PG8_WAIT_L(0); PG8_BAR; PG8_MMA(1, 0, At, B0); PG8_MMA(1, 1, At, B1); PG8_BAR; PG8_SCHED;
        }
        if (wr == 0) PG8_BAR;
        unsigned tk[2][2] = {{0u, 0u}, {0u, 0u}};
        if constexpr (GATHER) { has_nx2 = has_next && S.next(ui + 2, nx2); if (!has_nx2) nx2 = cur; PG8_GTOK(nx2, tk); }
        E(acc, cur, wr, wc, fr, fq);
        if (!has_next) break;
#pragma unroll
        for (int a = 0; a < 2; ++a)
#pragma unroll
            for (int b = 0; b < 2; ++b)
#pragma unroll
                for (int m = 0; m < 4; ++m)
#pragma unroll
                    for (int n = 0; n < 2; ++n) acc[a][b][m][n] = (f32x4){0.f, 0.f, 0.f, 0.f};
        cur = nxt; cA = nA; cB = nB; ++ui;
        if constexpr (GATHER) { va[0][0] = vn[0][0]; va[0][1] = vn[0][1]; va[1][0] = vn[1][0]; va[1][1] = vn[1][1];
            if (has_nx2) { nxt = nx2;
#pragma unroll
                for (int _h = 0; _h < 2; ++_h)
#pragma unroll
                    for (int _i = 0; _i < 2; ++_i) vn[_h][_i] = (tk[_h][_i] * (unsigned)K + (unsigned)aC[_i]) * 2u; }
            has_next = has_nx2; }
        if (wr == 1) PG8_BAR;
    }
    PG8_WAIT_V(0);
    PG8_BAR;
#undef PG8_SA
#undef PG8_SB
#undef PG8_STAGE
#undef PG8_GOFF
#undef PG8_GTOK
#undef PG8_LDA
#undef PG8_LDB
#undef PG8_MMA
#undef PG8_WAIT_V
#undef PG8_WAIT_L
#undef PG8_BAR
#undef PG8_SCHED
}
}

constexpr int NWAVES = 8, NTHREADS = 512;
constexpr int D = 1024, NCTX = 512, NLAT = 16384, NTOK = NCTX + NLAT, SEQ = 8192, CTXL = 256;
constexpr int NEXP = 32, MAXPADROWS = 75776, MAXPADTILES = 296;
constexpr int GLA_IN = 3104, GLA_INP = 3328;
constexpr float EPS = 1e-6f;

constexpr size_t MiB = 1u << 20;
constexpr size_t WS_CTL = 0, CTL_ZERO_BYTES = 1 * MiB;
constexpr size_t WS_ADA = 1 * MiB;
constexpr size_t WS_ROPE = 1 * MiB + 512 * 1024;
constexpr size_t WS_TOKI = 2 * MiB;
constexpr size_t WS_TOKG = 2 * MiB + 512 * 1024;
constexpr size_t WS_LIST = 3 * MiB;
constexpr size_t WS_WRH = 6 * MiB, WS_WRL = 6 * MiB + 256 * 1024;
constexpr size_t WS_WSB = 7 * MiB;
constexpr size_t WS_WAIN = 8 * MiB;
constexpr size_t WS_WAOUT = 16 * MiB;
constexpr size_t WS_WBIN = 20 * MiB;
constexpr size_t WS_WBOUT = 27 * MiB;
constexpr size_t WS_WCQKV = 29 * MiB;
constexpr size_t WS_WCOUT = 35 * MiB;
constexpr size_t WS_WGU = 64 * MiB;
constexpr size_t WS_WDN = 576 * MiB;
constexpr size_t WS_X = 832 * MiB;
constexpr size_t WS_H = 898 * MiB;
constexpr size_t WS_G = 931 * MiB;
constexpr size_t WS_BIG = 964 * MiB;
constexpr size_t WS_DS = 1072 * MiB;
constexpr size_t WS_SIN = 1204 * MiB;
constexpr size_t WS_DEC = 1336 * MiB;
constexpr size_t WS_AS = 1338 * MiB;
constexpr size_t WS_ACT = 1486 * MiB;
constexpr size_t WS_YB = 1634 * MiB;
constexpr size_t WS_END = 1782 * MiB;
constexpr int CW_TMO = 0;
constexpr int CW_BAR = 4096;
constexpr int CW_CNT = 8192;

constexpr int RING_OFF = 0, RING_BYTES = 131072;
constexpr int MISC_OFF = RING_BYTES;
constexpr int LDS_BYTES = 147456;

#define GAS __attribute__((address_space(1)))
#define LAS __attribute__((address_space(3)))
typedef unsigned short bf16;
typedef unsigned v4u __attribute__((ext_vector_type(4)));
typedef unsigned v2u __attribute__((ext_vector_type(2)));
typedef float f32x4 __attribute__((ext_vector_type(4)));
typedef short bf16x8 __attribute__((ext_vector_type(8)));
typedef short bf16x4 __attribute__((ext_vector_type(4)));
#define LDS_WAIT() asm volatile("s_waitcnt lgkmcnt(0)" ::: "memory")
#define VM_WAIT() asm volatile("s_waitcnt vmcnt(0)" ::: "memory")
__device__ __forceinline__ unsigned f2bf(float f) { unsigned u = __builtin_bit_cast(unsigned, f); return (u + 0x7fffu + ((u >> 16) & 1u)) >> 16; }
__device__ __forceinline__ unsigned pk2(float lo, float hi) { return f2bf(lo) | (f2bf(hi) << 16); }
__device__ __forceinline__ float bf2f(unsigned b) { return __builtin_bit_cast(float, b << 16); }
__device__ __forceinline__ float bflo(unsigned w) { return __builtin_bit_cast(float, w << 16); }
__device__ __forceinline__ float bfhi(unsigned w) { return __builtin_bit_cast(float, w & 0xffff0000u); }
#define MFMA16(a, b, c) __builtin_amdgcn_mfma_f32_16x16x32_bf16((a), (b), (c), 0, 0, 0)

#define XB_TMO      128
#define XB_XCNT(j)  (256  + 64 * (j))
#define XB_XSUB(j)  (1280 + 64 * (j))
#define XB_XGEN(j)  (2304 + 64 * (j))
#define XB_TOP      3328
#define XB_TOPGEN   3392
#define XCD_BAR_WORDS 3456
#define XB_SPIN_CAP (1u << 22)

__device__ __forceinline__ unsigned xb_ld(unsigned* p)              { return __hip_atomic_load(p, __ATOMIC_RELAXED, __HIP_MEMORY_SCOPE_AGENT); }
__device__ __forceinline__ unsigned xb_add(unsigned* p, unsigned v) { return __hip_atomic_fetch_add(p, v, __ATOMIC_RELAXED, __HIP_MEMORY_SCOPE_AGENT); }
__device__ __forceinline__ unsigned xb_xcc_id() { return (unsigned)__builtin_amdgcn_s_getreg((3 << 11) | 20) & 0xFu; }
#define XB_SPIN(cond, bar) do { unsigned _sp = 0; while (cond) { __builtin_amdgcn_s_sleep(1); \
    if ((++_sp & 255u) == 0u) { if (xb_ld(&(bar)[XB_TMO])) break; if (_sp > XB_SPIN_CAP) { atomicAdd(&(bar)[XB_TMO], 1u); break; } } } } while (0)

struct XcdBarrier { unsigned* bar; unsigned x; volatile LAS unsigned* st; };
__device__ __forceinline__ XcdBarrier xcd_barrier_post(unsigned* bar, volatile LAS unsigned* st) {
    XcdBarrier b; b.bar = bar; b.x = xb_xcc_id(); b.st = st;
    if (threadIdx.x == 0) (void)xb_add(&bar[XB_XCNT(b.x)], 1u);
    return b;
}
__device__ __forceinline__ void xcd_barrier_complete(unsigned* bar, unsigned x, unsigned& nloc, unsigned& nx) {
    const unsigned G = gridDim.x * gridDim.y * gridDim.z;
    unsigned sum, cnt, mine, sp = 0u;
    for (;;) {
        sum = 0u; cnt = 0u; mine = 0u;
#pragma unroll
        for (unsigned j = 0; j < 16; ++j) { const unsigned c = xb_ld(&bar[XB_XCNT(j)]); sum += c; cnt += (c > 0u) ? 1u : 0u; mine = (j == x) ? c : mine; }
        if (sum == G) break;
        __builtin_amdgcn_s_sleep(1);
        if ((++sp & 255u) == 0u) { if (xb_ld(&bar[XB_TMO])) break; if (sp > XB_SPIN_CAP) { atomicAdd(&bar[XB_TMO], 1u); break; } }
    }
    nloc = mine > 0u ? mine : 1u; nx = cnt > 0u ? cnt : 1u;
}
__device__ __forceinline__ void xcd_barrier(const XcdBarrier& b) {
    asm volatile("s_waitcnt vmcnt(0)" ::: "memory");
    __syncthreads();
    if (threadIdx.x == 0) {
        unsigned* bar = b.bar;
        __builtin_amdgcn_s_waitcnt(0);
        unsigned nloc = b.st[0], nx = b.st[1];
        if (nloc == 0u) { xcd_barrier_complete(bar, b.x, nloc, nx); b.st[0] = nloc; b.st[1] = nx; }
        const unsigned old = xb_add(&bar[XB_XSUB(b.x)], 1u);
        const unsigned gen = old / nloc;
        if (old + 1u == (gen + 1u) * nloc) {
            __builtin_amdgcn_fence(__ATOMIC_RELEASE, "agent");
            asm volatile("s_waitcnt vmcnt(0)" ::: "memory");
            const unsigned og = xb_add(&bar[XB_TOP], 1u);
            const unsigned tg = og / nx;
            if (og + 1u == (tg + 1u) * nx) xb_add(&bar[XB_TOPGEN], 1u);
            else XB_SPIN(xb_ld(&bar[XB_TOPGEN]) == tg, bar);
            __builtin_amdgcn_fence(__ATOMIC_ACQUIRE, "agent");
            xb_add(&bar[XB_XGEN(b.x)], 1u);
            asm volatile("s_waitcnt vmcnt(0)" ::: "memory");
        } else {
            XB_SPIN(xb_ld(&bar[XB_XGEN(b.x)]) == gen, bar);
            __builtin_amdgcn_fence(__ATOMIC_ACQUIRE, "agent");
            asm volatile("s_waitcnt vmcnt(0)" ::: "memory");
        }
    }
    __syncthreads();
}

struct Args { const float* in[28]; float* out; unsigned char* ws; int ph_lo, ph_hi; };
enum { I_X = 0, I_C, I_CTX, I_CCTX, I_ADAW, I_ADAB, I_NMIX, I_NFFN, I_NOUT, I_AWIN, I_AGV, I_AWS, I_ABS, I_AWOUT, I_BWIN, I_BWA2, I_BBA, I_BGO, I_BWOUT,
       I_CWQKV, I_CRPB, I_CWOUT, I_MWR, I_MBR, I_MWGU, I_MBGU, I_MWDN, I_MBDN };

struct Frame {
    LAS unsigned char* lds;
    unsigned* ctl;
    unsigned char* ws;
    int tid, lane, wave, vcu, G;
};

__device__ __forceinline__ float wave_sum(float v) {
#pragma unroll
    for (int o = 1; o < 64; o <<= 1) v += __shfl_xor(v, o);
    return v;
}
__device__ __forceinline__ int seg_of_row(int r) { return r < NCTX ? 0 : 1 + ((r - NCTX) >> 13); }

__device__ __forceinline__ void transpose_item64(const float* W, int N, int k0, int n0, bf16* WT, int K, int dst_row0, int ncols_valid, LAS float* scr, int lane) {
#pragma unroll 4
    for (int i = 0; i < 16; ++i) { const int row = 4 * i + (lane >> 4), c4 = (lane & 15) * 4;
        f32x4 v = (f32x4){0.f, 0.f, 0.f, 0.f};
        if (c4 < ncols_valid) v = *(const GAS f32x4*)(W + (size_t)(k0 + row) * N + n0 + c4);
        LAS float* s = scr + row * 65 + c4; s[0] = v.x; s[1] = v.y; s[2] = v.z; s[3] = v.w; }
    LDS_WAIT(); asm volatile("" ::: "memory");
    const int c = lane & 7;
#pragma unroll
    for (int j = 0; j < 8; ++j) { const int n = (lane >> 3) + 8 * j; const LAS float* s = scr + (8 * c) * 65 + n;
        v4u o; o.x = pk2(s[0 * 65], s[1 * 65]); o.y = pk2(s[2 * 65], s[3 * 65]); o.z = pk2(s[4 * 65], s[5 * 65]); o.w = pk2(s[6 * 65], s[7 * 65]);
        *(GAS v4u*)(WT + (size_t)(dst_row0 + n) * K + k0 + 8 * c) = o; }
    LDS_WAIT(); asm volatile("" ::: "memory");
}

__device__ __forceinline__ void p_prologue(Frame& F, const Args& a) {
    LAS float* scr = (LAS float*)(F.lds + F.wave * 16640);
    const int gw = F.vcu * NWAVES + F.wave, NGW = F.G * NWAVES;
    {
        constexpr int KB = 16;
        constexpr int I0 = 2 * KB * 32, I1 = 2 * KB * 16, I2 = KB * 52, I3 = KB * 16, I4 = KB * 48, I5 = KB * 16;
        constexpr int NI = I0 + I1 + I2 + I3 + I4 + I5;
        for (int it = gw; it < NI; it += NGW) {
            int r = it;
            if (r < I0) { const int j = r / (KB * 32), q = r % (KB * 32), kb = q / 32, nb = q % 32;
                transpose_item64(a.in[I_AWIN] + (size_t)j * 1024 * 2048, 2048, 64 * kb, 64 * nb, (bf16*)(F.ws + WS_WAIN) + (size_t)j * 2048 * 1024, 1024, 64 * nb, 64, scr, F.lane); continue; } r -= I0;
            if (r < I1) { const int j = r / (KB * 16), q = r % (KB * 16), kb = q / 16, nb = q % 16;
                transpose_item64(a.in[I_AWOUT] + (size_t)j * 1024 * 1024, 1024, 64 * kb, 64 * nb, (bf16*)(F.ws + WS_WAOUT) + (size_t)j * 1024 * 1024, 1024, 64 * nb, 64, scr, F.lane); continue; } r -= I1;
            if (r < I2) { const int kb = r / 52, nb = r % 52; const int nv = GLA_IN - 64 * nb;
                transpose_item64(a.in[I_BWIN], GLA_IN, 64 * kb, 64 * nb, (bf16*)(F.ws + WS_WBIN), 1024, 64 * nb, nv < 0 ? 0 : (nv > 64 ? 64 : nv), scr, F.lane); continue; } r -= I2;
            if (r < I3) { const int kb = r / 16, nb = r % 16;
                transpose_item64(a.in[I_BWOUT], 1024, 64 * kb, 64 * nb, (bf16*)(F.ws + WS_WBOUT), 1024, 64 * nb, 64, scr, F.lane); continue; } r -= I3;
            if (r < I4) { const int kb = r / 48, nb = r % 48;
                transpose_item64(a.in[I_CWQKV], 3072, 64 * kb, 64 * nb, (bf16*)(F.ws + WS_WCQKV), 1024, 64 * nb, 64, scr, F.lane); continue; } r -= I4;
            { const int kb = r / 16, nb = r % 16;
                transpose_item64(a.in[I_CWOUT], 1024, 64 * kb, 64 * nb, (bf16*)(F.ws + WS_WCOUT), 1024, 64 * nb, 64, scr, F.lane); }
        }
    }
    {
        constexpr int KB = 16, PER_GU = KB * 32, PER_DN = KB * 16, NGU = 128 * PER_GU, NDN = 128 * PER_DN;
        for (int it = gw; it < NGU + NDN; it += NGW) {
            if (it < NGU) { const int le = it / PER_GU, q = it % PER_GU, kb = q / 32, nb = q % 32;
                const int n0 = 64 * nb, half = n0 >> 10, jj = n0 & 1023, dst = (jj >> 7) * 256 + half * 128 + (jj & 127);
                transpose_item64(a.in[I_MWGU] + (size_t)le * 1024 * 2048, 2048, 64 * kb, n0, (bf16*)(F.ws + WS_WGU) + (size_t)le * 2048 * 1024, 1024, dst, 64, scr, F.lane); }
            else { const int r = it - NGU, le = r / PER_DN, q = r % PER_DN, kb = q / 16, nb = q % 16;
                transpose_item64(a.in[I_MWDN] + (size_t)le * 1024 * 1024, 1024, 64 * kb, 64 * nb, (bf16*)(F.ws + WS_WDN) + (size_t)le * 1024 * 1024, 1024, 64 * nb, 64, scr, F.lane); }
        }
    }
    const int gt = F.vcu * NTHREADS + F.tid, NGT = F.G * NTHREADS;
    for (int i = gt; i < 2 * 8 * 128 * 128; i += NGT) ((bf16*)(F.ws + WS_WSB))[i] = (bf16)f2bf(a.in[I_AWS][i]);
    for (int i = gt; i < 4 * 32 * 1024; i += NGT) { const int l = i >> 15, e = (i >> 10) & 31, k = i & 1023;
        const float w = a.in[I_MWR][((size_t)l * 1024 + k) * 32 + e]; const unsigned h = f2bf(w); const float rem = w - bf2f(h);
        ((bf16*)(F.ws + WS_WRH))[i] = (bf16)h; ((bf16*)(F.ws + WS_WRL))[i] = (bf16)f2bf(rem); }
    for (int i = gt; i < 128 * 32; i += NGT) { const int pos = i >> 5, f = i & 31;
        const float fr = powf(10000.0f, -(float)f / 32.0f); const float ang = (float)pos * fr; float sn, cs; sincosf(ang, &sn, &cs);
        ((float*)(F.ws + WS_ROPE))[2 * i] = cs; ((float*)(F.ws + WS_ROPE))[2 * i + 1] = sn; }
    {
        __syncthreads();
        LAS float* sv = (LAS float*)(F.lds);
        LAS float* red = sv + 3 * 1024;
        for (int i = F.tid; i < 3 * 1024; i += NTHREADS) { const int s = i >> 10, k = i & 1023;
            const float v = s == 0 ? a.in[I_CCTX][k] : a.in[I_C][(s - 1) * 1024 + k]; sv[i] = v / (1.0f + __expf(-v)); }
        __syncthreads();
        for (int u = F.vcu; u < 4 * 96; u += F.G) { const int l = u / 96, n0 = (u % 96) * 64;
            const float* w = a.in[I_ADAW] + (size_t)l * 1024 * 6144 + n0 + F.lane;
            float a0 = 0.f, a1 = 0.f, a2 = 0.f;
#pragma unroll 8
            for (int kk = 0; kk < 128; ++kk) { const int k = F.wave * 128 + kk; const float wv = w[(size_t)k * 6144];
                a0 += sv[k] * wv; a1 += sv[1024 + k] * wv; a2 += sv[2048 + k] * wv; }
            red[(F.wave * 3 + 0) * 64 + F.lane] = a0; red[(F.wave * 3 + 1) * 64 + F.lane] = a1; red[(F.wave * 3 + 2) * 64 + F.lane] = a2;
            __syncthreads();
            if (F.tid < 192) { const int s = F.tid >> 6, c = F.tid & 63; float t = a.in[I_ADAB][l * 6144 + n0 + c];
#pragma unroll
                for (int w8 = 0; w8 < 8; ++w8) t += red[(w8 * 3 + s) * 64 + c];
                ((float*)(F.ws + WS_ADA))[(size_t)(l * 3 + s) * 6144 + n0 + c] = t; }
            __syncthreads();
        }
    }
}

__device__ __forceinline__ void moe_tables(Frame& F, int layer) {
    LAS int* M = (LAS int*)(F.lds + MISC_OFF);
    __syncthreads();
    if (F.tid < 32) M[400 + F.tid] = (int)__hip_atomic_load(F.ctl + CW_CNT + (layer * 32 + F.tid) * 64, __ATOMIC_RELAXED, __HIP_MEMORY_SCOPE_AGENT);
    __syncthreads();
    if (F.tid < 64) { const int e = F.tid & 31; const int nt = (M[400 + e] + 255) >> 8; int incl = nt;
#pragma unroll
        for (int o = 1; o < 32; o <<= 1) { const int v = __shfl_up(incl, o, 32); if (e >= o) incl += v; }
        const int off = (incl - nt) << 8;
        if (F.tid < 32) { M[e] = off; for (int t = 0; t < nt; ++t) M[64 + (off >> 8) + t] = e; if (e == 31) M[32] = incl << 8; } }
    __syncthreads();
}

__device__ __forceinline__ void p_prenorm(Frame& F, const Args& a, int layer, bool fin, bool dry = false) {
    const int gw = F.vcu * NWAVES + F.wave, NGW = F.G * NWAVES;
    const int prev = layer - 1;
    const int row_lo = (layer >= 3) ? NCTX : 0;
    const bool combine = layer > 0;
    if (combine) moe_tables(F, prev);
    const LAS int* M = (const LAS int*)(F.lds + MISC_OFF);
    float* X = (float*)(F.ws + WS_X); bf16* H = (bf16*)(F.ws + (dry ? WS_AS : WS_H));
    const bf16* YB = (const bf16*)(F.ws + WS_YB);
    const float* ada = (const float*)(F.ws + WS_ADA);
    const v4u* TOKI = (const v4u*)(F.ws + WS_TOKI); const f32x4* TOKG = (const f32x4*)(F.ws + WS_TOKG);
    for (int row = row_lo + gw; row < NTOK; row += NGW) {
        const int seg = seg_of_row(row);
        const float* src = layer == 0 ? (row < NCTX ? a.in[I_CTX] + (size_t)row * D : a.in[I_X] + (size_t)(row - NCTX) * D) : X + (size_t)row * D;
        f32x4 v[4];
#pragma unroll
        for (int j = 0; j < 4; ++j) v[j] = *(const GAS f32x4*)(src + 4 * F.lane + 256 * j);
        if (combine) {
            const v4u ti = TOKI[row]; const f32x4 tg = TOKG[row];
            f32x4 acc[4];
#pragma unroll
            for (int j = 0; j < 4; ++j) acc[j] = (f32x4){0.f, 0.f, 0.f, 0.f};
#pragma unroll
            for (int k = 0; k < 4; ++k) { const unsigned t = ti[k]; const int pos = M[t >> 16] + (int)(t & 0xffffu); const float g = tg[k];
                const bf16* yr = YB + (size_t)pos * D + 4 * F.lane;
#pragma unroll
                for (int j = 0; j < 4; ++j) { const v2u y = *(const GAS v2u*)(yr + 256 * j);
                    acc[j].x += g * bflo(y.x); acc[j].y += g * bfhi(y.x); acc[j].z += g * bflo(y.y); acc[j].w += g * bfhi(y.y); } }
            const float* g5 = ada + (size_t)((prev * 3 + seg) * 6 + 5) * D;
#pragma unroll
            for (int j = 0; j < 4; ++j) { const f32x4 gg = *(const GAS f32x4*)(g5 + 4 * F.lane + 256 * j); v[j] = v[j] + gg * acc[j]; }
        }
        if (!fin && !dry && (combine || layer == 0)) {
#pragma unroll
            for (int j = 0; j < 4; ++j) *(GAS f32x4*)(X + (size_t)row * D + 4 * F.lane + 256 * j) = v[j];
        }
        float ss = 0.f;
#pragma unroll
        for (int j = 0; j < 4; ++j) ss += (v[j].x * v[j].x + v[j].y * v[j].y) + (v[j].z * v[j].z + v[j].w * v[j].w);
        const float rstd = 1.0f / sqrtf(wave_sum(ss) * (1.0f / D) + EPS);
        if (fin) {
            float* o = a.out + (size_t)(row - NCTX) * D;
#pragma unroll
            for (int j = 0; j < 4; ++j) { const f32x4 g = *(const GAS f32x4*)(a.in[I_NOUT] + 4 * F.lane + 256 * j); *(GAS f32x4*)(o + 4 * F.lane + 256 * j) = v[j] * rstd * g; }
        } else {
            const float* sh = ada + (size_t)((layer * 3 + seg) * 6 + 0) * D; const float* sc = sh + D;
            const float* nw = a.in[I_NMIX] + (size_t)layer * D;
#pragma unroll
            for (int j = 0; j < 4; ++j) { const int c = 4 * F.lane + 256 * j;
                const f32x4 g = *(const GAS f32x4*)(nw + c), s1 = *(const GAS f32x4*)(sc + c), s0 = *(const GAS f32x4*)(sh + c);
                const f32x4 h = v[j] * rstd * g * (s1 + 1.0f) + s0;
                v2u o; o.x = pk2(h.x, h.y); o.y = pk2(h.z, h.w);
                *(GAS v2u*)(H + (size_t)row * D + c) = o; }
        }
    }
}

__device__ __forceinline__ void p_router(Frame& F, const Args& a, int layer, bool dry = false) {
    const int row_lo = (layer >= 2) ? NCTX : 0;
    const int ntile = (NTOK - row_lo) / 16;
    float* X = (float*)(F.ws + WS_X); bf16* H = (bf16*)(F.ws + WS_H);
    const float* ada = (const float*)(F.ws + WS_ADA);
    constexpr int AST = 1032;
    LAS bf16* Ahi = (LAS bf16*)(F.lds); LAS bf16* Alo = Ahi + 16 * AST;
    LAS float* RED = (LAS float*)(F.lds + 2 * 16 * AST * 2);
    LAS float* LOG = RED + 8 * 16 * 32;
    const int fr = F.lane & 15, fq = F.lane >> 4;
    bf16x8 Bh[2][4], Bl[2][4];
    {
        const bf16* wh = (const bf16*)(F.ws + WS_WRH) + (size_t)layer * 32 * 1024; const bf16* wl = (const bf16*)(F.ws + WS_WRL) + (size_t)layer * 32 * 1024;
#pragma unroll
        for (int nt = 0; nt < 2; ++nt)
#pragma unroll
            for (int ks = 0; ks < 4; ++ks) { const size_t o = (size_t)(nt * 16 + fr) * 1024 + F.wave * 128 + ks * 32 + fq * 8;
                Bh[nt][ks] = *(const GAS bf16x8*)(wh + o); Bl[nt][ks] = *(const GAS bf16x8*)(wl + o); }
    }
    const float* nw = a.in[I_NFFN] + (size_t)layer * D;
    for (int tile = F.vcu; tile < ntile; tile += F.G) {
        const int r0 = row_lo + 16 * tile;
#pragma unroll
        for (int rr = 0; rr < 2; ++rr) {
            const int rl = 2 * F.wave + rr, row = r0 + rl, seg = seg_of_row(row);
            const float* sh = ada + (size_t)((layer * 3 + seg) * 6 + 3) * D; const float* sc = sh + D;
            f32x4 v[4]; float ss = 0.f;
#pragma unroll
            for (int j = 0; j < 4; ++j) { v[j] = *(const GAS f32x4*)(X + (size_t)row * D + 4 * F.lane + 256 * j); ss += (v[j].x * v[j].x + v[j].y * v[j].y) + (v[j].z * v[j].z + v[j].w * v[j].w); }
            const float rstd = 1.0f / sqrtf(wave_sum(ss) * (1.0f / D) + EPS);
#pragma unroll
            for (int j = 0; j < 4; ++j) { const int c = 4 * F.lane + 256 * j;
                const f32x4 g = *(const GAS f32x4*)(nw + c), s1 = *(const GAS f32x4*)(sc + c), s0 = *(const GAS f32x4*)(sh + c);
                const f32x4 h = v[j] * rstd * g * (s1 + 1.0f) + s0;
                const unsigned h0 = f2bf(h.x), h1 = f2bf(h.y), h2 = f2bf(h.z), h3 = f2bf(h.w);
                v2u o; o.x = h0 | (h1 << 16); o.y = h2 | (h3 << 16);
                *(GAS v2u*)(H + (size_t)row * D + c) = o;
                *(LAS v2u*)(Ahi + rl * AST + c) = o;
                v2u l; l.x = pk2(h.x - bf2f(h0), h.y - bf2f(h1)); l.y = pk2(h.z - bf2f(h2), h.w - bf2f(h3));
                *(LAS v2u*)(Alo + rl * AST + c) = l; }
        }
        __syncthreads();
        f32x4 acc[2] = {(f32x4){0.f, 0.f, 0.f, 0.f}, (f32x4){0.f, 0.f, 0.f, 0.f}};
#pragma unroll
        for (int ks = 0; ks < 4; ++ks) { const int o = fr * AST + F.wave * 128 + ks * 32 + fq * 8;
            const bf16x8 ah = *(const LAS bf16x8*)(Ahi + o), al = *(const LAS bf16x8*)(Alo + o);
#pragma unroll
            for (int nt = 0; nt < 2; ++nt) { acc[nt] = MFMA16(ah, Bh[nt][ks], acc[nt]); acc[nt] = MFMA16(ah, Bl[nt][ks], acc[nt]); acc[nt] = MFMA16(al, Bh[nt][ks], acc[nt]); } }
#pragma unroll
        for (int nt = 0; nt < 2; ++nt)
#pragma unroll
            for (int j = 0; j < 4; ++j) RED[(F.wave * 16 + fq * 4 + j) * 32 + nt * 16 + fr] = acc[nt][j];
        __syncthreads();
        {
            const int rl = F.tid >> 5, e = F.tid & 31, row = r0 + rl;
            float lg = a.in[I_MBR][layer * 32 + e];
#pragma unroll
            for (int w8 = 0; w8 < 8; ++w8) lg += RED[(w8 * 16 + rl) * 32 + e];
            float cur = lg; float tv[4]; int tix[4];
#pragma unroll
            for (int k = 0; k < 4; ++k) { float bv = cur; int bi = e;
#pragma unroll
                for (int o = 1; o < 32; o <<= 1) { const float ov = __shfl_xor(bv, o); const int oi = __shfl_xor(bi, o); if (ov > bv || (ov == bv && oi < bi)) { bv = ov; bi = oi; } }
                tv[k] = bv; tix[k] = bi; if (e == bi) cur = -3.0e38f; }
            const float e1 = __expf(tv[1] - tv[0]), e2 = __expf(tv[2] - tv[0]), e3 = __expf(tv[3] - tv[0]); const float inv = 1.0f / (1.0f + e1 + e2 + e3);
            if (e < 4 && !dry) { const int k = e; const int ek = k == 0 ? tix[0] : (k == 1 ? tix[1] : (k == 2 ? tix[2] : tix[3])); const float gk = (k == 0 ? 1.0f : (k == 1 ? e1 : (k == 2 ? e2 : e3))) * inv;
                const unsigned rank = atomicAdd(F.ctl + CW_CNT + (layer * 32 + ek) * 64, 1u);
                ((unsigned*)(F.ws + WS_LIST))[(size_t)ek * NTOK + rank] = (unsigned)row;
                ((unsigned*)(F.ws + WS_TOKI))[(size_t)row * 4 + k] = ((unsigned)ek << 16) | rank;
                ((float*)(F.ws + WS_TOKG))[(size_t)row * 4 + k] = gk; }
        }
        __syncthreads();
    }
}

__device__ __forceinline__ void p_gather(Frame& F, int layer) {
    moe_tables(F, layer);
    const LAS int* M = (const LAS int*)(F.lds + MISC_OFF);
    const int total = M[32];
    const int gw = F.vcu * NWAVES + F.wave, NGW = F.G * NWAVES;
    const bf16* H = (const bf16*)(F.ws + WS_H); bf16* AS = (bf16*)(F.ws + WS_AS);
    const unsigned* LIST = (const unsigned*)(F.ws + WS_LIST);
    for (int p = gw; p < total; p += NGW) {
        const int e = M[64 + (p >> 8)]; const int rank = p - M[e];
        v4u x0 = (v4u){0u, 0u, 0u, 0u}, x1 = x0;
        if (rank < M[400 + e]) { const unsigned r = LIST[(size_t)e * NTOK + rank]; const GAS v4u* s = (const GAS v4u*)(H + (size_t)r * D); x0 = s[F.lane]; x1 = s[64 + F.lane]; }
        GAS v4u* d = (GAS v4u*)(AS + (size_t)p * D); d[F.lane] = x0; d[64 + F.lane] = x1;
    }
}

typedef short s16x4 __attribute__((ext_vector_type(4)));
__device__ __forceinline__ bf16x8 tr_frag(const LAS bf16* T, int stride, int kb, int c0, int lane) {
    const int g = lane >> 4, w = lane & 15, q = w >> 2, p = w & 3;
    const LAS bf16* a0 = T + (kb + 4 * g + q) * stride + c0 + 4 * p;
    const s16x4 lo = __builtin_amdgcn_ds_read_tr16_b64_v4i16((LAS s16x4*)a0);
    const s16x4 hi = __builtin_amdgcn_ds_read_tr16_b64_v4i16((LAS s16x4*)(a0 + 16 * stride));
    return (bf16x8){lo[0], lo[1], lo[2], lo[3], hi[0], hi[1], hi[2], hi[3]};
}
__device__ __forceinline__ bf16x8 perm_frag(const LAS bf16* rowp, int kb, int quad) {
    const v2u lo = *(const LAS v2u*)(rowp + kb + 4 * quad), hi = *(const LAS v2u*)(rowp + kb + 16 + 4 * quad);
    v4u w; w.x = lo.x; w.y = lo.y; w.z = hi.x; w.w = hi.y; return __builtin_bit_cast(bf16x8, w);
}
__device__ __forceinline__ void p_spatial(Frame& F, const Args& a, int layer) {
    const int jl = layer / 3;
    const int c_lo = (layer >= 3) ? 4 : 0;
    const int nunit = (132 - c_lo) * 8;
    const bf16* ZB = (const bf16*)(F.ws + WS_BIG); bf16* G = (bf16*)(F.ws + WS_G);
    constexpr int ST = 144;
    LAS bf16* As = (LAS bf16*)(F.lds); LAS bf16* Bs = As + 128 * ST; LAS float* rs = (LAS float*)(F.lds + 2 * 128 * ST * 2);
    const int fr = F.lane & 15, fq = F.lane >> 4;
    for (int u = F.vcu; u < nunit; u += F.G) {
        const int c = c_lo + (u >> 3), g = u & 7, r0 = 128 * c;
        for (int rr = 0; rr < 16; ++rr) { const int rl = F.wave * 16 + rr; const GAS v4u* p = (const GAS v4u*)(ZB + (size_t)(r0 + rl) * 2048 + 1024 + 16 * F.lane);
            const v4u x0 = p[0], x1 = p[1]; float ss = 0.f;
#pragma unroll
            for (int i = 0; i < 4; ++i) { const float l0 = bflo(x0[i]), h0 = bfhi(x0[i]), l1 = bflo(x1[i]), h1 = bfhi(x1[i]); ss += l0 * l0 + h0 * h0 + l1 * l1 + h1 * h1; }
            ss = wave_sum(ss); if (F.lane == 0) rs[rl] = 1.0f / sqrtf(ss * (1.0f / 1024.0f) + EPS); }
        __syncthreads();
        {
            const bf16* wsb = (const bf16*)(F.ws + WS_WSB) + (size_t)(jl * 8 + g) * 128 * 128;
            const float* gv = a.in[I_AGV] + (size_t)jl * 1024 + 128 * g;
#pragma unroll
            for (int i = 0; i < 4; ++i) { const int id = F.tid + 512 * i, p = id >> 4, qc = id & 15;
                *(LAS v4u*)(As + p * ST + qc * 8) = *(const GAS v4u*)(wsb + p * 128 + qc * 8);
                const v4u x = *(const GAS v4u*)(ZB + (size_t)(r0 + p) * 2048 + 1024 + 128 * g + 8 * qc); const float rq = rs[p];
                const f32x4 g0 = *(const GAS f32x4*)(gv + 8 * qc), g1 = *(const GAS f32x4*)(gv + 8 * qc + 4);
                v4u o; o.x = pk2(bflo(x.x) * rq * g0.x, bfhi(x.x) * rq * g0.y); o.y = pk2(bflo(x.y) * rq * g0.z, bfhi(x.y) * rq * g0.w);
                o.z = pk2(bflo(x.z) * rq * g1.x, bfhi(x.z) * rq * g1.y); o.w = pk2(bflo(x.w) * rq * g1.z, bfhi(x.w) * rq * g1.w);
                *(LAS v4u*)(Bs + p * ST + qc * 8) = o; }
        }
        __syncthreads();
        f32x4 acc[8];
#pragma unroll
        for (int nt = 0; nt < 8; ++nt) acc[nt] = (f32x4){0.f, 0.f, 0.f, 0.f};
#pragma unroll
        for (int ks = 0; ks < 4; ++ks) { const bf16x8 af = tr_frag(Bs, ST, 32 * ks, 16 * F.wave, F.lane);
#pragma unroll
            for (int nt = 0; nt < 8; ++nt) { const bf16x8 bfr = perm_frag(As + (16 * nt + fr) * ST, 32 * ks, fq); acc[nt] = MFMA16(af, bfr, acc[nt]); } }
        const float* bs = a.in[I_ABS] + (size_t)(jl * 8 + g) * 128;
#pragma unroll
        for (int nt = 0; nt < 8; ++nt) { const int p = 16 * nt + fr; const float bb = bs[p]; const size_t row = (size_t)(r0 + p); const int cc = 128 * g + 16 * F.wave + 4 * fq;
            const v2u uu = *(const GAS v2u*)(ZB + row * 2048 + cc);
            v2u o; o.x = pk2(bflo(uu.x) * (acc[nt][0] + bb), bfhi(uu.x) * (acc[nt][1] + bb)); o.y = pk2(bflo(uu.y) * (acc[nt][2] + bb), bfhi(uu.y) * (acc[nt][3] + bb));
            *(GAS v2u*)(G + row * D + cc) = o; }
        __syncthreads();
    }
}

constexpr int PST = GLA_INP;
constexpr int CST = 132;
constexpr int KST = 144;
constexpr int VST = 272;
__device__ __forceinline__ void gla_cum(Frame& F, const Args& a, int c, int h, int dir, LAS float* cum, LAS float* rt, LAS float* tot) {
    const bf16* P = (const bf16*)(F.ws + WS_BIG);
    for (int i = F.tid; i < 64 * 8; i += NTHREADS) { const int ii = i >> 3, j2 = i & 7; const unsigned x = *(const GAS unsigned*)(P + (size_t)(64 * c + ii) * PST + 3072 + dir * 16 + 2 * j2);
        rt[ii * 16 + 2 * j2] = bflo(x); rt[ii * 16 + 2 * j2 + 1] = bfhi(x); }
    const int kk = F.tid & 127, part = F.tid >> 7;
    float w[16];
#pragma unroll
    for (int j = 0; j < 16; ++j) w[j] = a.in[I_BWA2][(size_t)(dir * 16 + j) * 512 + h * 128 + kk];
    const float ba = a.in[I_BBA][dir * 512 + h * 128 + kk];
    __syncthreads();
    float la[16];
#pragma unroll
    for (int ii = 0; ii < 16; ++ii) { const int i = part * 16 + ii; float z = ba;
        const f32x4 r0 = *(const LAS f32x4*)(rt + i * 16), r1 = *(const LAS f32x4*)(rt + i * 16 + 4), r2 = *(const LAS f32x4*)(rt + i * 16 + 8), r3 = *(const LAS f32x4*)(rt + i * 16 + 12);
        z += r0.x * w[0] + r0.y * w[1] + r0.z * w[2] + r0.w * w[3]; z += r1.x * w[4] + r1.y * w[5] + r1.z * w[6] + r1.w * w[7];
        z += r2.x * w[8] + r2.y * w[9] + r2.z * w[10] + r2.w * w[11]; z += r3.x * w[12] + r3.y * w[13] + r3.z * w[14] + r3.w * w[15];
        const float ls = fminf(z, 0.0f) - __logf(1.0f + __expf(-fabsf(z)));
        la[ii] = ls * (1.0f / 16.0f); }
    float run = 0.f;
    if (dir == 0) {
#pragma unroll
        for (int ii = 0; ii < 16; ++ii) { run += la[ii]; la[ii] = run; } }
    else {
#pragma unroll
        for (int ii = 15; ii >= 0; --ii) { run += la[ii]; la[ii] = run; } }
    tot[part * 128 + kk] = run;
    __syncthreads();
    float off = 0.f;
#pragma unroll
    for (int p = 0; p < 4; ++p) { const float t = tot[p * 128 + kk]; if (dir == 0 ? (p < part) : (p > part)) off += t; }
#pragma unroll
    for (int ii = 0; ii < 16; ++ii) cum[(part * 16 + ii) * CST + kk] = la[ii] + off;
    __syncthreads();
}
struct RowRaw { v4u o0, o1, p0, p1; };
__device__ __forceinline__ void row16_load(const bf16* x, int grp, bool lat, RowRaw& R) {
    R.o0 = *(const GAS v4u*)(x + 16 * grp); R.o1 = *(const GAS v4u*)(x + 16 * grp + 8);
    if (lat) { R.p0 = *(const GAS v4u*)(x + 16 * (grp ^ 2)); R.p1 = *(const GAS v4u*)(x + 16 * (grp ^ 2) + 8); } else { R.p0 = R.o0; R.p1 = R.o1; }
}
__device__ __forceinline__ void ropetab_load(const float* ROPE, int grp, int pr, int pc, bool lat, f32x4 (&tb)[8]) {
    const int pos = (grp >> 2) ? pc : pr; const float* t = ROPE + (size_t)(pos * 32 + 16 * (grp & 1)) * 2;
#pragma unroll
    for (int e2 = 0; e2 < 8; ++e2) tb[e2] = lat ? *(const GAS f32x4*)(t + 4 * e2) : (f32x4){1.f, 0.f, 1.f, 0.f};
}
__device__ __forceinline__ void rope16_apply(const RowRaw& R, const f32x4 (&tb)[8], int grp, bool lat, float (&out)[16]) {
    float own[16], par[16];
#pragma unroll
    for (int e = 0; e < 4; ++e) { own[2 * e] = bflo(R.o0[e]); own[2 * e + 1] = bfhi(R.o0[e]); own[8 + 2 * e] = bflo(R.o1[e]); own[8 + 2 * e + 1] = bfhi(R.o1[e]);
        par[2 * e] = bflo(R.p0[e]); par[2 * e + 1] = bfhi(R.p0[e]); par[8 + 2 * e] = bflo(R.p1[e]); par[8 + 2 * e + 1] = bfhi(R.p1[e]); }
    if (!lat) {
#pragma unroll
        for (int e = 0; e < 16; ++e) out[e] = own[e];
        return; }
    const bool second = (grp >> 1) & 1;
#pragma unroll
    for (int e2 = 0; e2 < 8; ++e2) { const f32x4 t = tb[e2];
        { const int e = 2 * e2; const float x1 = second ? par[e] : own[e], x2 = second ? own[e] : par[e]; out[e] = second ? (x1 * t.y + x2 * t.x) : (x1 * t.x - x2 * t.y); }
        { const int e = 2 * e2 + 1; const float x1 = second ? par[e] : own[e], x2 = second ? own[e] : par[e]; out[e] = second ? (x1 * t.w + x2 * t.z) : (x1 * t.z - x2 * t.w); } }
}
__device__ __forceinline__ void st16bf(LAS bf16* dst, const float (&v)[16]) {
    v4u a, b; a.x = pk2(v[0], v[1]); a.y = pk2(v[2], v[3]); a.z = pk2(v[4], v[5]); a.w = pk2(v[6], v[7]); b.x = pk2(v[8], v[9]); b.y = pk2(v[10], v[11]); b.z = pk2(v[12], v[13]); b.w = pk2(v[14], v[15]);
    *(LAS v4u*)dst = a; *(LAS v4u*)(dst + 8) = b;
}
__device__ __forceinline__ void ld16cum(const LAS float* p, float (&v)[16]) {
#pragma unroll
    for (int e = 0; e < 4; ++e) { const f32x4 t = *(const LAS f32x4*)(p + 4 * e); v[4 * e] = t.x; v[4 * e + 1] = t.y; v[4 * e + 2] = t.z; v[4 * e + 3] = t.w; }
}
__device__ __forceinline__ void gla_stage_v(Frame& F, int c, int h, LAS bf16* VL) {
    const bf16* P = (const bf16*)(F.ws + WS_BIG);
    const int i = F.tid & 63, grp = F.tid >> 6; const bf16* vp = P + (size_t)(64 * c + i) * PST + 1024 + h * 256 + grp * 32;
#pragma unroll
    for (int e = 0; e < 4; ++e) *(LAS v4u*)(VL + i * VST + grp * 32 + 8 * e) = *(const GAS v4u*)(vp + 8 * e);
}
__device__ __forceinline__ void p_gla_ds(Frame& F, const Args& a) {
    const bf16* P = (const bf16*)(F.ws + WS_BIG); const float* ROPE = (const float*)(F.ws + WS_ROPE);
    bf16* DS = (bf16*)(F.ws + WS_DS); float* DEC = (float*)(F.ws + WS_DEC);
    LAS float* cum = (LAS float*)(F.lds); LAS float* rt = cum + 64 * CST; LAS float* tot = rt + 64 * 16;
    LAS bf16* KE = (LAS bf16*)(tot + 4 * 128); LAS bf16* VL = KE + 64 * KST;
    const int fr = F.lane & 15, fq = F.lane >> 4;
    for (int u = F.vcu; u < 264 * 8; u += F.G) {
        const int c = u >> 3, h = (u >> 1) & 3, dir = u & 1; const bool lat = c >= 8; const int pr = (c - 8) & 127;
        RowRaw kraw; f32x4 tb[8];
        { const int i = F.tid & 63, grp = F.tid >> 6; row16_load(P + (size_t)(64 * c + i) * PST + 512 + h * 128, grp, lat, kraw); ropetab_load(ROPE, grp, pr, i, lat, tb); }
        gla_cum(F, a, c, h, dir, cum, rt, tot);
        const int lastrow = dir == 0 ? 63 : 0;
        {
            const int i = F.tid & 63, grp = F.tid >> 6;
            float kv[16], cl[16], ci[16];
            rope16_apply(kraw, tb, grp, lat, kv);
            ld16cum(cum + lastrow * CST + 16 * grp, cl); ld16cum(cum + i * CST + 16 * grp, ci);
#pragma unroll
            for (int e = 0; e < 16; ++e) kv[e] *= __expf(cl[e] - ci[e]);
            st16bf(KE + i * KST + 16 * grp, kv);
            gla_stage_v(F, c, h, VL);
            if (F.tid < 128) DEC[((size_t)(dir * 264 + c) * 4 + h) * 128 + F.tid] = __expf(cum[lastrow * CST + F.tid]);
        }
        __syncthreads();
        f32x4 acc[16];
#pragma unroll
        for (int nt = 0; nt < 16; ++nt) acc[nt] = (f32x4){0.f, 0.f, 0.f, 0.f};
#pragma unroll
        for (int ks = 0; ks < 2; ++ks) { const bf16x8 af = tr_frag(KE, KST, 32 * ks, 16 * F.wave, F.lane);
#pragma unroll
            for (int nt = 0; nt < 16; ++nt) { const bf16x8 bfr = tr_frag(VL, VST, 32 * ks, 16 * nt, F.lane); acc[nt] = MFMA16(af, bfr, acc[nt]); } }
        bf16* dsp = DS + ((size_t)(dir * 264 + c) * 4 + h) * 256 * 128;
#pragma unroll
        for (int nt = 0; nt < 16; ++nt) { v2u o; o.x = pk2(acc[nt][0], acc[nt][1]); o.y = pk2(acc[nt][2], acc[nt][3]);
            *(GAS v2u*)(dsp + (size_t)((((nt * 4 + (F.wave >> 1)) * 4 + ((2 * F.wave + (fq >> 1)) & 3)) * 16 + fr) * 8 + 4 * (fq & 1))) = o; }
        __syncthreads();
    }
}
__device__ __forceinline__ void p_gla_scan(Frame& F) {
    const bf16* DS = (const bf16*)(F.ws + WS_DS); bf16* SIN = (bf16*)(F.ws + WS_SIN); const float* DEC = (const float*)(F.ws + WS_DEC);
    LAS float* dl = (LAS float*)(F.lds);
    for (int job = F.vcu; job < 256; job += F.G) {
        const int vt = job & 15, h = (job >> 4) & 3, dir = (job >> 6) & 1, b = job >> 7;
        __syncthreads();
        for (int i = F.tid; i < 132 * 32; i += NTHREADS) { const int st = i >> 5, k4 = i & 31; int c;
            if (dir == 0) c = st < 4 ? 4 * b + st : 8 + 128 * b + (st - 4); else c = st < 4 ? 4 * b + 3 - st : 8 + 128 * b + 127 - (st - 4);
            *(LAS f32x4*)(dl + st * 128 + 4 * k4) = *(const GAS f32x4*)(DEC + ((size_t)(dir * 264 + c) * 4 + h) * 128 + 4 * k4); }
        __syncthreads();
        const int ks = F.wave >> 1, quad = 2 * (F.wave & 1) + (F.lane >> 5), fr = (F.lane >> 1) & 15, half = F.lane & 1;
        const int kk0 = 32 * ks + 8 * quad + 4 * half;
        const size_t eoff = (size_t)((((vt * 4 + ks) * 4 + quad) * 16 + fr) * 8 + 4 * half);
        f32x4 S = (f32x4){0.f, 0.f, 0.f, 0.f};
        for (int s0 = 0; s0 < 132; s0 += 12) {
            size_t o[12]; v2u d[12];
#pragma unroll
            for (int q = 0; q < 12; ++q) { const int st = s0 + q; int c;
                if (dir == 0) c = st < 4 ? 4 * b + st : 8 + 128 * b + (st - 4); else c = st < 4 ? 4 * b + 3 - st : 8 + 128 * b + 127 - (st - 4);
                o[q] = ((size_t)(dir * 264 + c) * 4 + h) * 32768 + eoff;
                d[q] = __builtin_nontemporal_load((const GAS v2u*)(DS + o[q])); }
#pragma unroll
            for (int q = 0; q < 12; ++q) { const f32x4 dc = *(const LAS f32x4*)(dl + (s0 + q) * 128 + kk0);
                v2u so; so.x = pk2(S.x, S.y); so.y = pk2(S.z, S.w);
                *(GAS v2u*)(SIN + o[q]) = so;
                S.x = S.x * dc.x + bflo(d[q].x); S.y = S.y * dc.y + bfhi(d[q].x); S.z = S.z * dc.z + bflo(d[q].y); S.w = S.w * dc.w + bfhi(d[q].y); }
        }
    }
}
__device__ __forceinline__ void p_gla_out(Frame& F, const Args& a) {
    const bf16* P = (const bf16*)(F.ws + WS_BIG); const float* ROPE = (const float*)(F.ws + WS_ROPE);
    const bf16* SIN = (const bf16*)(F.ws + WS_SIN); bf16* G = (bf16*)(F.ws + WS_G);
    constexpr int ST = 72;
    LAS float* cum = (LAS float*)(F.lds); LAS float* rt = cum + 64 * CST; LAS float* tot = rt + 64 * 16; LAS float* ssq = tot + 4 * 128;
    LAS bf16* VL = (LAS bf16*)(ssq + 8 * 64); LAS bf16* QD = VL + 64 * VST; LAS bf16* KI = QD + 64 * KST; LAS bf16* PL = KI + 64 * KST;
    const int fr = F.lane & 15, fq = F.lane >> 4;
    for (int u = F.vcu; u < 264 * 4; u += F.G) {
        const int c = u >> 2, h = u & 3; const bool lat = c >= 8; const int pr = (c - 8) & 127;
        f32x4 acc[2][4];
#pragma unroll
        for (int mt = 0; mt < 2; ++mt)
#pragma unroll
            for (int nt = 0; nt < 4; ++nt) acc[mt][nt] = (f32x4){0.f, 0.f, 0.f, 0.f};
        gla_stage_v(F, c, h, VL);
        RowRaw qraw0, kraw0; f32x4 tb0[8];
        for (int dir = 0; dir < 2; ++dir) {
            const bf16* sp = SIN + ((size_t)(dir * 264 + c) * 4 + h) * 256 * 128;
            bf16x8 sfr[4][2];
#pragma unroll
            for (int ks = 0; ks < 4; ++ks)
#pragma unroll
                for (int mt = 0; mt < 2; ++mt) sfr[ks][mt] = *(const GAS bf16x8*)(sp + (size_t)(((((2 * F.wave + mt) * 4 + ks) * 4 + fq) * 16 + fr) * 8));
            { const int i = F.tid & 63, grp = F.tid >> 6; const size_t row = (size_t)(64 * c + i);
                if (dir == 0) { row16_load(P + row * PST + h * 128, grp, lat, qraw0); row16_load(P + row * PST + 512 + h * 128, grp, lat, kraw0); ropetab_load(ROPE, grp, pr, i, lat, tb0); } }
            gla_cum(F, a, c, h, dir, cum, rt, tot);
            {
                const int i = F.tid & 63, grp = F.tid >> 6;
                float qv[16], kv[16], ci[16];
                rope16_apply(qraw0, tb0, grp, lat, qv); rope16_apply(kraw0, tb0, grp, lat, kv);
                ld16cum(cum + i * CST + 16 * grp, ci);
#pragma unroll
                for (int e = 0; e < 16; ++e) { const float ex = __expf(ci[e]); qv[e] *= 0.08838834764831845f * ex; kv[e] *= __builtin_amdgcn_rcpf(ex); }
                st16bf(QD + i * KST + 16 * grp, qv); st16bf(KI + i * KST + 16 * grp, kv);
            }
            __syncthreads();
            {
                const int jt = F.wave >> 1;
#pragma unroll
                for (int t2 = 0; t2 < 2; ++t2) { const int it = 2 * (F.wave & 1) + t2; f32x4 s = (f32x4){0.f, 0.f, 0.f, 0.f};
#pragma unroll
                    for (int ks = 0; ks < 4; ++ks) { const bf16x8 af = *(const LAS bf16x8*)(KI + (16 * jt + fr) * KST + ks * 32 + fq * 8), bfr = *(const LAS bf16x8*)(QD + (16 * it + fr) * KST + ks * 32 + fq * 8); s = MFMA16(af, bfr, s); }
                    const int i = 16 * it + fr, j0 = 16 * jt + fq * 4; float pv[4];
#pragma unroll
                    for (int r = 0; r < 4; ++r) { const int j = j0 + r; const bool keep = dir == 0 ? (j <= i) : (j >= i); pv[r] = keep ? s[r] : 0.0f; }
                    v2u o; o.x = pk2(pv[0], pv[1]); o.y = pk2(pv[2], pv[3]);
                    *(LAS v2u*)(PL + i * ST + j0) = o; }
            }
            __syncthreads();
#pragma unroll
            for (int ks = 0; ks < 2; ++ks) {
                bf16x8 bfr[4];
#pragma unroll
                for (int nt = 0; nt < 4; ++nt) bfr[nt] = perm_frag(PL + (16 * nt + fr) * ST, 32 * ks, fq);
#pragma unroll
                for (int mt = 0; mt < 2; ++mt) { const bf16x8 af = tr_frag(VL, VST, 32 * ks, 32 * F.wave + 16 * mt, F.lane);
#pragma unroll
                    for (int nt = 0; nt < 4; ++nt) acc[mt][nt] = MFMA16(af, bfr[nt], acc[mt][nt]); } }
#pragma unroll
            for (int ks = 0; ks < 4; ++ks) {
                bf16x8 bfr[4];
#pragma unroll
                for (int nt = 0; nt < 4; ++nt) bfr[nt] = *(const LAS bf16x8*)(QD + (16 * nt + fr) * KST + ks * 32 + fq * 8);
#pragma unroll
                for (int mt = 0; mt < 2; ++mt) {
#pragma unroll
                    for (int nt = 0; nt < 4; ++nt) acc[mt][nt] = MFMA16(sfr[ks][mt], bfr[nt], acc[mt][nt]); } }
            __syncthreads();
        }
#pragma unroll
        for (int nt = 0; nt < 4; ++nt) { float s = 0.f;
#pragma unroll
            for (int mt = 0; mt < 2; ++mt)
#pragma unroll
                for (int j = 0; j < 4; ++j) s += acc[mt][nt][j] * acc[mt][nt][j];
            s += __shfl_xor(s, 16); s += __shfl_xor(s, 32);
            if (fq == 0) ssq[F.wave * 64 + 16 * nt + fr] = s; }
        __syncthreads();
#pragma unroll
        for (int nt = 0; nt < 4; ++nt) { const int i = 16 * nt + fr; float s = 0.f;
#pragma unroll
            for (int w8 = 0; w8 < 8; ++w8) s += ssq[w8 * 64 + i];
            const float rstd = 1.0f / sqrtf(s * (1.0f / 256.0f) + EPS); const size_t row = (size_t)(64 * c + i);
#pragma unroll
            for (int mt = 0; mt < 2; ++mt) { const int v0 = 32 * F.wave + 16 * mt + fq * 4;
                const v2u gg = *(const GAS v2u*)(P + row * PST + 2048 + h * 256 + v0); const f32x4 go = *(const GAS f32x4*)(a.in[I_BGO] + v0);
                const float g0 = bflo(gg.x), g1 = bfhi(gg.x), g2 = bflo(gg.y), g3 = bfhi(gg.y);
                const float o0 = acc[mt][nt][0] * rstd * go.x * (g0 / (1.0f + __expf(-g0))), o1 = acc[mt][nt][1] * rstd * go.y * (g1 / (1.0f + __expf(-g1)));
                const float o2 = acc[mt][nt][2] * rstd * go.z * (g2 / (1.0f + __expf(-g2))), o3 = acc[mt][nt][3] * rstd * go.w * (g3 / (1.0f + __expf(-g3)));
                v2u o; o.x = pk2(o0, o1); o.y = pk2(o2, o3);
                *(GAS v2u*)(G + row * D + h * 256 + v0) = o; } }
        __syncthreads();
    }
}

__device__ __forceinline__ int na_koff(int key, int c16) { return key * 128 + ((c16 ^ ((key >> 1) & 7)) << 4); }
__device__ __forceinline__ int na_voff(int key, int c16) { return key * 128 + (((((c16 >> 1) ^ ((key >> 1) & 3)) << 1) | (c16 & 1)) << 4); }
__device__ __forceinline__ bf16x8 na_vfrag(const LAS unsigned char* V, int kb, int dt, int lane) {
    const int g = lane >> 4, w = lane & 15, q = w >> 2, p = w & 3; const int r0 = kb + 4 * g + q, r1 = r0 + 16;
    const s16x4 lo = __builtin_amdgcn_ds_read_tr16_b64_v4i16((LAS s16x4*)(V + r0 * 128 + ((dt ^ ((r0 >> 1) & 3)) << 5) + 8 * p));
    const s16x4 hi = __builtin_amdgcn_ds_read_tr16_b64_v4i16((LAS s16x4*)(V + r1 * 128 + ((dt ^ ((r1 >> 1) & 3)) << 5) + 8 * p));
    return (bf16x8){lo[0], lo[1], lo[2], lo[3], hi[0], hi[1], hi[2], hi[3]};
}
#define LBAR() do { asm volatile("s_waitcnt lgkmcnt(0)" ::: "memory"); __builtin_amdgcn_s_barrier(); asm volatile("" ::: "memory"); } while (0)
struct NaState { bf16x8 qf[2], qn[2]; f32x4 o[4]; float m_run, l_run; int cur_bh; };
__device__ __forceinline__ int na_r0(int r) { return r < 4 ? 0 : (r > 124 ? 120 : r - 4); }
__device__ __forceinline__ void na_load(Frame& F, int u_lo, int st, v4u (&kr)[4], v4u (&vr)[4]) {
    const bf16* QKV = (const bf16*)(F.ws + WS_BIG);
    const int u = u_lo + (st >> 1), bh = u >> 7, r = u & 127, b = bh >> 4, h = bh & 15;
    const size_t t0 = (size_t)NCTX + (size_t)b * SEQ + (size_t)(na_r0(r) + 4 * (st & 1)) * 64;
#pragma unroll
    for (int i = 0; i < 4; ++i) { const int id = F.tid + 512 * i, key = id >> 3, c = id & 7;
        const bf16* p = QKV + (t0 + key) * 3072 + 1024 + h * 64 + 8 * c; kr[i] = *(const GAS v4u*)p; vr[i] = *(const GAS v4u*)(p + 1024); }
}
__device__ __forceinline__ void na_loadq(Frame& F, int u, int qcol, int fq, bf16x8 (&q)[2]) {
    const bf16* QKV = (const bf16*)(F.ws + WS_BIG);
    const int bh = u >> 7, r = u & 127, b = bh >> 4, h = bh & 15;
#pragma unroll
    for (int ks = 0; ks < 2; ++ks) q[ks] = *(const GAS bf16x8*)(QKV + ((size_t)NCTX + (size_t)b * SEQ + (size_t)r * 64 + qcol) * 3072 + h * 64 + ks * 32 + fq * 8);
}
__device__ __forceinline__ void na_stage(Frame& F, const Args& a, const int u_lo, const int nstage, const int stage, v4u (&kr)[4], v4u (&vr)[4], NaState& S) {
    const bf16* QKV = (const bf16*)(F.ws + WS_BIG); bf16* G = (bf16*)(F.ws + WS_G);
    constexpr int QS = 3072;
    LAS unsigned char* KC = F.lds; LAS unsigned char* VC = F.lds + 32768; LAS unsigned char* KL = F.lds + 65536; LAS unsigned char* VL = F.lds + 98304;
    LAS float* RPB = (LAS float*)(F.lds + 131072); LAS float* MRG = RPB + 480;
    const int fr = F.lane & 15, fq = F.lane >> 4;
    const int jb = F.wave >> 1, role = F.wave & 1;
    const int bstart = jb == 0 ? 0 : (jb == 1 ? 8 : (jb == 2 ? 24 : 32));
    const int qcol = 16 * jb + fr; const int cstart = qcol < 8 ? 0 : (qcol > 56 ? 48 : qcol - 8);
    const int u = u_lo + (stage >> 1), pass = stage & 1;
    const int bh = u >> 7, r = u & 127, b = bh >> 4, h = bh & 15;
    const int r0 = na_r0(r);
    const size_t lat0 = (size_t)NCTX + (size_t)b * SEQ;
    LBAR();
    if (bh != S.cur_bh) {
        S.cur_bh = bh;
        for (int i = F.tid; i < 465; i += NTHREADS) RPB[i] = a.in[I_CRPB][h * 465 + i];
#pragma unroll
        for (int i = 0; i < 4; ++i) { const int id = F.tid + 512 * i, key = id >> 3, c = id & 7;
            const bf16* p = QKV + (size_t)(b * CTXL + key) * QS + 1024 + h * 64 + 8 * c;
            *(LAS v4u*)(KC + na_koff(key, c)) = *(const GAS v4u*)p; *(LAS v4u*)(VC + na_voff(key, c)) = *(const GAS v4u*)(p + 1024); }
    }
#pragma unroll
    for (int i = 0; i < 4; ++i) { const int id = F.tid + 512 * i, key = id >> 3, c = id & 7;
        *(LAS v4u*)(KL + na_koff(key, c)) = kr[i]; *(LAS v4u*)(VL + na_voff(key, c)) = vr[i]; }
    if (pass == 0) {
        S.qf[0] = S.qn[0]; S.qf[1] = S.qn[1];
#pragma unroll
        for (int dt = 0; dt < 4; ++dt) S.o[dt] = (f32x4){0.f, 0.f, 0.f, 0.f};
        S.m_run = -3.0e38f; S.l_run = 0.f;
        if (stage + 2 < nstage) na_loadq(F, u + 1, qcol, fq, S.qn);
    }
    if (stage + 1 < nstage) na_load(F, u_lo, stage + 1, kr, vr);
    LBAR();
    const LAS unsigned char* KB = role == 0 ? KL : KC; const LAS unsigned char* VB = role == 0 ? VL : VC;
    f32x4 s[8];
#pragma unroll
    for (int t = 0; t < 8; ++t) { const int kidx = role == 0 ? (t >> 1) * 64 + bstart + 16 * (t & 1) + fr : 128 * pass + 16 * t + fr;
        const bf16x8 k0 = *(const LAS bf16x8*)(KB + na_koff(kidx, fq)), k1 = *(const LAS bf16x8*)(KB + na_koff(kidx, 4 + fq));
        f32x4 tt = (f32x4){0.f, 0.f, 0.f, 0.f}; tt = MFMA16(k0, S.qf[0], tt); tt = MFMA16(k1, S.qf[1], tt); s[t] = tt; }
    float mx = S.m_run;
    if (role == 0) {
#pragma unroll
        for (int t4 = 0; t4 < 2; ++t4) {
            float bias[16];
#pragma unroll
            for (int q = 0; q < 16; ++q) { const int t = 4 * t4 + (q >> 2), j = q & 3; const int krow = r0 + 4 * pass + (t >> 1), kcol = bstart + 16 * (t & 1) + fq * 4 + j;
                int ci = kcol - qcol + 15; ci = ci < 0 ? 0 : (ci > 30 ? 30 : ci); bias[q] = RPB[(krow - r + 7) * 31 + ci]; }
            asm volatile("" : "+v"(bias[0]), "+v"(bias[1]), "+v"(bias[2]), "+v"(bias[3]), "+v"(bias[4]), "+v"(bias[5]), "+v"(bias[6]), "+v"(bias[7]),
                              "+v"(bias[8]), "+v"(bias[9]), "+v"(bias[10]), "+v"(bias[11]), "+v"(bias[12]), "+v"(bias[13]), "+v"(bias[14]), "+v"(bias[15]));
#pragma unroll
            for (int q = 0; q < 16; ++q) { const int t = 4 * t4 + (q >> 2), j = q & 3; const int kcol = bstart + 16 * (t & 1) + fq * 4 + j;
                const bool ok = kcol >= cstart && kcol < cstart + 16;
                const float v = ok ? s[t][j] * 0.125f + bias[q] : -3.0e38f;
                s[t][j] = v; mx = fmaxf(mx, v); } }
    } else {
#pragma unroll
        for (int t = 0; t < 8; ++t)
#pragma unroll
            for (int j = 0; j < 4; ++j) { const float v = s[t][j] * 0.125f; s[t][j] = v; mx = fmaxf(mx, v); }
    }
    mx = fmaxf(mx, __shfl_xor(mx, 16)); mx = fmaxf(mx, __shfl_xor(mx, 32));
    const float alpha = __expf(S.m_run - mx); S.m_run = mx;
    float l = 0.f;
#pragma unroll
    for (int t = 0; t < 8; ++t)
#pragma unroll
        for (int j = 0; j < 4; ++j) { const float p = s[t][j] > -1.0e38f ? __expf(s[t][j] - mx) : 0.0f; s[t][j] = p; l += p; }
    S.l_run = S.l_run * alpha + l;
#pragma unroll
    for (int dt = 0; dt < 4; ++dt) S.o[dt] = S.o[dt] * alpha;
#pragma unroll
    for (int st = 0; st < 4; ++st) {
        v4u pw; pw.x = pk2(s[2 * st][0], s[2 * st][1]); pw.y = pk2(s[2 * st][2], s[2 * st][3]); pw.z = pk2(s[2 * st + 1][0], s[2 * st + 1][1]); pw.w = pk2(s[2 * st + 1][2], s[2 * st + 1][3]);
        const bf16x8 pf = __builtin_bit_cast(bf16x8, pw);
        const int kb = role == 0 ? st * 64 + bstart : 128 * pass + 32 * st;
#pragma unroll
        for (int dt = 0; dt < 4; ++dt) S.o[dt] = MFMA16(na_vfrag(VB, kb, dt, F.lane), pf, S.o[dt]);
    }
    if (pass == 1) {
        float lt = S.l_run; lt += __shfl_xor(lt, 16); lt += __shfl_xor(lt, 32);
        if (role == 1) { LAS float* mg = MRG + jb * 10 * 64; mg[F.lane] = S.m_run; mg[64 + F.lane] = lt;
#pragma unroll
            for (int dt = 0; dt < 4; ++dt) { ((LAS unsigned*)mg)[(2 + 2 * dt) * 64 + F.lane] = pk2(S.o[dt][0], S.o[dt][1]); ((LAS unsigned*)mg)[(3 + 2 * dt) * 64 + F.lane] = pk2(S.o[dt][2], S.o[dt][3]); } }
        LBAR();
        if (role == 0) { const LAS float* mg = MRG + jb * 10 * 64; const float m1 = mg[F.lane], l1 = mg[64 + F.lane];
            const float mm = fmaxf(S.m_run, m1), a0 = __expf(S.m_run - mm), a1 = __expf(m1 - mm); const float inv = 1.0f / (lt * a0 + l1 * a1);
            bf16* op = G + (lat0 + (size_t)r * 64 + qcol) * D + h * 64 + fq * 4;
#pragma unroll
            for (int dt = 0; dt < 4; ++dt) { const unsigned w0 = ((const LAS unsigned*)mg)[(2 + 2 * dt) * 64 + F.lane], w1 = ((const LAS unsigned*)mg)[(3 + 2 * dt) * 64 + F.lane];
                v2u w; w.x = pk2((S.o[dt][0] * a0 + bflo(w0) * a1) * inv, (S.o[dt][1] * a0 + bfhi(w0) * a1) * inv); w.y = pk2((S.o[dt][2] * a0 + bflo(w1) * a1) * inv, (S.o[dt][3] * a0 + bfhi(w1) * a1) * inv);
                *(GAS v2u*)(op + 16 * dt) = w; } }
    }
}
__device__ __forceinline__ void p_natten(Frame& F, const Args& a) {
    const int u_lo = (int)(((long)F.vcu * 4096) / F.G), u_hi = (int)(((long)(F.vcu + 1) * 4096) / F.G);
    const int nstage = 2 * (u_hi - u_lo);
    if (nstage <= 0) return;
    const int fr = F.lane & 15, fq = F.lane >> 4, qcol = 16 * (F.wave >> 1) + fr;
    v4u kA[4], vA[4];
    NaState S; S.cur_bh = -1; S.m_run = -3.0e38f; S.l_run = 0.f;
#pragma unroll
    for (int dt = 0; dt < 4; ++dt) S.o[dt] = (f32x4){0.f, 0.f, 0.f, 0.f};
    na_loadq(F, u_lo, qcol, fq, S.qn); S.qf[0] = S.qn[0]; S.qf[1] = S.qn[1];
    na_load(F, u_lo, 0, kA, vA);
    for (int stage = 0; stage < nstage; ++stage) na_stage(F, a, u_lo, nstage, stage, kA, vA, S);
}

template <int MODE>
__device__ __forceinline__ void sgemm_region(Frame& F, const bf16* A, const bf16* Bt, int R0, int nrb, int C0, int ncb, bf16* O, int ldo, float* X, const float* gate, int u_first, int u_stride) {
    constexpr int ST = 264;
    LAS bf16* As = (LAS bf16*)(F.lds); LAS bf16* Bs = As + 64 * ST;
    const int fr = F.lane & 15, fq = F.lane >> 4, mt = F.wave >> 1, nt0 = 2 * (F.wave & 1);
    for (int u = u_first; u < nrb * ncb; u += u_stride) {
        const int rb = u % nrb, cb = u / nrb; const int r0 = R0 + 64 * rb, c0 = C0 + 64 * cb;
        pg8::f32x4 acc[2] = {(pg8::f32x4){0.f, 0.f, 0.f, 0.f}, (pg8::f32x4){0.f, 0.f, 0.f, 0.f}};
        v4u ra[4], rbv[4];
#pragma unroll
        for (int i = 0; i < 4; ++i) { const int id = F.tid + 512 * i, row = id >> 5, c = id & 31;
            ra[i] = *(const GAS v4u*)(A + (size_t)(r0 + row) * 1024 + 8 * c); rbv[i] = *(const GAS v4u*)(Bt + (size_t)(c0 + row) * 1024 + 8 * c); }
        for (int kc = 0; kc < 4; ++kc) {
            __syncthreads();
#pragma unroll
            for (int i = 0; i < 4; ++i) { const int id = F.tid + 512 * i, row = id >> 5, c = id & 31;
                *(LAS v4u*)(As + row * ST + 8 * c) = ra[i]; *(LAS v4u*)(Bs + row * ST + 8 * c) = rbv[i]; }
            if (kc < 3) {
#pragma unroll
                for (int i = 0; i < 4; ++i) { const int id = F.tid + 512 * i, row = id >> 5, c = id & 31;
                    ra[i] = *(const GAS v4u*)(A + (size_t)(r0 + row) * 1024 + 256 * (kc + 1) + 8 * c); rbv[i] = *(const GAS v4u*)(Bt + (size_t)(c0 + row) * 1024 + 256 * (kc + 1) + 8 * c); } }
            __syncthreads();
#pragma unroll
            for (int ks = 0; ks < 8; ++ks) { const bf16x8 af = *(const LAS bf16x8*)(As + (16 * mt + fr) * ST + ks * 32 + fq * 8);
#pragma unroll
                for (int n = 0; n < 2; ++n) { const bf16x8 bfr = *(const LAS bf16x8*)(Bs + (16 * (nt0 + n) + fr) * ST + ks * 32 + fq * 8); acc[n] = MFMA16(bfr, af, acc[n]); } }
        }
        const size_t row = (size_t)(r0 + 16 * mt + fr);
#pragma unroll
        for (int n = 0; n < 2; ++n) { const int col = c0 + 16 * (nt0 + n) + 4 * fq;
            if (MODE == 2) { f32x4* p = (f32x4*)(X + row * 1024 + col); const f32x4 g = *(const f32x4*)(gate + col); *p = *p + g * acc[n]; }
            else { f32x4 v = acc[n];
                if (MODE == 1) { const pg8::f32x2 a2 = pg8::gelu_pk((pg8::f32x2){v[0], v[1]}), b2 = pg8::gelu_pk((pg8::f32x2){v[2], v[3]}); v = (f32x4){a2.x, a2.y, b2.x, b2.y}; }
                v2u o; o.x = pk2(v[0], v[1]); o.y = pk2(v[2], v[3]); *(GAS v2u*)(O + row * ldo + col) = o; } }
    }
    __syncthreads();
}

__device__ __forceinline__ void ph_moe_gu(Frame& F, const Args& args, const int layer) {
    moe_tables(F, layer);
    const LAS int* Mt = (const LAS int*)(F.lds + MISC_OFF); const int total = Mt[32];
    pg8::Gemm g{(const bf16*)(F.ws + WS_H), (const bf16*)(F.ws + WS_WGU) + (size_t)layer * 32 * 2048 * 1024, total, 2048, D};
    pg8::GroupedOrder S; S.init(total, 2048, F.G, (int)blockIdx.x); S.tile_e = Mt + 64;
    pg8::EpiSwiglu E{(bf16*)(F.ws + WS_ACT), D, args.in[I_MBGU] + (size_t)layer * 32 * 2048, 2048};
    pg8::gemm_phase<pg8::EpiSwiglu, pg8::GroupedOrder, true>(F.lds + RING_OFF, g, S, E, (const unsigned*)(F.ws + WS_LIST), Mt, NTOK);
}
__device__ __forceinline__ void ph_moe_dn(Frame& F, const Args& args, const int layer) {
    moe_tables(F, layer);
    const LAS int* Mt = (const LAS int*)(F.lds + MISC_OFF); const int total = Mt[32];
    pg8::Gemm g{(const bf16*)(F.ws + WS_ACT), (const bf16*)(F.ws + WS_WDN) + (size_t)layer * 32 * 1024 * 1024, total, D, D};
    pg8::GroupedOrder S; S.init(total, D, F.G, (int)blockIdx.x); S.tile_e = Mt + 64;
    pg8::EpiBf16<0> E{(bf16*)(F.ws + WS_YB), D, args.in[I_MBDN] + (size_t)layer * 32 * 1024, 1024};
    pg8::gemm_phase<pg8::EpiBf16<0>, pg8::GroupedOrder>(F.lds + RING_OFF, g, S, E);
}
template <int LAYER> __device__ __forceinline__ void ph_ingemm(Frame& F) {
    constexpr int layer = LAYER, kind = layer % 3;
    const bf16* H = (const bf16*)(F.ws + WS_H);
    const bf16* A = H + (size_t)2 * 256 * D; constexpr int M = 64 * 256;
    if constexpr (kind == 0) {
        const bf16* Bt = (const bf16*)(F.ws + WS_WAIN) + (size_t)(layer / 3) * 2048 * 1024;
        pg8::Gemm g{A, Bt, M, 2048, D}; pg8::StaticOrder S; S.init(M, 2048, F.G, (int)blockIdx.x);
        pg8::EpiBf16<1> E{(bf16*)(F.ws + WS_BIG) + (size_t)2 * 256 * 2048, 2048, nullptr, 0};
        pg8::gemm_phase<pg8::EpiBf16<1>, pg8::StaticOrder>(F.lds + RING_OFF, g, S, E);
        if constexpr (layer < 3) sgemm_region<1>(F, H, Bt, 0, 8, 0, 32, (bf16*)(F.ws + WS_BIG), 2048, nullptr, nullptr, F.vcu, F.G);
    } else if constexpr (kind == 1) {
        const bf16* Bt = (const bf16*)(F.ws + WS_WBIN);
        pg8::Gemm g{A, Bt, M, 3072, D}; pg8::StaticOrder S; S.init(M, 3072, F.G, (int)blockIdx.x);
        pg8::EpiBf16<0> E{(bf16*)(F.ws + WS_BIG) + (size_t)2 * 256 * GLA_INP, GLA_INP, nullptr, 0};
        pg8::gemm_phase<pg8::EpiBf16<0>, pg8::StaticOrder>(F.lds + RING_OFF, g, S, E);
        sgemm_region<0>(F, H, Bt, 0, 8, 0, 48, (bf16*)(F.ws + WS_BIG), GLA_INP, nullptr, nullptr, F.vcu, F.G);
        sgemm_region<0>(F, H, Bt, 0, 264, 3072, 1, (bf16*)(F.ws + WS_BIG), GLA_INP, nullptr, nullptr, (F.vcu + 128) % F.G, F.G);
    } else {
        const bf16* Bt = (const bf16*)(F.ws + WS_WCQKV);
        pg8::Gemm g{A, Bt, M, 3072, D}; pg8::StaticOrder S; S.init(M, 3072, F.G, (int)blockIdx.x);
        pg8::EpiBf16<0> E{(bf16*)(F.ws + WS_BIG) + (size_t)2 * 256 * 3072, 3072, nullptr, 0};
        pg8::gemm_phase<pg8::EpiBf16<0>, pg8::StaticOrder>(F.lds + RING_OFF, g, S, E);
        sgemm_region<0>(F, H, Bt, 0, 8, 1024, 32, (bf16*)(F.ws + WS_BIG), 3072, nullptr, nullptr, F.vcu, F.G);
    }
}

#define IN(k) (lo <= (k) && (k) < hi)
#define SEAM(k) do { if (IN(k) && IN((k) + 1)) { xcd_barrier(bar); if (PROBE_BAR) xcd_barrier(bar); } else __syncthreads(); } while (0)
template <int LAYER> __device__ __forceinline__ void run_layer(Frame& F, const Args& args, const XcdBarrier& bar, const int lo, const int hi) {
    {
        constexpr int layer = LAYER; constexpr int kind = layer % 3, base = 1 + 10 * layer;
        constexpr int mt0 = (layer >= 3) ? 2 : 0;
        constexpr int mo0 = (layer >= 2) ? 2 : 0;
        if (IN(base + 0)) { p_prenorm(F, args, layer, false);
#if PROBE_TOK
            __syncthreads(); p_prenorm(F, args, layer, false, true);
#endif
        } SEAM(base + 0);
        if (IN(base + 1)) { ph_ingemm<LAYER>(F);
#if PROBE_ING
            __syncthreads(); ph_ingemm<LAYER>(F);
#endif
        }
        SEAM(base + 1);
        if (IN(base + 2)) for (int rep = 0; rep < 1 + (kind == 1 ? PROBE_GLA : (kind == 0 ? PROBE_MIX : PROBE_NAT)); ++rep) { if (rep) __syncthreads(); if constexpr (kind == 0) p_spatial(F, args, layer); else if constexpr (kind == 1) p_gla_ds(F, args); else p_natten(F, args); } SEAM(base + 2);
        if constexpr (kind == 1) { if (IN(base + 3)) for (int rep = 0; rep < 1 + PROBE_GLA; ++rep) { p_gla_scan(F); } SEAM(base + 3); }
        if constexpr (kind == 1) { if (IN(base + 4)) for (int rep = 0; rep < 1 + PROBE_GLA; ++rep) { if (rep) __syncthreads(); p_gla_out(F, args); } SEAM(base + 4); }
        if (IN(base + 5)) {
            constexpr int M = 64 * 256;
            const bf16* Bt = (const bf16*)(F.ws + (kind == 0 ? WS_WAOUT : (kind == 1 ? WS_WBOUT : WS_WCOUT))) + (kind == 0 ? (size_t)(layer / 3) * 1024 * 1024 : 0);
            const float* gate = (const float*)(F.ws + WS_ADA) + (size_t)(layer * 3 * 6 + 2) * D;
            pg8::Gemm g{(const bf16*)(F.ws + WS_G) + (size_t)2 * 256 * D, Bt, M, D, D}; pg8::StaticOrder S; S.init(M, D, F.G, (int)blockIdx.x);
            pg8::EpiResid E{(float*)(F.ws + WS_X) + (size_t)2 * 256 * D, gate, 6 * D, 2, false};
            pg8::gemm_phase<pg8::EpiResid, pg8::StaticOrder>(F.lds + RING_OFF, g, S, E);
#if PROBE_OUTG
            { __syncthreads(); pg8::EpiResid E2{(float*)(F.ws + WS_X) + (size_t)2 * 256 * D, gate, 6 * D, 2, true}; pg8::gemm_phase<pg8::EpiResid, pg8::StaticOrder>(F.lds + RING_OFF, g, S, E2); }
#endif
            if constexpr (layer < 2) sgemm_region<2>(F, (const bf16*)(F.ws + WS_G), Bt, 0, 8, 0, 16, nullptr, 0, (float*)(F.ws + WS_X), gate, F.vcu, F.G);
        }
        SEAM(base + 5);
        if (IN(base + 6)) { p_router(F, args, layer);
#if PROBE_TOK
            __syncthreads(); p_router(F, args, layer, true);
#endif
        } SEAM(base + 6);
        if (IN(base + 8)) { ph_moe_gu(F, args, layer);
#if PROBE_MOE
            __syncthreads(); ph_moe_gu(F, args, layer);
#endif
        }
        SEAM(base + 8);
        if (IN(base + 9)) { ph_moe_dn(F, args, layer);
#if PROBE_MOE
            __syncthreads(); ph_moe_dn(F, args, layer);
#endif
        }
        SEAM(base + 9);
    }
}

__global__ void __launch_bounds__(NTHREADS, 2) fwd(Args args) {
    extern __shared__ __attribute__((aligned(16))) unsigned char lds[];
    Frame F;
    F.lds = (LAS unsigned char*)lds;
    F.tid = threadIdx.x; F.lane = F.tid & 63; F.wave = __builtin_amdgcn_readfirstlane(F.tid >> 6);
    F.G = gridDim.x; { const int bx = blockIdx.x; F.vcu = (F.G % 8 == 0) ? (bx % 8) * (F.G / 8) + bx / 8 : bx; }
    F.ws = args.ws; F.ctl = (unsigned*)(args.ws + WS_CTL);
    volatile LAS unsigned* BST = (volatile LAS unsigned*)(F.lds + LDS_BYTES - 16);
    if (F.tid < 4) BST[F.tid] = 0u;
    __syncthreads();
    const int lo = args.ph_lo, hi = args.ph_hi;
    XcdBarrier bar; bar.bar = (unsigned*)(F.ctl + CW_BAR); bar.x = 0; bar.st = BST;
    if (hi - lo > 1) bar = xcd_barrier_post((unsigned*)(F.ctl + CW_BAR), BST);
    if (IN(0)) { p_prologue(F, args);
#if PROBE_PRO
        __syncthreads(); p_prologue(F, args);
#endif
    } SEAM(0);

    run_layer<0>(F, args, bar, lo, hi);
    run_layer<1>(F, args, bar, lo, hi);
    run_layer<2>(F, args, bar, lo, hi);
    run_layer<3>(F, args, bar, lo, hi);
    if (IN(41)) { p_prenorm(F, args, 4, true); }
#undef IN
#undef SEAM
}

extern "C" void kernel_launch(void* const* d_in, const int* in_sizes, int n_in, void* d_out, int out_size, void* d_ws, size_t ws_size, hipStream_t stream) {
    static int grid = 0;
    if (grid == 0) {
        if (n_in != 28 || out_size != NLAT * D || ws_size < WS_END) { fprintf(stderr, "kernel_launch: unexpected problem (n_in %d, out %d, ws %zu < %zu)\n", n_in, out_size, ws_size, (size_t)WS_END); grid = -1; return; }
        int dev = 0, cus = 0, per_cu = 0;
        if (hipGetDevice(&dev) != hipSuccess || hipDeviceGetAttribute(&cus, hipDeviceAttributeMultiprocessorCount, dev) != hipSuccess) { grid = -1; return; }
        if (hipFuncSetAttribute((const void*)fwd, hipFuncAttributeMaxDynamicSharedMemorySize, LDS_BYTES) != hipSuccess) { fprintf(stderr, "kernel_launch: hipFuncSetAttribute failed\n"); grid = -1; return; }
        if (hipOccupancyMaxActiveBlocksPerMultiprocessor(&per_cu, (const void*)fwd, NTHREADS, LDS_BYTES) != hipSuccess || per_cu < 1) { fprintf(stderr, "kernel_launch: occupancy query reports %d\n", per_cu); }
        (void)hipGetLastError();
        grid = cus;
    }
    if (grid < 0) return;
    (void)hipMemsetAsync((char*)d_ws + WS_CTL, 0, CTL_ZERO_BYTES, stream);
    Args a{};
    for (int i = 0; i < 28; ++i) a.in[i] = (const float*)d_in[i];
    a.out = (float*)d_out; a.ws = (unsigned char*)d_ws;
#if MK_ONE_LAUNCH
    a.ph_lo = 0; a.ph_hi = 42;
    hipLaunchKernelGGL(fwd, dim3(grid), dim3(NTHREADS), LDS_BYTES, stream, a);
#else
    for (int p = 0; p < 42; ++p) {
        if (p >= 1 && p <= 40) { const int layer = (p - 1) / 10, loc = (p - 1) % 10; if (((loc == 3 || loc == 4) && (layer % 3) != 1) || loc == 7) continue; }
        a.ph_lo = p; a.ph_hi = p + 1;
        hipLaunchKernelGGL(fwd, dim3(grid), dim3(NTHREADS), LDS_BYTES, stream, a);
    }
#endif
}
```

```cpp
#include <hip/hip_runtime.h>
#include <cstdio>
#include <cstdint>

#ifndef MK_ONE_LAUNCH
#define MK_ONE_LAUNCH 1
#endif
#ifndef PROBE_PRO
#define PROBE_PRO 0
#endif
#ifndef PROBE_MOE
#define PROBE_MOE 0
#endif
#ifndef PROBE_ING
#define PROBE_ING 0
#endif
#ifndef PROBE_MIX
#define PROBE_MIX 0
#endif
#ifndef PROBE_GLA
#define PROBE_GLA 0
#endif
#ifndef PROBE_TOK
#define PROBE_TOK 0
#endif
#ifndef PROBE_BAR
#define PROBE_BAR 0
#endif
#ifndef PROBE_OUTG
#define PROBE_OUTG 0
#endif
#ifndef PROBE_NAT
#define PROBE_NAT 0
#endif
#ifndef PROBE_GATHER
#define PROBE_GATHER 0
#endif

namespace pg8 {
#define PG8_LAS __attribute__((address_space(3)))
typedef unsigned short bf16_t;
typedef short bf16x8 __attribute__((ext_vector_type(8)));
typedef float f32x4 __attribute__((ext_vector_type(4)));
typedef unsigned u32x4 __attribute__((ext_vector_type(4)));
constexpr int BM = 256, BK = 64, HALF = 128, HTB = HALF * BK * 2, STAGE_BYTES = 8 * HTB, NXCD = 8, WGM = 8;

__host__ __device__ __forceinline__ int lds_byte(int r, int c) { const int st = (r >> 4) * 2 + (c >> 5), rr = r & 15, cc = c & 31, ob = rr * 64 + cc * 2; return st * 1024 + (ob ^ (((ob >> 9) & 1) << 5)); }
__host__ __device__ __forceinline__ void stage_rc(int b, int& R, int& C) { const int st = b / 1024, sb = b % 1024, swz = sb ^ (((sb >> 9) & 1) << 5); R = (st >> 1) * 16 + swz / 64; C = (st & 1) * 32 + (swz % 64) / 2; }
__host__ __device__ __forceinline__ int perm32(int rho) { const int n = rho >> 4, i = rho & 15; return 8 * (i >> 2) + 4 * n + (i & 3); }

struct Unit { int pm, pn, pb, e; };
struct Gemm { const bf16_t* A; const bf16_t* Bt; int M, N, K; };

struct StaticOrder {
    int nM, nN, nwg, G, c;
    __device__ void init(int M, int N, int G_, int c_) { nM = M / BM; nN = N / BM; nwg = nM * nN; G = G_; c = c_; }
    __device__ bool next(int i, Unit& u) const {
        const long L = (long)i * G + c; if (L >= nwg) return false;
        int wgid = (int)L; { const int q = nwg / NXCD, r = nwg % NXCD, xcd = wgid % NXCD, off = wgid / NXCD; wgid = (xcd < r ? xcd * (q + 1) : r * (q + 1) + (xcd - r) * q) + off; }
        const int nig = WGM * nN, gid = wgid / nig, fm = gid * WGM, gsz = (nM - fm) < WGM ? (nM - fm) : WGM;
        u.pm = fm + ((wgid % nig) % gsz); u.pn = (wgid % nig) / gsz; u.pb = u.pn; u.e = 0; return true;
    }
};
struct GroupedOrder : StaticOrder {
    const PG8_LAS int* tile_e;
    __device__ bool next(int i, Unit& u) const {
        if (!StaticOrder::next(i, u)) return false;
        u.e = __builtin_amdgcn_readfirstlane(tile_e[u.pm]); u.pb = u.e * nN + u.pn; return true;
    }
};

__device__ __forceinline__ unsigned cvt_pk_bf16(float lo, float hi) { unsigned r; asm volatile("v_cvt_pk_bf16_f32 %0, %1, %2" : "=v"(r) : "v"(lo), "v"(hi)); return r; }
typedef float f32x2 __attribute__((ext_vector_type(2)));
__device__ __forceinline__ f32x2 gelu_pk(f32x2 v) {
    const f32x2 av = __builtin_elementwise_abs(v), d = av * 0.2316418882f + 1.0f;
    f32x2 t; t.x = __builtin_amdgcn_rcpf(d.x); t.y = __builtin_amdgcn_rcpf(d.y);
    f32x2 q = t * 0.5307027145f + (-0.7265760135f); q = q * t + 0.7107068705f; q = q * t + (-0.142248368f); q = q * t + 0.127414796f; q = q * t;
    const f32x2 s = (v * v) * (-0.72134752044f);
    f32x2 e; e.x = __builtin_amdgcn_exp2f(s.x); e.y = __builtin_amdgcn_exp2f(s.y);
    const f32x2 m = v * (q * e), r = v - m;
    f32x2 o; o.x = v.x < 0.f ? m.x : r.x; o.y = v.y < 0.f ? m.y : r.y; return o;
}

template <int ACT> struct EpiBf16 {
    static constexpr bool PERM = true;
    bf16_t* O; int ldc; const float* bias; int bias_estride;
    __device__ __forceinline__ void operator()(const f32x4 (&acc)[2][2][4][2], const Unit& u, int wr, int wc, int fr, int fq) const {
        const int row0 = u.pm * BM + wr * 64 + fr; const int col0 = u.pn * BM + wc * 32 + 8 * fq;
        const float* bp = bias ? bias + (size_t)u.e * bias_estride : nullptr;
        f32x4 bv[2][2];
#pragma unroll
        for (int bj = 0; bj < 2; ++bj)
#pragma unroll
            for (int n = 0; n < 2; ++n) bv[bj][n] = bp ? *(const f32x4*)(bp + col0 + bj * HALF + 4 * n) : (f32x4){0.f, 0.f, 0.f, 0.f};
#pragma unroll
        for (int ai = 0; ai < 2; ++ai)
#pragma unroll
            for (int m = 0; m < 4; ++m) { bf16_t* rowp = O + (size_t)(row0 + ai * HALF + m * 16) * ldc + col0;
#pragma unroll
                for (int bj = 0; bj < 2; ++bj) { f32x4 v0 = acc[ai][bj][m][0] + bv[bj][0], v1 = acc[ai][bj][m][1] + bv[bj][1];
                    if (ACT == 1) { f32x2 a = gelu_pk((f32x2){v0[0], v0[1]}), b = gelu_pk((f32x2){v0[2], v0[3]}), c = gelu_pk((f32x2){v1[0], v1[1]}), d = gelu_pk((f32x2){v1[2], v1[3]});
                        v0 = (f32x4){a.x, a.y, b.x, b.y}; v1 = (f32x4){c.x, c.y, d.x, d.y}; }
                    u32x4 w; w.x = cvt_pk_bf16(v0[0], v0[1]); w.y = cvt_pk_bf16(v0[2], v0[3]); w.z = cvt_pk_bf16(v1[0], v1[1]); w.w = cvt_pk_bf16(v1[2], v1[3]);
                    *(u32x4*)(rowp + bj * HALF) = w; } }
    }
};
struct EpiSwiglu {
    static constexpr bool PERM = true;
    bf16_t* O; int ldc; const float* bias; int bias_estride;
    __device__ __forceinline__ void operator()(const f32x4 (&acc)[2][2][4][2], const Unit& u, int wr, int wc, int fr, int fq) const {
        const int row0 = u.pm * BM + wr * 64 + fr; const int col0 = u.pn * HALF + wc * 32 + 8 * fq;
        const float* bp = bias + (size_t)u.e * bias_estride;
        f32x4 bg[2], bl[2];
#pragma unroll
        for (int n = 0; n < 2; ++n) { bg[n] = *(const f32x4*)(bp + col0 + 4 * n); bl[n] = *(const f32x4*)(bp + 1024 + col0 + 4 * n); }
#pragma unroll
        for (int ai = 0; ai < 2; ++ai)
#pragma unroll
            for (int m = 0; m < 4; ++m) { bf16_t* rowp = O + (size_t)(row0 + ai * HALF + m * 16) * ldc + col0;
                float o[8];
#pragma unroll
                for (int n = 0; n < 2; ++n) { const f32x4 g4 = acc[ai][0][m][n] + bg[n], l4 = acc[ai][1][m][n] + bl[n];
#pragma unroll
                    for (int i = 0; i < 4; ++i) { const float g = fminf(g4[i], 7.0f), l = fminf(fmaxf(l4[i], -7.0f), 7.0f);
                        const float sg = __builtin_amdgcn_rcpf(1.0f + __builtin_amdgcn_exp2f(-1.702f * 1.44269504089f * g));
                        o[4 * n + i] = g * sg * (l + 1.0f); } }
                u32x4 w; w.x = cvt_pk_bf16(o[0], o[1]); w.y = cvt_pk_bf16(o[2], o[3]); w.z = cvt_pk_bf16(o[4], o[5]); w.w = cvt_pk_bf16(o[6], o[7]);
                *(u32x4*)rowp = w; }
    }
};
struct EpiResid {
    static constexpr bool PERM = false;
    float* X; const float* gate; int gstride; int pm0; bool dry;
    __device__ __forceinline__ void operator()(const f32x4 (&acc)[2][2][4][2], const Unit& u, int wr, int wc, int fr, int fq) const {
        const int t = u.pm + pm0; const int seg = t < 2 ? 0 : (t < 34 ? 1 : 2);
        const int row0 = u.pm * BM + wr * 64 + fr, col0 = u.pn * BM + wc * 32 + 4 * fq;
        const float* gp = gate + (size_t)seg * gstride;
        f32x4 gv[2][2];
#pragma unroll
        for (int bj = 0; bj < 2; ++bj)
#pragma unroll
            for (int n = 0; n < 2; ++n) gv[bj][n] = *(const f32x4*)(gp + col0 + bj * HALF + n * 16);
#pragma unroll
        for (int ai = 0; ai < 2; ++ai)
#pragma unroll
            for (int m = 0; m < 4; ++m) { float* rowp = X + (size_t)(row0 + ai * HALF + m * 16) * 1024 + col0;
#pragma unroll
                for (int bj = 0; bj < 2; ++bj)
#pragma unroll
                    for (int n = 0; n < 2; ++n) { f32x4* p = (f32x4*)(rowp + bj * HALF + n * 16); const f32x4 nv = *p + gv[bj][n] * acc[ai][bj][m][n]; if (!dry) *p = nv; else if (nv[0] == 1.2345e30f) *p = nv; } }
    }
};

template <class Epi, class Sched, bool GATHER = false>
__device__ __forceinline__ void gemm_phase(PG8_LAS unsigned char* lds, const Gemm g, const Sched& S, const Epi& E, const unsigned* glist = nullptr, const PG8_LAS int* gM = nullptr, int gstride = 0) {
    const int tid = threadIdx.x, wid = __builtin_amdgcn_readfirstlane(tid >> 6), lane = tid & 63, wr = wid >> 2, wc = wid & 3, fr = lane & 15, fq = lane >> 4;
    const int K = g.K, nt = K / BK;
    unsigned voffB[2], va[2][2], vn[2][2]; int aR[2], aC[2];
#pragma unroll
    for (int i = 0; i < 2; ++i) { int R, C; stage_rc(tid * 16 + i * 8192, R, C); const int Rb = Epi::PERM ? ((R & ~31) + perm32(R & 31)) : R;
        aR[i] = R; aC[i] = C; voffB[i] = (unsigned)(Rb * K + C) * 2u;
#pragma unroll
        for (int h = 0; h < 2; ++h) { va[h][i] = (unsigned)((HALF * h + R) * K + C) * 2u; vn[h][i] = va[h][i]; } }
#define PG8_GOFF(u, dst) do { if constexpr (GATHER) { const int _e = (u).e, _p0 = (u).pm * BM - gM[_e], _c1 = gM[400 + _e] - 1; _Pragma("unroll") for (int _h = 0; _h < 2; ++_h) _Pragma("unroll") for (int _i = 0; _i < 2; ++_i) { \
        int _rk = _p0 + HALF * _h + aR[_i]; _rk = _rk < _c1 ? _rk : _c1; const unsigned _tok = glist[(size_t)_e * gstride + _rk]; dst[_h][_i] = (_tok * (unsigned)K + (unsigned)aC[_i]) * 2u; } } } while (0)
#define PG8_GTOK(u, dst) do { const int _e = (u).e, _p0 = (u).pm * BM - gM[_e], _c1 = gM[400 + _e] - 1; _Pragma("unroll") for (int _h = 0; _h < 2; ++_h) _Pragma("unroll") for (int _i = 0; _i < 2; ++_i) { \
        int _rk = _p0 + HALF * _h + aR[_i]; _rk = _rk < _c1 ? _rk : _c1; dst[_h][_i] = glist[(size_t)_e * gstride + _rk]; } } while (0)
    const size_t kstep = (size_t)(BK * 2);
    const size_t hstep = (size_t)HALF * K * 2;
    const size_t tstep = 2 * hstep;
    const unsigned ldsw = (unsigned)wid * 1024u;
    const int aoff = lds_byte(wr * 64 + fr, fq * 8), boff = lds_byte(wc * 32 + fr, fq * 8);
#define PG8_SA(b, h) (((b) * 2 + (h)) * HTB)
#define PG8_SB(b, h) ((4 + (b) * 2 + (h)) * HTB)
#define PG8_STAGE(bufoff, gbase, voff) do { _Pragma("unroll") for (int _i = 0; _i < 2; ++_i) \
        __builtin_amdgcn_global_load_lds((const unsigned*)((const char*)(gbase) + (voff)[_i]), (PG8_LAS unsigned*)(lds + (bufoff) + ldsw + _i * 8192), 16, 0, 0); } while (0)
#define PG8_LDA(dst, b, h) do { _Pragma("unroll") for (int m = 0; m < 4; ++m) _Pragma("unroll") for (int k = 0; k < 2; ++k) dst[m][k] = *(const PG8_LAS bf16x8*)(lds + PG8_SA(b, h) + aoff + m * 2048 + k * 1024); } while (0)
#define PG8_LDB(dst, b, h) do { _Pragma("unroll") for (int n = 0; n < 2; ++n) _Pragma("unroll") for (int k = 0; k < 2; ++k) dst[n][k] = *(const PG8_LAS bf16x8*)(lds + PG8_SB(b, h) + boff + n * 2048 + k * 1024); } while (0)
#define PG8_MMA(ai, bj, At, Bt) do { __builtin_amdgcn_s_setprio(1); _Pragma("unroll") for (int m = 0; m < 4; ++m) _Pragma("unroll") for (int n = 0; n < 2; ++n) _Pragma("unroll") for (int k = 0; k < 2; ++k) \
        acc[ai][bj][m][n] = __builtin_amdgcn_mfma_f32_16x16x32_bf16(Bt[n][k], At[m][k], acc[ai][bj][m][n], 0, 0, 0); __builtin_amdgcn_s_setprio(0); } while (0)
#define PG8_WAIT_V(n) asm volatile("s_waitcnt vmcnt(" #n ")" ::: "memory")
#define PG8_WAIT_L(n) asm volatile("s_waitcnt lgkmcnt(" #n ")" ::: "memory")
#define PG8_BAR __builtin_amdgcn_s_barrier()
#define PG8_SCHED __builtin_amdgcn_sched_barrier(0)
    Unit cur, nxt, nx2; int ui = 0; bool has_next = false, has_nx2 = false;
    if (!S.next(0, cur)) return;
    f32x4 acc[2][2][4][2];
#pragma unroll
    for (int a = 0; a < 2; ++a)
#pragma unroll
        for (int b = 0; b < 2; ++b)
#pragma unroll
            for (int m = 0; m < 4; ++m)
#pragma unroll
                for (int n = 0; n < 2; ++n) acc[a][b][m][n] = (f32x4){0.f, 0.f, 0.f, 0.f};
    bf16x8 At[4][2], B0[2][2], B1[2][2];
    const char* cA = (const char*)g.A + (GATHER ? (size_t)0 : (size_t)cur.pm * tstep); const char* cB = (const char*)g.Bt + (size_t)cur.pb * tstep;
    PG8_GOFF(cur, va);
    if constexpr (GATHER) { has_next = S.next(1, nxt); if (has_next) PG8_GOFF(nxt, vn); }
    PG8_STAGE(PG8_SB(0, 0), cB, voffB); PG8_STAGE(PG8_SB(0, 1), cB + hstep, voffB); PG8_STAGE(PG8_SA(0, 0), cA, va[0]); PG8_STAGE(PG8_SA(0, 1), cA, va[1]);
    if (wr == 1) PG8_BAR;
    PG8_WAIT_V(2); PG8_BAR;
    PG8_STAGE(PG8_SB(1, 0), cB + kstep, voffB); PG8_STAGE(PG8_SA(1, 0), cA + kstep, va[0]); PG8_STAGE(PG8_SB(1, 1), cB + hstep + kstep, voffB);
    PG8_WAIT_V(6); PG8_BAR;
    for (;;) {
        if constexpr (!GATHER) has_next = S.next(ui + 1, nxt);
        const char* nA = (has_next && !GATHER) ? (const char*)g.A + (size_t)nxt.pm * tstep : cA; const char* nB = has_next ? (const char*)g.Bt + (size_t)nxt.pb * tstep : cB;
        for (int t = 0; t < nt; t += 2) {
            const bool last = (t == nt - 2);
            const char* a1 = cA + (size_t)(t + 1) * kstep;
            const char* a2 = last ? nA : cA + (size_t)(t + 2) * kstep; const char* b2 = last ? nB : cB + (size_t)(t + 2) * kstep;
            const char* a3 = a2 + kstep; const char* b3 = b2 + kstep;
            unsigned v2[2][2];
#pragma unroll
            for (int _h = 0; _h < 2; ++_h)
#pragma unroll
                for (int _i = 0; _i < 2; ++_i) v2[_h][_i] = (GATHER && last) ? vn[_h][_i] : va[_h][_i];
            PG8_LDB(B0, 0, 0); PG8_LDB(B1, 0, 1); PG8_SCHED; PG8_LDA(At, 0, 0); PG8_STAGE(PG8_SA(1, 1), a1, va[1]);
            PG8_WAIT_V(8); PG8_WAIT_L(0); PG8_BAR; PG8_MMA(0, 0, At, B0); PG8_MMA(0, 1, At, B1); PG8_BAR; PG8_SCHED;
            PG8_LDA(At, 0, 1); PG8_STAGE(PG8_SB(0, 0), b2, voffB); PG8_STAGE(PG8_SB(0, 1), b2 + hstep, voffB); PG8_STAGE(PG8_SA(0, 0), a2, v2[0]);
            PG8_WAIT_V(8); PG8_WAIT_L(0); PG8_BAR; PG8_MMA(1, 0, At, B0); PG8_MMA(1, 1, At, B1); PG8_BAR; PG8_SCHED;
            PG8_LDB(B0, 1, 0); PG8_LDB(B1, 1, 1); PG8_SCHED; PG8_LDA(At, 1, 0); PG8_STAGE(PG8_SA(0, 1), a2, v2[1]);
            PG8_WAIT_V(8); PG8_WAIT_L(0); PG8_BAR; PG8_MMA(0, 0, At, B0); PG8_MMA(0, 1, At, B1); PG8_BAR; PG8_SCHED;
            PG8_LDA(At, 1, 1); PG8_STAGE(PG8_SB(1, 0), b3, voffB); PG8_STAGE(PG8_SB(1, 1), b3 + hstep, voffB); PG8_STAGE(PG8_SA(1, 0), a3, v2[0]);
            PG8_WAIT_V(8); PG8_WAIT_L(0); PG8_BAR; PG8_MMA(1, 0, At, B0); PG8_MMA(1, 1, At, B1); PG8_BAR; PG8_SCHED;
        }
        if (wr == 0) PG8_BAR;
        unsigned tk[2][2] = {{0u, 0u}, {0u, 0u}};
        if constexpr (GATHER) { has_nx2 = has_next && S.next(ui + 2, nx2); if (!has_nx2) nx2 = cur; PG8_GTOK(nx2, tk); }
        E(acc, cur, wr, wc, fr, fq);
        if (!has_next) break;
#pragma unroll
        for (int a = 0; a < 2; ++a)
#pragma unroll
            for (int b = 0; b < 2; ++b)
#pragma unroll
                for (int m = 0; m < 4; ++m)
#pragma unroll
                    for (int n = 0; n < 2; ++n) acc[a][b][m][n] = (f32x4){0.f, 0.f, 0.f, 0.f};
        cur = nxt; cA = nA; cB = nB; ++ui;
        if constexpr (GATHER) { va[0][0] = vn[0][0]; va[0][1] = vn[0][1]; va[1][0] = vn[1][0]; va[1][1] = vn[1][1];
            if (has_nx2) { nxt = nx2;
#pragma unroll
                for (int _h = 0; _h < 2; ++_h)
#pragma unroll
                    for (int _i = 0; _i < 2; ++_i) vn[_h][_i] = (tk[_h][_i] * (unsigned)K + (unsigned)aC[_i]) * 2u; }
            has_next = has_nx2; }
        if (wr == 1) PG8_BAR;
    }
    PG8_WAIT_V(0);
    PG8_BAR;
#undef PG8_SA
#undef PG8_SB
#undef PG8_STAGE
#undef PG8_GOFF
#undef PG8_GTOK
#undef PG8_LDA
#undef PG8_LDB
#undef PG8_MMA
#undef PG8_WAIT_V
#undef PG8_WAIT_L
#undef PG8_BAR
#undef PG8_SCHED
}
}

constexpr int NWAVES = 8, NTHREADS = 512;
constexpr int D = 1024, NCTX = 512, NLAT = 16384, NTOK = NCTX + NLAT, SEQ = 8192, CTXL = 256;
constexpr int NEXP = 32, MAXPADROWS = 75776, MAXPADTILES = 296;
constexpr int GLA_IN = 3104, GLA_INP = 3328;
constexpr float EPS = 1e-6f;

constexpr size_t MiB = 1u << 20;
constexpr size_t WS_CTL = 0, CTL_ZERO_BYTES = 1 * MiB;
constexpr size_t WS_ADA = 1 * MiB;
constexpr size_t WS_ROPE = 1 * MiB + 512 * 1024;
constexpr size_t WS_TOKI = 2 * MiB;
constexpr size_t WS_TOKG = 2 * MiB + 512 * 1024;
constexpr size_t WS_LIST = 3 * MiB;
constexpr size_t WS_WRH = 6 * MiB, WS_WRL = 6 * MiB + 256 * 1024;
constexpr size_t WS_WSB = 7 * MiB;
constexpr size_t WS_WAIN = 8 * MiB;
constexpr size_t WS_WAOUT = 16 * MiB;
constexpr size_t WS_WBIN = 20 * MiB;
constexpr size_t WS_WBOUT = 27 * MiB;
constexpr size_t WS_WCQKV = 29 * MiB;
constexpr size_t WS_WCOUT = 35 * MiB;
constexpr size_t WS_WGU = 64 * MiB;
constexpr size_t WS_WDN = 576 * MiB;
constexpr size_t WS_X = 832 * MiB;
constexpr size_t WS_H = 898 * MiB;
constexpr size_t WS_G = 931 * MiB;
constexpr size_t WS_BIG = 964 * MiB;
constexpr size_t WS_DS = 1072 * MiB;
constexpr size_t WS_SIN = 1204 * MiB;
constexpr size_t WS_DEC = 1336 * MiB;
constexpr size_t WS_AS = 1338 * MiB;
constexpr size_t WS_ACT = 1486 * MiB;
constexpr size_t WS_YB = 1634 * MiB;
constexpr size_t WS_END = 1782 * MiB;
constexpr int CW_TMO = 0;
constexpr int CW_BAR = 4096;
constexpr int CW_CNT = 8192;

constexpr int RING_OFF = 0, RING_BYTES = 131072;
constexpr int MISC_OFF = RING_BYTES;
constexpr int LDS_BYTES = 147456;

#define GAS __attribute__((address_space(1)))
#define LAS __attribute__((address_space(3)))
typedef unsigned short bf16;
typedef unsigned v4u __attribute__((ext_vector_type(4)));
typedef unsigned v2u __attribute__((ext_vector_type(2)));
typedef float f32x4 __attribute__((ext_vector_type(4)));
typedef short bf16x8 __attribute__((ext_vector_type(8)));
typedef short bf16x4 __attribute__((ext_vector_type(4)));
#define LDS_WAIT() asm volatile("s_waitcnt lgkmcnt(0)" ::: "memory")
#define VM_WAIT() asm volatile("s_waitcnt vmcnt(0)" ::: "memory")
__device__ __forceinline__ unsigned f2bf(float f) { unsigned u = __builtin_bit_cast(unsigned, f); return (u + 0x7fffu + ((u >> 16) & 1u)) >> 16; }
__device__ __forceinline__ unsigned pk2(float lo, float hi) { return f2bf(lo) | (f2bf(hi) << 16); }
__device__ __forceinline__ float bf2f(unsigned b) { return __builtin_bit_cast(float, b << 16); }
__device__ __forceinline__ float bflo(unsigned w) { return __builtin_bit_cast(float, w << 16); }
__device__ __forceinline__ float bfhi(unsigned w) { return __builtin_bit_cast(float, w & 0xffff0000u); }
#define MFMA16(a, b, c) __builtin_amdgcn_mfma_f32_16x16x32_bf16((a), (b), (c), 0, 0, 0)

#define XB_TMO      128
#define XB_XCNT(j)  (256  + 64 * (j))
#define XB_XSUB(j)  (1280 + 64 * (j))
#define XB_XGEN(j)  (2304 + 64 * (j))
#define XB_TOP      3328
#define XB_TOPGEN   3392
#define XCD_BAR_WORDS 3456
#define XB_SPIN_CAP (1u << 22)

__device__ __forceinline__ unsigned xb_ld(unsigned* p)              { return __hip_atomic_load(p, __ATOMIC_RELAXED, __HIP_MEMORY_SCOPE_AGENT); }
__device__ __forceinline__ unsigned xb_add(unsigned* p, unsigned v) { return __hip_atomic_fetch_add(p, v, __ATOMIC_RELAXED, __HIP_MEMORY_SCOPE_AGENT); }
__device__ __forceinline__ unsigned xb_xcc_id() { return (unsigned)__builtin_amdgcn_s_getreg((3 << 11) | 20) & 0xFu; }
#define XB_SPIN(cond, bar) do { unsigned _sp = 0; while (cond) { __builtin_amdgcn_s_sleep(1); \
    if ((++_sp & 255u) == 0u) { if (xb_ld(&(bar)[XB_TMO])) break; if (_sp > XB_SPIN_CAP) { atomicAdd(&(bar)[XB_TMO], 1u); break; } } } } while (0)

struct XcdBarrier { unsigned* bar; unsigned x; volatile LAS unsigned* st; };
__device__ __forceinline__ XcdBarrier xcd_barrier_post(unsigned* bar, volatile LAS unsigned* st) {
    XcdBarrier b; b.bar = bar; b.x = xb_xcc_id(); b.st = st;
    if (threadIdx.x == 0) (void)xb_add(&bar[XB_XCNT(b.x)], 1u);
    return b;
}
__device__ __forceinline__ void xcd_barrier_complete(unsigned* bar, unsigned x, unsigned& nloc, unsigned& nx) {
    const unsigned G = gridDim.x * gridDim.y * gridDim.z;
    unsigned sum, cnt, mine, sp = 0u;
    for (;;) {
        sum = 0u; cnt = 0u; mine = 0u;
#pragma unroll
        for (unsigned j = 0; j < 16; ++j) { const unsigned c = xb_ld(&bar[XB_XCNT(j)]); sum += c; cnt += (c > 0u) ? 1u : 0u; mine = (j == x) ? c : mine; }
        if (sum == G) break;
        __builtin_amdgcn_s_sleep(1);
        if ((++sp & 255u) == 0u) { if (xb_ld(&bar[XB_TMO])) break; if (sp > XB_SPIN_CAP) { atomicAdd(&bar[XB_TMO], 1u); break; } }
    }
    nloc = mine > 0u ? mine : 1u; nx = cnt > 0u ? cnt : 1u;
}
__device__ __forceinline__ void xcd_barrier(const XcdBarrier& b) {
    asm volatile("s_waitcnt vmcnt(0)" ::: "memory");
    __syncthreads();
    if (threadIdx.x == 0) {
        unsigned* bar = b.bar;
        __builtin_amdgcn_s_waitcnt(0);
        unsigned nloc = b.st[0], nx = b.st[1];
        if (nloc == 0u) { xcd_barrier_complete(bar, b.x, nloc, nx); b.st[0] = nloc; b.st[1] = nx; }
        const unsigned old = xb_add(&bar[XB_XSUB(b.x)], 1u);
        const unsigned gen = old / nloc;
        if (old + 1u == (gen + 1u) * nloc) {
            __builtin_amdgcn_fence(__ATOMIC_RELEASE, "agent");
            asm volatile("s_waitcnt vmcnt(0)" ::: "memory");
            const unsigned og = xb_add(&bar[XB_TOP], 1u);
            const unsigned tg = og / nx;
            if (og + 1u == (tg + 1u) * nx) xb_add(&bar[XB_TOPGEN], 1u);
            else XB_SPIN(xb_ld(&bar[XB_TOPGEN]) == tg, bar);
            __builtin_amdgcn_fence(__ATOMIC_ACQUIRE, "agent");
            xb_add(&bar[XB_XGEN(b.x)], 1u);
            asm volatile("s_waitcnt vmcnt(0)" ::: "memory");
        } else {
            XB_SPIN(xb_ld(&bar[XB_XGEN(b.x)]) == gen, bar);
            __builtin_amdgcn_fence(__ATOMIC_ACQUIRE, "agent");
            asm volatile("s_waitcnt vmcnt(0)" ::: "memory");
        }
    }
    __syncthreads();
}

struct Args { const float* in[28]; float* out; unsigned char* ws; int ph_lo, ph_hi; };
enum { I_X = 0, I_C, I_CTX, I_CCTX, I_ADAW, I_ADAB, I_NMIX, I_NFFN, I_NOUT, I_AWIN, I_AGV, I_AWS, I_ABS, I_AWOUT, I_BWIN, I_BWA2, I_BBA, I_BGO, I_BWOUT,
       I_CWQKV, I_CRPB, I_CWOUT, I_MWR, I_MBR, I_MWGU, I_MBGU, I_MWDN, I_MBDN };

struct Frame {
    LAS unsigned char* lds;
    unsigned* ctl;
    unsigned char* ws;
    int tid, lane, wave, vcu, G;
};

__device__ __forceinline__ float wave_sum(float v) {
#pragma unroll
    for (int o = 1; o < 64; o <<= 1) v += __shfl_xor(v, o);
    return v;
}
__device__ __forceinline__ int seg_of_row(int r) { return r < NCTX ? 0 : 1 + ((r - NCTX) >> 13); }

__device__ __forceinline__ void transpose_item64(const float* W, int N, int k0, int n0, bf16* WT, int K, int dst_row0, int ncols_valid, LAS float* scr, int lane) {
#pragma unroll 4
    for (int i = 0; i < 16; ++i) { const int row = 4 * i + (lane >> 4), c4 = (lane & 15) * 4;
        f32x4 v = (f32x4){0.f, 0.f, 0.f, 0.f};
        if (c4 < ncols_valid) v = *(const GAS f32x4*)(W + (size_t)(k0 + row) * N + n0 + c4);
        LAS float* s = scr + row * 65 + c4; s[0] = v.x; s[1] = v.y; s[2] = v.z; s[3] = v.w; }
    LDS_WAIT(); asm volatile("" ::: "memory");
    const int c = lane & 7;
#pragma unroll
    for (int j = 0; j < 8; ++j) { const int n = (lane >> 3) + 8 * j; const LAS float* s = scr + (8 * c) * 65 + n;
        v4u o; o.x = pk2(s[0 * 65], s[1 * 65]); o.y = pk2(s[2 * 65], s[3 * 65]); o.z = pk2(s[4 * 65], s[5 * 65]); o.w = pk2(s[6 * 65], s[7 * 65]);
        *(GAS v4u*)(WT + (size_t)(dst_row0 + n) * K + k0 + 8 * c) = o; }
    LDS_WAIT(); asm volatile("" ::: "memory");
}

__device__ __forceinline__ void p_prologue(Frame& F, const Args& a) {
    LAS float* scr = (LAS float*)(F.lds + F.wave * 16640);
    const int gw = F.vcu * NWAVES + F.wave, NGW = F.G * NWAVES;
    {
        constexpr int KB = 16;
        constexpr int I0 = 2 * KB * 32, I1 = 2 * KB * 16, I2 = KB * 52, I3 = KB * 16, I4 = KB * 48, I5 = KB * 16;
        constexpr int NI = I0 + I1 + I2 + I3 + I4 + I5;
        for (int it = gw; it < NI; it += NGW) {
            int r = it;
            if (r < I0) { const int j = r / (KB * 32), q = r % (KB * 32), kb = q / 32, nb = q % 32;
                transpose_item64(a.in[I_AWIN] + (size_t)j * 1024 * 2048, 2048, 64 * kb, 64 * nb, (bf16*)(F.ws + WS_WAIN) + (size_t)j * 2048 * 1024, 1024, 64 * nb, 64, scr, F.lane); continue; } r -= I0;
            if (r < I1) { const int j = r / (KB * 16), q = r % (KB * 16), kb = q / 16, nb = q % 16;
                transpose_item64(a.in[I_AWOUT] + (size_t)j * 1024 * 1024, 1024, 64 * kb, 64 * nb, (bf16*)(F.ws + WS_WAOUT) + (size_t)j * 1024 * 1024, 1024, 64 * nb, 64, scr, F.lane); continue; } r -= I1;
            if (r < I2) { const int kb = r / 52, nb = r % 52; const int nv = GLA_IN - 64 * nb;
                transpose_item64(a.in[I_BWIN], GLA_IN, 64 * kb, 64 * nb, (bf16*)(F.ws + WS_WBIN), 1024, 64 * nb, nv < 0 ? 0 : (nv > 64 ? 64 : nv), scr, F.lane); continue; } r -= I2;
            if (r < I3) { const int kb = r / 16, nb = r % 16;
                transpose_item64(a.in[I_BWOUT], 1024, 64 * kb, 64 * nb, (bf16*)(F.ws + WS_WBOUT), 1024, 64 * nb, 64, scr, F.lane); continue; } r -= I3;
            if (r < I4) { const int kb = r / 48, nb = r % 48;
                transpose_item64(a.in[I_CWQKV], 3072, 64 * kb, 64 * nb, (bf16*)(F.ws + WS_WCQKV), 1024, 64 * nb, 64, scr, F.lane); continue; } r -= I4;
            { const int kb = r / 16, nb = r % 16;
                transpose_item64(a.in[I_CWOUT], 1024, 64 * kb, 64 * nb, (bf16*)(F.ws + WS_WCOUT), 1024, 64 * nb, 64, scr, F.lane); }
        }
    }
    {
        constexpr int KB = 16, PER_GU = KB * 32, PER_DN = KB * 16, NGU = 128 * PER_GU, NDN = 128 * PER_DN;
        for (int it = gw; it < NGU + NDN; it += NGW) {
            if (it < NGU) { const int le = it / PER_GU, q = it % PER_GU, kb = q / 32, nb = q % 32;
                const int n0 = 64 * nb, half = n0 >> 10, jj = n0 & 1023, dst = (jj >> 7) * 256 + half * 128 + (jj & 127);
                transpose_item64(a.in[I_MWGU] + (size_t)le * 1024 * 2048, 2048, 64 * kb, n0, (bf16*)(F.ws + WS_WGU) + (size_t)le * 2048 * 1024, 1024, dst, 64, scr, F.lane); }
            else { const int r = it - NGU, le = r / PER_DN, q = r % PER_DN, kb = q / 16, nb = q % 16;
                transpose_item64(a.in[I_MWDN] + (size_t)le * 1024 * 1024, 1024, 64 * kb, 64 * nb, (bf16*)(F.ws + WS_WDN) + (size_t)le * 1024 * 1024, 1024, 64 * nb, 64, scr, F.lane); }
        }
    }
    const int gt = F.vcu * NTHREADS + F.tid, NGT = F.G * NTHREADS;
    for (int i = gt; i < 2 * 8 * 128 * 128; i += NGT) ((bf16*)(F.ws + WS_WSB))[i] = (bf16)f2bf(a.in[I_AWS][i]);
    for (int i = gt; i < 4 * 32 * 1024; i += NGT) { const int l = i >> 15, e = (i >> 10) & 31, k = i & 1023;
        const float w = a.in[I_MWR][((size_t)l * 1024 + k) * 32 + e]; const unsigned h = f2bf(w); const float rem = w - bf2f(h);
        ((bf16*)(F.ws + WS_WRH))[i] = (bf16)h; ((bf16*)(F.ws + WS_WRL))[i] = (bf16)f2bf(rem); }
    for (int i = gt; i < 128 * 32; i += NGT) { const int pos = i >> 5, f = i & 31;
        const float fr = powf(10000.0f, -(float)f / 32.0f); const float ang = (float)pos * fr; float sn, cs; sincosf(ang, &sn, &cs);
        ((float*)(F.ws + WS_ROPE))[2 * i] = cs; ((float*)(F.ws + WS_ROPE))[2 * i + 1] = sn; }
    {
        __syncthreads();
        LAS float* sv = (LAS float*)(F.lds);
        LAS float* red = sv + 3 * 1024;
        for (int i = F.tid; i < 3 * 1024; i += NTHREADS) { const int s = i >> 10, k = i & 1023;
            const float v = s == 0 ? a.in[I_CCTX][k] : a.in[I_C][(s - 1) * 1024 + k]; sv[i] = v / (1.0f + __expf(-v)); }
        __syncthreads();
        for (int u = F.vcu; u < 4 * 96; u += F.G) { const int l = u / 96, n0 = (u % 96) * 64;
            const float* w = a.in[I_ADAW] + (size_t)l * 1024 * 6144 + n0 + F.lane;
            float a0 = 0.f, a1 = 0.f, a2 = 0.f;
#pragma unroll 8
            for (int kk = 0; kk < 128; ++kk) { const int k = F.wave * 128 + kk; const float wv = w[(size_t)k * 6144];
                a0 += sv[k] * wv; a1 += sv[1024 + k] * wv; a2 += sv[2048 + k] * wv; }
            red[(F.wave * 3 + 0) * 64 + F.lane] = a0; red[(F.wave * 3 + 1) * 64 + F.lane] = a1; red[(F.wave * 3 + 2) * 64 + F.lane] = a2;
            __syncthreads();
            if (F.tid < 192) { const int s = F.tid >> 6, c = F.tid & 63; float t = a.in[I_ADAB][l * 6144 + n0 + c];
#pragma unroll
                for (int w8 = 0; w8 < 8; ++w8) t += red[(w8 * 3 + s) * 64 + c];
                ((float*)(F.ws + WS_ADA))[(size_t)(l * 3 + s) * 6144 + n0 + c] = t; }
            __syncthreads();
        }
    }
}

__device__ __forceinline__ void moe_tables(Frame& F, int layer) {
    LAS int* M = (LAS int*)(F.lds + MISC_OFF);
    __syncthreads();
    if (F.tid < 32) M[400 + F.tid] = (int)__hip_atomic_load(F.ctl + CW_CNT + (layer * 32 + F.tid) * 64, __ATOMIC_RELAXED, __HIP_MEMORY_SCOPE_AGENT);
    __syncthreads();
    if (F.tid < 64) { const int e = F.tid & 31; const int nt = (M[400 + e] + 255) >> 8; int incl = nt;
#pragma unroll
        for (int o = 1; o < 32; o <<= 1) { const int v = __shfl_up(incl, o, 32); if (e >= o) incl += v; }
        const int off = (incl - nt) << 8;
        if (F.tid < 32) { M[e] = off; for (int t = 0; t < nt; ++t) M[64 + (off >> 8) + t] = e; if (e == 31) M[32] = incl << 8; } }
    __syncthreads();
}

__device__ __forceinline__ void p_prenorm(Frame& F, const Args& a, int layer, bool fin, bool dry = false) {
    const int gw = F.vcu * NWAVES + F.wave, NGW = F.G * NWAVES;
    const int prev = layer - 1;
    const int row_lo = (layer >= 3) ? NCTX : 0;
    const bool combine = layer > 0;
    if (combine) moe_tables(F, prev);
    const LAS int* M = (const LAS int*)(F.lds + MISC_OFF);
    float* X = (float*)(F.ws + WS_X); bf16* H = (bf16*)(F.ws + (dry ? WS_AS : WS_H));
    const bf16* YB = (const bf16*)(F.ws + WS_YB);
    const float* ada = (const float*)(F.ws + WS_ADA);
    const v4u* TOKI = (const v4u*)(F.ws + WS_TOKI); const f32x4* TOKG = (const f32x4*)(F.ws + WS_TOKG);
    LAS float* V = (LAS float*)(F.lds);
    __syncthreads();
    for (int i = F.tid; i < 10 * D; i += NTHREADS) { const int w = i >> 10, c = i & 1023; float x;
        if (w == 0) x = fin ? a.in[I_NOUT][c] : a.in[I_NMIX][(size_t)layer * D + c];
        else { const int seg = (w - 1) / 3, k = (w - 1) % 3; x = k == 2 ? (combine ? ada[(size_t)((prev * 3 + seg) * 6 + 5) * D + c] : 0.f) : (fin ? 0.f : ada[(size_t)((layer * 3 + seg) * 6 + k) * D + c]); }
        V[i] = x; }
    __syncthreads();
    for (int row0 = row_lo + gw; row0 < NTOK; row0 += 2 * NGW) {
        const int row1r = row0 + NGW; const bool has1 = row1r < NTOK; const int row1 = has1 ? row1r : row0;
        f32x4 v[2][4]; v4u ti[2]; f32x4 tg[2];
#pragma unroll
        for (int q = 0; q < 2; ++q) { const int row = q ? row1 : row0;
            const float* src = layer == 0 ? (row < NCTX ? a.in[I_CTX] + (size_t)row * D : a.in[I_X] + (size_t)(row - NCTX) * D) : X + (size_t)row * D;
#pragma unroll
            for (int j = 0; j < 4; ++j) v[q][j] = *(const GAS f32x4*)(src + 4 * F.lane + 256 * j);
            if (combine) { ti[q] = TOKI[row]; tg[q] = TOKG[row]; } }
        if (combine) {
            v2u y[2][4][4];
#pragma unroll
            for (int q = 0; q < 2; ++q)
#pragma unroll
                for (int k = 0; k < 4; ++k) { const unsigned t = ti[q][k]; const int pos = M[t >> 16] + (int)(t & 0xffffu); const bf16* yr = YB + (size_t)pos * D + 4 * F.lane;
#pragma unroll
                    for (int j = 0; j < 4; ++j) y[q][k][j] = *(const GAS v2u*)(yr + 256 * j); }
#pragma unroll
            for (int q = 0; q < 2; ++q) { const int seg = seg_of_row(q ? row1 : row0);
#pragma unroll
                for (int j = 0; j < 4; ++j) { f32x4 acc = (f32x4){0.f, 0.f, 0.f, 0.f};
#pragma unroll
                    for (int k = 0; k < 4; ++k) { const float g = tg[q][k]; const v2u yy = y[q][k][j]; acc.x += g * bflo(yy.x); acc.y += g * bfhi(yy.x); acc.z += g * bflo(yy.y); acc.w += g * bfhi(yy.y); }
                    const f32x4 gg = *(const LAS f32x4*)(V + (1 + 3 * seg + 2) * D + 4 * F.lane + 256 * j); v[q][j] = v[q][j] + gg * acc; } }
        }
#pragma unroll
        for (int q = 0; q < 2; ++q) { if (q == 1 && !has1) break; const int row = q ? row1 : row0, seg = seg_of_row(row);
            if (!fin && !dry && (combine || layer == 0)) {
#pragma unroll
                for (int j = 0; j < 4; ++j) *(GAS f32x4*)(X + (size_t)row * D + 4 * F.lane + 256 * j) = v[q][j];
            }
            float ss = 0.f;
#pragma unroll
            for (int j = 0; j < 4; ++j) ss += (v[q][j].x * v[q][j].x + v[q][j].y * v[q][j].y) + (v[q][j].z * v[q][j].z + v[q][j].w * v[q][j].w);
            const float rstd = 1.0f / sqrtf(wave_sum(ss) * (1.0f / D) + EPS);
            if (fin) {
                float* o = a.out + (size_t)(row - NCTX) * D;
#pragma unroll
                for (int j = 0; j < 4; ++j) { const f32x4 g = *(const LAS f32x4*)(V + 4 * F.lane + 256 * j); *(GAS f32x4*)(o + 4 * F.lane + 256 * j) = v[q][j] * rstd * g; }
            } else {
#pragma unroll
                for (int j = 0; j < 4; ++j) { const int c = 4 * F.lane + 256 * j;
                    const f32x4 g = *(const LAS f32x4*)(V + c), s0 = *(const LAS f32x4*)(V + (1 + 3 * seg) * D + c), s1 = *(const LAS f32x4*)(V + (2 + 3 * seg) * D + c);
                    const f32x4 h = v[q][j] * rstd * g * (s1 + 1.0f) + s0;
                    v2u o; o.x = pk2(h.x, h.y); o.y = pk2(h.z, h.w);
                    *(GAS v2u*)(H + (size_t)row * D + c) = o; }
            }
        }
    }
}

__device__ __forceinline__ void p_router(Frame& F, const Args& a, int layer, bool dry = false) {
    const int row_lo = (layer >= 2) ? NCTX : 0;
    const int ntile = (NTOK - row_lo) / 16;
    float* X = (float*)(F.ws + WS_X); bf16* H = (bf16*)(F.ws + WS_H);
    const float* ada = (const float*)(F.ws + WS_ADA);
    constexpr int AST = 1032;
    LAS bf16* Ahi = (LAS bf16*)(F.lds); LAS bf16* Alo = Ahi + 16 * AST;
    LAS float* RED = (LAS float*)(F.lds + 2 * 16 * AST * 2);
    LAS float* LOG = RED + 8 * 16 * 32;
    const int fr = F.lane & 15, fq = F.lane >> 4;
    bf16x8 Bh[2][4], Bl[2][4];
    {
        const bf16* wh = (const bf16*)(F.ws + WS_WRH) + (size_t)layer * 32 * 1024; const bf16* wl = (const bf16*)(F.ws + WS_WRL) + (size_t)layer * 32 * 1024;
#pragma unroll
        for (int nt = 0; nt < 2; ++nt)
#pragma unroll
            for (int ks = 0; ks < 4; ++ks) { const size_t o = (size_t)(nt * 16 + fr) * 1024 + F.wave * 128 + ks * 32 + fq * 8;
                Bh[nt][ks] = *(const GAS bf16x8*)(wh + o); Bl[nt][ks] = *(const GAS bf16x8*)(wl + o); }
    }
    const float* nw = a.in[I_NFFN] + (size_t)layer * D;
    for (int tile = F.vcu; tile < ntile; tile += F.G) {
        const int r0 = row_lo + 16 * tile;
#pragma unroll
        for (int rr = 0; rr < 2; ++rr) {
            const int rl = 2 * F.wave + rr, row = r0 + rl, seg = seg_of_row(row);
            const float* sh = ada + (size_t)((layer * 3 + seg) * 6 + 3) * D; const float* sc = sh + D;
            f32x4 v[4]; float ss = 0.f;
#pragma unroll
            for (int j = 0; j < 4; ++j) { v[j] = *(const GAS f32x4*)(X + (size_t)row * D + 4 * F.lane + 256 * j); ss += (v[j].x * v[j].x + v[j].y * v[j].y) + (v[j].z * v[j].z + v[j].w * v[j].w); }
            const float rstd = 1.0f / sqrtf(wave_sum(ss) * (1.0f / D) + EPS);
#pragma unroll
            for (int j = 0; j < 4; ++j) { const int c = 4 * F.lane + 256 * j;
                const f32x4 g = *(const GAS f32x4*)(nw + c), s1 = *(const GAS f32x4*)(sc + c), s0 = *(const GAS f32x4*)(sh + c);
                const f32x4 h = v[j] * rstd * g * (s1 + 1.0f) + s0;
                const unsigned h0 = f2bf(h.x), h1 = f2bf(h.y), h2 = f2bf(h.z), h3 = f2bf(h.w);
                v2u o; o.x = h0 | (h1 << 16); o.y = h2 | (h3 << 16);
                *(GAS v2u*)(H + (size_t)row * D + c) = o;
                *(LAS v2u*)(Ahi + rl * AST + c) = o;
                v2u l; l.x = pk2(h.x - bf2f(h0), h.y - bf2f(h1)); l.y = pk2(h.z - bf2f(h2), h.w - bf2f(h3));
                *(LAS v2u*)(Alo + rl * AST + c) = l; }
        }
        __syncthreads();
        f32x4 acc[2] = {(f32x4){0.f, 0.f, 0.f, 0.f}, (f32x4){0.f, 0.f, 0.f, 0.f}};
#pragma unroll
        for (int ks = 0; ks < 4; ++ks) { const int o = fr * AST + F.wave * 128 + ks * 32 + fq * 8;
            const bf16x8 ah = *(const LAS bf16x8*)(Ahi + o), al = *(const LAS bf16x8*)(Alo + o);
#pragma unroll
            for (int nt = 0; nt < 2; ++nt) { acc[nt] = MFMA16(ah, Bh[nt][ks], acc[nt]); acc[nt] = MFMA16(ah, Bl[nt][ks], acc[nt]); acc[nt] = MFMA16(al, Bh[nt][ks], acc[nt]); } }
#pragma unroll
        for (int nt = 0; nt < 2; ++nt)
#pragma unroll
            for (int j = 0; j < 4; ++j) RED[(F.wave * 16 + fq * 4 + j) * 32 + nt * 16 + fr] = acc[nt][j];
        __syncthreads();
        {
            const int rl = F.tid >> 5, e = F.tid & 31, row = r0 + rl;
            float lg = a.in[I_MBR][layer * 32 + e];
#pragma unroll
            for (int w8 = 0; w8 < 8; ++w8) lg += RED[(w8 * 16 + rl) * 32 + e];
            float cur = lg; float tv[4]; int tix[4];
#pragma unroll
            for (int k = 0; k < 4; ++k) { float bv = cur; int bi = e;
#pragma unroll
                for (int o = 1; o < 32; o <<= 1) { const float ov = __shfl_xor(bv, o); const int oi = __shfl_xor(bi, o); if (ov > bv || (ov == bv && oi < bi)) { bv = ov; bi = oi; } }
                tv[k] = bv; tix[k] = bi; if (e == bi) cur = -3.0e38f; }
            const float e1 = __expf(tv[1] - tv[0]), e2 = __expf(tv[2] - tv[0]), e3 = __expf(tv[3] - tv[0]); const float inv = 1.0f / (1.0f + e1 + e2 + e3);
            if (e < 4 && !dry) { const int k = e; const int ek = k == 0 ? tix[0] : (k == 1 ? tix[1] : (k == 2 ? tix[2] : tix[3])); const float gk = (k == 0 ? 1.0f : (k == 1 ? e1 : (k == 2 ? e2 : e3))) * inv;
                const unsigned rank = atomicAdd(F.ctl + CW_CNT + (layer * 32 + ek) * 64, 1u);
                ((unsigned*)(F.ws + WS_LIST))[(size_t)ek * NTOK + rank] = (unsigned)row;
                ((unsigned*)(F.ws + WS_TOKI))[(size_t)row * 4 + k] = ((unsigned)ek << 16) | rank;
                ((float*)(F.ws + WS_TOKG))[(size_t)row * 4 + k] = gk; }
        }
        __syncthreads();
    }
}

__device__ __forceinline__ void p_gather(Frame& F, int layer) {
    moe_tables(F, layer);
    const LAS int* M = (const LAS int*)(F.lds + MISC_OFF);
    const int total = M[32];
    const int gw = F.vcu * NWAVES + F.wave, NGW = F.G * NWAVES;
    const bf16* H = (const bf16*)(F.ws + WS_H); bf16* AS = (bf16*)(F.ws + WS_AS);
    const unsigned* LIST = (const unsigned*)(F.ws + WS_LIST);
    for (int p = gw; p < total; p += NGW) {
        const int e = M[64 + (p >> 8)]; const int rank = p - M[e];
        v4u x0 = (v4u){0u, 0u, 0u, 0u}, x1 = x0;
        if (rank < M[400 + e]) { const unsigned r = LIST[(size_t)e * NTOK + rank]; const GAS v4u* s = (const GAS v4u*)(H + (size_t)r * D); x0 = s[F.lane]; x1 = s[64 + F.lane]; }
        GAS v4u* d = (GAS v4u*)(AS + (size_t)p * D); d[F.lane] = x0; d[64 + F.lane] = x1;
    }
}

typedef short s16x4 __attribute__((ext_vector_type(4)));
__device__ __forceinline__ bf16x8 tr_frag(const LAS bf16* T, int stride, int kb, int c0, int lane) {
    const int g = lane >> 4, w = lane & 15, q = w >> 2, p = w & 3;
    const LAS bf16* a0 = T + (kb + 4 * g + q) * stride + c0 + 4 * p;
    const s16x4 lo = __builtin_amdgcn_ds_read_tr16_b64_v4i16((LAS s16x4*)a0);
    const s16x4 hi = __builtin_amdgcn_ds_read_tr16_b64_v4i16((LAS s16x4*)(a0 + 16 * stride));
    return (bf16x8){lo[0], lo[1], lo[2], lo[3], hi[0], hi[1], hi[2], hi[3]};
}
__device__ __forceinline__ bf16x8 perm_frag(const LAS bf16* rowp, int kb, int quad) {
    const v2u lo = *(const LAS v2u*)(rowp + kb + 4 * quad), hi = *(const LAS v2u*)(rowp + kb + 16 + 4 * quad);
    v4u w; w.x = lo.x; w.y = lo.y; w.z = hi.x; w.w = hi.y; return __builtin_bit_cast(bf16x8, w);
}
__device__ __forceinline__ void p_spatial(Frame& F, const Args& a, int layer) {
    const int jl = layer / 3;
    const int c_lo = (layer >= 3) ? 4 : 0;
    const int nunit = (132 - c_lo) * 8;
    const bf16* ZB = (const bf16*)(F.ws + WS_BIG); bf16* G = (bf16*)(F.ws + WS_G);
    constexpr int ST = 144;
    LAS bf16* As = (LAS bf16*)(F.lds); LAS bf16* Bs = As + 128 * ST; LAS float* rs = (LAS float*)(F.lds + 2 * 128 * ST * 2);
    const int fr = F.lane & 15, fq = F.lane >> 4;
    const int u_lo = (int)(((long)F.vcu * nunit) / F.G), u_hi = (int)(((long)(F.vcu + 1) * nunit) / F.G);
    int cur_c = -1;
    for (int u = u_lo; u < u_hi; ++u) {
        const int c = c_lo + (u >> 3), g = u & 7, r0 = 128 * c;
        if (c != cur_c) {
            cur_c = c;
            __syncthreads();
#pragma unroll
            for (int hb = 0; hb < 2; ++hb) {
                v4u x0[8], x1[8];
#pragma unroll
                for (int rr = 0; rr < 8; ++rr) { const GAS v4u* p = (const GAS v4u*)(ZB + (size_t)(r0 + F.wave * 16 + hb * 8 + rr) * 2048 + 1024 + 16 * F.lane); x0[rr] = p[0]; x1[rr] = p[1]; }
#pragma unroll
                for (int rr = 0; rr < 8; ++rr) { float ss = 0.f;
#pragma unroll
                    for (int i = 0; i < 4; ++i) { const float l0 = bflo(x0[rr][i]), h0 = bfhi(x0[rr][i]), l1 = bflo(x1[rr][i]), h1 = bfhi(x1[rr][i]); ss += l0 * l0 + h0 * h0 + l1 * l1 + h1 * h1; }
                    ss = wave_sum(ss); if (F.lane == 0) rs[F.wave * 16 + hb * 8 + rr] = 1.0f / sqrtf(ss * (1.0f / 1024.0f) + EPS); }
            }
        }
        __syncthreads();
        {
            const bf16* wsb = (const bf16*)(F.ws + WS_WSB) + (size_t)(jl * 8 + g) * 128 * 128;
            const float* gv = a.in[I_AGV] + (size_t)jl * 1024 + 128 * g;
#pragma unroll
            for (int i = 0; i < 4; ++i) { const int id = F.tid + 512 * i, p = id >> 4, qc = id & 15;
                *(LAS v4u*)(As + p * ST + qc * 8) = *(const GAS v4u*)(wsb + p * 128 + qc * 8);
                const v4u x = *(const GAS v4u*)(ZB + (size_t)(r0 + p) * 2048 + 1024 + 128 * g + 8 * qc); const float rq = rs[p];
                const f32x4 g0 = *(const GAS f32x4*)(gv + 8 * qc), g1 = *(const GAS f32x4*)(gv + 8 * qc + 4);
                v4u o; o.x = pk2(bflo(x.x) * rq * g0.x, bfhi(x.x) * rq * g0.y); o.y = pk2(bflo(x.y) * rq * g0.z, bfhi(x.y) * rq * g0.w);
                o.z = pk2(bflo(x.z) * rq * g1.x, bfhi(x.z) * rq * g1.y); o.w = pk2(bflo(x.w) * rq * g1.z, bfhi(x.w) * rq * g1.w);
                *(LAS v4u*)(Bs + p * ST + qc * 8) = o; }
        }
        __syncthreads();
        f32x4 acc[8];
#pragma unroll
        for (int nt = 0; nt < 8; ++nt) acc[nt] = (f32x4){0.f, 0.f, 0.f, 0.f};
#pragma unroll
        for (int ks = 0; ks < 4; ++ks) { const bf16x8 af = tr_frag(Bs, ST, 32 * ks, 16 * F.wave, F.lane);
#pragma unroll
            for (int nt = 0; nt < 8; ++nt) { const bf16x8 bfr = perm_frag(As + (16 * nt + fr) * ST, 32 * ks, fq); acc[nt] = MFMA16(af, bfr, acc[nt]); } }
        const float* bs = a.in[I_ABS] + (size_t)(jl * 8 + g) * 128;
#pragma unroll
        for (int nt = 0; nt < 8; ++nt) { const int p = 16 * nt + fr; const float bb = bs[p]; const size_t row = (size_t)(r0 + p); const int cc = 128 * g + 16 * F.wave + 4 * fq;
            const v2u uu = *(const GAS v2u*)(ZB + row * 2048 + cc);
            v2u o; o.x = pk2(bflo(uu.x) * (acc[nt][0] + bb), bfhi(uu.x) * (acc[nt][1] + bb)); o.y = pk2(bflo(uu.y) * (acc[nt][2] + bb), bfhi(uu.y) * (acc[nt][3] + bb));
            *(GAS v2u*)(G + row * D + cc) = o; }
        __syncthreads();
    }
}

constexpr int PST = GLA_INP;
constexpr int CST = 132;
constexpr int KST = 144;
constexpr int VST = 272;
__device__ __forceinline__ void gla_cum(Frame& F, const Args& a, int c, int h, int dir, LAS float* cum, LAS float* rt, LAS float* tot) {
    const bf16* P = (const bf16*)(F.ws + WS_BIG);
    for (int i = F.tid; i < 64 * 8; i += NTHREADS) { const int ii = i >> 3, j2 = i & 7; const unsigned x = *(const GAS unsigned*)(P + (size_t)(64 * c + ii) * PST + 3072 + dir * 16 + 2 * j2);
        rt[ii * 16 + 2 * j2] = bflo(x); rt[ii * 16 + 2 * j2 + 1] = bfhi(x); }
    const int kk = F.tid & 127, part = F.tid >> 7;
    float w[16];
#pragma unroll
    for (int j = 0; j < 16; ++j) w[j] = a.in[I_BWA2][(size_t)(dir * 16 + j) * 512 + h * 128 + kk];
    const float ba = a.in[I_BBA][dir * 512 + h * 128 + kk];
    __syncthreads();
    float la[16];
#pragma unroll
    for (int ii = 0; ii < 16; ++ii) { const int i = part * 16 + ii; float z = ba;
        const f32x4 r0 = *(const LAS f32x4*)(rt + i * 16), r1 = *(const LAS f32x4*)(rt + i * 16 + 4), r2 = *(const LAS f32x4*)(rt + i * 16 + 8), r3 = *(const LAS f32x4*)(rt + i * 16 + 12);
        z += r0.x * w[0] + r0.y * w[1] + r0.z * w[2] + r0.w * w[3]; z += r1.x * w[4] + r1.y * w[5] + r1.z * w[6] + r1.w * w[7];
        z += r2.x * w[8] + r2.y * w[9] + r2.z * w[10] + r2.w * w[11]; z += r3.x * w[12] + r3.y * w[13] + r3.z * w[14] + r3.w * w[15];
        const float ls = fminf(z, 0.0f) - __logf(1.0f + __expf(-fabsf(z)));
        la[ii] = ls * (1.0f / 16.0f); }
    float run = 0.f;
    if (dir == 0) {
#pragma unroll
        for (int ii = 0; ii < 16; ++ii) { run += la[ii]; la[ii] = run; } }
    else {
#pragma unroll
        for (int ii = 15; ii >= 0; --ii) { run += la[ii]; la[ii] = run; } }
    tot[part * 128 + kk] = run;
    __syncthreads();
    float off = 0.f;
#pragma unroll
    for (int p = 0; p < 4; ++p) { const float t = tot[p * 128 + kk]; if (dir == 0 ? (p < part) : (p > part)) off += t; }
#pragma unroll
    for (int ii = 0; ii < 16; ++ii) cum[(part * 16 + ii) * CST + kk] = la[ii] + off;
    __syncthreads();
}
struct RowRaw { v4u o0, o1, p0, p1; };
__device__ __forceinline__ void row16_load(const bf16* x, int grp, bool lat, RowRaw& R) {
    R.o0 = *(const GAS v4u*)(x + 16 * grp); R.o1 = *(const GAS v4u*)(x + 16 * grp + 8);
    if (lat) { R.p0 = *(const GAS v4u*)(x + 16 * (grp ^ 2)); R.p1 = *(const GAS v4u*)(x + 16 * (grp ^ 2) + 8); } else { R.p0 = R.o0; R.p1 = R.o1; }
}
__device__ __forceinline__ void ropetab_load(const float* ROPE, int grp, int pr, int pc, bool lat, f32x4 (&tb)[8]) {
    const int pos = (grp >> 2) ? pc : pr; const float* t = ROPE + (size_t)(pos * 32 + 16 * (grp & 1)) * 2;
#pragma unroll
    for (int e2 = 0; e2 < 8; ++e2) tb[e2] = lat ? *(const GAS f32x4*)(t + 4 * e2) : (f32x4){1.f, 0.f, 1.f, 0.f};
}
__device__ __forceinline__ void rope16_apply(const RowRaw& R, const f32x4 (&tb)[8], int grp, bool lat, float (&out)[16]) {
    float own[16], par[16];
#pragma unroll
    for (int e = 0; e < 4; ++e) { own[2 * e] = bflo(R.o0[e]); own[2 * e + 1] = bfhi(R.o0[e]); own[8 + 2 * e] = bflo(R.o1[e]); own[8 + 2 * e + 1] = bfhi(R.o1[e]);
        par[2 * e] = bflo(R.p0[e]); par[2 * e + 1] = bfhi(R.p0[e]); par[8 + 2 * e] = bflo(R.p1[e]); par[8 + 2 * e + 1] = bfhi(R.p1[e]); }
    if (!lat) {
#pragma unroll
        for (int e = 0; e < 16; ++e) out[e] = own[e];
        return; }
    const bool second = (grp >> 1) & 1;
#pragma unroll
    for (int e2 = 0; e2 < 8; ++e2) { const f32x4 t = tb[e2];
        { const int e = 2 * e2; const float x1 = second ? par[e] : own[e], x2 = second ? own[e] : par[e]; out[e] = second ? (x1 * t.y + x2 * t.x) : (x1 * t.x - x2 * t.y); }
        { const int e = 2 * e2 + 1; const float x1 = second ? par[e] : own[e], x2 = second ? own[e] : par[e]; out[e] = second ? (x1 * t.w + x2 * t.z) : (x1 * t.z - x2 * t.w); } }
}
__device__ __forceinline__ void st16bf(LAS bf16* dst, const float (&v)[16]) {
    v4u a, b; a.x = pk2(v[0], v[1]); a.y = pk2(v[2], v[3]); a.z = pk2(v[4], v[5]); a.w = pk2(v[6], v[7]); b.x = pk2(v[8], v[9]); b.y = pk2(v[10], v[11]); b.z = pk2(v[12], v[13]); b.w = pk2(v[14], v[15]);
    *(LAS v4u*)dst = a; *(LAS v4u*)(dst + 8) = b;
}
__device__ __forceinline__ void ld16cum(const LAS float* p, float (&v)[16]) {
#pragma unroll
    for (int e = 0; e < 4; ++e) { const f32x4 t = *(const LAS f32x4*)(p + 4 * e); v[4 * e] = t.x; v[4 * e + 1] = t.y; v[4 * e + 2] = t.z; v[4 * e + 3] = t.w; }
}
__device__ __forceinline__ void gla_stage_v(Frame& F, int c, int h, LAS bf16* VL) {
    const bf16* P = (const bf16*)(F.ws + WS_BIG);
    const int i = F.tid & 63, grp = F.tid >> 6; const bf16* vp = P + (size_t)(64 * c + i) * PST + 1024 + h * 256 + grp * 32;
#pragma unroll
    for (int e = 0; e < 4; ++e) *(LAS v4u*)(VL + i * VST + grp * 32 + 8 * e) = *(const GAS v4u*)(vp + 8 * e);
}
__device__ __forceinline__ void p_gla_ds(Frame& F, const Args& a) {
    const bf16* P = (const bf16*)(F.ws + WS_BIG); const float* ROPE = (const float*)(F.ws + WS_ROPE);
    bf16* DS = (bf16*)(F.ws + WS_DS); float* DEC = (float*)(F.ws + WS_DEC);
    LAS float* cum = (LAS float*)(F.lds); LAS float* rt = cum + 64 * CST; LAS float* tot = rt + 64 * 16;
    LAS bf16* KE = (LAS bf16*)(tot + 4 * 128); LAS bf16* VL = KE + 64 * KST;
    const int fr = F.lane & 15, fq = F.lane >> 4;
    for (int u = F.vcu; u < 264 * 8; u += F.G) {
        const int c = u >> 3, h = (u >> 1) & 3, dir = u & 1; const bool lat = c >= 8; const int pr = (c - 8) & 127;
        RowRaw kraw; f32x4 tb[8];
        { const int i = F.tid & 63, grp = F.tid >> 6; row16_load(P + (size_t)(64 * c + i) * PST + 512 + h * 128, grp, lat, kraw); ropetab_load(ROPE, grp, pr, i, lat, tb); }
        gla_cum(F, a, c, h, dir, cum, rt, tot);
        const int lastrow = dir == 0 ? 63 : 0;
        {
            const int i = F.tid & 63, grp = F.tid >> 6;
            float kv[16], cl[16], ci[16];
            rope16_apply(kraw, tb, grp, lat, kv);
            ld16cum(cum + lastrow * CST + 16 * grp, cl); ld16cum(cum + i * CST + 16 * grp, ci);
#pragma unroll
            for (int e = 0; e < 16; ++e) kv[e] *= __expf(cl[e] - ci[e]);
            st16bf(KE + i * KST + 16 * grp, kv);
            gla_stage_v(F, c, h, VL);
            if (F.tid < 128) DEC[((size_t)(dir * 264 + c) * 4 + h) * 128 + F.tid] = __expf(cum[lastrow * CST + F.tid]);
        }
        __syncthreads();
        f32x4 acc[16];
#pragma unroll
        for (int nt = 0; nt < 16; ++nt) acc[nt] = (f32x4){0.f, 0.f, 0.f, 0.f};
#pragma unroll
        for (int ks = 0; ks < 2; ++ks) { const bf16x8 af = tr_frag(KE, KST, 32 * ks, 16 * F.wave, F.lane);
#pragma unroll
            for (int nt = 0; nt < 16; ++nt) { const bf16x8 bfr = tr_frag(VL, VST, 32 * ks, 16 * nt, F.lane); acc[nt] = MFMA16(af, bfr, acc[nt]); } }
        bf16* dsp = DS + ((size_t)(dir * 264 + c) * 4 + h) * 256 * 128;
#pragma unroll
        for (int nt = 0; nt < 16; ++nt) { v2u o; o.x = pk2(acc[nt][0], acc[nt][1]); o.y = pk2(acc[nt][2], acc[nt][3]);
            *(GAS v2u*)(dsp + (size_t)((((nt * 4 + (F.wave >> 1)) * 4 + ((2 * F.wave + (fq >> 1)) & 3)) * 16 + fr) * 8 + 4 * (fq & 1))) = o; }
        __syncthreads();
    }
}
__device__ __forceinline__ void p_gla_scan(Frame& F) {
    const bf16* DS = (const bf16*)(F.ws + WS_DS); bf16* SIN = (bf16*)(F.ws + WS_SIN); const float* DEC = (const float*)(F.ws + WS_DEC);
    LAS float* dl = (LAS float*)(F.lds);
    for (int job = F.vcu; job < 256; job += F.G) {
        const int vt = job & 15, h = (job >> 4) & 3, dir = (job >> 6) & 1, b = job >> 7;
        __syncthreads();
        for (int i = F.tid; i < 132 * 32; i += NTHREADS) { const int st = i >> 5, k4 = i & 31; int c;
            if (dir == 0) c = st < 4 ? 4 * b + st : 8 + 128 * b + (st - 4); else c = st < 4 ? 4 * b + 3 - st : 8 + 128 * b + 127 - (st - 4);
            *(LAS f32x4*)(dl + st * 128 + 4 * k4) = *(const GAS f32x4*)(DEC + ((size_t)(dir * 264 + c) * 4 + h) * 128 + 4 * k4); }
        __syncthreads();
        const int ks = F.wave >> 1, quad = 2 * (F.wave & 1) + (F.lane >> 5), fr = (F.lane >> 1) & 15, half = F.lane & 1;
        const int kk0 = 32 * ks + 8 * quad + 4 * half;
        const size_t eoff = (size_t)((((vt * 4 + ks) * 4 + quad) * 16 + fr) * 8 + 4 * half);
        f32x4 S = (f32x4){0.f, 0.f, 0.f, 0.f};
        for (int s0 = 0; s0 < 132; s0 += 12) {
            size_t o[12]; v2u d[12];
#pragma unroll
            for (int q = 0; q < 12; ++q) { const int st = s0 + q; int c;
                if (dir == 0) c = st < 4 ? 4 * b + st : 8 + 128 * b + (st - 4); else c = st < 4 ? 4 * b + 3 - st : 8 + 128 * b + 127 - (st - 4);
                o[q] = ((size_t)(dir * 264 + c) * 4 + h) * 32768 + eoff;
                d[q] = __builtin_nontemporal_load((const GAS v2u*)(DS + o[q])); }
#pragma unroll
            for (int q = 0; q < 12; ++q) { const f32x4 dc = *(const LAS f32x4*)(dl + (s0 + q) * 128 + kk0);
                v2u so; so.x = pk2(S.x, S.y); so.y = pk2(S.z, S.w);
                *(GAS v2u*)(SIN + o[q]) = so;
                S.x = S.x * dc.x + bflo(d[q].x); S.y = S.y * dc.y + bfhi(d[q].x); S.z = S.z * dc.z + bflo(d[q].y); S.w = S.w * dc.w + bfhi(d[q].y); }
        }
    }
}
__device__ __forceinline__ void p_gla_out(Frame& F, const Args& a) {
    const bf16* P = (const bf16*)(F.ws + WS_BIG); const float* ROPE = (const float*)(F.ws + WS_ROPE);
    const bf16* SIN = (const bf16*)(F.ws + WS_SIN); bf16* G = (bf16*)(F.ws + WS_G);
    constexpr int ST = 72;
    LAS float* cum = (LAS float*)(F.lds); LAS float* rt = cum + 64 * CST; LAS float* tot = rt + 64 * 16; LAS float* ssq = tot + 4 * 128;
    LAS bf16* VL = (LAS bf16*)(ssq + 8 * 64); LAS bf16* QD = VL + 64 * VST; LAS bf16* KI = QD + 64 * KST; LAS bf16* PL = KI + 64 * KST;
    const int fr = F.lane & 15, fq = F.lane >> 4;
    for (int u = F.vcu; u < 264 * 4; u += F.G) {
        const int c = u >> 2, h = u & 3; const bool lat = c >= 8; const int pr = (c - 8) & 127;
        f32x4 acc[2][4];
#pragma unroll
        for (int mt = 0; mt < 2; ++mt)
#pragma unroll
            for (int nt = 0; nt < 4; ++nt) acc[mt][nt] = (f32x4){0.f, 0.f, 0.f, 0.f};
        gla_stage_v(F, c, h, VL);
        float qv0[16], kv0[16];
#pragma unroll
        for (int dir = 0; dir < 2; ++dir) {
            RowRaw qraw0, kraw0; f32x4 tb0[8];
            const bf16* sp = SIN + ((size_t)(dir * 264 + c) * 4 + h) * 256 * 128;
            bf16x8 sfr[4][2];
#pragma unroll
            for (int ks = 0; ks < 4; ++ks)
#pragma unroll
                for (int mt = 0; mt < 2; ++mt) sfr[ks][mt] = *(const GAS bf16x8*)(sp + (size_t)(((((2 * F.wave + mt) * 4 + ks) * 4 + fq) * 16 + fr) * 8));
            { const int i = F.tid & 63, grp = F.tid >> 6; const size_t row = (size_t)(64 * c + i);
                if (dir == 0) { row16_load(P + row * PST + h * 128, grp, lat, qraw0); row16_load(P + row * PST + 512 + h * 128, grp, lat, kraw0); ropetab_load(ROPE, grp, pr, i, lat, tb0); } }
            gla_cum(F, a, c, h, dir, cum, rt, tot);
            {
                const int i = F.tid & 63, grp = F.tid >> 6;
                if (dir == 0) { rope16_apply(qraw0, tb0, grp, lat, qv0); rope16_apply(kraw0, tb0, grp, lat, kv0); }
                float qv[16], kv[16], ci[16];
                ld16cum(cum + i * CST + 16 * grp, ci);
#pragma unroll
                for (int e = 0; e < 16; ++e) { const float ex = __expf(ci[e]); qv[e] = qv0[e] * (0.08838834764831845f * ex); kv[e] = kv0[e] * __builtin_amdgcn_rcpf(ex); }
                st16bf(QD + i * KST + 16 * grp, qv); st16bf(KI + i * KST + 16 * grp, kv);
            }
            __syncthreads();
            {
                const int jt = F.wave >> 1;
#pragma unroll
                for (int t2 = 0; t2 < 2; ++t2) { const int it = 2 * (F.wave & 1) + t2; f32x4 s = (f32x4){0.f, 0.f, 0.f, 0.f};
#pragma unroll
                    for (int ks = 0; ks < 4; ++ks) { const bf16x8 af = *(const LAS bf16x8*)(KI + (16 * jt + fr) * KST + ks * 32 + fq * 8), bfr = *(const LAS bf16x8*)(QD + (16 * it + fr) * KST + ks * 32 + fq * 8); s = MFMA16(af, bfr, s); }
                    const int i = 16 * it + fr, j0 = 16 * jt + fq * 4; float pv[4];
#pragma unroll
                    for (int r = 0; r < 4; ++r) { const int j = j0 + r; const bool keep = dir == 0 ? (j <= i) : (j >= i); pv[r] = keep ? s[r] : 0.0f; }
                    v2u o; o.x = pk2(pv[0], pv[1]); o.y = pk2(pv[2], pv[3]);
                    *(LAS v2u*)(PL + i * ST + j0) = o; }
            }
            __syncthreads();
#pragma unroll
            for (int ks = 0; ks < 2; ++ks) {
                bf16x8 bfr[4];
#pragma unroll
                for (int nt = 0; nt < 4; ++nt) bfr[nt] = perm_frag(PL + (16 * nt + fr) * ST, 32 * ks, fq);
#pragma unroll
                for (int mt = 0; mt < 2; ++mt) { const bf16x8 af = tr_frag(VL, VST, 32 * ks, 32 * F.wave + 16 * mt, F.lane);
#pragma unroll
                    for (int nt = 0; nt < 4; ++nt) acc[mt][nt] = MFMA16(af, bfr[nt], acc[mt][nt]); } }
#pragma unroll
            for (int ks = 0; ks < 4; ++ks) {
                bf16x8 bfr[4];
#pragma unroll
                for (int nt = 0; nt < 4; ++nt) bfr[nt] = *(const LAS bf16x8*)(QD + (16 * nt + fr) * KST + ks * 32 + fq * 8);
#pragma unroll
                for (int mt = 0; mt < 2; ++mt) {
#pragma unroll
                    for (int nt = 0; nt < 4; ++nt) acc[mt][nt] = MFMA16(sfr[ks][mt], bfr[nt], acc[mt][nt]); } }
            __syncthreads();
        }
#pragma unroll
        for (int nt = 0; nt < 4; ++nt) { float s = 0.f;
#pragma unroll
            for (int mt = 0; mt < 2; ++mt)
#pragma unroll
                for (int j = 0; j < 4; ++j) s += acc[mt][nt][j] * acc[mt][nt][j];
            s += __shfl_xor(s, 16); s += __shfl_xor(s, 32);
            if (fq == 0) ssq[F.wave * 64 + 16 * nt + fr] = s; }
        __syncthreads();
#pragma unroll
        for (int nt = 0; nt < 4; ++nt) { const int i = 16 * nt + fr; float s = 0.f;
#pragma unroll
            for (int w8 = 0; w8 < 8; ++w8) s += ssq[w8 * 64 + i];
            const float rstd = 1.0f / sqrtf(s * (1.0f / 256.0f) + EPS); const size_t row = (size_t)(64 * c + i);
#pragma unroll
            for (int mt = 0; mt < 2; ++mt) { const int v0 = 32 * F.wave + 16 * mt + fq * 4;
                const v2u gg = *(const GAS v2u*)(P + row * PST + 2048 + h * 256 + v0); const f32x4 go = *(const GAS f32x4*)(a.in[I_BGO] + v0);
                const float g0 = bflo(gg.x), g1 = bfhi(gg.x), g2 = bflo(gg.y), g3 = bfhi(gg.y);
                const float o0 = acc[mt][nt][0] * rstd * go.x * (g0 / (1.0f + __expf(-g0))), o1 = acc[mt][nt][1] * rstd * go.y * (g1 / (1.0f + __expf(-g1)));
                const float o2 = acc[mt][nt][2] * rstd * go.z * (g2 / (1.0f + __expf(-g2))), o3 = acc[mt][nt][3] * rstd * go.w * (g3 / (1.0f + __expf(-g3)));
                v2u o; o.x = pk2(o0, o1); o.y = pk2(o2, o3);
                *(GAS v2u*)(G + row * D + h * 256 + v0) = o; } }
        __syncthreads();
    }
}

__device__ __forceinline__ int na_koff(int key, int c16) { return key * 128 + ((c16 ^ ((key >> 1) & 7)) << 4); }
__device__ __forceinline__ int na_voff(int key, int c16) { return key * 128 + (((((c16 >> 1) ^ ((key >> 1) & 3)) << 1) | (c16 & 1)) << 4); }
__device__ __forceinline__ bf16x8 na_vfrag(const LAS unsigned char* V, int kb, int dt, int lane) {
    const int g = lane >> 4, w = lane & 15, q = w >> 2, p = w & 3; const int r0 = kb + 4 * g + q, r1 = r0 + 16;
    const s16x4 lo = __builtin_amdgcn_ds_read_tr16_b64_v4i16((LAS s16x4*)(V + r0 * 128 + ((dt ^ ((r0 >> 1) & 3)) << 5) + 8 * p));
    const s16x4 hi = __builtin_amdgcn_ds_read_tr16_b64_v4i16((LAS s16x4*)(V + r1 * 128 + ((dt ^ ((r1 >> 1) & 3)) << 5) + 8 * p));
    return (bf16x8){lo[0], lo[1], lo[2], lo[3], hi[0], hi[1], hi[2], hi[3]};
}
#define LBAR() do { asm volatile("s_waitcnt lgkmcnt(0)" ::: "memory"); __builtin_amdgcn_s_barrier(); asm volatile("" ::: "memory"); } while (0)
struct NaState { bf16x8 qf[2], qn[2]; f32x4 o[4]; float m_run, l_run; int cur_bh; };
__device__ __forceinline__ int na_r0(int r) { return r < 4 ? 0 : (r > 124 ? 120 : r - 4); }
__device__ __forceinline__ void na_load(Frame& F, int u_lo, int st, v4u (&kr)[3], v4u (&vr)[3]) {
    const bf16* QKV = (const bf16*)(F.ws + WS_BIG);
    const int u = u_lo + st / 3, pass = st % 3, bh = u >> 6, rp = u & 63, b = bh >> 4, h = bh & 15;
    const int rbase = na_r0(2 * rp) + 3 * pass;
#pragma unroll
    for (int i = 0; i < 3; ++i) { const int id = F.tid + 512 * i, key = id >> 3, c = id & 7; int row = rbase + (key >> 6); row = row > 127 ? 127 : row;
        const bf16* p = QKV + ((size_t)NCTX + (size_t)b * SEQ + (size_t)row * 64 + (key & 63)) * 3072 + 1024 + h * 64 + 8 * c; kr[i] = *(const GAS v4u*)p; vr[i] = *(const GAS v4u*)(p + 1024); }
}
__device__ __forceinline__ void na_loadq(Frame& F, int u, int fq, bf16x8 (&q)[2]) {
    const bf16* QKV = (const bf16*)(F.ws + WS_BIG);
    const int bh = u >> 6, rp = u & 63, b = bh >> 4, h = bh & 15, r = 2 * rp + (F.wave >> 2), qcol = 16 * (F.wave & 3) + (F.lane & 15);
#pragma unroll
    for (int ks = 0; ks < 2; ++ks) q[ks] = *(const GAS bf16x8*)(QKV + ((size_t)NCTX + (size_t)b * SEQ + (size_t)r * 64 + qcol) * 3072 + h * 64 + ks * 32 + fq * 8);
}
__device__ __forceinline__ void na_stage(Frame& F, const Args& a, const int u_lo, const int nstage, const int stage, v4u (&kr)[3], v4u (&vr)[3], NaState& S) {
    const bf16* QKV = (const bf16*)(F.ws + WS_BIG); bf16* G = (bf16*)(F.ws + WS_G);
    constexpr int QS = 3072;
    LAS unsigned char* KC = F.lds; LAS unsigned char* VC = F.lds + 32768; LAS unsigned char* KL = F.lds + 65536; LAS unsigned char* VL = F.lds + 65536 + 24576;
    LAS float* RPB = (LAS float*)(F.lds + 65536 + 49152);
    const int fr = F.lane & 15, fq = F.lane >> 4;
    const int qr = F.wave >> 2, jb = F.wave & 3;
    const int bstart = jb == 0 ? 0 : (jb == 1 ? 8 : (jb == 2 ? 24 : 32));
    const int qcol = 16 * jb + fr; const int cstart = qcol < 8 ? 0 : (qcol > 56 ? 48 : qcol - 8);
    const int u = u_lo + stage / 3, pass = stage % 3;
    const int bh = u >> 6, rp = u & 63, b = bh >> 4, h = bh & 15;
    const int r = 2 * rp + qr, r0q = na_r0(r), rbase = na_r0(2 * rp) + 3 * pass;
    const size_t lat0 = (size_t)NCTX + (size_t)b * SEQ;
    LBAR();
    if (bh != S.cur_bh) {
        S.cur_bh = bh;
        for (int i = F.tid; i < 465; i += NTHREADS) RPB[i] = a.in[I_CRPB][h * 465 + i];
#pragma unroll
        for (int i = 0; i < 4; ++i) { const int id = F.tid + 512 * i, key = id >> 3, c = id & 7;
            const bf16* p = QKV + (size_t)(b * CTXL + key) * QS + 1024 + h * 64 + 8 * c;
            *(LAS v4u*)(KC + na_koff(key, c)) = *(const GAS v4u*)p; *(LAS v4u*)(VC + na_voff(key, c)) = *(const GAS v4u*)(p + 1024); }
    }
#pragma unroll
    for (int i = 0; i < 3; ++i) { const int id = F.tid + 512 * i, key = id >> 3, c = id & 7;
        *(LAS v4u*)(KL + na_koff(key, c)) = kr[i]; *(LAS v4u*)(VL + na_voff(key, c)) = vr[i]; }
    if (pass == 0) {
        S.qf[0] = S.qn[0]; S.qf[1] = S.qn[1];
#pragma unroll
        for (int dt = 0; dt < 4; ++dt) S.o[dt] = (f32x4){0.f, 0.f, 0.f, 0.f};
        S.m_run = -3.0e38f; S.l_run = 0.f;
        if (stage + 3 < nstage) na_loadq(F, u + 1, fq, S.qn);
    }
    if (stage + 1 < nstage) na_load(F, u_lo, stage + 1, kr, vr);
    LBAR();
    f32x4 s[12];
#pragma unroll
    for (int t = 0; t < 6; ++t) { const int kidx = (t >> 1) * 64 + bstart + 16 * (t & 1) + fr;
        const bf16x8 k0 = *(const LAS bf16x8*)(KL + na_koff(kidx, fq)), k1 = *(const LAS bf16x8*)(KL + na_koff(kidx, 4 + fq));
        f32x4 tt = (f32x4){0.f, 0.f, 0.f, 0.f}; tt = MFMA16(k0, S.qf[0], tt); tt = MFMA16(k1, S.qf[1], tt); s[t] = tt; }
#pragma unroll
    for (int t = 0; t < 6; ++t) { const int kidx = (16 * (6 * pass + t) + fr) & 255;
        const bf16x8 k0 = *(const LAS bf16x8*)(KC + na_koff(kidx, fq)), k1 = *(const LAS bf16x8*)(KC + na_koff(kidx, 4 + fq));
        f32x4 tt = (f32x4){0.f, 0.f, 0.f, 0.f}; tt = MFMA16(k0, S.qf[0], tt); tt = MFMA16(k1, S.qf[1], tt); s[6 + t] = tt; }
    float mx = S.m_run;
    {
        float bias[24];
#pragma unroll
        for (int q = 0; q < 24; ++q) { const int t = q >> 2, j = q & 3; const int krow = rbase + (t >> 1), kcol = bstart + 16 * (t & 1) + fq * 4 + j;
            int ci = kcol - qcol + 15; ci = ci < 0 ? 0 : (ci > 30 ? 30 : ci); int ri = krow - r + 7; ri = ri < 0 ? 0 : (ri > 14 ? 14 : ri); bias[q] = RPB[ri * 31 + ci]; }
        asm volatile("" : "+v"(bias[0]), "+v"(bias[1]), "+v"(bias[2]), "+v"(bias[3]), "+v"(bias[4]), "+v"(bias[5]), "+v"(bias[6]), "+v"(bias[7]),
                          "+v"(bias[8]), "+v"(bias[9]), "+v"(bias[10]), "+v"(bias[11]), "+v"(bias[12]), "+v"(bias[13]), "+v"(bias[14]), "+v"(bias[15]));
        asm volatile("" : "+v"(bias[16]), "+v"(bias[17]), "+v"(bias[18]), "+v"(bias[19]), "+v"(bias[20]), "+v"(bias[21]), "+v"(bias[22]), "+v"(bias[23]));
#pragma unroll
        for (int q = 0; q < 24; ++q) { const int t = q >> 2, j = q & 3; const int krow = rbase + (t >> 1), kcol = bstart + 16 * (t & 1) + fq * 4 + j;
            const bool ok = kcol >= cstart && kcol < cstart + 16 && krow >= r0q && krow <= r0q + 7;
            const float v = ok ? s[t][j] * 0.125f + bias[q] : -3.0e38f;
            s[t][j] = v; mx = fmaxf(mx, v); }
    }
#pragma unroll
    for (int t = 0; t < 6; ++t) { const bool ok = 6 * pass + t < 16;
#pragma unroll
        for (int j = 0; j < 4; ++j) { const float v = ok ? s[6 + t][j] * 0.125f : -3.0e38f; s[6 + t][j] = v; mx = fmaxf(mx, v); } }
    mx = fmaxf(mx, __shfl_xor(mx, 16)); mx = fmaxf(mx, __shfl_xor(mx, 32));
    const float alpha = __expf(S.m_run - mx); S.m_run = mx;
    float l = 0.f;
#pragma unroll
    for (int t = 0; t < 12; ++t)
#pragma unroll
        for (int j = 0; j < 4; ++j) { const float p = s[t][j] > -1.0e38f ? __expf(s[t][j] - mx) : 0.0f; s[t][j] = p; l += p; }
    S.l_run = S.l_run * alpha + l;
#pragma unroll
    for (int dt = 0; dt < 4; ++dt) S.o[dt] = S.o[dt] * alpha;
#pragma unroll
    for (int st = 0; st < 6; ++st) {
        v4u pw; pw.x = pk2(s[2 * st][0], s[2 * st][1]); pw.y = pk2(s[2 * st][2], s[2 * st][3]); pw.z = pk2(s[2 * st + 1][0], s[2 * st + 1][1]); pw.w = pk2(s[2 * st + 1][2], s[2 * st + 1][3]);
        const bf16x8 pf = __builtin_bit_cast(bf16x8, pw);
        const LAS unsigned char* VB = st < 3 ? VL : VC;
        const int kb = st < 3 ? st * 64 + bstart : (16 * (6 * pass + 2 * (st - 3))) & 255;
#pragma unroll
        for (int dt = 0; dt < 4; ++dt) S.o[dt] = MFMA16(na_vfrag(VB, kb, dt, F.lane), pf, S.o[dt]);
    }
    if (pass == 2) {
        float lt = S.l_run; lt += __shfl_xor(lt, 16); lt += __shfl_xor(lt, 32);
        const float inv = 1.0f / lt;
        bf16* op = G + (lat0 + (size_t)r * 64 + qcol) * D + h * 64 + fq * 4;
#pragma unroll
        for (int dt = 0; dt < 4; ++dt) { v2u w; w.x = pk2(S.o[dt][0] * inv, S.o[dt][1] * inv); w.y = pk2(S.o[dt][2] * inv, S.o[dt][3] * inv); *(GAS v2u*)(op + 16 * dt) = w; }
    }
}
__device__ __forceinline__ void p_natten(Frame& F, const Args& a) {
    const int u_lo = (int)(((long)F.vcu * 2048) / F.G), u_hi = (int)(((long)(F.vcu + 1) * 2048) / F.G);
    const int nstage = 3 * (u_hi - u_lo);
    if (nstage <= 0) return;
    const int fq = F.lane >> 4;
    v4u kA[3], vA[3];
    NaState S; S.cur_bh = -1; S.m_run = -3.0e38f; S.l_run = 0.f;
#pragma unroll
    for (int dt = 0; dt < 4; ++dt) S.o[dt] = (f32x4){0.f, 0.f, 0.f, 0.f};
    na_loadq(F, u_lo, fq, S.qn); S.qf[0] = S.qn[0]; S.qf[1] = S.qn[1];
    na_load(F, u_lo, 0, kA, vA);
    for (int stage = 0; stage < nstage; ++stage) na_stage(F, a, u_lo, nstage, stage, kA, vA, S);
}

template <int MODE>
__device__ __forceinline__ void sgemm_region(Frame& F, const bf16* A, const bf16* Bt, int R0, int nrb, int C0, int ncb, bf16* O, int ldo, float* X, const float* gate, int u_first, int u_stride) {
    constexpr int ST = 264;
    LAS bf16* As = (LAS bf16*)(F.lds); LAS bf16* Bs = As + 64 * ST;
    const int fr = F.lane & 15, fq = F.lane >> 4, mt = F.wave >> 1, nt0 = 2 * (F.wave & 1);
    for (int u = u_first; u < nrb * ncb; u += u_stride) {
        const int rb = u % nrb, cb = u / nrb; const int r0 = R0 + 64 * rb, c0 = C0 + 64 * cb;
        pg8::f32x4 acc[2] = {(pg8::f32x4){0.f, 0.f, 0.f, 0.f}, (pg8::f32x4){0.f, 0.f, 0.f, 0.f}};
        v4u ra[4], rbv[4];
#pragma unroll
        for (int i = 0; i < 4; ++i) { const int id = F.tid + 512 * i, row = id >> 5, c = id & 31;
            ra[i] = *(const GAS v4u*)(A + (size_t)(r0 + row) * 1024 + 8 * c); rbv[i] = *(const GAS v4u*)(Bt + (size_t)(c0 + row) * 1024 + 8 * c); }
        for (int kc = 0; kc < 4; ++kc) {
            __syncthreads();
#pragma unroll
            for (int i = 0; i < 4; ++i) { const int id = F.tid + 512 * i, row = id >> 5, c = id & 31;
                *(LAS v4u*)(As + row * ST + 8 * c) = ra[i]; *(LAS v4u*)(Bs + row * ST + 8 * c) = rbv[i]; }
            if (kc < 3) {
#pragma unroll
                for (int i = 0; i < 4; ++i) { const int id = F.tid + 512 * i, row = id >> 5, c = id & 31;
                    ra[i] = *(const GAS v4u*)(A + (size_t)(r0 + row) * 1024 + 256 * (kc + 1) + 8 * c); rbv[i] = *(const GAS v4u*)(Bt + (size_t)(c0 + row) * 1024 + 256 * (kc + 1) + 8 * c); } }
            __syncthreads();
#pragma unroll
            for (int ks = 0; ks < 8; ++ks) { const bf16x8 af = *(const LAS bf16x8*)(As + (16 * mt + fr) * ST + ks * 32 + fq * 8);
#pragma unroll
                for (int n = 0; n < 2; ++n) { const bf16x8 bfr = *(const LAS bf16x8*)(Bs + (16 * (nt0 + n) + fr) * ST + ks * 32 + fq * 8); acc[n] = MFMA16(bfr, af, acc[n]); } }
        }
        const size_t row = (size_t)(r0 + 16 * mt + fr);
#pragma unroll
        for (int n = 0; n < 2; ++n) { const int col = c0 + 16 * (nt0 + n) + 4 * fq;
            if (MODE == 2) { f32x4* p = (f32x4*)(X + row * 1024 + col); const f32x4 g = *(const f32x4*)(gate + col); *p = *p + g * acc[n]; }
            else { f32x4 v = acc[n];
                if (MODE == 1) { const pg8::f32x2 a2 = pg8::gelu_pk((pg8::f32x2){v[0], v[1]}), b2 = pg8::gelu_pk((pg8::f32x2){v[2], v[3]}); v = (f32x4){a2.x, a2.y, b2.x, b2.y}; }
                v2u o; o.x = pk2(v[0], v[1]); o.y = pk2(v[2], v[3]); *(GAS v2u*)(O + row * ldo + col) = o; } }
    }
    __syncthreads();
}

__device__ __forceinline__ void ph_moe_gu(Frame& F, const Args& args, const int layer) {
    moe_tables(F, layer);
    const LAS int* Mt = (const LAS int*)(F.lds + MISC_OFF); const int total = Mt[32];
    pg8::Gemm g{(const bf16*)(F.ws + WS_H), (const bf16*)(F.ws + WS_WGU) + (size_t)layer * 32 * 2048 * 1024, total, 2048, D};
    pg8::GroupedOrder S; S.init(total, 2048, F.G, (int)blockIdx.x); S.tile_e = Mt + 64;
    pg8::EpiSwiglu E{(bf16*)(F.ws + WS_ACT), D, args.in[I_MBGU] + (size_t)layer * 32 * 2048, 2048};
    pg8::gemm_phase<pg8::EpiSwiglu, pg8::GroupedOrder, true>(F.lds + RING_OFF, g, S, E, (const unsigned*)(F.ws + WS_LIST), Mt, NTOK);
}
__device__ __forceinline__ void ph_moe_dn(Frame& F, const Args& args, const int layer) {
    moe_tables(F, layer);
    const LAS int* Mt = (const LAS int*)(F.lds + MISC_OFF); const int total = Mt[32];
    pg8::Gemm g{(const bf16*)(F.ws + WS_ACT), (const bf16*)(F.ws + WS_WDN) + (size_t)layer * 32 * 1024 * 1024, total, D, D};
    pg8::GroupedOrder S; S.init(total, D, F.G, (int)blockIdx.x); S.tile_e = Mt + 64;
    pg8::EpiBf16<0> E{(bf16*)(F.ws + WS_YB), D, args.in[I_MBDN] + (size_t)layer * 32 * 1024, 1024};
    pg8::gemm_phase<pg8::EpiBf16<0>, pg8::GroupedOrder>(F.lds + RING_OFF, g, S, E);
}
template <int LAYER> __device__ __forceinline__ void ph_ingemm(Frame& F) {
    constexpr int layer = LAYER, kind = layer % 3;
    const bf16* H = (const bf16*)(F.ws + WS_H);
    const bf16* A = H + (size_t)2 * 256 * D; constexpr int M = 64 * 256;
    if constexpr (kind == 0) {
        const bf16* Bt = (const bf16*)(F.ws + WS_WAIN) + (size_t)(layer / 3) * 2048 * 1024;
        pg8::Gemm g{A, Bt, M, 2048, D}; pg8::StaticOrder S; S.init(M, 2048, F.G, (int)blockIdx.x);
        pg8::EpiBf16<1> E{(bf16*)(F.ws + WS_BIG) + (size_t)2 * 256 * 2048, 2048, nullptr, 0};
        pg8::gemm_phase<pg8::EpiBf16<1>, pg8::StaticOrder>(F.lds + RING_OFF, g, S, E);
        if constexpr (layer < 3) sgemm_region<1>(F, H, Bt, 0, 8, 0, 32, (bf16*)(F.ws + WS_BIG), 2048, nullptr, nullptr, F.vcu, F.G);
    } else if constexpr (kind == 1) {
        const bf16* Bt = (const bf16*)(F.ws + WS_WBIN);
        pg8::Gemm g{A, Bt, M, 3072, D}; pg8::StaticOrder S; S.init(M, 3072, F.G, (int)blockIdx.x);
        pg8::EpiBf16<0> E{(bf16*)(F.ws + WS_BIG) + (size_t)2 * 256 * GLA_INP, GLA_INP, nullptr, 0};
        pg8::gemm_phase<pg8::EpiBf16<0>, pg8::StaticOrder>(F.lds + RING_OFF, g, S, E);
        sgemm_region<0>(F, H, Bt, 0, 8, 0, 48, (bf16*)(F.ws + WS_BIG), GLA_INP, nullptr, nullptr, F.vcu, F.G);
        sgemm_region<0>(F, H, Bt, 0, 264, 3072, 1, (bf16*)(F.ws + WS_BIG), GLA_INP, nullptr, nullptr, (F.vcu + 128) % F.G, F.G);
    } else {
        const bf16* Bt = (const bf16*)(F.ws + WS_WCQKV);
        pg8::Gemm g{A, Bt, M, 3072, D}; pg8::StaticOrder S; S.init(M, 3072, F.G, (int)blockIdx.x);
        pg8::EpiBf16<0> E{(bf16*)(F.ws + WS_BIG) + (size_t)2 * 256 * 3072, 3072, nullptr, 0};
        pg8::gemm_phase<pg8::EpiBf16<0>, pg8::StaticOrder>(F.lds + RING_OFF, g, S, E);
        sgemm_region<0>(F, H, Bt, 0, 8, 1024, 32, (bf16*)(F.ws + WS_BIG), 3072, nullptr, nullptr, F.vcu, F.G);
    }
}

#define IN(k) (lo <= (k) && (k) < hi)
#define SEAM(k) do { if (IN(k) && IN((k) + 1)) { xcd_barrier(bar); if (PROBE_BAR) xcd_barrier(bar); } else __syncthreads(); } while (0)
template <int LAYER> __device__ __forceinline__ void run_layer(Frame& F, const Args& args, const XcdBarrier& bar, const int lo, const int hi) {
    {
        constexpr int layer = LAYER; constexpr int kind = layer % 3, base = 1 + 10 * layer;
        constexpr int mt0 = (layer >= 3) ? 2 : 0;
        constexpr int mo0 = (layer >= 2) ? 2 : 0;
        if (IN(base + 0)) { p_prenorm(F, args, layer, false);
#if PROBE_TOK
            __syncthreads(); p_prenorm(F, args, layer, false, true);
#endif
        } SEAM(base + 0);
        if (IN(base + 1)) { ph_ingemm<LAYER>(F);
#if PROBE_ING
            __syncthreads(); ph_ingemm<LAYER>(F);
#endif
        }
        SEAM(base + 1);
        if (IN(base + 2)) for (int rep = 0; rep < 1 + (kind == 1 ? PROBE_GLA : (kind == 0 ? PROBE_MIX : PROBE_NAT)); ++rep) { if (rep) __syncthreads(); if constexpr (kind == 0) p_spatial(F, args, layer); else if constexpr (kind == 1) p_gla_ds(F, args); else p_natten(F, args); } SEAM(base + 2);
        if constexpr (kind == 1) { if (IN(base + 3)) for (int rep = 0; rep < 1 + PROBE_GLA; ++rep) { p_gla_scan(F); } SEAM(base + 3); }
        if constexpr (kind == 1) { if (IN(base + 4)) for (int rep = 0; rep < 1 + PROBE_GLA; ++rep) { if (rep) __syncthreads(); p_gla_out(F, args); } SEAM(base + 4); }
        if (IN(base + 5)) {
            constexpr int M = 64 * 256;
            const bf16* Bt = (const bf16*)(F.ws + (kind == 0 ? WS_WAOUT : (kind == 1 ? WS_WBOUT : WS_WCOUT))) + (kind == 0 ? (size_t)(layer / 3) * 1024 * 1024 : 0);
            const float* gate = (const float*)(F.ws + WS_ADA) + (size_t)(layer * 3 * 6 + 2) * D;
            pg8::Gemm g{(const bf16*)(F.ws + WS_G) + (size_t)2 * 256 * D, Bt, M, D, D}; pg8::StaticOrder S; S.init(M, D, F.G, (int)blockIdx.x);
            pg8::EpiResid E{(float*)(F.ws + WS_X) + (size_t)2 * 256 * D, gate, 6 * D, 2, false};
            pg8::gemm_phase<pg8::EpiResid, pg8::StaticOrder>(F.lds + RING_OFF, g, S, E);
#if PROBE_OUTG
            { __syncthreads(); pg8::EpiResid E2{(float*)(F.ws + WS_X) + (size_t)2 * 256 * D, gate, 6 * D, 2, true}; pg8::gemm_phase<pg8::EpiResid, pg8::StaticOrder>(F.lds + RING_OFF, g, S, E2); }
#endif
            if constexpr (layer < 2) sgemm_region<2>(F, (const bf16*)(F.ws + WS_G), Bt, 0, 8, 0, 16, nullptr, 0, (float*)(F.ws + WS_X), gate, F.vcu, F.G);
        }
        SEAM(base + 5);
        if (IN(base + 6)) { p_router(F, args, layer);
#if PROBE_TOK
            __syncthreads(); p_router(F, args, layer, true);
#endif
        } SEAM(base + 6);
        if (IN(base + 8)) { ph_moe_gu(F, args, layer);
#if PROBE_MOE
            __syncthreads(); ph_moe_gu(F, args, layer);
#endif
        }
        SEAM(base + 8);
        if (IN(base + 9)) { ph_moe_dn(F, args, layer);
#if PROBE_MOE
            __syncthreads(); ph_moe_dn(F, args, layer);
#endif
        }
        SEAM(base + 9);
    }
}

__global__ void __launch_bounds__(NTHREADS, 2) fwd(Args args) {
    extern __shared__ __attribute__((aligned(16))) unsigned char lds[];
    Frame F;
    F.lds = (LAS unsigned char*)lds;
    F.tid = threadIdx.x; F.lane = F.tid & 63; F.wave = __builtin_amdgcn_readfirstlane(F.tid >> 6);
    F.G = gridDim.x; { const int bx = blockIdx.x; F.vcu = (F.G % 8 == 0) ? (bx % 8) * (F.G / 8) + bx / 8 : bx; }
    F.ws = args.ws; F.ctl = (unsigned*)(args.ws + WS_CTL);
    volatile LAS unsigned* BST = (volatile LAS unsigned*)(F.lds + LDS_BYTES - 16);
    if (F.tid < 4) BST[F.tid] = 0u;
    __syncthreads();
    const int lo = args.ph_lo, hi = args.ph_hi;
    XcdBarrier bar; bar.bar = (unsigned*)(F.ctl + CW_BAR); bar.x = 0; bar.st = BST;
    if (hi - lo > 1) bar = xcd_barrier_post((unsigned*)(F.ctl + CW_BAR), BST);
    if (IN(0)) { p_prologue(F, args);
#if PROBE_PRO
        __syncthreads(); p_prologue(F, args);
#endif
    } SEAM(0);

    run_layer<0>(F, args, bar, lo, hi);
    run_layer<1>(F, args, bar, lo, hi);
    run_layer<2>(F, args, bar, lo, hi);
    run_layer<3>(F, args, bar, lo, hi);
    if (IN(41)) { p_prenorm(F, args, 4, true); }
#undef IN
#undef SEAM
}

extern "C" void kernel_launch(void* const* d_in, const int* in_sizes, int n_in, void* d_out, int out_size, void* d_ws, size_t ws_size, hipStream_t stream) {
    static int grid = 0;
    if (grid == 0) {
        if (n_in != 28 || out_size != NLAT * D || ws_size < WS_END) { fprintf(stderr, "kernel_launch: unexpected problem (n_in %d, out %d, ws %zu < %zu)\n", n_in, out_size, ws_size, (size_t)WS_END); grid = -1; return; }
        int dev = 0, cus = 0, per_cu = 0;
        if (hipGetDevice(&dev) != hipSuccess || hipDeviceGetAttribute(&cus, hipDeviceAttributeMultiprocessorCount, dev) != hipSuccess) { grid = -1; return; }
        if (hipFuncSetAttribute((const void*)fwd, hipFuncAttributeMaxDynamicSharedMemorySize, LDS_BYTES) != hipSuccess) { fprintf(stderr, "kernel_launch: hipFuncSetAttribute failed\n"); grid = -1; return; }
        if (hipOccupancyMaxActiveBlocksPerMultiprocessor(&per_cu, (const void*)fwd, NTHREADS, LDS_BYTES) != hipSuccess || per_cu < 1) { fprintf(stderr, "kernel_launch: occupancy query reports %d\n", per_cu); }
        (void)hipGetLastError();
        grid = cus;
    }
    if (grid < 0) return;
    (void)hipMemsetAsync((char*)d_ws + WS_CTL, 0, CTL_ZERO_BYTES, stream);
    Args a{};
    for (int i = 0; i < 28; ++i) a.in[i] = (const float*)d_in[i];
    a.out = (float*)d_out; a.ws = (unsigned char*)d_ws;
#if MK_ONE_LAUNCH
    a.ph_lo = 0; a.ph_hi = 42;
    hipLaunchKernelGGL(fwd, dim3(grid), dim3(NTHREADS), LDS_BYTES, stream, a);
#else
    for (int p = 0; p < 42; ++p) {
        if (p >= 1 && p <= 40) { const int layer = (p - 1) / 10, loc = (p - 1) % 10; if (((loc == 3 || loc == 4) && (layer % 3) != 1) || loc == 7) continue; }
        a.ph_lo = p; a.ph_hi = p + 1;
        hipLaunchKernelGGL(fwd, dim3(grid), dim3(NTHREADS), LDS_BYTES, stream, a);
    }
#endif
}
```

```cpp
#include <hip/hip_runtime.h>
#include <cstdio>
#include <cstdint>

#ifndef MK_ONE_LAUNCH
#define MK_ONE_LAUNCH 1
#endif
#ifndef PROBE_PRO
#define PROBE_PRO 0
#endif
#ifndef PROBE_MOE
#define PROBE_MOE 0
#endif
#ifndef PROBE_ING
#define PROBE_ING 0
#endif
#ifndef PROBE_MIX
#define PROBE_MIX 0
#endif
#ifndef PROBE_GLA
#define PROBE_GLA 0
#endif
#ifndef PROBE_TOK
#define PROBE_TOK 0
#endif
#ifndef PROBE_BAR
#define PROBE_BAR 0
#endif
#ifndef PROBE_OUTG
#define PROBE_OUTG 0
#endif
#ifndef PROBE_NAT
#define PROBE_NAT 0
#endif
#ifndef PROBE_GATHER
#define PROBE_GATHER 0
#endif

namespace pg8 {
#define PG8_LAS __attribute__((address_space(3)))
typedef unsigned short bf16_t;
typedef short bf16x8 __attribute__((ext_vector_type(8)));
typedef float f32x4 __attribute__((ext_vector_type(4)));
typedef unsigned u32x4 __attribute__((ext_vector_type(4)));
constexpr int BM = 256, BK = 64, HALF = 128, HTB = HALF * BK * 2, STAGE_BYTES = 8 * HTB, NXCD = 8, WGM = 8;

__host__ __device__ __forceinline__ int lds_byte(int r, int c) { const int st = (r >> 4) * 2 + (c >> 5), rr = r & 15, cc = c & 31, ob = rr * 64 + cc * 2; return st * 1024 + (ob ^ (((ob >> 9) & 1) << 5)); }
__host__ __device__ __forceinline__ void stage_rc(int b, int& R, int& C) { const int st = b / 1024, sb = b % 1024, swz = sb ^ (((sb >> 9) & 1) << 5); R = (st >> 1) * 16 + swz / 64; C = (st & 1) * 32 + (swz % 64) / 2; }
__host__ __device__ __forceinline__ int perm32(int rho) { const int n = rho >> 4, i = rho & 15; return 8 * (i >> 2) + 4 * n + (i & 3); }

struct Unit { int pm, pn, pb, e; };
struct Gemm { const bf16_t* A; const bf16_t* Bt; int M, N, K; };

struct StaticOrder {
    int nM, nN, nwg, G, c;
    __device__ void init(int M, int N, int G_, int c_) { nM = M / BM; nN = N / BM; nwg = nM * nN; G = G_; c = c_; }
    __device__ bool next(int i, Unit& u) const {
        const long L = (long)i * G + c; if (L >= nwg) return false;
        int wgid = (int)L; { const int q = nwg / NXCD, r = nwg % NXCD, xcd = wgid % NXCD, off = wgid / NXCD; wgid = (xcd < r ? xcd * (q + 1) : r * (q + 1) + (xcd - r) * q) + off; }
        const int nig = WGM * nN, gid = wgid / nig, fm = gid * WGM, gsz = (nM - fm) < WGM ? (nM - fm) : WGM;
        u.pm = fm + ((wgid % nig) % gsz); u.pn = (wgid % nig) / gsz; u.pb = u.pn; u.e = 0; return true;
    }
};
struct GroupedOrder : StaticOrder {
    const PG8_LAS int* tile_e;
    __device__ bool next(int i, Unit& u) const {
        if (!StaticOrder::next(i, u)) return false;
        u.e = __builtin_amdgcn_readfirstlane(tile_e[u.pm]); u.pb = u.e * nN + u.pn; return true;
    }
};

__device__ __forceinline__ unsigned cvt_pk_bf16(float lo, float hi) { unsigned r; asm volatile("v_cvt_pk_bf16_f32 %0, %1, %2" : "=v"(r) : "v"(lo), "v"(hi)); return r; }
typedef float f32x2 __attribute__((ext_vector_type(2)));
__device__ __forceinline__ f32x2 gelu_pk(f32x2 v) {
    const f32x2 av = __builtin_elementwise_abs(v), d = av * 0.2316418882f + 1.0f;
    f32x2 t; t.x = __builtin_amdgcn_rcpf(d.x); t.y = __builtin_amdgcn_rcpf(d.y);
    f32x2 q = t * 0.5307027145f + (-0.7265760135f); q = q * t + 0.7107068705f; q = q * t + (-0.142248368f); q = q * t + 0.127414796f; q = q * t;
    const f32x2 s = (v * v) * (-0.72134752044f);
    f32x2 e; e.x = __builtin_amdgcn_exp2f(s.x); e.y = __builtin_amdgcn_exp2f(s.y);
    const f32x2 m = v * (q * e), r = v - m;
    f32x2 o; o.x = v.x < 0.f ? m.x : r.x; o.y = v.y < 0.f ? m.y : r.y; return o;
}

template <int ACT> struct EpiBf16 {
    static constexpr bool PERM = true;
    bf16_t* O; int ldc; const float* bias; int bias_estride;
    __device__ __forceinline__ void operator()(const f32x4 (&acc)[2][2][4][2], const Unit& u, int wr, int wc, int fr, int fq) const {
        const int row0 = u.pm * BM + wr * 64 + fr; const int col0 = u.pn * BM + wc * 32 + 8 * fq;
        const float* bp = bias ? bias + (size_t)u.e * bias_estride : nullptr;
        f32x4 bv[2][2];
#pragma unroll
        for (int bj = 0; bj < 2; ++bj)
#pragma unroll
            for (int n = 0; n < 2; ++n) bv[bj][n] = bp ? *(const f32x4*)(bp + col0 + bj * HALF + 4 * n) : (f32x4){0.f, 0.f, 0.f, 0.f};
#pragma unroll
        for (int ai = 0; ai < 2; ++ai)
#pragma unroll
            for (int m = 0; m < 4; ++m) { bf16_t* rowp = O + (size_t)(row0 + ai * HALF + m * 16) * ldc + col0;
#pragma unroll
                for (int bj = 0; bj < 2; ++bj) { f32x4 v0 = acc[ai][bj][m][0] + bv[bj][0], v1 = acc[ai][bj][m][1] + bv[bj][1];
                    if (ACT == 1) { f32x2 a = gelu_pk((f32x2){v0[0], v0[1]}), b = gelu_pk((f32x2){v0[2], v0[3]}), c = gelu_pk((f32x2){v1[0], v1[1]}), d = gelu_pk((f32x2){v1[2], v1[3]});
                        v0 = (f32x4){a.x, a.y, b.x, b.y}; v1 = (f32x4){c.x, c.y, d.x, d.y}; }
                    u32x4 w; w.x = cvt_pk_bf16(v0[0], v0[1]); w.y = cvt_pk_bf16(v0[2], v0[3]); w.z = cvt_pk_bf16(v1[0], v1[1]); w.w = cvt_pk_bf16(v1[2], v1[3]);
                    *(u32x4*)(rowp + bj * HALF) = w; } }
    }
};
struct EpiSwiglu {
    static constexpr bool PERM = true;
    bf16_t* O; int ldc; const float* bias; int bias_estride;
    __device__ __forceinline__ void operator()(const f32x4 (&acc)[2][2][4][2], const Unit& u, int wr, int wc, int fr, int fq) const {
        const int row0 = u.pm * BM + wr * 64 + fr; const int col0 = u.pn * HALF + wc * 32 + 8 * fq;
        const float* bp = bias + (size_t)u.e * bias_estride;
        f32x4 bg[2], bl[2];
#pragma unroll
        for (int n = 0; n < 2; ++n) { bg[n] = *(const f32x4*)(bp + col0 + 4 * n); bl[n] = *(const f32x4*)(bp + 1024 + col0 + 4 * n); }
#pragma unroll
        for (int ai = 0; ai < 2; ++ai)
#pragma unroll
            for (int m = 0; m < 4; ++m) { bf16_t* rowp = O + (size_t)(row0 + ai * HALF + m * 16) * ldc + col0;
                float o[8];
#pragma unroll
                for (int n = 0; n < 2; ++n) { const f32x4 g4 = acc[ai][0][m][n] + bg[n], l4 = acc[ai][1][m][n] + bl[n];
#pragma unroll
                    for (int i = 0; i < 4; ++i) { const float g = fminf(g4[i], 7.0f), l = fminf(fmaxf(l4[i], -7.0f), 7.0f);
                        const float sg = __builtin_amdgcn_rcpf(1.0f + __builtin_amdgcn_exp2f(-1.702f * 1.44269504089f * g));
                        o[4 * n + i] = g * sg * (l + 1.0f); } }
                u32x4 w; w.x = cvt_pk_bf16(o[0], o[1]); w.y = cvt_pk_bf16(o[2], o[3]); w.z = cvt_pk_bf16(o[4], o[5]); w.w = cvt_pk_bf16(o[6], o[7]);
                *(u32x4*)rowp = w; }
    }
};
struct EpiResid {
    static constexpr bool PERM = false;
    float* X; const float* gate; int gstride; int pm0; bool dry;
    __device__ __forceinline__ void operator()(const f32x4 (&acc)[2][2][4][2], const Unit& u, int wr, int wc, int fr, int fq) const {
        const int t = u.pm + pm0; const int seg = t < 2 ? 0 : (t < 34 ? 1 : 2);
        const int row0 = u.pm * BM + wr * 64 + fr, col0 = u.pn * BM + wc * 32 + 4 * fq;
        const float* gp = gate + (size_t)seg * gstride;
        f32x4 gv[2][2];
#pragma unroll
        for (int bj = 0; bj < 2; ++bj)
#pragma unroll
            for (int n = 0; n < 2; ++n) gv[bj][n] = *(const f32x4*)(gp + col0 + bj * HALF + n * 16);
#pragma unroll
        for (int ai = 0; ai < 2; ++ai)
#pragma unroll
            for (int m = 0; m < 4; ++m) { float* rowp = X + (size_t)(row0 + ai * HALF + m * 16) * 1024 + col0;
#pragma unroll
                for (int bj = 0; bj < 2; ++bj)
#pragma unroll
                    for (int n = 0; n < 2; ++n) { f32x4* p = (f32x4*)(rowp + bj * HALF + n * 16); const f32x4 nv = *p + gv[bj][n] * acc[ai][bj][m][n]; if (!dry) *p = nv; else if (nv[0] == 1.2345e30f) *p = nv; } }
    }
};

template <class Epi, class Sched, bool GATHER = false>
__device__ __forceinline__ void gemm_phase(PG8_LAS unsigned char* lds, const Gemm g, const Sched& S, const Epi& E, const unsigned* glist = nullptr, const PG8_LAS int* gM = nullptr, int gstride = 0) {
    const int tid = threadIdx.x, wid = __builtin_amdgcn_readfirstlane(tid >> 6), lane = tid & 63, wr = wid >> 2, wc = wid & 3, fr = lane & 15, fq = lane >> 4;
    const int K = g.K, nt = K / BK;
    unsigned voffB[2], va[2][2], vn[2][2]; int aR[2], aC[2];
#pragma unroll
    for (int i = 0; i < 2; ++i) { int R, C; stage_rc(tid * 16 + i * 8192, R, C); const int Rb = Epi::PERM ? ((R & ~31) + perm32(R & 31)) : R;
        aR[i] = R; aC[i] = C; voffB[i] = (unsigned)(Rb * K + C) * 2u;
#pragma unroll
        for (int h = 0; h < 2; ++h) { va[h][i] = (unsigned)((HALF * h + R) * K + C) * 2u; vn[h][i] = va[h][i]; } }
#define PG8_GOFF(u, dst) do { if constexpr (GATHER) { const int _e = (u).e, _p0 = (u).pm * BM - gM[_e], _c1 = gM[400 + _e] - 1; _Pragma("unroll") for (int _h = 0; _h < 2; ++_h) _Pragma("unroll") for (int _i = 0; _i < 2; ++_i) { \
        int _rk = _p0 + HALF * _h + aR[_i]; _rk = _rk < _c1 ? _rk : _c1; const unsigned _tok = glist[(size_t)_e * gstride + _rk]; dst[_h][_i] = (_tok * (unsigned)K + (unsigned)aC[_i]) * 2u; } } } while (0)
#define PG8_GTOK(u, dst) do { const int _e = (u).e, _p0 = (u).pm * BM - gM[_e], _c1 = gM[400 + _e] - 1; _Pragma("unroll") for (int _h = 0; _h < 2; ++_h) _Pragma("unroll") for (int _i = 0; _i < 2; ++_i) { \
        int _rk = _p0 + HALF * _h + aR[_i]; _rk = _rk < _c1 ? _rk : _c1; dst[_h][_i] = glist[(size_t)_e * gstride + _rk]; } } while (0)
    const size_t kstep = (size_t)(BK * 2);
    const size_t hstep = (size_t)HALF * K * 2;
    const size_t tstep = 2 * hstep;
    const unsigned ldsw = (unsigned)wid * 1024u;
    const int aoff = lds_byte(wr * 64 + fr, fq * 8), boff = lds_byte(wc * 32 + fr, fq * 8);
#define PG8_SA(b, h) (((b) * 2 + (h)) * HTB)
#define PG8_SB(b, h) ((4 + (b) * 2 + (h)) * HTB)
#define PG8_STAGE(bufoff, gbase, voff) do { _Pragma("unroll") for (int _i = 0; _i < 2; ++_i) \
        __builtin_amdgcn_global_load_lds((const unsigned*)((const char*)(gbase) + (voff)[_i]), (PG8_LAS unsigned*)(lds + (bufoff) + ldsw + _i * 8192), 16, 0, 0); } while (0)
#define PG8_LDA(dst, b, h) do { _Pragma("unroll") for (int m = 0; m < 4; ++m) _Pragma("unroll") for (int k = 0; k < 2; ++k) dst[m][k] = *(const PG8_LAS bf16x8*)(lds + PG8_SA(b, h) + aoff + m * 2048 + k * 1024); } while (0)
#define PG8_LDB(dst, b, h) do { _Pragma("unroll") for (int n = 0; n < 2; ++n) _Pragma("unroll") for (int k = 0; k < 2; ++k) dst[n][k] = *(const PG8_LAS bf16x8*)(lds + PG8_SB(b, h) + boff + n * 2048 + k * 1024); } while (0)
#define PG8_MMA(ai, bj, At, Bt) do { __builtin_amdgcn_s_setprio(1); _Pragma("unroll") for (int m = 0; m < 4; ++m) _Pragma("unroll") for (int n = 0; n < 2; ++n) _Pragma("unroll") for (int k = 0; k < 2; ++k) \
        acc[ai][bj][m][n] = __builtin_amdgcn_mfma_f32_16x16x32_bf16(Bt[n][k], At[m][k], acc[ai][bj][m][n], 0, 0, 0); __builtin_amdgcn_s_setprio(0); } while (0)
#define PG8_WAIT_V(n) asm volatile("s_waitcnt vmcnt(" #n ")" ::: "memory")
#define PG8_WAIT_L(n) asm volatile("s_waitcnt lgkmcnt(" #n ")" ::: "memory")
#define PG8_BAR __builtin_amdgcn_s_barrier()
#define PG8_SCHED __builtin_amdgcn_sched_barrier(0)
    Unit cur, nxt, nx2; int ui = 0; bool has_next = false, has_nx2 = false;
    if (!S.next(0, cur)) return;
    f32x4 acc[2][2][4][2];
#pragma unroll
    for (int a = 0; a < 2; ++a)
#pragma unroll
        for (int b = 0; b < 2; ++b)
#pragma unroll
            for (int m = 0; m < 4; ++m)
#pragma unroll
                for (int n = 0; n < 2; ++n) acc[a][b][m][n] = (f32x4){0.f, 0.f, 0.f, 0.f};
    bf16x8 At[4][2], B0[2][2], B1[2][2];
    const char* cA = (const char*)g.A + (GATHER ? (size_t)0 : (size_t)cur.pm * tstep); const char* cB = (const char*)g.Bt + (size_t)cur.pb * tstep;
    PG8_GOFF(cur, va);
    if constexpr (GATHER) { has_next = S.next(1, nxt); if (has_next) PG8_GOFF(nxt, vn); }
    PG8_STAGE(PG8_SB(0, 0), cB, voffB); PG8_STAGE(PG8_SB(0, 1), cB + hstep, voffB); PG8_STAGE(PG8_SA(0, 0), cA, va[0]); PG8_STAGE(PG8_SA(0, 1), cA, va[1]);
    if (wr == 1) PG8_BAR;
    PG8_WAIT_V(2); PG8_BAR;
    PG8_STAGE(PG8_SB(1, 0), cB + kstep, voffB); PG8_STAGE(PG8_SA(1, 0), cA + kstep, va[0]); PG8_STAGE(PG8_SB(1, 1), cB + hstep + kstep, voffB);
    PG8_WAIT_V(6); PG8_BAR;
    for (;;) {
        if constexpr (!GATHER) has_next = S.next(ui + 1, nxt);
        const char* nA = (has_next && !GATHER) ? (const char*)g.A + (size_t)nxt.pm * tstep : cA; const char* nB = has_next ? (const char*)g.Bt + (size_t)nxt.pb * tstep : cB;
        for (int t = 0; t < nt; t += 2) {
            const bool last = (t == nt - 2);
            const char* a1 = cA + (size_t)(t + 1) * kstep;
            const char* a2 = last ? nA : cA + (size_t)(t + 2) * kstep; const char* b2 = last ? nB : cB + (size_t)(t + 2) * kstep;
            const char* a3 = a2 + kstep; const char* b3 = b2 + kstep;
            unsigned v2[2][2];
#pragma unroll
            for (int _h = 0; _h < 2; ++_h)
#pragma unroll
                for (int _i = 0; _i < 2; ++_i) v2[_h][_i] = (GATHER && last) ? vn[_h][_i] : va[_h][_i];
            PG8_LDB(B0, 0, 0); PG8_LDB(B1, 0, 1); PG8_SCHED; PG8_LDA(At, 0, 0); PG8_STAGE(PG8_SA(1, 1), a1, va[1]);
            PG8_WAIT_V(8); PG8_WAIT_L(0); PG8_BAR; PG8_MMA(0, 0, At, B0); PG8_MMA(0, 1, At, B1); PG8_BAR; PG8_SCHED;
            PG8_LDA(At, 0, 1); PG8_STAGE(PG8_SB(0, 0), b2, voffB); PG8_STAGE(PG8_SB(0, 1), b2 + hstep, voffB); PG8_STAGE(PG8_SA(0, 0), a2, v2[0]);
            PG8_WAIT_V(8); PG8_WAIT_L(0); PG8_BAR; PG8_MMA(1, 0, At, B0); PG8_MMA(1, 1, At, B1); PG8_BAR; PG8_SCHED;
            PG8_LDB(B0, 1, 0); PG8_LDB(B1, 1, 1); PG8_SCHED; PG8_LDA(At, 1, 0); PG8_STAGE(PG8_SA(0, 1), a2, v2[1]);
            PG8_WAIT_V(8); PG8_WAIT_L(0); PG8_BAR; PG8_MMA(0, 0, At, B0); PG8_MMA(0, 1, At, B1); PG8_BAR; PG8_SCHED;
            PG8_LDA(At, 1, 1); PG8_STAGE(PG8_SB(1, 0), b3, voffB); PG8_STAGE(PG8_SB(1, 1), b3 + hstep, voffB); PG8_STAGE(PG8_SA(1, 0), a3, v2[0]);
            PG8_WAIT_V(8); PG8_WAIT_L(0); PG8_BAR; PG8_MMA(1, 0, At, B0); PG8_MMA(1, 1, At, B1); PG8_BAR; PG8_SCHED;
        }
        if (wr == 0) PG8_BAR;
        unsigned tk[2][2] = {{0u, 0u}, {0u, 0u}};
        if constexpr (GATHER) { has_nx2 = has_next && S.next(ui + 2, nx2); if (!has_nx2) nx2 = cur; PG8_GTOK(nx2, tk); }
        E(acc, cur, wr, wc, fr, fq);
        if (!has_next) break;
#pragma unroll
        for (int a = 0; a < 2; ++a)
#pragma unroll
            for (int b = 0; b < 2; ++b)
#pragma unroll
                for (int m = 0; m < 4; ++m)
#pragma unroll
                    for (int n = 0; n < 2; ++n) acc[a][b][m][n] = (f32x4){0.f, 0.f, 0.f, 0.f};
        cur = nxt; cA = nA; cB = nB; ++ui;
        if constexpr (GATHER) { va[0][0] = vn[0][0]; va[0][1] = vn[0][1]; va[1][0] = vn[1][0]; va[1][1] = vn[1][1];
            if (has_nx2) { nxt = nx2;
#pragma unroll
                for (int _h = 0; _h < 2; ++_h)
#pragma unroll
                    for (int _i = 0; _i < 2; ++_i) vn[_h][_i] = (tk[_h][_i] * (unsigned)K + (unsigned)aC[_i]) * 2u; }
            has_next = has_nx2; }
        if (wr == 1) PG8_BAR;
    }
    PG8_WAIT_V(0);
    PG8_BAR;
#undef PG8_SA
#undef PG8_SB
#undef PG8_STAGE
#undef PG8_GOFF
#undef PG8_GTOK
#undef PG8_LDA
#undef PG8_LDB
#undef PG8_MMA
#undef PG8_WAIT_V
#undef PG8_WAIT_L
#undef PG8_BAR
#undef PG8_SCHED
}
}

constexpr int NWAVES = 8, NTHREADS = 512;
constexpr int D = 1024, NCTX = 512, NLAT = 16384, NTOK = NCTX + NLAT, SEQ = 8192, CTXL = 256;
constexpr int NEXP = 32, MAXPADROWS = 75776, MAXPADTILES = 296;
constexpr int GLA_IN = 3104, GLA_INP = 3328;
constexpr float EPS = 1e-6f;

constexpr size_t MiB = 1u << 20;
constexpr size_t WS_CTL = 0, CTL_ZERO_BYTES = 65536;
constexpr size_t WS_ADA = 1 * MiB;
constexpr size_t WS_ROPE = 1 * MiB + 512 * 1024;
constexpr size_t WS_TOKI = 2 * MiB;
constexpr size_t WS_TOKG = 2 * MiB + 512 * 1024;
constexpr size_t WS_LIST = 3 * MiB;
constexpr size_t WS_WRH = 6 * MiB, WS_WRL = 6 * MiB + 256 * 1024;
constexpr size_t WS_WSB = 7 * MiB;
constexpr size_t WS_WAIN = 8 * MiB;
constexpr size_t WS_WAOUT = 16 * MiB;
constexpr size_t WS_WBIN = 20 * MiB;
constexpr size_t WS_WBOUT = 27 * MiB;
constexpr size_t WS_WCQKV = 29 * MiB;
constexpr size_t WS_WCOUT = 35 * MiB;
constexpr size_t WS_WGU = 64 * MiB;
constexpr size_t WS_WDN = 576 * MiB;
constexpr size_t WS_X = 832 * MiB;
constexpr size_t WS_H = 898 * MiB;
constexpr size_t WS_G = 931 * MiB;
constexpr size_t WS_BIG = 964 * MiB;
constexpr size_t WS_DS = 1072 * MiB;
constexpr size_t WS_SIN = 1204 * MiB;
constexpr size_t WS_DEC = 1336 * MiB;
constexpr size_t WS_AS = 1338 * MiB;
constexpr size_t WS_ACT = 1486 * MiB;
constexpr size_t WS_YB = 1634 * MiB;
constexpr size_t WS_END = 1782 * MiB;
constexpr int CW_TMO = 0;
constexpr int CW_BAR = 4096;
constexpr int CW_CNT = 8192;
static_assert((CW_CNT + 128 * 64) * 4 <= 65536 && (CW_BAR + 3456) <= CW_CNT, "control words inside the per-call memset");

constexpr int RING_OFF = 0, RING_BYTES = 131072;
constexpr int MISC_OFF = RING_BYTES;
constexpr int LDS_BYTES = 147456;

#define GAS __attribute__((address_space(1)))
#define LAS __attribute__((address_space(3)))
typedef unsigned short bf16;
typedef unsigned v4u __attribute__((ext_vector_type(4)));
typedef unsigned v2u __attribute__((ext_vector_type(2)));
typedef float f32x4 __attribute__((ext_vector_type(4)));
typedef short bf16x8 __attribute__((ext_vector_type(8)));
typedef short bf16x4 __attribute__((ext_vector_type(4)));
#define LDS_WAIT() asm volatile("s_waitcnt lgkmcnt(0)" ::: "memory")
#define VM_WAIT() asm volatile("s_waitcnt vmcnt(0)" ::: "memory")
__device__ __forceinline__ unsigned f2bf(float f) { unsigned u = __builtin_bit_cast(unsigned, f); return (u + 0x7fffu + ((u >> 16) & 1u)) >> 16; }
__device__ __forceinline__ unsigned pk2(float lo, float hi) { return f2bf(lo) | (f2bf(hi) << 16); }
__device__ __forceinline__ float bf2f(unsigned b) { return __builtin_bit_cast(float, b << 16); }
__device__ __forceinline__ float bflo(unsigned w) { return __builtin_bit_cast(float, w << 16); }
__device__ __forceinline__ float bfhi(unsigned w) { return __builtin_bit_cast(float, w & 0xffff0000u); }
#define MFMA16(a, b, c) __builtin_amdgcn_mfma_f32_16x16x32_bf16((a), (b), (c), 0, 0, 0)

#define XB_TMO      128
#define XB_XCNT(j)  (256  + 64 * (j))
#define XB_XSUB(j)  (1280 + 64 * (j))
#define XB_XGEN(j)  (2304 + 64 * (j))
#define XB_TOP      3328
#define XB_TOPGEN   3392
#define XCD_BAR_WORDS 3456
#define XB_SPIN_CAP (1u << 22)

__device__ __forceinline__ unsigned xb_ld(unsigned* p)              { return __hip_atomic_load(p, __ATOMIC_RELAXED, __HIP_MEMORY_SCOPE_AGENT); }
__device__ __forceinline__ unsigned xb_add(unsigned* p, unsigned v) { return __hip_atomic_fetch_add(p, v, __ATOMIC_RELAXED, __HIP_MEMORY_SCOPE_AGENT); }
__device__ __forceinline__ unsigned xb_xcc_id() { return (unsigned)__builtin_amdgcn_s_getreg((3 << 11) | 20) & 0xFu; }
#define XB_SPIN(cond, bar) do { unsigned _sp = 0; while (cond) { __builtin_amdgcn_s_sleep(1); \
    if ((++_sp & 255u) == 0u) { if (xb_ld(&(bar)[XB_TMO])) break; if (_sp > XB_SPIN_CAP) { atomicAdd(&(bar)[XB_TMO], 1u); break; } } } } while (0)

struct XcdBarrier { unsigned* bar; unsigned x; volatile LAS unsigned* st; };
__device__ __forceinline__ XcdBarrier xcd_barrier_post(unsigned* bar, volatile LAS unsigned* st) {
    XcdBarrier b; b.bar = bar; b.x = xb_xcc_id(); b.st = st;
    if (threadIdx.x == 0) (void)xb_add(&bar[XB_XCNT(b.x)], 1u);
    return b;
}
__device__ __forceinline__ void xcd_barrier_complete(unsigned* bar, unsigned x, unsigned& nloc, unsigned& nx) {
    const unsigned G = gridDim.x * gridDim.y * gridDim.z;
    unsigned sum, cnt, mine, sp = 0u;
    for (;;) {
        sum = 0u; cnt = 0u; mine = 0u;
#pragma unroll
        for (unsigned j = 0; j < 16; ++j) { const unsigned c = xb_ld(&bar[XB_XCNT(j)]); sum += c; cnt += (c > 0u) ? 1u : 0u; mine = (j == x) ? c : mine; }
        if (sum == G) break;
        __builtin_amdgcn_s_sleep(1);
        if ((++sp & 255u) == 0u) { if (xb_ld(&bar[XB_TMO])) break; if (sp > XB_SPIN_CAP) { atomicAdd(&bar[XB_TMO], 1u); break; } }
    }
    nloc = mine > 0u ? mine : 1u; nx = cnt > 0u ? cnt : 1u;
}
__device__ __forceinline__ void xcd_barrier(const XcdBarrier& b) {
    asm volatile("s_waitcnt vmcnt(0)" ::: "memory");
    __syncthreads();
    if (threadIdx.x == 0) {
        unsigned* bar = b.bar;
        __builtin_amdgcn_s_waitcnt(0);
        unsigned nloc = b.st[0], nx = b.st[1];
        if (nloc == 0u) { xcd_barrier_complete(bar, b.x, nloc, nx); b.st[0] = nloc; b.st[1] = nx; }
        const unsigned old = xb_add(&bar[XB_XSUB(b.x)], 1u);
        const unsigned gen = old / nloc;
        if (old + 1u == (gen + 1u) * nloc) {
            __builtin_amdgcn_fence(__ATOMIC_RELEASE, "agent");
            asm volatile("s_waitcnt vmcnt(0)" ::: "memory");
            const unsigned og = xb_add(&bar[XB_TOP], 1u);
            const unsigned tg = og / nx;
            if (og + 1u == (tg + 1u) * nx) xb_add(&bar[XB_TOPGEN], 1u);
            else XB_SPIN(xb_ld(&bar[XB_TOPGEN]) == tg, bar);
            __builtin_amdgcn_fence(__ATOMIC_ACQUIRE, "agent");
            xb_add(&bar[XB_XGEN(b.x)], 1u);
            asm volatile("s_waitcnt vmcnt(0)" ::: "memory");
        } else {
            XB_SPIN(xb_ld(&bar[XB_XGEN(b.x)]) == gen, bar);
            __builtin_amdgcn_fence(__ATOMIC_ACQUIRE, "agent");
            asm volatile("s_waitcnt vmcnt(0)" ::: "memory");
        }
    }
    __syncthreads();
}

struct Args { const float* in[28]; float* out; unsigned char* ws; int ph_lo, ph_hi; };
enum { I_X = 0, I_C, I_CTX, I_CCTX, I_ADAW, I_ADAB, I_NMIX, I_NFFN, I_NOUT, I_AWIN, I_AGV, I_AWS, I_ABS, I_AWOUT, I_BWIN, I_BWA2, I_BBA, I_BGO, I_BWOUT,
       I_CWQKV, I_CRPB, I_CWOUT, I_MWR, I_MBR, I_MWGU, I_MBGU, I_MWDN, I_MBDN };

struct Frame {
    LAS unsigned char* lds;
    unsigned* ctl;
    unsigned char* ws;
    int tid, lane, wave, vcu, G;
};

__device__ __forceinline__ float wave_sum(float v) {
#pragma unroll
    for (int o = 1; o < 64; o <<= 1) v += __shfl_xor(v, o);
    return v;
}
__device__ __forceinline__ int seg_of_row(int r) { return r < NCTX ? 0 : 1 + ((r - NCTX) >> 13); }

__device__ __forceinline__ void transpose_item64(const float* W, int N, int k0, int n0, bf16* WT, int K, int dst_row0, int ncols_valid, LAS float* scr, int lane) {
#pragma unroll 4
    for (int i = 0; i < 16; ++i) { const int row = 4 * i + (lane >> 4), c4 = (lane & 15) * 4;
        f32x4 v = (f32x4){0.f, 0.f, 0.f, 0.f};
        if (c4 < ncols_valid) v = *(const GAS f32x4*)(W + (size_t)(k0 + row) * N + n0 + c4);
        LAS float* s = scr + row * 65 + c4; s[0] = v.x; s[1] = v.y; s[2] = v.z; s[3] = v.w; }
    LDS_WAIT(); asm volatile("" ::: "memory");
    const int c = lane & 7;
#pragma unroll
    for (int j = 0; j < 8; ++j) { const int n = (lane >> 3) + 8 * j; const LAS float* s = scr + (8 * c) * 65 + n;
        v4u o; o.x = pk2(s[0 * 65], s[1 * 65]); o.y = pk2(s[2 * 65], s[3 * 65]); o.z = pk2(s[4 * 65], s[5 * 65]); o.w = pk2(s[6 * 65], s[7 * 65]);
        *(GAS v4u*)(WT + (size_t)(dst_row0 + n) * K + k0 + 8 * c) = o; }
    LDS_WAIT(); asm volatile("" ::: "memory");
}

__device__ __forceinline__ void p_prologue(Frame& F, const Args& a) {
    LAS float* scr = (LAS float*)(F.lds + F.wave * 16640);
    const int gw = F.vcu * NWAVES + F.wave, NGW = F.G * NWAVES;
    {
        constexpr int KB = 16;
        constexpr int I0 = 2 * KB * 32, I1 = 2 * KB * 16, I2 = KB * 52, I3 = KB * 16, I4 = KB * 48, I5 = KB * 16;
        constexpr int NI = I0 + I1 + I2 + I3 + I4 + I5;
        for (int it = gw; it < NI; it += NGW) {
            int r = it;
            if (r < I0) { const int j = r / (KB * 32), q = r % (KB * 32), kb = q / 32, nb = q % 32;
                transpose_item64(a.in[I_AWIN] + (size_t)j * 1024 * 2048, 2048, 64 * kb, 64 * nb, (bf16*)(F.ws + WS_WAIN) + (size_t)j * 2048 * 1024, 1024, 64 * nb, 64, scr, F.lane); continue; } r -= I0;
            if (r < I1) { const int j = r / (KB * 16), q = r % (KB * 16), kb = q / 16, nb = q % 16;
                transpose_item64(a.in[I_AWOUT] + (size_t)j * 1024 * 1024, 1024, 64 * kb, 64 * nb, (bf16*)(F.ws + WS_WAOUT) + (size_t)j * 1024 * 1024, 1024, 64 * nb, 64, scr, F.lane); continue; } r -= I1;
            if (r < I2) { const int kb = r / 52, nb = r % 52; const int nv = GLA_IN - 64 * nb;
                transpose_item64(a.in[I_BWIN], GLA_IN, 64 * kb, 64 * nb, (bf16*)(F.ws + WS_WBIN), 1024, 64 * nb, nv < 0 ? 0 : (nv > 64 ? 64 : nv), scr, F.lane); continue; } r -= I2;
            if (r < I3) { const int kb = r / 16, nb = r % 16;
                transpose_item64(a.in[I_BWOUT], 1024, 64 * kb, 64 * nb, (bf16*)(F.ws + WS_WBOUT), 1024, 64 * nb, 64, scr, F.lane); continue; } r -= I3;
            if (r < I4) { const int kb = r / 48, nb = r % 48;
                transpose_item64(a.in[I_CWQKV], 3072, 64 * kb, 64 * nb, (bf16*)(F.ws + WS_WCQKV), 1024, 64 * nb, 64, scr, F.lane); continue; } r -= I4;
            { const int kb = r / 16, nb = r % 16;
                transpose_item64(a.in[I_CWOUT], 1024, 64 * kb, 64 * nb, (bf16*)(F.ws + WS_WCOUT), 1024, 64 * nb, 64, scr, F.lane); }
        }
    }
    {
        constexpr int KB = 16, PER_GU = KB * 32, PER_DN = KB * 16, NGU = 128 * PER_GU, NDN = 128 * PER_DN;
        for (int it = gw; it < NGU + NDN; it += NGW) {
            if (it < NGU) { const int le = it / PER_GU, q = it % PER_GU, kb = q / 32, nb = q % 32;
                const int n0 = 64 * nb, half = n0 >> 10, jj = n0 & 1023, dst = (jj >> 7) * 256 + half * 128 + (jj & 127);
                transpose_item64(a.in[I_MWGU] + (size_t)le * 1024 * 2048, 2048, 64 * kb, n0, (bf16*)(F.ws + WS_WGU) + (size_t)le * 2048 * 1024, 1024, dst, 64, scr, F.lane); }
            else { const int r = it - NGU, le = r / PER_DN, q = r % PER_DN, kb = q / 16, nb = q % 16;
                transpose_item64(a.in[I_MWDN] + (size_t)le * 1024 * 1024, 1024, 64 * kb, 64 * nb, (bf16*)(F.ws + WS_WDN) + (size_t)le * 1024 * 1024, 1024, 64 * nb, 64, scr, F.lane); }
        }
    }
    const int gt = F.vcu * NTHREADS + F.tid, NGT = F.G * NTHREADS;
    for (int i = gt; i < 2 * 8 * 128 * 128; i += NGT) ((bf16*)(F.ws + WS_WSB))[i] = (bf16)f2bf(a.in[I_AWS][i]);
    for (int i = gt; i < 4 * 32 * 1024; i += NGT) { const int l = i >> 15, e = (i >> 10) & 31, k = i & 1023;
        const float w = a.in[I_MWR][((size_t)l * 1024 + k) * 32 + e]; const unsigned h = f2bf(w); const float rem = w - bf2f(h);
        ((bf16*)(F.ws + WS_WRH))[i] = (bf16)h; ((bf16*)(F.ws + WS_WRL))[i] = (bf16)f2bf(rem); }
    for (int i = gt; i < 128 * 32; i += NGT) { const int pos = i >> 5, f = i & 31;
        const float fr = powf(10000.0f, -(float)f / 32.0f); const float ang = (float)pos * fr; float sn, cs; sincosf(ang, &sn, &cs);
        ((float*)(F.ws + WS_ROPE))[2 * i] = cs; ((float*)(F.ws + WS_ROPE))[2 * i + 1] = sn; }
    {
        __syncthreads();
        LAS float* sv = (LAS float*)(F.lds);
        LAS float* red = sv + 3 * 1024;
        for (int i = F.tid; i < 3 * 1024; i += NTHREADS) { const int s = i >> 10, k = i & 1023;
            const float v = s == 0 ? a.in[I_CCTX][k] : a.in[I_C][(s - 1) * 1024 + k]; sv[i] = v / (1.0f + __expf(-v)); }
        __syncthreads();
        for (int u = F.vcu; u < 4 * 96; u += F.G) { const int l = u / 96, n0 = (u % 96) * 64;
            const float* w = a.in[I_ADAW] + (size_t)l * 1024 * 6144 + n0 + F.lane;
            float a0 = 0.f, a1 = 0.f, a2 = 0.f;
#pragma unroll 8
            for (int kk = 0; kk < 128; ++kk) { const int k = F.wave * 128 + kk; const float wv = w[(size_t)k * 6144];
                a0 += sv[k] * wv; a1 += sv[1024 + k] * wv; a2 += sv[2048 + k] * wv; }
            red[(F.wave * 3 + 0) * 64 + F.lane] = a0; red[(F.wave * 3 + 1) * 64 + F.lane] = a1; red[(F.wave * 3 + 2) * 64 + F.lane] = a2;
            __syncthreads();
            if (F.tid < 192) { const int s = F.tid >> 6, c = F.tid & 63; float t = a.in[I_ADAB][l * 6144 + n0 + c];
#pragma unroll
                for (int w8 = 0; w8 < 8; ++w8) t += red[(w8 * 3 + s) * 64 + c];
                ((float*)(F.ws + WS_ADA))[(size_t)(l * 3 + s) * 6144 + n0 + c] = t; }
            __syncthreads();
        }
    }
}

__device__ __forceinline__ void moe_tables(Frame& F, int layer) {
    LAS int* M = (LAS int*)(F.lds + MISC_OFF);
    __syncthreads();
    if (F.tid < 32) M[400 + F.tid] = (int)__hip_atomic_load(F.ctl + CW_CNT + (layer * 32 + F.tid) * 64, __ATOMIC_RELAXED, __HIP_MEMORY_SCOPE_AGENT);
    __syncthreads();
    if (F.tid < 64) { const int e = F.tid & 31; const int nt = (M[400 + e] + 255) >> 8; int incl = nt;
#pragma unroll
        for (int o = 1; o < 32; o <<= 1) { const int v = __shfl_up(incl, o, 32); if (e >= o) incl += v; }
        const int off = (incl - nt) << 8;
        if (F.tid < 32) { M[e] = off; for (int t = 0; t < nt; ++t) M[64 + (off >> 8) + t] = e; if (e == 31) M[32] = incl << 8; } }
    __syncthreads();
}

__device__ __forceinline__ void p_prenorm(Frame& F, const Args& a, int layer, bool fin, bool dry = false) {
    const int gw = F.vcu * NWAVES + F.wave, NGW = F.G * NWAVES;
    const int prev = layer - 1;
    const int row_lo = (layer >= 3) ? NCTX : 0;
    const bool combine = layer > 0;
    if (combine) moe_tables(F, prev);
    const LAS int* M = (const LAS int*)(F.lds + MISC_OFF);
    float* X = (float*)(F.ws + WS_X); bf16* H = (bf16*)(F.ws + (dry ? WS_AS : WS_H));
    const bf16* YB = (const bf16*)(F.ws + WS_YB);
    const float* ada = (const float*)(F.ws + WS_ADA);
    const v4u* TOKI = (const v4u*)(F.ws + WS_TOKI); const f32x4* TOKG = (const f32x4*)(F.ws + WS_TOKG);
    LAS float* V = (LAS float*)(F.lds);
    __syncthreads();
    for (int i = F.tid; i < 10 * D; i += NTHREADS) { const int w = i >> 10, c = i & 1023; float x;
        if (w == 0) x = fin ? a.in[I_NOUT][c] : a.in[I_NMIX][(size_t)layer * D + c];
        else { const int seg = (w - 1) / 3, k = (w - 1) % 3; x = k == 2 ? (combine ? ada[(size_t)((prev * 3 + seg) * 6 + 5) * D + c] : 0.f) : (fin ? 0.f : ada[(size_t)((layer * 3 + seg) * 6 + k) * D + c]); }
        V[i] = x; }
    __syncthreads();
    for (int row0 = row_lo + gw; row0 < NTOK; row0 += 2 * NGW) {
        const int row1r = row0 + NGW; const bool has1 = row1r < NTOK; const int row1 = has1 ? row1r : row0;
        f32x4 v[2][4]; v4u ti[2]; f32x4 tg[2];
#pragma unroll
        for (int q = 0; q < 2; ++q) { const int row = q ? row1 : row0;
            const float* src = layer == 0 ? (row < NCTX ? a.in[I_CTX] + (size_t)row * D : a.in[I_X] + (size_t)(row - NCTX) * D) : X + (size_t)row * D;
#pragma unroll
            for (int j = 0; j < 4; ++j) v[q][j] = *(const GAS f32x4*)(src + 4 * F.lane + 256 * j);
            if (combine) { ti[q] = TOKI[row]; tg[q] = TOKG[row]; } }
        if (combine) {
            v2u y[2][4][4];
#pragma unroll
            for (int q = 0; q < 2; ++q)
#pragma unroll
                for (int k = 0; k < 4; ++k) { const unsigned t = ti[q][k]; const int pos = M[t >> 16] + (int)(t & 0xffffu); const bf16* yr = YB + (size_t)pos * D + 4 * F.lane;
#pragma unroll
                    for (int j = 0; j < 4; ++j) y[q][k][j] = *(const GAS v2u*)(yr + 256 * j); }
#pragma unroll
            for (int q = 0; q < 2; ++q) { const int seg = seg_of_row(q ? row1 : row0);
#pragma unroll
                for (int j = 0; j < 4; ++j) { f32x4 acc = (f32x4){0.f, 0.f, 0.f, 0.f};
#pragma unroll
                    for (int k = 0; k < 4; ++k) { const float g = tg[q][k]; const v2u yy = y[q][k][j]; acc.x += g * bflo(yy.x); acc.y += g * bfhi(yy.x); acc.z += g * bflo(yy.y); acc.w += g * bfhi(yy.y); }
                    const f32x4 gg = *(const LAS f32x4*)(V + (1 + 3 * seg + 2) * D + 4 * F.lane + 256 * j); v[q][j] = v[q][j] + gg * acc; } }
        }
#pragma unroll
        for (int q = 0; q < 2; ++q) { if (q == 1 && !has1) break; const int row = q ? row1 : row0, seg = seg_of_row(row);
            if (!fin && !dry && (combine || layer == 0)) {
#pragma unroll
                for (int j = 0; j < 4; ++j) *(GAS f32x4*)(X + (size_t)row * D + 4 * F.lane + 256 * j) = v[q][j];
            }
            float ss = 0.f;
#pragma unroll
            for (int j = 0; j < 4; ++j) ss += (v[q][j].x * v[q][j].x + v[q][j].y * v[q][j].y) + (v[q][j].z * v[q][j].z + v[q][j].w * v[q][j].w);
            const float rstd = 1.0f / sqrtf(wave_sum(ss) * (1.0f / D) + EPS);
            if (fin) {
                float* o = a.out + (size_t)(row - NCTX) * D;
#pragma unroll
                for (int j = 0; j < 4; ++j) { const f32x4 g = *(const LAS f32x4*)(V + 4 * F.lane + 256 * j); *(GAS f32x4*)(o + 4 * F.lane + 256 * j) = v[q][j] * rstd * g; }
            } else {
#pragma unroll
                for (int j = 0; j < 4; ++j) { const int c = 4 * F.lane + 256 * j;
                    const f32x4 g = *(const LAS f32x4*)(V + c), s0 = *(const LAS f32x4*)(V + (1 + 3 * seg) * D + c), s1 = *(const LAS f32x4*)(V + (2 + 3 * seg) * D + c);
                    const f32x4 h = v[q][j] * rstd * g * (s1 + 1.0f) + s0;
                    v2u o; o.x = pk2(h.x, h.y); o.y = pk2(h.z, h.w);
                    *(GAS v2u*)(H + (size_t)row * D + c) = o; }
            }
        }
    }
}

__device__ __forceinline__ void p_router(Frame& F, const Args& a, int layer, bool dry = false) {
    const int row_lo = (layer >= 2) ? NCTX : 0;
    const int ntile = (NTOK - row_lo) / 16;
    float* X = (float*)(F.ws + WS_X); bf16* H = (bf16*)(F.ws + WS_H);
    const float* ada = (const float*)(F.ws + WS_ADA);
    constexpr int AST = 1032;
    LAS bf16* Ahi = (LAS bf16*)(F.lds); LAS bf16* Alo = Ahi + 16 * AST;
    LAS float* RED = (LAS float*)(F.lds + 2 * 16 * AST * 2);
    LAS float* LOG = RED + 8 * 16 * 32;
    const int fr = F.lane & 15, fq = F.lane >> 4;
    bf16x8 Bh[2][4], Bl[2][4];
    {
        const bf16* wh = (const bf16*)(F.ws + WS_WRH) + (size_t)layer * 32 * 1024; const bf16* wl = (const bf16*)(F.ws + WS_WRL) + (size_t)layer * 32 * 1024;
#pragma unroll
        for (int nt = 0; nt < 2; ++nt)
#pragma unroll
            for (int ks = 0; ks < 4; ++ks) { const size_t o = (size_t)(nt * 16 + fr) * 1024 + F.wave * 128 + ks * 32 + fq * 8;
                Bh[nt][ks] = *(const GAS bf16x8*)(wh + o); Bl[nt][ks] = *(const GAS bf16x8*)(wl + o); }
    }
    const float* nw = a.in[I_NFFN] + (size_t)layer * D;
    for (int tile = F.vcu; tile < ntile; tile += F.G) {
        const int r0 = row_lo + 16 * tile;
#pragma unroll
        for (int rr = 0; rr < 2; ++rr) {
            const int rl = 2 * F.wave + rr, row = r0 + rl, seg = seg_of_row(row);
            const float* sh = ada + (size_t)((layer * 3 + seg) * 6 + 3) * D; const float* sc = sh + D;
            f32x4 v[4]; float ss = 0.f;
#pragma unroll
            for (int j = 0; j < 4; ++j) { v[j] = *(const GAS f32x4*)(X + (size_t)row * D + 4 * F.lane + 256 * j); ss += (v[j].x * v[j].x + v[j].y * v[j].y) + (v[j].z * v[j].z + v[j].w * v[j].w); }
            const float rstd = 1.0f / sqrtf(wave_sum(ss) * (1.0f / D) + EPS);
#pragma unroll
            for (int j = 0; j < 4; ++j) { const int c = 4 * F.lane + 256 * j;
                const f32x4 g = *(const GAS f32x4*)(nw + c), s1 = *(const GAS f32x4*)(sc + c), s0 = *(const GAS f32x4*)(sh + c);
                const f32x4 h = v[j] * rstd * g * (s1 + 1.0f) + s0;
                const unsigned h0 = f2bf(h.x), h1 = f2bf(h.y), h2 = f2bf(h.z), h3 = f2bf(h.w);
                v2u o; o.x = h0 | (h1 << 16); o.y = h2 | (h3 << 16);
                *(GAS v2u*)(H + (size_t)row * D + c) = o;
                *(LAS v2u*)(Ahi + rl * AST + c) = o;
                v2u l; l.x = pk2(h.x - bf2f(h0), h.y - bf2f(h1)); l.y = pk2(h.z - bf2f(h2), h.w - bf2f(h3));
                *(LAS v2u*)(Alo + rl * AST + c) = l; }
        }
        __syncthreads();
        f32x4 acc[2] = {(f32x4){0.f, 0.f, 0.f, 0.f}, (f32x4){0.f, 0.f, 0.f, 0.f}};
#pragma unroll
        for (int ks = 0; ks < 4; ++ks) { const int o = fr * AST + F.wave * 128 + ks * 32 + fq * 8;
            const bf16x8 ah = *(const LAS bf16x8*)(Ahi + o), al = *(const LAS bf16x8*)(Alo + o);
#pragma unroll
            for (int nt = 0; nt < 2; ++nt) { acc[nt] = MFMA16(ah, Bh[nt][ks], acc[nt]); acc[nt] = MFMA16(ah, Bl[nt][ks], acc[nt]); acc[nt] = MFMA16(al, Bh[nt][ks], acc[nt]); } }
#pragma unroll
        for (int nt = 0; nt < 2; ++nt)
#pragma unroll
            for (int j = 0; j < 4; ++j) RED[(F.wave * 16 + fq * 4 + j) * 32 + nt * 16 + fr] = acc[nt][j];
        __syncthreads();
        {
            const int rl = F.tid >> 5, e = F.tid & 31, row = r0 + rl;
            float lg = a.in[I_MBR][layer * 32 + e];
#pragma unroll
            for (int w8 = 0; w8 < 8; ++w8) lg += RED[(w8 * 16 + rl) * 32 + e];
            float cur = lg; float tv[4]; int tix[4];
#pragma unroll
            for (int k = 0; k < 4; ++k) { float bv = cur; int bi = e;
#pragma unroll
                for (int o = 1; o < 32; o <<= 1) { const float ov = __shfl_xor(bv, o); const int oi = __shfl_xor(bi, o); if (ov > bv || (ov == bv && oi < bi)) { bv = ov; bi = oi; } }
                tv[k] = bv; tix[k] = bi; if (e == bi) cur = -3.0e38f; }
            const float e1 = __expf(tv[1] - tv[0]), e2 = __expf(tv[2] - tv[0]), e3 = __expf(tv[3] - tv[0]); const float inv = 1.0f / (1.0f + e1 + e2 + e3);
            if (e < 4 && !dry) { const int k = e; const int ek = k == 0 ? tix[0] : (k == 1 ? tix[1] : (k == 2 ? tix[2] : tix[3])); const float gk = (k == 0 ? 1.0f : (k == 1 ? e1 : (k == 2 ? e2 : e3))) * inv;
                const unsigned rank = atomicAdd(F.ctl + CW_CNT + (layer * 32 + ek) * 64, 1u);
                ((unsigned*)(F.ws + WS_LIST))[(size_t)ek * NTOK + rank] = (unsigned)row;
                ((unsigned*)(F.ws + WS_TOKI))[(size_t)row * 4 + k] = ((unsigned)ek << 16) | rank;
                ((float*)(F.ws + WS_TOKG))[(size_t)row * 4 + k] = gk; }
        }
        __syncthreads();
    }
}

__device__ __forceinline__ void p_gather(Frame& F, int layer) {
    moe_tables(F, layer);
    const LAS int* M = (const LAS int*)(F.lds + MISC_OFF);
    const int total = M[32];
    const int gw = F.vcu * NWAVES + F.wave, NGW = F.G * NWAVES;
    const bf16* H = (const bf16*)(F.ws + WS_H); bf16* AS = (bf16*)(F.ws + WS_AS);
    const unsigned* LIST = (const unsigned*)(F.ws + WS_LIST);
    for (int p = gw; p < total; p += NGW) {
        const int e = M[64 + (p >> 8)]; const int rank = p - M[e];
        v4u x0 = (v4u){0u, 0u, 0u, 0u}, x1 = x0;
        if (rank < M[400 + e]) { const unsigned r = LIST[(size_t)e * NTOK + rank]; const GAS v4u* s = (const GAS v4u*)(H + (size_t)r * D); x0 = s[F.lane]; x1 = s[64 + F.lane]; }
        GAS v4u* d = (GAS v4u*)(AS + (size_t)p * D); d[F.lane] = x0; d[64 + F.lane] = x1;
    }
}

typedef short s16x4 __attribute__((ext_vector_type(4)));
__device__ __forceinline__ bf16x8 tr_frag(const LAS bf16* T, int stride, int kb, int c0, int lane) {
    const int g = lane >> 4, w = lane & 15, q = w >> 2, p = w & 3;
    const LAS bf16* a0 = T + (kb + 4 * g + q) * stride + c0 + 4 * p;
    const s16x4 lo = __builtin_amdgcn_ds_read_tr16_b64_v4i16((LAS s16x4*)a0);
    const s16x4 hi = __builtin_amdgcn_ds_read_tr16_b64_v4i16((LAS s16x4*)(a0 + 16 * stride));
    return (bf16x8){lo[0], lo[1], lo[2], lo[3], hi[0], hi[1], hi[2], hi[3]};
}
__device__ __forceinline__ bf16x8 perm_frag(const LAS bf16* rowp, int kb, int quad) {
    const v2u lo = *(const LAS v2u*)(rowp + kb + 4 * quad), hi = *(const LAS v2u*)(rowp + kb + 16 + 4 * quad);
    v4u w; w.x = lo.x; w.y = lo.y; w.z = hi.x; w.w = hi.y; return __builtin_bit_cast(bf16x8, w);
}
__device__ __forceinline__ void p_spatial(Frame& F, const Args& a, int layer) {
    const int jl = layer / 3;
    const int c_lo = (layer >= 3) ? 4 : 0;
    const int nunit = (132 - c_lo) * 8;
    const bf16* ZB = (const bf16*)(F.ws + WS_BIG); bf16* G = (bf16*)(F.ws + WS_G);
    constexpr int ST = 144;
    LAS bf16* As = (LAS bf16*)(F.lds); LAS bf16* Bs = As + 128 * ST; LAS float* rs = (LAS float*)(F.lds + 2 * 128 * ST * 2);
    const int fr = F.lane & 15, fq = F.lane >> 4;
    const int u_lo = (int)(((long)F.vcu * nunit) / F.G), u_hi = (int)(((long)(F.vcu + 1) * nunit) / F.G);
    int cur_c = -1;
    for (int u = u_lo; u < u_hi; ++u) {
        const int c = c_lo + (u >> 3), g = u & 7, r0 = 128 * c;
        if (c != cur_c) {
            cur_c = c;
            __syncthreads();
#pragma unroll
            for (int hb = 0; hb < 2; ++hb) {
                v4u x0[8], x1[8];
#pragma unroll
                for (int rr = 0; rr < 8; ++rr) { const GAS v4u* p = (const GAS v4u*)(ZB + (size_t)(r0 + F.wave * 16 + hb * 8 + rr) * 2048 + 1024 + 16 * F.lane); x0[rr] = p[0]; x1[rr] = p[1]; }
#pragma unroll
                for (int rr = 0; rr < 8; ++rr) { float ss = 0.f;
#pragma unroll
                    for (int i = 0; i < 4; ++i) { const float l0 = bflo(x0[rr][i]), h0 = bfhi(x0[rr][i]), l1 = bflo(x1[rr][i]), h1 = bfhi(x1[rr][i]); ss += l0 * l0 + h0 * h0 + l1 * l1 + h1 * h1; }
                    ss = wave_sum(ss); if (F.lane == 0) rs[F.wave * 16 + hb * 8 + rr] = 1.0f / sqrtf(ss * (1.0f / 1024.0f) + EPS); }
            }
        }
        __syncthreads();
        {
            const bf16* wsb = (const bf16*)(F.ws + WS_WSB) + (size_t)(jl * 8 + g) * 128 * 128;
            const float* gv = a.in[I_AGV] + (size_t)jl * 1024 + 128 * g;
#pragma unroll
            for (int i = 0; i < 4; ++i) { const int id = F.tid + 512 * i, p = id >> 4, qc = id & 15;
                *(LAS v4u*)(As + p * ST + qc * 8) = *(const GAS v4u*)(wsb + p * 128 + qc * 8);
                const v4u x = *(const GAS v4u*)(ZB + (size_t)(r0 + p) * 2048 + 1024 + 128 * g + 8 * qc); const float rq = rs[p];
                const f32x4 g0 = *(const GAS f32x4*)(gv + 8 * qc), g1 = *(const GAS f32x4*)(gv + 8 * qc + 4);
                v4u o; o.x = pk2(bflo(x.x) * rq * g0.x, bfhi(x.x) * rq * g0.y); o.y = pk2(bflo(x.y) * rq * g0.z, bfhi(x.y) * rq * g0.w);
                o.z = pk2(bflo(x.z) * rq * g1.x, bfhi(x.z) * rq * g1.y); o.w = pk2(bflo(x.w) * rq * g1.z, bfhi(x.w) * rq * g1.w);
                *(LAS v4u*)(Bs + p * ST + qc * 8) = o; }
        }
        __syncthreads();
        f32x4 acc[8];
#pragma unroll
        for (int nt = 0; nt < 8; ++nt) acc[nt] = (f32x4){0.f, 0.f, 0.f, 0.f};
#pragma unroll
        for (int ks = 0; ks < 4; ++ks) { const bf16x8 af = tr_frag(Bs, ST, 32 * ks, 16 * F.wave, F.lane);
#pragma unroll
            for (int nt = 0; nt < 8; ++nt) { const bf16x8 bfr = perm_frag(As + (16 * nt + fr) * ST, 32 * ks, fq); acc[nt] = MFMA16(af, bfr, acc[nt]); } }
        const float* bs = a.in[I_ABS] + (size_t)(jl * 8 + g) * 128;
#pragma unroll
        for (int nt = 0; nt < 8; ++nt) { const int p = 16 * nt + fr; const float bb = bs[p]; const size_t row = (size_t)(r0 + p); const int cc = 128 * g + 16 * F.wave + 4 * fq;
            const v2u uu = *(const GAS v2u*)(ZB + row * 2048 + cc);
            v2u o; o.x = pk2(bflo(uu.x) * (acc[nt][0] + bb), bfhi(uu.x) * (acc[nt][1] + bb)); o.y = pk2(bflo(uu.y) * (acc[nt][2] + bb), bfhi(uu.y) * (acc[nt][3] + bb));
            *(GAS v2u*)(G + row * D + cc) = o; }
        __syncthreads();
    }
}

constexpr int PST = GLA_INP;
constexpr int CST = 132;
constexpr int KST = 144;
constexpr int VST = 272;
__device__ __forceinline__ void gla_cum(Frame& F, const Args& a, int c, int h, int dir, LAS float* cum, LAS float* rt, LAS float* tot) {
    const bf16* P = (const bf16*)(F.ws + WS_BIG);
    for (int i = F.tid; i < 64 * 8; i += NTHREADS) { const int ii = i >> 3, j2 = i & 7; const unsigned x = *(const GAS unsigned*)(P + (size_t)(64 * c + ii) * PST + 3072 + dir * 16 + 2 * j2);
        rt[ii * 16 + 2 * j2] = bflo(x); rt[ii * 16 + 2 * j2 + 1] = bfhi(x); }
    const int kk = F.tid & 127, part = F.tid >> 7;
    float w[16];
#pragma unroll
    for (int j = 0; j < 16; ++j) w[j] = a.in[I_BWA2][(size_t)(dir * 16 + j) * 512 + h * 128 + kk];
    const float ba = a.in[I_BBA][dir * 512 + h * 128 + kk];
    __syncthreads();
    float la[16];
#pragma unroll
    for (int ii = 0; ii < 16; ++ii) { const int i = part * 16 + ii; float z = ba;
        const f32x4 r0 = *(const LAS f32x4*)(rt + i * 16), r1 = *(const LAS f32x4*)(rt + i * 16 + 4), r2 = *(const LAS f32x4*)(rt + i * 16 + 8), r3 = *(const LAS f32x4*)(rt + i * 16 + 12);
        z += r0.x * w[0] + r0.y * w[1] + r0.z * w[2] + r0.w * w[3]; z += r1.x * w[4] + r1.y * w[5] + r1.z * w[6] + r1.w * w[7];
        z += r2.x * w[8] + r2.y * w[9] + r2.z * w[10] + r2.w * w[11]; z += r3.x * w[12] + r3.y * w[13] + r3.z * w[14] + r3.w * w[15];
        const float ls = fminf(z, 0.0f) - __logf(1.0f + __expf(-fabsf(z)));
        la[ii] = ls * (1.0f / 16.0f); }
    float run = 0.f;
    if (dir == 0) {
#pragma unroll
        for (int ii = 0; ii < 16; ++ii) { run += la[ii]; la[ii] = run; } }
    else {
#pragma unroll
        for (int ii = 15; ii >= 0; --ii) { run += la[ii]; la[ii] = run; } }
    tot[part * 128 + kk] = run;
    __syncthreads();
    float off = 0.f;
#pragma unroll
    for (int p = 0; p < 4; ++p) { const float t = tot[p * 128 + kk]; if (dir == 0 ? (p < part) : (p > part)) off += t; }
#pragma unroll
    for (int ii = 0; ii < 16; ++ii) cum[(part * 16 + ii) * CST + kk] = la[ii] + off;
    __syncthreads();
}
struct RowRaw { v4u o0, o1, p0, p1; };
__device__ __forceinline__ void row16_load(const bf16* x, int grp, bool lat, RowRaw& R) {
    R.o0 = *(const GAS v4u*)(x + 16 * grp); R.o1 = *(const GAS v4u*)(x + 16 * grp + 8);
    if (lat) { R.p0 = *(const GAS v4u*)(x + 16 * (grp ^ 2)); R.p1 = *(const GAS v4u*)(x + 16 * (grp ^ 2) + 8); } else { R.p0 = R.o0; R.p1 = R.o1; }
}
__device__ __forceinline__ void ropetab_load(const float* ROPE, int grp, int pr, int pc, bool lat, f32x4 (&tb)[8]) {
    const int pos = (grp >> 2) ? pc : pr; const float* t = ROPE + (size_t)(pos * 32 + 16 * (grp & 1)) * 2;
#pragma unroll
    for (int e2 = 0; e2 < 8; ++e2) tb[e2] = lat ? *(const GAS f32x4*)(t + 4 * e2) : (f32x4){1.f, 0.f, 1.f, 0.f};
}
__device__ __forceinline__ void rope16_apply(const RowRaw& R, const f32x4 (&tb)[8], int grp, bool lat, float (&out)[16]) {
    float own[16], par[16];
#pragma unroll
    for (int e = 0; e < 4; ++e) { own[2 * e] = bflo(R.o0[e]); own[2 * e + 1] = bfhi(R.o0[e]); own[8 + 2 * e] = bflo(R.o1[e]); own[8 + 2 * e + 1] = bfhi(R.o1[e]);
        par[2 * e] = bflo(R.p0[e]); par[2 * e + 1] = bfhi(R.p0[e]); par[8 + 2 * e] = bflo(R.p1[e]); par[8 + 2 * e + 1] = bfhi(R.p1[e]); }
    if (!lat) {
#pragma unroll
        for (int e = 0; e < 16; ++e) out[e] = own[e];
        return; }
    const bool second = (grp >> 1) & 1;
#pragma unroll
    for (int e2 = 0; e2 < 8; ++e2) { const f32x4 t = tb[e2];
        { const int e = 2 * e2; const float x1 = second ? par[e] : own[e], x2 = second ? own[e] : par[e]; out[e] = second ? (x1 * t.y + x2 * t.x) : (x1 * t.x - x2 * t.y); }
        { const int e = 2 * e2 + 1; const float x1 = second ? par[e] : own[e], x2 = second ? own[e] : par[e]; out[e] = second ? (x1 * t.w + x2 * t.z) : (x1 * t.z - x2 * t.w); } }
}
__device__ __forceinline__ void st16bf(LAS bf16* dst, const float (&v)[16]) {
    v4u a, b; a.x = pk2(v[0], v[1]); a.y = pk2(v[2], v[3]); a.z = pk2(v[4], v[5]); a.w = pk2(v[6], v[7]); b.x = pk2(v[8], v[9]); b.y = pk2(v[10], v[11]); b.z = pk2(v[12], v[13]); b.w = pk2(v[14], v[15]);
    *(LAS v4u*)dst = a; *(LAS v4u*)(dst + 8) = b;
}
__device__ __forceinline__ void ld16cum(const LAS float* p, float (&v)[16]) {
#pragma unroll
    for (int e = 0; e < 4; ++e) { const f32x4 t = *(const LAS f32x4*)(p + 4 * e); v[4 * e] = t.x; v[4 * e + 1] = t.y; v[4 * e + 2] = t.z; v[4 * e + 3] = t.w; }
}
__device__ __forceinline__ void gla_stage_v(Frame& F, int c, int h, LAS bf16* VL) {
    const bf16* P = (const bf16*)(F.ws + WS_BIG);
    const int i = F.tid & 63, grp = F.tid >> 6; const bf16* vp = P + (size_t)(64 * c + i) * PST + 1024 + h * 256 + grp * 32;
#pragma unroll
    for (int e = 0; e < 4; ++e) *(LAS v4u*)(VL + i * VST + grp * 32 + 8 * e) = *(const GAS v4u*)(vp + 8 * e);
}
__device__ __forceinline__ void p_gla_ds(Frame& F, const Args& a) {
    const bf16* P = (const bf16*)(F.ws + WS_BIG); const float* ROPE = (const float*)(F.ws + WS_ROPE);
    bf16* DS = (bf16*)(F.ws + WS_DS); float* DEC = (float*)(F.ws + WS_DEC);
    LAS float* cum = (LAS float*)(F.lds); LAS float* rt = cum + 64 * CST; LAS float* tot = rt + 64 * 16;
    LAS bf16* KE = (LAS bf16*)(tot + 4 * 128); LAS bf16* VL = KE + 64 * KST;
    const int fr = F.lane & 15, fq = F.lane >> 4;
    for (int u = F.vcu; u < 264 * 8; u += F.G) {
        const int c = u >> 3, h = (u >> 1) & 3, dir = u & 1; const bool lat = c >= 8; const int pr = (c - 8) & 127;
        RowRaw kraw; f32x4 tb[8];
        { const int i = F.tid & 63, grp = F.tid >> 6; row16_load(P + (size_t)(64 * c + i) * PST + 512 + h * 128, grp, lat, kraw); ropetab_load(ROPE, grp, pr, i, lat, tb); }
        gla_cum(F, a, c, h, dir, cum, rt, tot);
        const int lastrow = dir == 0 ? 63 : 0;
        {
            const int i = F.tid & 63, grp = F.tid >> 6;
            float kv[16], cl[16], ci[16];
            rope16_apply(kraw, tb, grp, lat, kv);
            ld16cum(cum + lastrow * CST + 16 * grp, cl); ld16cum(cum + i * CST + 16 * grp, ci);
#pragma unroll
            for (int e = 0; e < 16; ++e) kv[e] *= __expf(cl[e] - ci[e]);
            st16bf(KE + i * KST + 16 * grp, kv);
            gla_stage_v(F, c, h, VL);
            if (F.tid < 128) DEC[((size_t)(dir * 264 + c) * 4 + h) * 128 + F.tid] = __expf(cum[lastrow * CST + F.tid]);
        }
        __syncthreads();
        f32x4 acc[16];
#pragma unroll
        for (int nt = 0; nt < 16; ++nt) acc[nt] = (f32x4){0.f, 0.f, 0.f, 0.f};
#pragma unroll
        for (int ks = 0; ks < 2; ++ks) { const bf16x8 af = tr_frag(KE, KST, 32 * ks, 16 * F.wave, F.lane);
#pragma unroll
            for (int nt = 0; nt < 16; ++nt) { const bf16x8 bfr = tr_frag(VL, VST, 32 * ks, 16 * nt, F.lane); acc[nt] = MFMA16(af, bfr, acc[nt]); } }
        bf16* dsp = DS + ((size_t)(dir * 264 + c) * 4 + h) * 256 * 128;
#pragma unroll
        for (int nt = 0; nt < 16; ++nt) { v2u o; o.x = pk2(acc[nt][0], acc[nt][1]); o.y = pk2(acc[nt][2], acc[nt][3]);
            *(GAS v2u*)(dsp + (size_t)((((nt * 4 + (F.wave >> 1)) * 4 + ((2 * F.wave + (fq >> 1)) & 3)) * 16 + fr) * 8 + 4 * (fq & 1))) = o; }
        __syncthreads();
    }
}
__device__ __forceinline__ void p_gla_scan(Frame& F) {
    const bf16* DS = (const bf16*)(F.ws + WS_DS); bf16* SIN = (bf16*)(F.ws + WS_SIN); const float* DEC = (const float*)(F.ws + WS_DEC);
    LAS float* dl = (LAS float*)(F.lds);
    for (int job = F.vcu; job < 256; job += F.G) {
        const int vt = job & 15, h = (job >> 4) & 3, dir = (job >> 6) & 1, b = job >> 7;
        __syncthreads();
        for (int i = F.tid; i < 132 * 32; i += NTHREADS) { const int st = i >> 5, k4 = i & 31; int c;
            if (dir == 0) c = st < 4 ? 4 * b + st : 8 + 128 * b + (st - 4); else c = st < 4 ? 4 * b + 3 - st : 8 + 128 * b + 127 - (st - 4);
            *(LAS f32x4*)(dl + st * 128 + 4 * k4) = *(const GAS f32x4*)(DEC + ((size_t)(dir * 264 + c) * 4 + h) * 128 + 4 * k4); }
        __syncthreads();
        const int ks = F.wave >> 1, quad = 2 * (F.wave & 1) + (F.lane >> 5), fr = (F.lane >> 1) & 15, half = F.lane & 1;
        const int kk0 = 32 * ks + 8 * quad + 4 * half;
        const size_t eoff = (size_t)((((vt * 4 + ks) * 4 + quad) * 16 + fr) * 8 + 4 * half);
        f32x4 S = (f32x4){0.f, 0.f, 0.f, 0.f};
        for (int s0 = 0; s0 < 132; s0 += 12) {
            size_t o[12]; v2u d[12];
#pragma unroll
            for (int q = 0; q < 12; ++q) { const int st = s0 + q; int c;
                if (dir == 0) c = st < 4 ? 4 * b + st : 8 + 128 * b + (st - 4); else c = st < 4 ? 4 * b + 3 - st : 8 + 128 * b + 127 - (st - 4);
                o[q] = ((size_t)(dir * 264 + c) * 4 + h) * 32768 + eoff;
                d[q] = __builtin_nontemporal_load((const GAS v2u*)(DS + o[q])); }
#pragma unroll
            for (int q = 0; q < 12; ++q) { const f32x4 dc = *(const LAS f32x4*)(dl + (s0 + q) * 128 + kk0);
                v2u so; so.x = pk2(S.x, S.y); so.y = pk2(S.z, S.w);
                *(GAS v2u*)(SIN + o[q]) = so;
                S.x = S.x * dc.x + bflo(d[q].x); S.y = S.y * dc.y + bfhi(d[q].x); S.z = S.z * dc.z + bflo(d[q].y); S.w = S.w * dc.w + bfhi(d[q].y); }
        }
    }
}
__device__ __forceinline__ void p_gla_out(Frame& F, const Args& a) {
    const bf16* P = (const bf16*)(F.ws + WS_BIG); const float* ROPE = (const float*)(F.ws + WS_ROPE);
    const bf16* SIN = (const bf16*)(F.ws + WS_SIN); bf16* G = (bf16*)(F.ws + WS_G);
    constexpr int ST = 72;
    LAS float* cum = (LAS float*)(F.lds); LAS float* rt = cum + 64 * CST; LAS float* tot = rt + 64 * 16; LAS float* ssq = tot + 4 * 128;
    LAS bf16* VL = (LAS bf16*)(ssq + 8 * 64); LAS bf16* QD = VL + 64 * VST; LAS bf16* KI = QD + 64 * KST; LAS bf16* PL = KI + 64 * KST;
    const int fr = F.lane & 15, fq = F.lane >> 4;
    for (int u = F.vcu; u < 264 * 4; u += F.G) {
        const int c = u >> 2, h = u & 3; const bool lat = c >= 8; const int pr = (c - 8) & 127;
        f32x4 acc[2][4];
#pragma unroll
        for (int mt = 0; mt < 2; ++mt)
#pragma unroll
            for (int nt = 0; nt < 4; ++nt) acc[mt][nt] = (f32x4){0.f, 0.f, 0.f, 0.f};
        gla_stage_v(F, c, h, VL);
        float qv0[16], kv0[16];
#pragma unroll
        for (int dir = 0; dir < 2; ++dir) {
            RowRaw qraw0, kraw0; f32x4 tb0[8];
            const bf16* sp = SIN + ((size_t)(dir * 264 + c) * 4 + h) * 256 * 128;
            bf16x8 sfr[4][2];
#pragma unroll
            for (int ks = 0; ks < 4; ++ks)
#pragma unroll
                for (int mt = 0; mt < 2; ++mt) sfr[ks][mt] = *(const GAS bf16x8*)(sp + (size_t)(((((2 * F.wave + mt) * 4 + ks) * 4 + fq) * 16 + fr) * 8));
            { const int i = F.tid & 63, grp = F.tid >> 6; const size_t row = (size_t)(64 * c + i);
                if (dir == 0) { row16_load(P + row * PST + h * 128, grp, lat, qraw0); row16_load(P + row * PST + 512 + h * 128, grp, lat, kraw0); ropetab_load(ROPE, grp, pr, i, lat, tb0); } }
            gla_cum(F, a, c, h, dir, cum, rt, tot);
            {
                const int i = F.tid & 63, grp = F.tid >> 6;
                if (dir == 0) { rope16_apply(qraw0, tb0, grp, lat, qv0); rope16_apply(kraw0, tb0, grp, lat, kv0); }
                float qv[16], kv[16], ci[16];
                ld16cum(cum + i * CST + 16 * grp, ci);
#pragma unroll
                for (int e = 0; e < 16; ++e) { const float ex = __expf(ci[e]); qv[e] = qv0[e] * (0.08838834764831845f * ex); kv[e] = kv0[e] * __builtin_amdgcn_rcpf(ex); }
                st16bf(QD + i * KST + 16 * grp, qv); st16bf(KI + i * KST + 16 * grp, kv);
            }
            __syncthreads();
            {
                const int jt = F.wave >> 1;
#pragma unroll
                for (int t2 = 0; t2 < 2; ++t2) { const int it = 2 * (F.wave & 1) + t2; f32x4 s = (f32x4){0.f, 0.f, 0.f, 0.f};
#pragma unroll
                    for (int ks = 0; ks < 4; ++ks) { const bf16x8 af = *(const LAS bf16x8*)(KI + (16 * jt + fr) * KST + ks * 32 + fq * 8), bfr = *(const LAS bf16x8*)(QD + (16 * it + fr) * KST + ks * 32 + fq * 8); s = MFMA16(af, bfr, s); }
                    const int i = 16 * it + fr, j0 = 16 * jt + fq * 4; float pv[4];
#pragma unroll
                    for (int r = 0; r < 4; ++r) { const int j = j0 + r; const bool keep = dir == 0 ? (j <= i) : (j >= i); pv[r] = keep ? s[r] : 0.0f; }
                    v2u o; o.x = pk2(pv[0], pv[1]); o.y = pk2(pv[2], pv[3]);
                    *(LAS v2u*)(PL + i * ST + j0) = o; }
            }
            __syncthreads();
#pragma unroll
            for (int ks = 0; ks < 2; ++ks) {
                bf16x8 bfr[4];
#pragma unroll
                for (int nt = 0; nt < 4; ++nt) bfr[nt] = perm_frag(PL + (16 * nt + fr) * ST, 32 * ks, fq);
#pragma unroll
                for (int mt = 0; mt < 2; ++mt) { const bf16x8 af = tr_frag(VL, VST, 32 * ks, 32 * F.wave + 16 * mt, F.lane);
#pragma unroll
                    for (int nt = 0; nt < 4; ++nt) acc[mt][nt] = MFMA16(af, bfr[nt], acc[mt][nt]); } }
#pragma unroll
            for (int ks = 0; ks < 4; ++ks) {
                bf16x8 bfr[4];
#pragma unroll
                for (int nt = 0; nt < 4; ++nt) bfr[nt] = *(const LAS bf16x8*)(QD + (16 * nt + fr) * KST + ks * 32 + fq * 8);
#pragma unroll
                for (int mt = 0; mt < 2; ++mt) {
#pragma unroll
                    for (int nt = 0; nt < 4; ++nt) acc[mt][nt] = MFMA16(sfr[ks][mt], bfr[nt], acc[mt][nt]); } }
            __syncthreads();
        }
#pragma unroll
        for (int nt = 0; nt < 4; ++nt) { float s = 0.f;
#pragma unroll
            for (int mt = 0; mt < 2; ++mt)
#pragma unroll
                for (int j = 0; j < 4; ++j) s += acc[mt][nt][j] * acc[mt][nt][j];
            s += __shfl_xor(s, 16); s += __shfl_xor(s, 32);
            if (fq == 0) ssq[F.wave * 64 + 16 * nt + fr] = s; }
        __syncthreads();
#pragma unroll
        for (int nt = 0; nt < 4; ++nt) { const int i = 16 * nt + fr; float s = 0.f;
#pragma unroll
            for (int w8 = 0; w8 < 8; ++w8) s += ssq[w8 * 64 + i];
            const float rstd = 1.0f / sqrtf(s * (1.0f / 256.0f) + EPS); const size_t row = (size_t)(64 * c + i);
#pragma unroll
            for (int mt = 0; mt < 2; ++mt) { const int v0 = 32 * F.wave + 16 * mt + fq * 4;
                const v2u gg = *(const GAS v2u*)(P + row * PST + 2048 + h * 256 + v0); const f32x4 go = *(const GAS f32x4*)(a.in[I_BGO] + v0);
                const float g0 = bflo(gg.x), g1 = bfhi(gg.x), g2 = bflo(gg.y), g3 = bfhi(gg.y);
                const float o0 = acc[mt][nt][0] * rstd * go.x * (g0 / (1.0f + __expf(-g0))), o1 = acc[mt][nt][1] * rstd * go.y * (g1 / (1.0f + __expf(-g1)));
                const float o2 = acc[mt][nt][2] * rstd * go.z * (g2 / (1.0f + __expf(-g2))), o3 = acc[mt][nt][3] * rstd * go.w * (g3 / (1.0f + __expf(-g3)));
                v2u o; o.x = pk2(o0, o1); o.y = pk2(o2, o3);
                *(GAS v2u*)(G + row * D + h * 256 + v0) = o; } }
        __syncthreads();
    }
}

__device__ __forceinline__ int na_koff(int key, int c16) { return key * 128 + ((c16 ^ ((key >> 1) & 7)) << 4); }
__device__ __forceinline__ int na_voff(int key, int c16) { return key * 128 + (((((c16 >> 1) ^ ((key >> 1) & 3)) << 1) | (c16 & 1)) << 4); }
__device__ __forceinline__ bf16x8 na_vfrag(const LAS unsigned char* V, int kb, int dt, int lane) {
    const int g = lane >> 4, w = lane & 15, q = w >> 2, p = w & 3; const int r0 = kb + 4 * g + q, r1 = r0 + 16;
    const s16x4 lo = __builtin_amdgcn_ds_read_tr16_b64_v4i16((LAS s16x4*)(V + r0 * 128 + ((dt ^ ((r0 >> 1) & 3)) << 5) + 8 * p));
    const s16x4 hi = __builtin_amdgcn_ds_read_tr16_b64_v4i16((LAS s16x4*)(V + r1 * 128 + ((dt ^ ((r1 >> 1) & 3)) << 5) + 8 * p));
    return (bf16x8){lo[0], lo[1], lo[2], lo[3], hi[0], hi[1], hi[2], hi[3]};
}
#define LBAR() do { asm volatile("s_waitcnt lgkmcnt(0)" ::: "memory"); __builtin_amdgcn_s_barrier(); asm volatile("" ::: "memory"); } while (0)
struct NaState { bf16x8 qf[2], qn[2]; f32x4 o[4]; float m_run, l_run; int cur_bh; };
__device__ __forceinline__ int na_r0(int r) { return r < 4 ? 0 : (r > 124 ? 120 : r - 4); }
__device__ __forceinline__ void na_load(Frame& F, int u_lo, int st, v4u (&kr)[3], v4u (&vr)[3]) {
    const bf16* QKV = (const bf16*)(F.ws + WS_BIG);
    const int u = u_lo + st / 3, pass = st % 3, bh = u >> 6, rp = u & 63, b = bh >> 4, h = bh & 15;
    const int rbase = na_r0(2 * rp) + 3 * pass;
#pragma unroll
    for (int i = 0; i < 3; ++i) { const int id = F.tid + 512 * i, key = id >> 3, c = id & 7; int row = rbase + (key >> 6); row = row > 127 ? 127 : row;
        const bf16* p = QKV + ((size_t)NCTX + (size_t)b * SEQ + (size_t)row * 64 + (key & 63)) * 3072 + 1024 + h * 64 + 8 * c; kr[i] = *(const GAS v4u*)p; vr[i] = *(const GAS v4u*)(p + 1024); }
}
__device__ __forceinline__ void na_loadq(Frame& F, int u, int fq, bf16x8 (&q)[2]) {
    const bf16* QKV = (const bf16*)(F.ws + WS_BIG);
    const int bh = u >> 6, rp = u & 63, b = bh >> 4, h = bh & 15, r = 2 * rp + (F.wave >> 2), qcol = 16 * (F.wave & 3) + (F.lane & 15);
#pragma unroll
    for (int ks = 0; ks < 2; ++ks) q[ks] = *(const GAS bf16x8*)(QKV + ((size_t)NCTX + (size_t)b * SEQ + (size_t)r * 64 + qcol) * 3072 + h * 64 + ks * 32 + fq * 8);
}
__device__ __forceinline__ void na_stage(Frame& F, const Args& a, const int u_lo, const int nstage, const int stage, v4u (&kr)[3], v4u (&vr)[3], NaState& S) {
    const bf16* QKV = (const bf16*)(F.ws + WS_BIG); bf16* G = (bf16*)(F.ws + WS_G);
    constexpr int QS = 3072;
    LAS unsigned char* KC = F.lds; LAS unsigned char* VC = F.lds + 32768; LAS unsigned char* KL = F.lds + 65536; LAS unsigned char* VL = F.lds + 65536 + 24576;
    LAS float* RPB = (LAS float*)(F.lds + 65536 + 49152);
    const int fr = F.lane & 15, fq = F.lane >> 4;
    const int qr = F.wave >> 2, jb = F.wave & 3;
    const int bstart = jb == 0 ? 0 : (jb == 1 ? 8 : (jb == 2 ? 24 : 32));
    const int qcol = 16 * jb + fr; const int cstart = qcol < 8 ? 0 : (qcol > 56 ? 48 : qcol - 8);
    const int u = u_lo + stage / 3, pass = stage % 3;
    const int bh = u >> 6, rp = u & 63, b = bh >> 4, h = bh & 15;
    const int r = 2 * rp + qr, r0q = na_r0(r), rbase = na_r0(2 * rp) + 3 * pass;
    const size_t lat0 = (size_t)NCTX + (size_t)b * SEQ;
    LBAR();
    if (bh != S.cur_bh) {
        S.cur_bh = bh;
        for (int i = F.tid; i < 465; i += NTHREADS) RPB[i] = a.in[I_CRPB][h * 465 + i];
#pragma unroll
        for (int i = 0; i < 4; ++i) { const int id = F.tid + 512 * i, key = id >> 3, c = id & 7;
            const bf16* p = QKV + (size_t)(b * CTXL + key) * QS + 1024 + h * 64 + 8 * c;
            *(LAS v4u*)(KC + na_koff(key, c)) = *(const GAS v4u*)p; *(LAS v4u*)(VC + na_voff(key, c)) = *(const GAS v4u*)(p + 1024); }
    }
#pragma unroll
    for (int i = 0; i < 3; ++i) { const int id = F.tid + 512 * i, key = id >> 3, c = id & 7;
        *(LAS v4u*)(KL + na_koff(key, c)) = kr[i]; *(LAS v4u*)(VL + na_voff(key, c)) = vr[i]; }
    if (pass == 0) {
        S.qf[0] = S.qn[0]; S.qf[1] = S.qn[1];
#pragma unroll
        for (int dt = 0; dt < 4; ++dt) S.o[dt] = (f32x4){0.f, 0.f, 0.f, 0.f};
        S.m_run = -3.0e38f; S.l_run = 0.f;
        if (stage + 3 < nstage) na_loadq(F, u + 1, fq, S.qn);
    }
    if (stage + 1 < nstage) na_load(F, u_lo, stage + 1, kr, vr);
    LBAR();
    f32x4 s[12];
#pragma unroll
    for (int t = 0; t < 6; ++t) { const int kidx = (t >> 1) * 64 + bstart + 16 * (t & 1) + fr;
        const bf16x8 k0 = *(const LAS bf16x8*)(KL + na_koff(kidx, fq)), k1 = *(const LAS bf16x8*)(KL + na_koff(kidx, 4 + fq));
        f32x4 tt = (f32x4){0.f, 0.f, 0.f, 0.f}; tt = MFMA16(k0, S.qf[0], tt); tt = MFMA16(k1, S.qf[1], tt); s[t] = tt; }
#pragma unroll
    for (int t = 0; t < 6; ++t) { const int kidx = (16 * (6 * pass + t) + fr) & 255;
        const bf16x8 k0 = *(const LAS bf16x8*)(KC + na_koff(kidx, fq)), k1 = *(const LAS bf16x8*)(KC + na_koff(kidx, 4 + fq));
        f32x4 tt = (f32x4){0.f, 0.f, 0.f, 0.f}; tt = MFMA16(k0, S.qf[0], tt); tt = MFMA16(k1, S.qf[1], tt); s[6 + t] = tt; }
    float mx = S.m_run;
    {
        float bias[24];
#pragma unroll
        for (int q = 0; q < 24; ++q) { const int t = q >> 2, j = q & 3; const int krow = rbase + (t >> 1), kcol = bstart + 16 * (t & 1) + fq * 4 + j;
            int ci = kcol - qcol + 15; ci = ci < 0 ? 0 : (ci > 30 ? 30 : ci); int ri = krow - r + 7; ri = ri < 0 ? 0 : (ri > 14 ? 14 : ri); bias[q] = RPB[ri * 31 + ci]; }
        asm volatile("" : "+v"(bias[0]), "+v"(bias[1]), "+v"(bias[2]), "+v"(bias[3]), "+v"(bias[4]), "+v"(bias[5]), "+v"(bias[6]), "+v"(bias[7]),
                          "+v"(bias[8]), "+v"(bias[9]), "+v"(bias[10]), "+v"(bias[11]), "+v"(bias[12]), "+v"(bias[13]), "+v"(bias[14]), "+v"(bias[15]));
        asm volatile("" : "+v"(bias[16]), "+v"(bias[17]), "+v"(bias[18]), "+v"(bias[19]), "+v"(bias[20]), "+v"(bias[21]), "+v"(bias[22]), "+v"(bias[23]));
#pragma unroll
        for (int q = 0; q < 24; ++q) { const int t = q >> 2, j = q & 3; const int krow = rbase + (t >> 1), kcol = bstart + 16 * (t & 1) + fq * 4 + j;
            const bool ok = kcol >= cstart && kcol < cstart + 16 && krow >= r0q && krow <= r0q + 7;
            const float v = ok ? s[t][j] * 0.125f + bias[q] : -3.0e38f;
            s[t][j] = v; mx = fmaxf(mx, v); }
    }
#pragma unroll
    for (int t = 0; t < 6; ++t) { const bool ok = 6 * pass + t < 16;
#pragma unroll
        for (int j = 0; j < 4; ++j) { const float v = ok ? s[6 + t][j] * 0.125f : -3.0e38f; s[6 + t][j] = v; mx = fmaxf(mx, v); } }
    mx = fmaxf(mx, __shfl_xor(mx, 16)); mx = fmaxf(mx, __shfl_xor(mx, 32));
    const float alpha = __expf(S.m_run - mx); S.m_run = mx;
    float l = 0.f;
#pragma unroll
    for (int t = 0; t < 12; ++t)
#pragma unroll
        for (int j = 0; j < 4; ++j) { const float p = s[t][j] > -1.0e38f ? __expf(s[t][j] - mx) : 0.0f; s[t][j] = p; l += p; }
    S.l_run = S.l_run * alpha + l;
#pragma unroll
    for (int dt = 0; dt < 4; ++dt) S.o[dt] = S.o[dt] * alpha;
#pragma unroll
    for (int st = 0; st < 6; ++st) {
        v4u pw; pw.x = pk2(s[2 * st][0], s[2 * st][1]); pw.y = pk2(s[2 * st][2], s[2 * st][3]); pw.z = pk2(s[2 * st + 1][0], s[2 * st + 1][1]); pw.w = pk2(s[2 * st + 1][2], s[2 * st + 1][3]);
        const bf16x8 pf = __builtin_bit_cast(bf16x8, pw);
        const LAS unsigned char* VB = st < 3 ? VL : VC;
        const int kb = st < 3 ? st * 64 + bstart : (16 * (6 * pass + 2 * (st - 3))) & 255;
#pragma unroll
        for (int dt = 0; dt < 4; ++dt) S.o[dt] = MFMA16(na_vfrag(VB, kb, dt, F.lane), pf, S.o[dt]);
    }
    if (pass == 2) {
        float lt = S.l_run; lt += __shfl_xor(lt, 16); lt += __shfl_xor(lt, 32);
        const float inv = 1.0f / lt;
        bf16* op = G + (lat0 + (size_t)r * 64 + qcol) * D + h * 64 + fq * 4;
#pragma unroll
        for (int dt = 0; dt < 4; ++dt) { v2u w; w.x = pk2(S.o[dt][0] * inv, S.o[dt][1] * inv); w.y = pk2(S.o[dt][2] * inv, S.o[dt][3] * inv); *(GAS v2u*)(op + 16 * dt) = w; }
    }
}
__device__ __forceinline__ void p_natten(Frame& F, const Args& a) {
    const int u_lo = (int)(((long)F.vcu * 2048) / F.G), u_hi = (int)(((long)(F.vcu + 1) * 2048) / F.G);
    const int nstage = 3 * (u_hi - u_lo);
    if (nstage <= 0) return;
    const int fq = F.lane >> 4;
    v4u kA[3], vA[3];
    NaState S; S.cur_bh = -1; S.m_run = -3.0e38f; S.l_run = 0.f;
#pragma unroll
    for (int dt = 0; dt < 4; ++dt) S.o[dt] = (f32x4){0.f, 0.f, 0.f, 0.f};
    na_loadq(F, u_lo, fq, S.qn); S.qf[0] = S.qn[0]; S.qf[1] = S.qn[1];
    na_load(F, u_lo, 0, kA, vA);
    for (int stage = 0; stage < nstage; ++stage) na_stage(F, a, u_lo, nstage, stage, kA, vA, S);
}

template <int MODE>
__device__ __forceinline__ void sgemm_region(Frame& F, const bf16* A, const bf16* Bt, int R0, int nrb, int C0, int ncb, bf16* O, int ldo, float* X, const float* gate, int u_first, int u_stride) {
    constexpr int ST = 264;
    LAS bf16* As = (LAS bf16*)(F.lds); LAS bf16* Bs = As + 64 * ST;
    const int fr = F.lane & 15, fq = F.lane >> 4, mt = F.wave >> 1, nt0 = 2 * (F.wave & 1);
    for (int u = u_first; u < nrb * ncb; u += u_stride) {
        const int rb = u % nrb, cb = u / nrb; const int r0 = R0 + 64 * rb, c0 = C0 + 64 * cb;
        pg8::f32x4 acc[2] = {(pg8::f32x4){0.f, 0.f, 0.f, 0.f}, (pg8::f32x4){0.f, 0.f, 0.f, 0.f}};
        v4u ra[4], rbv[4];
#pragma unroll
        for (int i = 0; i < 4; ++i) { const int id = F.tid + 512 * i, row = id >> 5, c = id & 31;
            ra[i] = *(const GAS v4u*)(A + (size_t)(r0 + row) * 1024 + 8 * c); rbv[i] = *(const GAS v4u*)(Bt + (size_t)(c0 + row) * 1024 + 8 * c); }
        for (int kc = 0; kc < 4; ++kc) {
            __syncthreads();
#pragma unroll
            for (int i = 0; i < 4; ++i) { const int id = F.tid + 512 * i, row = id >> 5, c = id & 31;
                *(LAS v4u*)(As + row * ST + 8 * c) = ra[i]; *(LAS v4u*)(Bs + row * ST + 8 * c) = rbv[i]; }
            if (kc < 3) {
#pragma unroll
                for (int i = 0; i < 4; ++i) { const int id = F.tid + 512 * i, row = id >> 5, c = id & 31;
                    ra[i] = *(const GAS v4u*)(A + (size_t)(r0 + row) * 1024 + 256 * (kc + 1) + 8 * c); rbv[i] = *(const GAS v4u*)(Bt + (size_t)(c0 + row) * 1024 + 256 * (kc + 1) + 8 * c); } }
            __syncthreads();
#pragma unroll
            for (int ks = 0; ks < 8; ++ks) { const bf16x8 af = *(const LAS bf16x8*)(As + (16 * mt + fr) * ST + ks * 32 + fq * 8);
#pragma unroll
                for (int n = 0; n < 2; ++n) { const bf16x8 bfr = *(const LAS bf16x8*)(Bs + (16 * (nt0 + n) + fr) * ST + ks * 32 + fq * 8); acc[n] = MFMA16(bfr, af, acc[n]); } }
        }
        const size_t row = (size_t)(r0 + 16 * mt + fr);
#pragma unroll
        for (int n = 0; n < 2; ++n) { const int col = c0 + 16 * (nt0 + n) + 4 * fq;
            if (MODE == 2) { f32x4* p = (f32x4*)(X + row * 1024 + col); const f32x4 g = *(const f32x4*)(gate + col); *p = *p + g * acc[n]; }
            else { f32x4 v = acc[n];
                if (MODE == 1) { const pg8::f32x2 a2 = pg8::gelu_pk((pg8::f32x2){v[0], v[1]}), b2 = pg8::gelu_pk((pg8::f32x2){v[2], v[3]}); v = (f32x4){a2.x, a2.y, b2.x, b2.y}; }
                v2u o; o.x = pk2(v[0], v[1]); o.y = pk2(v[2], v[3]); *(GAS v2u*)(O + row * ldo + col) = o; } }
    }
    __syncthreads();
}

__device__ __forceinline__ void ph_moe_gu(Frame& F, const Args& args, const int layer) {
    moe_tables(F, layer);
    const LAS int* Mt = (const LAS int*)(F.lds + MISC_OFF); const int total = Mt[32];
    pg8::Gemm g{(const bf16*)(F.ws + WS_H), (const bf16*)(F.ws + WS_WGU) + (size_t)layer * 32 * 2048 * 1024, total, 2048, D};
    pg8::GroupedOrder S; S.init(total, 2048, F.G, (int)blockIdx.x); S.tile_e = Mt + 64;
    pg8::EpiSwiglu E{(bf16*)(F.ws + WS_ACT), D, args.in[I_MBGU] + (size_t)layer * 32 * 2048, 2048};
    pg8::gemm_phase<pg8::EpiSwiglu, pg8::GroupedOrder, true>(F.lds + RING_OFF, g, S, E, (const unsigned*)(F.ws + WS_LIST), Mt, NTOK);
}
__device__ __forceinline__ void ph_moe_dn(Frame& F, const Args& args, const int layer) {
    moe_tables(F, layer);
    const LAS int* Mt = (const LAS int*)(F.lds + MISC_OFF); const int total = Mt[32];
    pg8::Gemm g{(const bf16*)(F.ws + WS_ACT), (const bf16*)(F.ws + WS_WDN) + (size_t)layer * 32 * 1024 * 1024, total, D, D};
    pg8::GroupedOrder S; S.init(total, D, F.G, (int)blockIdx.x); S.tile_e = Mt + 64;
    pg8::EpiBf16<0> E{(bf16*)(F.ws + WS_YB), D, args.in[I_MBDN] + (size_t)layer * 32 * 1024, 1024};
    pg8::gemm_phase<pg8::EpiBf16<0>, pg8::GroupedOrder>(F.lds + RING_OFF, g, S, E);
}
template <int LAYER> __device__ __forceinline__ void ph_ingemm(Frame& F) {
    constexpr int layer = LAYER, kind = layer % 3;
    const bf16* H = (const bf16*)(F.ws + WS_H);
    const bf16* A = H + (size_t)2 * 256 * D; constexpr int M = 64 * 256;
    if constexpr (kind == 0) {
        const bf16* Bt = (const bf16*)(F.ws + WS_WAIN) + (size_t)(layer / 3) * 2048 * 1024;
        pg8::Gemm g{A, Bt, M, 2048, D}; pg8::StaticOrder S; S.init(M, 2048, F.G, (int)blockIdx.x);
        pg8::EpiBf16<1> E{(bf16*)(F.ws + WS_BIG) + (size_t)2 * 256 * 2048, 2048, nullptr, 0};
        pg8::gemm_phase<pg8::EpiBf16<1>, pg8::StaticOrder>(F.lds + RING_OFF, g, S, E);
        if constexpr (layer < 3) sgemm_region<1>(F, H, Bt, 0, 8, 0, 32, (bf16*)(F.ws + WS_BIG), 2048, nullptr, nullptr, F.vcu, F.G);
    } else if constexpr (kind == 1) {
        const bf16* Bt = (const bf16*)(F.ws + WS_WBIN);
        pg8::Gemm g{A, Bt, M, 3072, D}; pg8::StaticOrder S; S.init(M, 3072, F.G, (int)blockIdx.x);
        pg8::EpiBf16<0> E{(bf16*)(F.ws + WS_BIG) + (size_t)2 * 256 * GLA_INP, GLA_INP, nullptr, 0};
        pg8::gemm_phase<pg8::EpiBf16<0>, pg8::StaticOrder>(F.lds + RING_OFF, g, S, E);
        sgemm_region<0>(F, H, Bt, 0, 8, 0, 48, (bf16*)(F.ws + WS_BIG), GLA_INP, nullptr, nullptr, F.vcu, F.G);
        sgemm_region<0>(F, H, Bt, 0, 264, 3072, 1, (bf16*)(F.ws + WS_BIG), GLA_INP, nullptr, nullptr, (F.vcu + 128) % F.G, F.G);
    } else {
        const bf16* Bt = (const bf16*)(F.ws + WS_WCQKV);
        pg8::Gemm g{A, Bt, M, 3072, D}; pg8::StaticOrder S; S.init(M, 3072, F.G, (int)blockIdx.x);
        pg8::EpiBf16<0> E{(bf16*)(F.ws + WS_BIG) + (size_t)2 * 256 * 3072, 3072, nullptr, 0};
        pg8::gemm_phase<pg8::EpiBf16<0>, pg8::StaticOrder>(F.lds + RING_OFF, g, S, E);
        sgemm_region<0>(F, H, Bt, 0, 8, 1024, 32, (bf16*)(F.ws + WS_BIG), 3072, nullptr, nullptr, F.vcu, F.G);
    }
}

#define IN(k) (lo <= (k) && (k) < hi)
#define SEAM(k) do { if (IN(k) && IN((k) + 1)) { xcd_barrier(bar); if (PROBE_BAR) xcd_barrier(bar); } else __syncthreads(); } while (0)
template <int LAYER> __device__ __forceinline__ void run_layer(Frame& F, const Args& args, const XcdBarrier& bar, const int lo, const int hi) {
    {
        constexpr int layer = LAYER; constexpr int kind = layer % 3, base = 1 + 10 * layer;
        constexpr int mt0 = (layer >= 3) ? 2 : 0;
        constexpr int mo0 = (layer >= 2) ? 2 : 0;
        if (IN(base + 0)) { p_prenorm(F, args, layer, false);
#if PROBE_TOK
            __syncthreads(); p_prenorm(F, args, layer, false, true);
#endif
        } SEAM(base + 0);
        if (IN(base + 1)) { ph_ingemm<LAYER>(F);
#if PROBE_ING
            __syncthreads(); ph_ingemm<LAYER>(F);
#endif
        }
        SEAM(base + 1);
        if (IN(base + 2)) for (int rep = 0; rep < 1 + (kind == 1 ? PROBE_GLA : (kind == 0 ? PROBE_MIX : PROBE_NAT)); ++rep) { if (rep) __syncthreads(); if constexpr (kind == 0) p_spatial(F, args, layer); else if constexpr (kind == 1) p_gla_ds(F, args); else p_natten(F, args); } SEAM(base + 2);
        if constexpr (kind == 1) { if (IN(base + 3)) for (int rep = 0; rep < 1 + PROBE_GLA; ++rep) { p_gla_scan(F); } SEAM(base + 3); }
        if constexpr (kind == 1) { if (IN(base + 4)) for (int rep = 0; rep < 1 + PROBE_GLA; ++rep) { if (rep) __syncthreads(); p_gla_out(F, args); } SEAM(base + 4); }
        if (IN(base + 5)) {
            constexpr int M = 64 * 256;
            const bf16* Bt = (const bf16*)(F.ws + (kind == 0 ? WS_WAOUT : (kind == 1 ? WS_WBOUT : WS_WCOUT))) + (kind == 0 ? (size_t)(layer / 3) * 1024 * 1024 : 0);
            const float* gate = (const float*)(F.ws + WS_ADA) + (size_t)(layer * 3 * 6 + 2) * D;
            pg8::Gemm g{(const bf16*)(F.ws + WS_G) + (size_t)2 * 256 * D, Bt, M, D, D}; pg8::StaticOrder S; S.init(M, D, F.G, (int)blockIdx.x);
            pg8::EpiResid E{(float*)(F.ws + WS_X) + (size_t)2 * 256 * D, gate, 6 * D, 2, false};
            pg8::gemm_phase<pg8::EpiResid, pg8::StaticOrder>(F.lds + RING_OFF, g, S, E);
#if PROBE_OUTG
            { __syncthreads(); pg8::EpiResid E2{(float*)(F.ws + WS_X) + (size_t)2 * 256 * D, gate, 6 * D, 2, true}; pg8::gemm_phase<pg8::EpiResid, pg8::StaticOrder>(F.lds + RING_OFF, g, S, E2); }
#endif
            if constexpr (layer < 2) sgemm_region<2>(F, (const bf16*)(F.ws + WS_G), Bt, 0, 8, 0, 16, nullptr, 0, (float*)(F.ws + WS_X), gate, F.vcu, F.G);
        }
        SEAM(base + 5);
        if (IN(base + 6)) { p_router(F, args, layer);
#if PROBE_TOK
            __syncthreads(); p_router(F, args, layer, true);
#endif
        } SEAM(base + 6);
        if (IN(base + 8)) { ph_moe_gu(F, args, layer);
#if PROBE_MOE
            __syncthreads(); ph_moe_gu(F, args, layer);
#endif
        }
        SEAM(base + 8);
        if (IN(base + 9)) { ph_moe_dn(F, args, layer);
#if PROBE_MOE
            __syncthreads(); ph_moe_dn(F, args, layer);
#endif
        }
        SEAM(base + 9);
    }
}

__global__ void __launch_bounds__(NTHREADS, 2) fwd(Args args) {
    extern __shared__ __attribute__((aligned(16))) unsigned char lds[];
    Frame F;
    F.lds = (LAS unsigned char*)lds;
    F.tid = threadIdx.x; F.lane = F.tid & 63; F.wave = __builtin_amdgcn_readfirstlane(F.tid >> 6);
    F.G = gridDim.x; { const int bx = blockIdx.x; F.vcu = (F.G % 8 == 0) ? (bx % 8) * (F.G / 8) + bx / 8 : bx; }
    F.ws = args.ws; F.ctl = (unsigned*)(args.ws + WS_CTL);
    volatile LAS unsigned* BST = (volatile LAS unsigned*)(F.lds + LDS_BYTES - 16);
    if (F.tid < 4) BST[F.tid] = 0u;
    __syncthreads();
    const int lo = args.ph_lo, hi = args.ph_hi;
    XcdBarrier bar; bar.bar = (unsigned*)(F.ctl + CW_BAR); bar.x = 0; bar.st = BST;
    if (hi - lo > 1) bar = xcd_barrier_post((unsigned*)(F.ctl + CW_BAR), BST);
    if (IN(0)) { p_prologue(F, args);
#if PROBE_PRO
        __syncthreads(); p_prologue(F, args);
#endif
    } SEAM(0);

    run_layer<0>(F, args, bar, lo, hi);
    run_layer<1>(F, args, bar, lo, hi);
    run_layer<2>(F, args, bar, lo, hi);
    run_layer<3>(F, args, bar, lo, hi);
    if (IN(41)) { p_prenorm(F, args, 4, true); }
#undef IN
#undef SEAM
}

extern "C" void kernel_launch(void* const* d_in, const int* in_sizes, int n_in, void* d_out, int out_size, void* d_ws, size_t ws_size, hipStream_t stream) {
    static int grid = 0;
    if (grid == 0) {
        if (n_in != 28 || out_size != NLAT * D || ws_size < WS_END) { fprintf(stderr, "kernel_launch: unexpected problem (n_in %d, out %d, ws %zu < %zu)\n", n_in, out_size, ws_size, (size_t)WS_END); grid = -1; return; }
        int dev = 0, cus = 0, per_cu = 0;
        if (hipGetDevice(&dev) != hipSuccess || hipDeviceGetAttribute(&cus, hipDeviceAttributeMultiprocessorCount, dev) != hipSuccess) { grid = -1; return; }
        if (hipFuncSetAttribute((const void*)fwd, hipFuncAttributeMaxDynamicSharedMemorySize, LDS_BYTES) != hipSuccess) { fprintf(stderr, "kernel_launch: hipFuncSetAttribute failed\n"); grid = -1; return; }
        if (hipOccupancyMaxActiveBlocksPerMultiprocessor(&per_cu, (const void*)fwd, NTHREADS, LDS_BYTES) != hipSuccess || per_cu < 1) { fprintf(stderr, "kernel_launch: occupancy query reports %d\n", per_cu); }
        (void)hipGetLastError();
        grid = cus;
    }
    if (grid < 0) return;
    (void)hipMemsetAsync((char*)d_ws + WS_CTL, 0, CTL_ZERO_BYTES, stream);
    Args a{};
    for (int i = 0; i < 28; ++i) a.in[i] = (const float*)d_in[i];
    a.out = (float*)d_out; a.ws = (unsigned char*)d_ws;
#if MK_ONE_LAUNCH
    a.ph_lo = 0; a.ph_hi = 42;
    hipLaunchKernelGGL(fwd, dim3(grid), dim3(NTHREADS), LDS_BYTES, stream, a);
#else
    for (int p = 0; p < 42; ++p) {
        if (p >= 1 && p <= 40) { const int layer = (p - 1) / 10, loc = (p - 1) % 10; if (((loc == 3 || loc == 4) && (layer % 3) != 1) || loc == 7) continue; }
        a.ph_lo = p; a.ph_hi = p + 1;
        hipLaunchKernelGGL(fwd, dim3(grid), dim3(NTHREADS), LDS_BYTES, stream, a);
    }
#endif
}
```

```cpp
#include <hip/hip_runtime.h>
#include <cstdio>
#include <cstdint>

#ifndef MK_ONE_LAUNCH
#define MK_ONE_LAUNCH 1
#endif
#ifndef PROBE_PRO
#define PROBE_PRO 0
#endif
#ifndef PROBE_MOE
#define PROBE_MOE 0
#endif
#ifndef PROBE_ING
#define PROBE_ING 0
#endif
#ifndef PROBE_MIX
#define PROBE_MIX 0
#endif
#ifndef PROBE_GLA
#define PROBE_GLA 0
#endif
#ifndef PROBE_TOK
#define PROBE_TOK 0
#endif
#ifndef PROBE_BAR
#define PROBE_BAR 0
#endif
#ifndef PROBE_OUTG
#define PROBE_OUTG 0
#endif
#ifndef PROBE_NAT
#define PROBE_NAT 0
#endif
#ifndef PROBE_GATHER
#define PROBE_GATHER 0
#endif

namespace pg8 {
#define PG8_LAS __attribute__((address_space(3)))
typedef unsigned short bf16_t;
typedef short bf16x8 __attribute__((ext_vector_type(8)));
typedef float f32x4 __attribute__((ext_vector_type(4)));
typedef unsigned u32x4 __attribute__((ext_vector_type(4)));
constexpr int BM = 256, BK = 64, HALF = 128, HTB = HALF * BK * 2, STAGE_BYTES = 8 * HTB, NXCD = 8, WGM = 8;

__host__ __device__ __forceinline__ int lds_byte(int r, int c) { const int st = (r >> 4) * 2 + (c >> 5), rr = r & 15, cc = c & 31, ob = rr * 64 + cc * 2; return st * 1024 + (ob ^ (((ob >> 9) & 1) << 5)); }
__host__ __device__ __forceinline__ void stage_rc(int b, int& R, int& C) { const int st = b / 1024, sb = b % 1024, swz = sb ^ (((sb >> 9) & 1) << 5); R = (st >> 1) * 16 + swz / 64; C = (st & 1) * 32 + (swz % 64) / 2; }
__host__ __device__ __forceinline__ int perm32(int rho) { const int n = rho >> 4, i = rho & 15; return 8 * (i >> 2) + 4 * n + (i & 3); }

struct Unit { int pm, pn, pb, e; };
struct Gemm { const bf16_t* A; const bf16_t* Bt; int M, N, K; };

struct StaticOrder {
    int nM, nN, nwg, G, c;
    __device__ void init(int M, int N, int G_, int c_) { nM = M / BM; nN = N / BM; nwg = nM * nN; G = G_; c = c_; }
    __device__ bool next(int i, Unit& u) const {
        const long L = (long)i * G + c; if (L >= nwg) return false;
        int wgid = (int)L; { const int q = nwg / NXCD, r = nwg % NXCD, xcd = wgid % NXCD, off = wgid / NXCD; wgid = (xcd < r ? xcd * (q + 1) : r * (q + 1) + (xcd - r) * q) + off; }
        const int nig = WGM * nN, gid = wgid / nig, fm = gid * WGM, gsz = (nM - fm) < WGM ? (nM - fm) : WGM;
        u.pm = fm + ((wgid % nig) % gsz); u.pn = (wgid % nig) / gsz; u.pb = u.pn; u.e = 0; return true;
    }
};
struct GroupedOrder : StaticOrder {
    const PG8_LAS int* tile_e;
    __device__ bool next(int i, Unit& u) const {
        if (!StaticOrder::next(i, u)) return false;
        u.e = __builtin_amdgcn_readfirstlane(tile_e[u.pm]); u.pb = u.e * nN + u.pn; return true;
    }
};

__device__ __forceinline__ unsigned cvt_pk_bf16(float lo, float hi) { unsigned r; asm volatile("v_cvt_pk_bf16_f32 %0, %1, %2" : "=v"(r) : "v"(lo), "v"(hi)); return r; }
typedef float f32x2 __attribute__((ext_vector_type(2)));
__device__ __forceinline__ f32x2 gelu_pk(f32x2 v) {
    const f32x2 av = __builtin_elementwise_abs(v), d = av * 0.2316418882f + 1.0f;
    f32x2 t; t.x = __builtin_amdgcn_rcpf(d.x); t.y = __builtin_amdgcn_rcpf(d.y);
    f32x2 q = t * 0.5307027145f + (-0.7265760135f); q = q * t + 0.7107068705f; q = q * t + (-0.142248368f); q = q * t + 0.127414796f; q = q * t;
    const f32x2 s = (v * v) * (-0.72134752044f);
    f32x2 e; e.x = __builtin_amdgcn_exp2f(s.x); e.y = __builtin_amdgcn_exp2f(s.y);
    const f32x2 m = v * (q * e), r = v - m;
    f32x2 o; o.x = v.x < 0.f ? m.x : r.x; o.y = v.y < 0.f ? m.y : r.y; return o;
}

template <int ACT> struct EpiBf16 {
    static constexpr bool PERM = true;
    bf16_t* O; int ldc; const float* bias; int bias_estride;
    __device__ __forceinline__ void operator()(const f32x4 (&acc)[2][2][4][2], const Unit& u, int wr, int wc, int fr, int fq) const {
        const int row0 = u.pm * BM + wr * 64 + fr; const int col0 = u.pn * BM + wc * 32 + 8 * fq;
        const float* bp = bias ? bias + (size_t)u.e * bias_estride : nullptr;
        f32x4 bv[2][2];
#pragma unroll
        for (int bj = 0; bj < 2; ++bj)
#pragma unroll
            for (int n = 0; n < 2; ++n) bv[bj][n] = bp ? *(const f32x4*)(bp + col0 + bj * HALF + 4 * n) : (f32x4){0.f, 0.f, 0.f, 0.f};
#pragma unroll
        for (int ai = 0; ai < 2; ++ai)
#pragma unroll
            for (int m = 0; m < 4; ++m) { bf16_t* rowp = O + (size_t)(row0 + ai * HALF + m * 16) * ldc + col0;
#pragma unroll
                for (int bj = 0; bj < 2; ++bj) { f32x4 v0 = acc[ai][bj][m][0] + bv[bj][0], v1 = acc[ai][bj][m][1] + bv[bj][1];
                    if (ACT == 1) { f32x2 a = gelu_pk((f32x2){v0[0], v0[1]}), b = gelu_pk((f32x2){v0[2], v0[3]}), c = gelu_pk((f32x2){v1[0], v1[1]}), d = gelu_pk((f32x2){v1[2], v1[3]});
                        v0 = (f32x4){a.x, a.y, b.x, b.y}; v1 = (f32x4){c.x, c.y, d.x, d.y}; }
                    u32x4 w; w.x = cvt_pk_bf16(v0[0], v0[1]); w.y = cvt_pk_bf16(v0[2], v0[3]); w.z = cvt_pk_bf16(v1[0], v1[1]); w.w = cvt_pk_bf16(v1[2], v1[3]);
                    *(u32x4*)(rowp + bj * HALF) = w; } }
    }
};
struct EpiSwiglu {
    static constexpr bool PERM = true;
    bf16_t* O; int ldc; const float* bias; int bias_estride;
    __device__ __forceinline__ void operator()(const f32x4 (&acc)[2][2][4][2], const Unit& u, int wr, int wc, int fr, int fq) const {
        const int row0 = u.pm * BM + wr * 64 + fr; const int col0 = u.pn * HALF + wc * 32 + 8 * fq;
        const float* bp = bias + (size_t)u.e * bias_estride;
        f32x4 bg[2], bl[2];
#pragma unroll
        for (int n = 0; n < 2; ++n) { bg[n] = *(const f32x4*)(bp + col0 + 4 * n); bl[n] = *(const f32x4*)(bp + 1024 + col0 + 4 * n); }
#pragma unroll
        for (int ai = 0; ai < 2; ++ai)
#pragma unroll
            for (int m = 0; m < 4; ++m) { bf16_t* rowp = O + (size_t)(row0 + ai * HALF + m * 16) * ldc + col0;
                float o[8];
#pragma unroll
                for (int n = 0; n < 2; ++n) { const f32x4 g4 = acc[ai][0][m][n] + bg[n], l4 = acc[ai][1][m][n] + bl[n];
#pragma unroll
                    for (int i = 0; i < 4; ++i) { const float g = fminf(g4[i], 7.0f), l = fminf(fmaxf(l4[i], -7.0f), 7.0f);
                        const float sg = __builtin_amdgcn_rcpf(1.0f + __builtin_amdgcn_exp2f(-1.702f * 1.44269504089f * g));
                        o[4 * n + i] = g * sg * (l + 1.0f); } }
                u32x4 w; w.x = cvt_pk_bf16(o[0], o[1]); w.y = cvt_pk_bf16(o[2], o[3]); w.z = cvt_pk_bf16(o[4], o[5]); w.w = cvt_pk_bf16(o[6], o[7]);
                *(u32x4*)rowp = w; }
    }
};
struct EpiResid {
    static constexpr bool PERM = false;
    float* X; const float* gate; int gstride; int pm0; bool dry;
    __device__ __forceinline__ void operator()(const f32x4 (&acc)[2][2][4][2], const Unit& u, int wr, int wc, int fr, int fq) const {
        const int t = u.pm + pm0; const int seg = t < 2 ? 0 : (t < 34 ? 1 : 2);
        const int row0 = u.pm * BM + wr * 64 + fr, col0 = u.pn * BM + wc * 32 + 4 * fq;
        const float* gp = gate + (size_t)seg * gstride;
        f32x4 gv[2][2];
#pragma unroll
        for (int bj = 0; bj < 2; ++bj)
#pragma unroll
            for (int n = 0; n < 2; ++n) gv[bj][n] = *(const f32x4*)(gp + col0 + bj * HALF + n * 16);
#pragma unroll
        for (int ai = 0; ai < 2; ++ai)
#pragma unroll
            for (int m = 0; m < 4; ++m) { float* rowp = X + (size_t)(row0 + ai * HALF + m * 16) * 1024 + col0;
#pragma unroll
                for (int bj = 0; bj < 2; ++bj)
#pragma unroll
                    for (int n = 0; n < 2; ++n) { f32x4* p = (f32x4*)(rowp + bj * HALF + n * 16); const f32x4 nv = *p + gv[bj][n] * acc[ai][bj][m][n]; if (!dry) *p = nv; else if (nv[0] == 1.2345e30f) *p = nv; } }
    }
};

template <class Epi, class Sched, bool GATHER = false>
__device__ __forceinline__ void gemm_phase(PG8_LAS unsigned char* lds, const Gemm g, const Sched& S, const Epi& E, const unsigned* glist = nullptr, const PG8_LAS int* gM = nullptr, int gstride = 0) {
    const int tid = threadIdx.x, wid = __builtin_amdgcn_readfirstlane(tid >> 6), lane = tid & 63, wr = wid >> 2, wc = wid & 3, fr = lane & 15, fq = lane >> 4;
    const int K = g.K, nt = K / BK;
    unsigned voffB[2], va[2][2], vn[2][2]; int aR[2], aC[2];
#pragma unroll
    for (int i = 0; i < 2; ++i) { int R, C; stage_rc(tid * 16 + i * 8192, R, C); const int Rb = Epi::PERM ? ((R & ~31) + perm32(R & 31)) : R;
        aR[i] = R; aC[i] = C; voffB[i] = (unsigned)(Rb * K + C) * 2u;
#pragma unroll
        for (int h = 0; h < 2; ++h) { va[h][i] = (unsigned)((HALF * h + R) * K + C) * 2u; vn[h][i] = va[h][i]; } }
#define PG8_GOFF(u, dst) do { if constexpr (GATHER) { const int _e = (u).e, _p0 = (u).pm * BM - gM[_e], _c1 = gM[400 + _e] - 1; _Pragma("unroll") for (int _h = 0; _h < 2; ++_h) _Pragma("unroll") for (int _i = 0; _i < 2; ++_i) { \
        int _rk = _p0 + HALF * _h + aR[_i]; _rk = _rk < _c1 ? _rk : _c1; const unsigned _tok = glist[(size_t)_e * gstride + _rk]; dst[_h][_i] = (_tok * (unsigned)K + (unsigned)aC[_i]) * 2u; } } } while (0)
#define PG8_GTOK(u, dst) do { const int _e = (u).e, _p0 = (u).pm * BM - gM[_e], _c1 = gM[400 + _e] - 1; _Pragma("unroll") for (int _h = 0; _h < 2; ++_h) _Pragma("unroll") for (int _i = 0; _i < 2; ++_i) { \
        int _rk = _p0 + HALF * _h + aR[_i]; _rk = _rk < _c1 ? _rk : _c1; dst[_h][_i] = glist[(size_t)_e * gstride + _rk]; } } while (0)
    const size_t kstep = (size_t)(BK * 2);
    const size_t hstep = (size_t)HALF * K * 2;
    const size_t tstep = 2 * hstep;
    const unsigned ldsw = (unsigned)wid * 1024u;
    const int aoff = lds_byte(wr * 64 + fr, fq * 8), boff = lds_byte(wc * 32 + fr, fq * 8);
#define PG8_SA(b, h) (((b) * 2 + (h)) * HTB)
#define PG8_SB(b, h) ((4 + (b) * 2 + (h)) * HTB)
#define PG8_STAGE(bufoff, gbase, voff) do { _Pragma("unroll") for (int _i = 0; _i < 2; ++_i) \
        __builtin_amdgcn_global_load_lds((const unsigned*)((const char*)(gbase) + (voff)[_i]), (PG8_LAS unsigned*)(lds + (bufoff) + ldsw + _i * 8192), 16, 0, 0); } while (0)
#define PG8_LDA(dst, b, h) do { _Pragma("unroll") for (int m = 0; m < 4; ++m) _Pragma("unroll") for (int k = 0; k < 2; ++k) dst[m][k] = *(const PG8_LAS bf16x8*)(lds + PG8_SA(b, h) + aoff + m * 2048 + k * 1024); } while (0)
#define PG8_LDB(dst, b, h) do { _Pragma("unroll") for (int n = 0; n < 2; ++n) _Pragma("unroll") for (int k = 0; k < 2; ++k) dst[n][k] = *(const PG8_LAS bf16x8*)(lds + PG8_SB(b, h) + boff + n * 2048 + k * 1024); } while (0)
#define PG8_MMA(ai, bj, At, Bt) do { __builtin_amdgcn_s_setprio(1); _Pragma("unroll") for (int m = 0; m < 4; ++m) _Pragma("unroll") for (int n = 0; n < 2; ++n) _Pragma("unroll") for (int k = 0; k < 2; ++k) \
        acc[ai][bj][m][n] = __builtin_amdgcn_mfma_f32_16x16x32_bf16(Bt[n][k], At[m][k], acc[ai][bj][m][n], 0, 0, 0); __builtin_amdgcn_s_setprio(0); } while (0)
#define PG8_WAIT_V(n) asm volatile("s_waitcnt vmcnt(" #n ")" ::: "memory")
#define PG8_WAIT_L(n) asm volatile("s_waitcnt lgkmcnt(" #n ")" ::: "memory")
#define PG8_BAR __builtin_amdgcn_s_barrier()
#define PG8_SCHED __builtin_amdgcn_sched_barrier(0)
    Unit cur, nxt, nx2; int ui = 0; bool has_next = false, has_nx2 = false;
    if (!S.next(0, cur)) return;
    f32x4 acc[2][2][4][2];
#pragma unroll
    for (int a = 0; a < 2; ++a)
#pragma unroll
        for (int b = 0; b < 2; ++b)
#pragma unroll
            for (int m = 0; m < 4; ++m)
#pragma unroll
                for (int n = 0; n < 2; ++n) acc[a][b][m][n] = (f32x4){0.f, 0.f, 0.f, 0.f};
    bf16x8 At[4][2], B0[2][2], B1[2][2];
    const char* cA = (const char*)g.A + (GATHER ? (size_t)0 : (size_t)cur.pm * tstep); const char* cB = (const char*)g.Bt + (size_t)cur.pb * tstep;
    PG8_GOFF(cur, va);
    if constexpr (GATHER) { has_next = S.next(1, nxt); if (has_next) PG8_GOFF(nxt, vn); }
    PG8_STAGE(PG8_SB(0, 0), cB, voffB); PG8_STAGE(PG8_SB(0, 1), cB + hstep, voffB); PG8_STAGE(PG8_SA(0, 0), cA, va[0]); PG8_STAGE(PG8_SA(0, 1), cA, va[1]);
    if (wr == 1) PG8_BAR;
    PG8_WAIT_V(2); PG8_BAR;
    PG8_STAGE(PG8_SB(1, 0), cB + kstep, voffB); PG8_STAGE(PG8_SA(1, 0), cA + kstep, va[0]); PG8_STAGE(PG8_SB(1, 1), cB + hstep + kstep, voffB);
    PG8_WAIT_V(6); PG8_BAR;
    for (;;) {
        if constexpr (!GATHER) has_next = S.next(ui + 1, nxt);
        const char* nA = (has_next && !GATHER) ? (const char*)g.A + (size_t)nxt.pm * tstep : cA; const char* nB = has_next ? (const char*)g.Bt + (size_t)nxt.pb * tstep : cB;
        for (int t = 0; t < nt; t += 2) {
            const bool last = (t == nt - 2);
            const char* a1 = cA + (size_t)(t + 1) * kstep;
            const char* a2 = last ? nA : cA + (size_t)(t + 2) * kstep; const char* b2 = last ? nB : cB + (size_t)(t + 2) * kstep;
            const char* a3 = a2 + kstep; const char* b3 = b2 + kstep;
            unsigned v2[2][2];
#pragma unroll
            for (int _h = 0; _h < 2; ++_h)
#pragma unroll
                for (int _i = 0; _i < 2; ++_i) v2[_h][_i] = (GATHER && last) ? vn[_h][_i] : va[_h][_i];
            PG8_LDB(B0, 0, 0); PG8_LDB(B1, 0, 1); PG8_SCHED; PG8_LDA(At, 0, 0); PG8_STAGE(PG8_SA(1, 1), a1, va[1]);
            PG8_WAIT_V(8); PG8_WAIT_L(0); PG8_BAR; PG8_MMA(0, 0, At, B0); PG8_MMA(0, 1, At, B1); PG8_BAR; PG8_SCHED;
            PG8_LDA(At, 0, 1); PG8_STAGE(PG8_SB(0, 0), b2, voffB); PG8_STAGE(PG8_SB(0, 1), b2 + hstep, voffB); PG8_STAGE(PG8_SA(0, 0), a2, v2[0]);
            PG8_WAIT_V(8); PG8_WAIT_L(0); PG8_BAR; PG8_MMA(1, 0, At, B0); PG8_MMA(1, 1, At, B1); PG8_BAR; PG8_SCHED;
            PG8_LDB(B0, 1, 0); PG8_LDB(B1, 1, 1); PG8_SCHED; PG8_LDA(At, 1, 0); PG8_STAGE(PG8_SA(0, 1), a2, v2[1]);
            PG8_WAIT_V(8); PG8_WAIT_L(0); PG8_BAR; PG8_MMA(0, 0, At, B0); PG8_MMA(0, 1, At, B1); PG8_BAR; PG8_SCHED;
            PG8_LDA(At, 1, 1); PG8_STAGE(PG8_SB(1, 0), b3, voffB); PG8_STAGE(PG8_SB(1, 1), b3 + hstep, voffB); PG8_STAGE(PG8_SA(1, 0), a3, v2[0]);
            PG8_WAIT_V(8); PG8_WAIT_L(0); PG8_BAR; PG8_MMA(1, 0, At, B0); PG8_MMA(1, 1, At, B1); PG8_BAR; PG8_SCHED;
        }
        if (wr == 0) PG8_BAR;
        unsigned tk[2][2] = {{0u, 0u}, {0u, 0u}};
        if constexpr (GATHER) { has_nx2 = has_next && S.next(ui + 2, nx2); if (!has_nx2) nx2 = cur; PG8_GTOK(nx2, tk); }
        E(acc, cur, wr, wc, fr, fq);
        if (!has_next) break;
#pragma unroll
        for (int a = 0; a < 2; ++a)
#pragma unroll
            for (int b = 0; b < 2; ++b)
#pragma unroll
                for (int m = 0; m < 4; ++m)
#pragma unroll
                    for (int n = 0; n < 2; ++n) acc[a][b][m][n] = (f32x4){0.f, 0.f, 0.f, 0.f};
        cur = nxt; cA = nA; cB = nB; ++ui;
        if constexpr (GATHER) { va[0][0] = vn[0][0]; va[0][1] = vn[0][1]; va[1][0] = vn[1][0]; va[1][1] = vn[1][1];
            if (has_nx2) { nxt = nx2;
#pragma unroll
                for (int _h = 0; _h < 2; ++_h)
#pragma unroll
                    for (int _i = 0; _i < 2; ++_i) vn[_h][_i] = (tk[_h][_i] * (unsigned)K + (unsigned)aC[_i]) * 2u; }
            has_next = has_nx2; }
        if (wr == 1) PG8_BAR;
    }
    PG8_WAIT_V(0);
    PG8_BAR;
#undef PG8_SA
#undef PG8_SB
#undef PG8_STAGE
#undef PG8_GOFF
#undef PG8_GTOK
#undef PG8_LDA
#undef PG8_LDB
#undef PG8_MMA
#undef PG8_WAIT_V
#undef PG8_WAIT_L
#undef PG8_BAR
#undef PG8_SCHED
}
}

constexpr int NWAVES = 8, NTHREADS = 512;
constexpr int D = 1024, NCTX = 512, NLAT = 16384, NTOK = NCTX + NLAT, SEQ = 8192, CTXL = 256;
constexpr int NEXP = 32, MAXPADROWS = 75776, MAXPADTILES = 296;
constexpr int GLA_IN = 3104, GLA_INP = 3328;
constexpr float EPS = 1e-6f;

constexpr size_t MiB = 1u << 20;
constexpr size_t WS_CTL = 0, CTL_ZERO_BYTES = 65536;
constexpr size_t WS_ADA = 1 * MiB;
constexpr size_t WS_ROPE = 1 * MiB + 512 * 1024;
constexpr size_t WS_TOKI = 2 * MiB;
constexpr size_t WS_TOKG = 2 * MiB + 512 * 1024;
constexpr size_t WS_LIST = 3 * MiB;
constexpr size_t WS_WRH = 6 * MiB, WS_WRL = 6 * MiB + 256 * 1024;
constexpr size_t WS_WSB = 7 * MiB;
constexpr size_t WS_WAIN = 8 * MiB;
constexpr size_t WS_WAOUT = 16 * MiB;
constexpr size_t WS_WBIN = 20 * MiB;
constexpr size_t WS_WBOUT = 27 * MiB;
constexpr size_t WS_WCQKV = 29 * MiB;
constexpr size_t WS_WCOUT = 35 * MiB;
constexpr size_t WS_WGU = 64 * MiB;
constexpr size_t WS_WDN = 576 * MiB;
constexpr size_t WS_X = 832 * MiB;
constexpr size_t WS_H = 898 * MiB;
constexpr size_t WS_G = 931 * MiB;
constexpr size_t WS_BIG = 964 * MiB;
constexpr size_t WS_DS = 1072 * MiB;
constexpr size_t WS_SIN = 1204 * MiB;
constexpr size_t WS_DEC = 1336 * MiB;
constexpr size_t WS_AS = 1338 * MiB;
constexpr size_t WS_ACT = 1486 * MiB;
constexpr size_t WS_YB = 1634 * MiB;
constexpr size_t WS_END = 1782 * MiB;
constexpr int CW_TMO = 0;
constexpr int CW_BAR = 4096;
constexpr int CW_CNT = 8192;
static_assert((CW_CNT + 128 * 64) * 4 <= 65536 && (CW_BAR + 3456) <= CW_CNT, "control words inside the per-call memset");

constexpr int RING_OFF = 0, RING_BYTES = 131072;
constexpr int MISC_OFF = RING_BYTES;
constexpr int LDS_BYTES = 147456;

#define GAS __attribute__((address_space(1)))
#define LAS __attribute__((address_space(3)))
typedef unsigned short bf16;
typedef unsigned v4u __attribute__((ext_vector_type(4)));
typedef unsigned v2u __attribute__((ext_vector_type(2)));
typedef float f32x4 __attribute__((ext_vector_type(4)));
typedef short bf16x8 __attribute__((ext_vector_type(8)));
typedef short bf16x4 __attribute__((ext_vector_type(4)));
#define LDS_WAIT() asm volatile("s_waitcnt lgkmcnt(0)" ::: "memory")
#define VM_WAIT() asm volatile("s_waitcnt vmcnt(0)" ::: "memory")
__device__ __forceinline__ unsigned f2bf(float f) { unsigned u = __builtin_bit_cast(unsigned, f); return (u + 0x7fffu + ((u >> 16) & 1u)) >> 16; }
__device__ __forceinline__ unsigned pk2(float lo, float hi) { return f2bf(lo) | (f2bf(hi) << 16); }
__device__ __forceinline__ float bf2f(unsigned b) { return __builtin_bit_cast(float, b << 16); }
__device__ __forceinline__ float bflo(unsigned w) { return __builtin_bit_cast(float, w << 16); }
__device__ __forceinline__ float bfhi(unsigned w) { return __builtin_bit_cast(float, w & 0xffff0000u); }
#define MFMA16(a, b, c) __builtin_amdgcn_mfma_f32_16x16x32_bf16((a), (b), (c), 0, 0, 0)

#define XB_TMO      128
#define XB_XCNT(j)  (256  + 64 * (j))
#define XB_XSUB(j)  (1280 + 64 * (j))
#define XB_XGEN(j)  (2304 + 64 * (j))
#define XB_TOP      3328
#define XB_TOPGEN   3392
#define XCD_BAR_WORDS 3456
#define XB_SPIN_CAP (1u << 22)

__device__ __forceinline__ unsigned xb_ld(unsigned* p)              { return __hip_atomic_load(p, __ATOMIC_RELAXED, __HIP_MEMORY_SCOPE_AGENT); }
__device__ __forceinline__ unsigned xb_add(unsigned* p, unsigned v) { return __hip_atomic_fetch_add(p, v, __ATOMIC_RELAXED, __HIP_MEMORY_SCOPE_AGENT); }
__device__ __forceinline__ unsigned xb_xcc_id() { return (unsigned)__builtin_amdgcn_s_getreg((3 << 11) | 20) & 0xFu; }
#define XB_SPIN(cond, bar) do { unsigned _sp = 0; while (cond) { __builtin_amdgcn_s_sleep(1); \
    if ((++_sp & 255u) == 0u) { if (xb_ld(&(bar)[XB_TMO])) break; if (_sp > XB_SPIN_CAP) { atomicAdd(&(bar)[XB_TMO], 1u); break; } } } } while (0)

struct XcdBarrier { unsigned* bar; unsigned x; volatile LAS unsigned* st; };
__device__ __forceinline__ XcdBarrier xcd_barrier_post(unsigned* bar, volatile LAS unsigned* st) {
    XcdBarrier b; b.bar = bar; b.x = xb_xcc_id(); b.st = st;
    if (threadIdx.x == 0) (void)xb_add(&bar[XB_XCNT(b.x)], 1u);
    return b;
}
__device__ __forceinline__ void xcd_barrier_complete(unsigned* bar, unsigned x, unsigned& nloc, unsigned& nx) {
    const unsigned G = gridDim.x * gridDim.y * gridDim.z;
    unsigned sum, cnt, mine, sp = 0u;
    for (;;) {
        sum = 0u; cnt = 0u; mine = 0u;
#pragma unroll
        for (unsigned j = 0; j < 16; ++j) { const unsigned c = xb_ld(&bar[XB_XCNT(j)]); sum += c; cnt += (c > 0u) ? 1u : 0u; mine = (j == x) ? c : mine; }
        if (sum == G) break;
        __builtin_amdgcn_s_sleep(1);
        if ((++sp & 255u) == 0u) { if (xb_ld(&bar[XB_TMO])) break; if (sp > XB_SPIN_CAP) { atomicAdd(&bar[XB_TMO], 1u); break; } }
    }
    nloc = mine > 0u ? mine : 1u; nx = cnt > 0u ? cnt : 1u;
}
__device__ __forceinline__ void xcd_barrier(const XcdBarrier& b) {
    asm volatile("s_waitcnt vmcnt(0)" ::: "memory");
    __syncthreads();
    if (threadIdx.x == 0) {
        unsigned* bar = b.bar;
        __builtin_amdgcn_s_waitcnt(0);
        unsigned nloc = b.st[0], nx = b.st[1];
        if (nloc == 0u) { xcd_barrier_complete(bar, b.x, nloc, nx); b.st[0] = nloc; b.st[1] = nx; }
        const unsigned old = xb_add(&bar[XB_XSUB(b.x)], 1u);
        const unsigned gen = old / nloc;
        if (old + 1u == (gen + 1u) * nloc) {
            __builtin_amdgcn_fence(__ATOMIC_RELEASE, "agent");
            asm volatile("s_waitcnt vmcnt(0)" ::: "memory");
            const unsigned og = xb_add(&bar[XB_TOP], 1u);
            const unsigned tg = og / nx;
            if (og + 1u == (tg + 1u) * nx) xb_add(&bar[XB_TOPGEN], 1u);
            else XB_SPIN(xb_ld(&bar[XB_TOPGEN]) == tg, bar);
            __builtin_amdgcn_fence(__ATOMIC_ACQUIRE, "agent");
            xb_add(&bar[XB_XGEN(b.x)], 1u);
            asm volatile("s_waitcnt vmcnt(0)" ::: "memory");
        } else {
            XB_SPIN(xb_ld(&bar[XB_XGEN(b.x)]) == gen, bar);
            __builtin_amdgcn_fence(__ATOMIC_ACQUIRE, "agent");
            asm volatile("s_waitcnt vmcnt(0)" ::: "memory");
        }
    }
    __syncthreads();
}

struct Args { const float* in[28]; float* out; unsigned char* ws; int ph_lo, ph_hi; };
enum { I_X = 0, I_C, I_CTX, I_CCTX, I_ADAW, I_ADAB, I_NMIX, I_NFFN, I_NOUT, I_AWIN, I_AGV, I_AWS, I_ABS, I_AWOUT, I_BWIN, I_BWA2, I_BBA, I_BGO, I_BWOUT,
       I_CWQKV, I_CRPB, I_CWOUT, I_MWR, I_MBR, I_MWGU, I_MBGU, I_MWDN, I_MBDN };

struct Frame {
    LAS unsigned char* lds;
    unsigned* ctl;
    unsigned char* ws;
    int tid, lane, wave, vcu, G;
};

__device__ __forceinline__ float wave_sum(float v) {
#pragma unroll
    for (int o = 1; o < 64; o <<= 1) v += __shfl_xor(v, o);
    return v;
}
__device__ __forceinline__ int seg_of_row(int r) { return r < NCTX ? 0 : 1 + ((r - NCTX) >> 13); }

__device__ __forceinline__ void transpose_item64(const float* W, int N, int k0, int n0, bf16* WT, int K, int dst_row0, int ncols_valid, LAS float* scr, int lane) {
#pragma unroll 4
    for (int i = 0; i < 16; ++i) { const int row = 4 * i + (lane >> 4), c4 = (lane & 15) * 4;
        f32x4 v = (f32x4){0.f, 0.f, 0.f, 0.f};
        if (c4 < ncols_valid) v = __builtin_nontemporal_load((const GAS f32x4*)(W + (size_t)(k0 + row) * N + n0 + c4));
        LAS float* s = scr + row * 65 + c4; s[0] = v.x; s[1] = v.y; s[2] = v.z; s[3] = v.w; }
    LDS_WAIT(); asm volatile("" ::: "memory");
    const int c = lane & 7;
#pragma unroll
    for (int j = 0; j < 8; ++j) { const int n = (lane >> 3) + 8 * j; const LAS float* s = scr + (8 * c) * 65 + n;
        v4u o; o.x = pk2(s[0 * 65], s[1 * 65]); o.y = pk2(s[2 * 65], s[3 * 65]); o.z = pk2(s[4 * 65], s[5 * 65]); o.w = pk2(s[6 * 65], s[7 * 65]);
        __builtin_nontemporal_store(o, (GAS v4u*)(WT + (size_t)(dst_row0 + n) * K + k0 + 8 * c)); }
    LDS_WAIT(); asm volatile("" ::: "memory");
}

__device__ __forceinline__ void p_prologue(Frame& F, const Args& a) {
    LAS float* scr = (LAS float*)(F.lds + F.wave * 16640);
    const int gw = F.vcu * NWAVES + F.wave, NGW = F.G * NWAVES;
    {
        constexpr int KB = 16;
        constexpr int I0 = 2 * KB * 32, I1 = 2 * KB * 16, I2 = KB * 52, I3 = KB * 16, I4 = KB * 48, I5 = KB * 16;
        constexpr int NI = I0 + I1 + I2 + I3 + I4 + I5;
        for (int it = gw; it < NI; it += NGW) {
            int r = it;
            if (r < I0) { const int j = r / (KB * 32), q = r % (KB * 32), kb = q / 32, nb = q % 32;
                transpose_item64(a.in[I_AWIN] + (size_t)j * 1024 * 2048, 2048, 64 * kb, 64 * nb, (bf16*)(F.ws + WS_WAIN) + (size_t)j * 2048 * 1024, 1024, 64 * nb, 64, scr, F.lane); continue; } r -= I0;
            if (r < I1) { const int j = r / (KB * 16), q = r % (KB * 16), kb = q / 16, nb = q % 16;
                transpose_item64(a.in[I_AWOUT] + (size_t)j * 1024 * 1024, 1024, 64 * kb, 64 * nb, (bf16*)(F.ws + WS_WAOUT) + (size_t)j * 1024 * 1024, 1024, 64 * nb, 64, scr, F.lane); continue; } r -= I1;
            if (r < I2) { const int kb = r / 52, nb = r % 52; const int nv = GLA_IN - 64 * nb;
                transpose_item64(a.in[I_BWIN], GLA_IN, 64 * kb, 64 * nb, (bf16*)(F.ws + WS_WBIN), 1024, 64 * nb, nv < 0 ? 0 : (nv > 64 ? 64 : nv), scr, F.lane); continue; } r -= I2;
            if (r < I3) { const int kb = r / 16, nb = r % 16;
                transpose_item64(a.in[I_BWOUT], 1024, 64 * kb, 64 * nb, (bf16*)(F.ws + WS_WBOUT), 1024, 64 * nb, 64, scr, F.lane); continue; } r -= I3;
            if (r < I4) { const int kb = r / 48, nb = r % 48;
                transpose_item64(a.in[I_CWQKV], 3072, 64 * kb, 64 * nb, (bf16*)(F.ws + WS_WCQKV), 1024, 64 * nb, 64, scr, F.lane); continue; } r -= I4;
            { const int kb = r / 16, nb = r % 16;
                transpose_item64(a.in[I_CWOUT], 1024, 64 * kb, 64 * nb, (bf16*)(F.ws + WS_WCOUT), 1024, 64 * nb, 64, scr, F.lane); }
        }
    }
    {
        constexpr int KB = 16, PER_GU = KB * 32, PER_DN = KB * 16, NGU = 128 * PER_GU, NDN = 128 * PER_DN;
        for (int it = gw; it < NGU + NDN; it += NGW) {
            if (it < NGU) { const int le = it / PER_GU, q = it % PER_GU, kb = q / 32, nb = q % 32;
                const int n0 = 64 * nb, half = n0 >> 10, jj = n0 & 1023, dst = (jj >> 7) * 256 + half * 128 + (jj & 127);
                transpose_item64(a.in[I_MWGU] + (size_t)le * 1024 * 2048, 2048, 64 * kb, n0, (bf16*)(F.ws + WS_WGU) + (size_t)le * 2048 * 1024, 1024, dst, 64, scr, F.lane); }
            else { const int r = it - NGU, le = r / PER_DN, q = r % PER_DN, kb = q / 16, nb = q % 16;
                transpose_item64(a.in[I_MWDN] + (size_t)le * 1024 * 1024, 1024, 64 * kb, 64 * nb, (bf16*)(F.ws + WS_WDN) + (size_t)le * 1024 * 1024, 1024, 64 * nb, 64, scr, F.lane); }
        }
    }
    const int gt = F.vcu * NTHREADS + F.tid, NGT = F.G * NTHREADS;
    for (int i = gt; i < 2 * 8 * 128 * 128; i += NGT) ((bf16*)(F.ws + WS_WSB))[i] = (bf16)f2bf(a.in[I_AWS][i]);
    for (int i = gt; i < 4 * 32 * 1024; i += NGT) { const int l = i >> 15, e = (i >> 10) & 31, k = i & 1023;
        const float w = a.in[I_MWR][((size_t)l * 1024 + k) * 32 + e]; const unsigned h = f2bf(w); const float rem = w - bf2f(h);
        ((bf16*)(F.ws + WS_WRH))[i] = (bf16)h; ((bf16*)(F.ws + WS_WRL))[i] = (bf16)f2bf(rem); }
    for (int i = gt; i < 128 * 32; i += NGT) { const int pos = i >> 5, f = i & 31;
        const float fr = powf(10000.0f, -(float)f / 32.0f); const float ang = (float)pos * fr; float sn, cs; sincosf(ang, &sn, &cs);
        ((float*)(F.ws + WS_ROPE))[2 * i] = cs; ((float*)(F.ws + WS_ROPE))[2 * i + 1] = sn; }
    {
        __syncthreads();
        LAS float* sv = (LAS float*)(F.lds);
        LAS float* red = sv + 3 * 1024;
        for (int i = F.tid; i < 3 * 1024; i += NTHREADS) { const int s = i >> 10, k = i & 1023;
            const float v = s == 0 ? a.in[I_CCTX][k] : a.in[I_C][(s - 1) * 1024 + k]; sv[i] = v / (1.0f + __expf(-v)); }
        __syncthreads();
        for (int u = F.vcu; u < 4 * 96; u += F.G) { const int l = u / 96, n0 = (u % 96) * 64;
            const float* w = a.in[I_ADAW] + (size_t)l * 1024 * 6144 + n0 + F.lane;
            float a0 = 0.f, a1 = 0.f, a2 = 0.f;
#pragma unroll 8
            for (int kk = 0; kk < 128; ++kk) { const int k = F.wave * 128 + kk; const float wv = w[(size_t)k * 6144];
                a0 += sv[k] * wv; a1 += sv[1024 + k] * wv; a2 += sv[2048 + k] * wv; }
            red[(F.wave * 3 + 0) * 64 + F.lane] = a0; red[(F.wave * 3 + 1) * 64 + F.lane] = a1; red[(F.wave * 3 + 2) * 64 + F.lane] = a2;
            __syncthreads();
            if (F.tid < 192) { const int s = F.tid >> 6, c = F.tid & 63; float t = a.in[I_ADAB][l * 6144 + n0 + c];
#pragma unroll
                for (int w8 = 0; w8 < 8; ++w8) t += red[(w8 * 3 + s) * 64 + c];
                ((float*)(F.ws + WS_ADA))[(size_t)(l * 3 + s) * 6144 + n0 + c] = t; }
            __syncthreads();
        }
    }
}

__device__ __forceinline__ void moe_tables(Frame& F, int layer) {
    LAS int* M = (LAS int*)(F.lds + MISC_OFF);
    __syncthreads();
    if (F.tid < 32) M[400 + F.tid] = (int)__hip_atomic_load(F.ctl + CW_CNT + (layer * 32 + F.tid) * 64, __ATOMIC_RELAXED, __HIP_MEMORY_SCOPE_AGENT);
    __syncthreads();
    if (F.tid < 64) { const int e = F.tid & 31; const int nt = (M[400 + e] + 255) >> 8; int incl = nt;
#pragma unroll
        for (int o = 1; o < 32; o <<= 1) { const int v = __shfl_up(incl, o, 32); if (e >= o) incl += v; }
        const int off = (incl - nt) << 8;
        if (F.tid < 32) { M[e] = off; for (int t = 0; t < nt; ++t) M[64 + (off >> 8) + t] = e; if (e == 31) M[32] = incl << 8; } }
    __syncthreads();
}

__device__ __forceinline__ void p_prenorm(Frame& F, const Args& a, int layer, bool fin, bool dry = false) {
    const int gw = F.vcu * NWAVES + F.wave, NGW = F.G * NWAVES;
    const int prev = layer - 1;
    const int row_lo = (layer >= 3) ? NCTX : 0;
    const bool combine = layer > 0;
    if (combine) moe_tables(F, prev);
    const LAS int* M = (const LAS int*)(F.lds + MISC_OFF);
    float* X = (float*)(F.ws + WS_X); bf16* H = (bf16*)(F.ws + (dry ? WS_AS : WS_H));
    const bf16* YB = (const bf16*)(F.ws + WS_YB);
    const float* ada = (const float*)(F.ws + WS_ADA);
    const v4u* TOKI = (const v4u*)(F.ws + WS_TOKI); const f32x4* TOKG = (const f32x4*)(F.ws + WS_TOKG);
    LAS float* V = (LAS float*)(F.lds);
    __syncthreads();
    for (int i = F.tid; i < 10 * D; i += NTHREADS) { const int w = i >> 10, c = i & 1023; float x;
        if (w == 0) x = fin ? a.in[I_NOUT][c] : a.in[I_NMIX][(size_t)layer * D + c];
        else { const int seg = (w - 1) / 3, k = (w - 1) % 3; x = k == 2 ? (combine ? ada[(size_t)((prev * 3 + seg) * 6 + 5) * D + c] : 0.f) : (fin ? 0.f : ada[(size_t)((layer * 3 + seg) * 6 + k) * D + c]); }
        V[i] = x; }
    __syncthreads();
    for (int row0 = row_lo + gw; row0 < NTOK; row0 += 2 * NGW) {
        const int row1r = row0 + NGW; const bool has1 = row1r < NTOK; const int row1 = has1 ? row1r : row0;
        f32x4 v[2][4]; v4u ti[2]; f32x4 tg[2];
#pragma unroll
        for (int q = 0; q < 2; ++q) { const int row = q ? row1 : row0;
            const float* src = layer == 0 ? (row < NCTX ? a.in[I_CTX] + (size_t)row * D : a.in[I_X] + (size_t)(row - NCTX) * D) : X + (size_t)row * D;
#pragma unroll
            for (int j = 0; j < 4; ++j) v[q][j] = *(const GAS f32x4*)(src + 4 * F.lane + 256 * j);
            if (combine) { ti[q] = TOKI[row]; tg[q] = TOKG[row]; } }
        if (combine) {
            v2u y[2][4][4];
#pragma unroll
            for (int q = 0; q < 2; ++q)
#pragma unroll
                for (int k = 0; k < 4; ++k) { const unsigned t = ti[q][k]; const int pos = M[t >> 16] + (int)(t & 0xffffu); const bf16* yr = YB + (size_t)pos * D + 4 * F.lane;
#pragma unroll
                    for (int j = 0; j < 4; ++j) y[q][k][j] = *(const GAS v2u*)(yr + 256 * j); }
#pragma unroll
            for (int q = 0; q < 2; ++q) { const int seg = seg_of_row(q ? row1 : row0);
#pragma unroll
                for (int j = 0; j < 4; ++j) { f32x4 acc = (f32x4){0.f, 0.f, 0.f, 0.f};
#pragma unroll
                    for (int k = 0; k < 4; ++k) { const float g = tg[q][k]; const v2u yy = y[q][k][j]; acc.x += g * bflo(yy.x); acc.y += g * bfhi(yy.x); acc.z += g * bflo(yy.y); acc.w += g * bfhi(yy.y); }
                    const f32x4 gg = *(const LAS f32x4*)(V + (1 + 3 * seg + 2) * D + 4 * F.lane + 256 * j); v[q][j] = v[q][j] + gg * acc; } }
        }
#pragma unroll
        for (int q = 0; q < 2; ++q) { if (q == 1 && !has1) break; const int row = q ? row1 : row0, seg = seg_of_row(row);
            if (!fin && !dry && (combine || layer == 0)) {
#pragma unroll
                for (int j = 0; j < 4; ++j) *(GAS f32x4*)(X + (size_t)row * D + 4 * F.lane + 256 * j) = v[q][j];
            }
            float ss = 0.f;
#pragma unroll
            for (int j = 0; j < 4; ++j) ss += (v[q][j].x * v[q][j].x + v[q][j].y * v[q][j].y) + (v[q][j].z * v[q][j].z + v[q][j].w * v[q][j].w);
            const float rstd = 1.0f / sqrtf(wave_sum(ss) * (1.0f / D) + EPS);
            if (fin) {
                float* o = a.out + (size_t)(row - NCTX) * D;
#pragma unroll
                for (int j = 0; j < 4; ++j) { const f32x4 g = *(const LAS f32x4*)(V + 4 * F.lane + 256 * j); *(GAS f32x4*)(o + 4 * F.lane + 256 * j) = v[q][j] * rstd * g; }
            } else {
#pragma unroll
                for (int j = 0; j < 4; ++j) { const int c = 4 * F.lane + 256 * j;
                    const f32x4 g = *(const LAS f32x4*)(V + c), s0 = *(const LAS f32x4*)(V + (1 + 3 * seg) * D + c), s1 = *(const LAS f32x4*)(V + (2 + 3 * seg) * D + c);
                    const f32x4 h = v[q][j] * rstd * g * (s1 + 1.0f) + s0;
                    v2u o; o.x = pk2(h.x, h.y); o.y = pk2(h.z, h.w);
                    *(GAS v2u*)(H + (size_t)row * D + c) = o; }
            }
        }
    }
}

__device__ __forceinline__ void p_router(Frame& F, const Args& a, int layer, bool dry = false) {
    const int row_lo = (layer >= 2) ? NCTX : 0;
    const int ntile = (NTOK - row_lo) / 16;
    float* X = (float*)(F.ws + WS_X); bf16* H = (bf16*)(F.ws + WS_H);
    const float* ada = (const float*)(F.ws + WS_ADA);
    constexpr int AST = 1032;
    LAS bf16* Ahi = (LAS bf16*)(F.lds); LAS bf16* Alo = Ahi + 16 * AST;
    LAS float* RED = (LAS float*)(F.lds + 2 * 16 * AST * 2);
    LAS float* LOG = RED + 8 * 16 * 32;
    const int fr = F.lane & 15, fq = F.lane >> 4;
    bf16x8 Bh[2][4], Bl[2][4];
    {
        const bf16* wh = (const bf16*)(F.ws + WS_WRH) + (size_t)layer * 32 * 1024; const bf16* wl = (const bf16*)(F.ws + WS_WRL) + (size_t)layer * 32 * 1024;
#pragma unroll
        for (int nt = 0; nt < 2; ++nt)
#pragma unroll
            for (int ks = 0; ks < 4; ++ks) { const size_t o = (size_t)(nt * 16 + fr) * 1024 + F.wave * 128 + ks * 32 + fq * 8;
                Bh[nt][ks] = *(const GAS bf16x8*)(wh + o); Bl[nt][ks] = *(const GAS bf16x8*)(wl + o); }
    }
    const float* nw = a.in[I_NFFN] + (size_t)layer * D;
    for (int tile = F.vcu; tile < ntile; tile += F.G) {
        const int r0 = row_lo + 16 * tile;
#pragma unroll
        for (int rr = 0; rr < 2; ++rr) {
            const int rl = 2 * F.wave + rr, row = r0 + rl, seg = seg_of_row(row);
            const float* sh = ada + (size_t)((layer * 3 + seg) * 6 + 3) * D; const float* sc = sh + D;
            f32x4 v[4]; float ss = 0.f;
#pragma unroll
            for (int j = 0; j < 4; ++j) { v[j] = *(const GAS f32x4*)(X + (size_t)row * D + 4 * F.lane + 256 * j); ss += (v[j].x * v[j].x + v[j].y * v[j].y) + (v[j].z * v[j].z + v[j].w * v[j].w); }
            const float rstd = 1.0f / sqrtf(wave_sum(ss) * (1.0f / D) + EPS);
#pragma unroll
            for (int j = 0; j < 4; ++j) { const int c = 4 * F.lane + 256 * j;
                const f32x4 g = *(const GAS f32x4*)(nw + c), s1 = *(const GAS f32x4*)(sc + c), s0 = *(const GAS f32x4*)(sh + c);
                const f32x4 h = v[j] * rstd * g * (s1 + 1.0f) + s0;
                const unsigned h0 = f2bf(h.x), h1 = f2bf(h.y), h2 = f2bf(h.z), h3 = f2bf(h.w);
                v2u o; o.x = h0 | (h1 << 16); o.y = h2 | (h3 << 16);
                *(GAS v2u*)(H + (size_t)row * D + c) = o;
                *(LAS v2u*)(Ahi + rl * AST + c) = o;
                v2u l; l.x = pk2(h.x - bf2f(h0), h.y - bf2f(h1)); l.y = pk2(h.z - bf2f(h2), h.w - bf2f(h3));
                *(LAS v2u*)(Alo + rl * AST + c) = l; }
        }
        __syncthreads();
        f32x4 acc[2] = {(f32x4){0.f, 0.f, 0.f, 0.f}, (f32x4){0.f, 0.f, 0.f, 0.f}};
#pragma unroll
        for (int ks = 0; ks < 4; ++ks) { const int o = fr * AST + F.wave * 128 + ks * 32 + fq * 8;
            const bf16x8 ah = *(const LAS bf16x8*)(Ahi + o), al = *(const LAS bf16x8*)(Alo + o);
#pragma unroll
            for (int nt = 0; nt < 2; ++nt) { acc[nt] = MFMA16(ah, Bh[nt][ks], acc[nt]); acc[nt] = MFMA16(ah, Bl[nt][ks], acc[nt]); acc[nt] = MFMA16(al, Bh[nt][ks], acc[nt]); } }
#pragma unroll
        for (int nt = 0; nt < 2; ++nt)
#pragma unroll
            for (int j = 0; j < 4; ++j) RED[(F.wave * 16 + fq * 4 + j) * 32 + nt * 16 + fr] = acc[nt][j];
        __syncthreads();
        {
            const int rl = F.tid >> 5, e = F.tid & 31, row = r0 + rl;
            float lg = a.in[I_MBR][layer * 32 + e];
#pragma unroll
            for (int w8 = 0; w8 < 8; ++w8) lg += RED[(w8 * 16 + rl) * 32 + e];
            float cur = lg; float tv[4]; int tix[4];
#pragma unroll
            for (int k = 0; k < 4; ++k) { float bv = cur; int bi = e;
#pragma unroll
                for (int o = 1; o < 32; o <<= 1) { const float ov = __shfl_xor(bv, o); const int oi = __shfl_xor(bi, o); if (ov > bv || (ov == bv && oi < bi)) { bv = ov; bi = oi; } }
                tv[k] = bv; tix[k] = bi; if (e == bi) cur = -3.0e38f; }
            const float e1 = __expf(tv[1] - tv[0]), e2 = __expf(tv[2] - tv[0]), e3 = __expf(tv[3] - tv[0]); const float inv = 1.0f / (1.0f + e1 + e2 + e3);
            if (e < 4 && !dry) { const int k = e; const int ek = k == 0 ? tix[0] : (k == 1 ? tix[1] : (k == 2 ? tix[2] : tix[3])); const float gk = (k == 0 ? 1.0f : (k == 1 ? e1 : (k == 2 ? e2 : e3))) * inv;
                const unsigned rank = atomicAdd(F.ctl + CW_CNT + (layer * 32 + ek) * 64, 1u);
                ((unsigned*)(F.ws + WS_LIST))[(size_t)ek * NTOK + rank] = (unsigned)row;
                ((unsigned*)(F.ws + WS_TOKI))[(size_t)row * 4 + k] = ((unsigned)ek << 16) | rank;
                ((float*)(F.ws + WS_TOKG))[(size_t)row * 4 + k] = gk; }
        }
        __syncthreads();
    }
}

__device__ __forceinline__ void p_gather(Frame& F, int layer) {
    moe_tables(F, layer);
    const LAS int* M = (const LAS int*)(F.lds + MISC_OFF);
    const int total = M[32];
    const int gw = F.vcu * NWAVES + F.wave, NGW = F.G * NWAVES;
    const bf16* H = (const bf16*)(F.ws + WS_H); bf16* AS = (bf16*)(F.ws + WS_AS);
    const unsigned* LIST = (const unsigned*)(F.ws + WS_LIST);
    for (int p = gw; p < total; p += NGW) {
        const int e = M[64 + (p >> 8)]; const int rank = p - M[e];
        v4u x0 = (v4u){0u, 0u, 0u, 0u}, x1 = x0;
        if (rank < M[400 + e]) { const unsigned r = LIST[(size_t)e * NTOK + rank]; const GAS v4u* s = (const GAS v4u*)(H + (size_t)r * D); x0 = s[F.lane]; x1 = s[64 + F.lane]; }
        GAS v4u* d = (GAS v4u*)(AS + (size_t)p * D); d[F.lane] = x0; d[64 + F.lane] = x1;
    }
}

typedef short s16x4 __attribute__((ext_vector_type(4)));
__device__ __forceinline__ bf16x8 tr_frag(const LAS bf16* T, int stride, int kb, int c0, int lane) {
    const int g = lane >> 4, w = lane & 15, q = w >> 2, p = w & 3;
    const LAS bf16* a0 = T + (kb + 4 * g + q) * stride + c0 + 4 * p;
    const s16x4 lo = __builtin_amdgcn_ds_read_tr16_b64_v4i16((LAS s16x4*)a0);
    const s16x4 hi = __builtin_amdgcn_ds_read_tr16_b64_v4i16((LAS s16x4*)(a0 + 16 * stride));
    return (bf16x8){lo[0], lo[1], lo[2], lo[3], hi[0], hi[1], hi[2], hi[3]};
}
__device__ __forceinline__ bf16x8 perm_frag(const LAS bf16* rowp, int kb, int quad) {
    const v2u lo = *(const LAS v2u*)(rowp + kb + 4 * quad), hi = *(const LAS v2u*)(rowp + kb + 16 + 4 * quad);
    v4u w; w.x = lo.x; w.y = lo.y; w.z = hi.x; w.w = hi.y; return __builtin_bit_cast(bf16x8, w);
}
__device__ __forceinline__ void p_spatial(Frame& F, const Args& a, int layer) {
    const int jl = layer / 3;
    const int c_lo = (layer >= 3) ? 4 : 0;
    const int nunit = (132 - c_lo) * 8;
    const bf16* ZB = (const bf16*)(F.ws + WS_BIG); bf16* G = (bf16*)(F.ws + WS_G);
    constexpr int ST = 144;
    LAS bf16* As = (LAS bf16*)(F.lds); LAS bf16* Bs = As + 128 * ST; LAS float* rs = (LAS float*)(F.lds + 2 * 128 * ST * 2);
    const int fr = F.lane & 15, fq = F.lane >> 4;
    const int u_lo = (int)(((long)F.vcu * nunit) / F.G), u_hi = (int)(((long)(F.vcu + 1) * nunit) / F.G);
    int cur_c = -1;
    for (int u = u_lo; u < u_hi; ++u) {
        const int c = c_lo + (u >> 3), g = u & 7, r0 = 128 * c;
        if (c != cur_c) {
            cur_c = c;
            __syncthreads();
#pragma unroll
            for (int hb = 0; hb < 2; ++hb) {
                v4u x0[8], x1[8];
#pragma unroll
                for (int rr = 0; rr < 8; ++rr) { const GAS v4u* p = (const GAS v4u*)(ZB + (size_t)(r0 + F.wave * 16 + hb * 8 + rr) * 2048 + 1024 + 16 * F.lane); x0[rr] = p[0]; x1[rr] = p[1]; }
#pragma unroll
                for (int rr = 0; rr < 8; ++rr) { float ss = 0.f;
#pragma unroll
                    for (int i = 0; i < 4; ++i) { const float l0 = bflo(x0[rr][i]), h0 = bfhi(x0[rr][i]), l1 = bflo(x1[rr][i]), h1 = bfhi(x1[rr][i]); ss += l0 * l0 + h0 * h0 + l1 * l1 + h1 * h1; }
                    ss = wave_sum(ss); if (F.lane == 0) rs[F.wave * 16 + hb * 8 + rr] = 1.0f / sqrtf(ss * (1.0f / 1024.0f) + EPS); }
            }
        }
        __syncthreads();
        {
            const bf16* wsb = (const bf16*)(F.ws + WS_WSB) + (size_t)(jl * 8 + g) * 128 * 128;
            const float* gv = a.in[I_AGV] + (size_t)jl * 1024 + 128 * g;
#pragma unroll
            for (int i = 0; i < 4; ++i) { const int id = F.tid + 512 * i, p = id >> 4, qc = id & 15;
                *(LAS v4u*)(As + p * ST + qc * 8) = *(const GAS v4u*)(wsb + p * 128 + qc * 8);
                const v4u x = *(const GAS v4u*)(ZB + (size_t)(r0 + p) * 2048 + 1024 + 128 * g + 8 * qc); const float rq = rs[p];
                const f32x4 g0 = *(const GAS f32x4*)(gv + 8 * qc), g1 = *(const GAS f32x4*)(gv + 8 * qc + 4);
                v4u o; o.x = pk2(bflo(x.x) * rq * g0.x, bfhi(x.x) * rq * g0.y); o.y = pk2(bflo(x.y) * rq * g0.z, bfhi(x.y) * rq * g0.w);
                o.z = pk2(bflo(x.z) * rq * g1.x, bfhi(x.z) * rq * g1.y); o.w = pk2(bflo(x.w) * rq * g1.z, bfhi(x.w) * rq * g1.w);
                *(LAS v4u*)(Bs + p * ST + qc * 8) = o; }
        }
        __syncthreads();
        f32x4 acc[8];
#pragma unroll
        for (int nt = 0; nt < 8; ++nt) acc[nt] = (f32x4){0.f, 0.f, 0.f, 0.f};
#pragma unroll
        for (int ks = 0; ks < 4; ++ks) { const bf16x8 af = tr_frag(Bs, ST, 32 * ks, 16 * F.wave, F.lane);
#pragma unroll
            for (int nt = 0; nt < 8; ++nt) { const bf16x8 bfr = perm_frag(As + (16 * nt + fr) * ST, 32 * ks, fq); acc[nt] = MFMA16(af, bfr, acc[nt]); } }
        const float* bs = a.in[I_ABS] + (size_t)(jl * 8 + g) * 128;
#pragma unroll
        for (int nt = 0; nt < 8; ++nt) { const int p = 16 * nt + fr; const float bb = bs[p]; const size_t row = (size_t)(r0 + p); const int cc = 128 * g + 16 * F.wave + 4 * fq;
            const v2u uu = *(const GAS v2u*)(ZB + row * 2048 + cc);
            v2u o; o.x = pk2(bflo(uu.x) * (acc[nt][0] + bb), bfhi(uu.x) * (acc[nt][1] + bb)); o.y = pk2(bflo(uu.y) * (acc[nt][2] + bb), bfhi(uu.y) * (acc[nt][3] + bb));
            *(GAS v2u*)(G + row * D + cc) = o; }
        __syncthreads();
    }
}

constexpr int PST = GLA_INP;
constexpr int CST = 132;
constexpr int KST = 144;
constexpr int VST = 272;
__device__ __forceinline__ void gla_cum(Frame& F, const Args& a, int c, int h, int dir, LAS float* cum, LAS float* rt, LAS float* tot) {
    const bf16* P = (const bf16*)(F.ws + WS_BIG);
    for (int i = F.tid; i < 64 * 8; i += NTHREADS) { const int ii = i >> 3, j2 = i & 7; const unsigned x = *(const GAS unsigned*)(P + (size_t)(64 * c + ii) * PST + 3072 + dir * 16 + 2 * j2);
        rt[ii * 16 + 2 * j2] = bflo(x); rt[ii * 16 + 2 * j2 + 1] = bfhi(x); }
    const int kk = F.tid & 127, part = F.tid >> 7;
    float w[16];
#pragma unroll
    for (int j = 0; j < 16; ++j) w[j] = a.in[I_BWA2][(size_t)(dir * 16 + j) * 512 + h * 128 + kk];
    const float ba = a.in[I_BBA][dir * 512 + h * 128 + kk];
    __syncthreads();
    float la[16];
#pragma unroll
    for (int ii = 0; ii < 16; ++ii) { const int i = part * 16 + ii; float z = ba;
        const f32x4 r0 = *(const LAS f32x4*)(rt + i * 16), r1 = *(const LAS f32x4*)(rt + i * 16 + 4), r2 = *(const LAS f32x4*)(rt + i * 16 + 8), r3 = *(const LAS f32x4*)(rt + i * 16 + 12);
        z += r0.x * w[0] + r0.y * w[1] + r0.z * w[2] + r0.w * w[3]; z += r1.x * w[4] + r1.y * w[5] + r1.z * w[6] + r1.w * w[7];
        z += r2.x * w[8] + r2.y * w[9] + r2.z * w[10] + r2.w * w[11]; z += r3.x * w[12] + r3.y * w[13] + r3.z * w[14] + r3.w * w[15];
        const float ls = fminf(z, 0.0f) - __logf(1.0f + __expf(-fabsf(z)));
        la[ii] = ls * (1.0f / 16.0f); }
    float run = 0.f;
    if (dir == 0) {
#pragma unroll
        for (int ii = 0; ii < 16; ++ii) { run += la[ii]; la[ii] = run; } }
    else {
#pragma unroll
        for (int ii = 15; ii >= 0; --ii) { run += la[ii]; la[ii] = run; } }
    tot[part * 128 + kk] = run;
    __syncthreads();
    float off = 0.f;
#pragma unroll
    for (int p = 0; p < 4; ++p) { const float t = tot[p * 128 + kk]; if (dir == 0 ? (p < part) : (p > part)) off += t; }
#pragma unroll
    for (int ii = 0; ii < 16; ++ii) cum[(part * 16 + ii) * CST + kk] = la[ii] + off;
    __syncthreads();
}
struct RowRaw { v4u o0, o1, p0, p1; };
__device__ __forceinline__ void row16_load(const bf16* x, int grp, bool lat, RowRaw& R) {
    R.o0 = *(const GAS v4u*)(x + 16 * grp); R.o1 = *(const GAS v4u*)(x + 16 * grp + 8);
    if (lat) { R.p0 = *(const GAS v4u*)(x + 16 * (grp ^ 2)); R.p1 = *(const GAS v4u*)(x + 16 * (grp ^ 2) + 8); } else { R.p0 = R.o0; R.p1 = R.o1; }
}
__device__ __forceinline__ void ropetab_load(const float* ROPE, int grp, int pr, int pc, bool lat, f32x4 (&tb)[8]) {
    const int pos = (grp >> 2) ? pc : pr; const float* t = ROPE + (size_t)(pos * 32 + 16 * (grp & 1)) * 2;
#pragma unroll
    for (int e2 = 0; e2 < 8; ++e2) tb[e2] = lat ? *(const GAS f32x4*)(t + 4 * e2) : (f32x4){1.f, 0.f, 1.f, 0.f};
}
__device__ __forceinline__ void rope16_apply(const RowRaw& R, const f32x4 (&tb)[8], int grp, bool lat, float (&out)[16]) {
    float own[16], par[16];
#pragma unroll
    for (int e = 0; e < 4; ++e) { own[2 * e] = bflo(R.o0[e]); own[2 * e + 1] = bfhi(R.o0[e]); own[8 + 2 * e] = bflo(R.o1[e]); own[8 + 2 * e + 1] = bfhi(R.o1[e]);
        par[2 * e] = bflo(R.p0[e]); par[2 * e + 1] = bfhi(R.p0[e]); par[8 + 2 * e] = bflo(R.p1[e]); par[8 + 2 * e + 1] = bfhi(R.p1[e]); }
    if (!lat) {
#pragma unroll
        for (int e = 0; e < 16; ++e) out[e] = own[e];
        return; }
    const bool second = (grp >> 1) & 1;
#pragma unroll
    for (int e2 = 0; e2 < 8; ++e2) { const f32x4 t = tb[e2];
        { const int e = 2 * e2; const float x1 = second ? par[e] : own[e], x2 = second ? own[e] : par[e]; out[e] = second ? (x1 * t.y + x2 * t.x) : (x1 * t.x - x2 * t.y); }
        { const int e = 2 * e2 + 1; const float x1 = second ? par[e] : own[e], x2 = second ? own[e] : par[e]; out[e] = second ? (x1 * t.w + x2 * t.z) : (x1 * t.z - x2 * t.w); } }
}
__device__ __forceinline__ void st16bf(LAS bf16* dst, const float (&v)[16]) {
    v4u a, b; a.x = pk2(v[0], v[1]); a.y = pk2(v[2], v[3]); a.z = pk2(v[4], v[5]); a.w = pk2(v[6], v[7]); b.x = pk2(v[8], v[9]); b.y = pk2(v[10], v[11]); b.z = pk2(v[12], v[13]); b.w = pk2(v[14], v[15]);
    *(LAS v4u*)dst = a; *(LAS v4u*)(dst + 8) = b;
}
__device__ __forceinline__ void ld16cum(const LAS float* p, float (&v)[16]) {
#pragma unroll
    for (int e = 0; e < 4; ++e) { const f32x4 t = *(const LAS f32x4*)(p + 4 * e); v[4 * e] = t.x; v[4 * e + 1] = t.y; v[4 * e + 2] = t.z; v[4 * e + 3] = t.w; }
}
__device__ __forceinline__ void gla_stage_v(Frame& F, int c, int h, LAS bf16* VL) {
    const bf16* P = (const bf16*)(F.ws + WS_BIG);
    const int i = F.tid & 63, grp = F.tid >> 6; const bf16* vp = P + (size_t)(64 * c + i) * PST + 1024 + h * 256 + grp * 32;
#pragma unroll
    for (int e = 0; e < 4; ++e) *(LAS v4u*)(VL + i * VST + grp * 32 + 8 * e) = *(const GAS v4u*)(vp + 8 * e);
}
__device__ __forceinline__ void p_gla_ds(Frame& F, const Args& a) {
    const bf16* P = (const bf16*)(F.ws + WS_BIG); const float* ROPE = (const float*)(F.ws + WS_ROPE);
    bf16* DS = (bf16*)(F.ws + WS_DS); float* DEC = (float*)(F.ws + WS_DEC);
    LAS float* cum = (LAS float*)(F.lds); LAS float* rt = cum + 64 * CST; LAS float* tot = rt + 64 * 16;
    LAS bf16* KE = (LAS bf16*)(tot + 4 * 128); LAS bf16* VL = KE + 64 * KST;
    const int fr = F.lane & 15, fq = F.lane >> 4;
    for (int u = F.vcu; u < 264 * 8; u += F.G) {
        const int c = u >> 3, h = (u >> 1) & 3, dir = u & 1; const bool lat = c >= 8; const int pr = (c - 8) & 127;
        RowRaw kraw; f32x4 tb[8];
        { const int i = F.tid & 63, grp = F.tid >> 6; row16_load(P + (size_t)(64 * c + i) * PST + 512 + h * 128, grp, lat, kraw); ropetab_load(ROPE, grp, pr, i, lat, tb); }
        gla_cum(F, a, c, h, dir, cum, rt, tot);
        const int lastrow = dir == 0 ? 63 : 0;
        {
            const int i = F.tid & 63, grp = F.tid >> 6;
            float kv[16], cl[16], ci[16];
            rope16_apply(kraw, tb, grp, lat, kv);
            ld16cum(cum + lastrow * CST + 16 * grp, cl); ld16cum(cum + i * CST + 16 * grp, ci);
#pragma unroll
            for (int e = 0; e < 16; ++e) kv[e] *= __expf(cl[e] - ci[e]);
            st16bf(KE + i * KST + 16 * grp, kv);
            gla_stage_v(F, c, h, VL);
            if (F.tid < 128) DEC[((size_t)(dir * 264 + c) * 4 + h) * 128 + F.tid] = __expf(cum[lastrow * CST + F.tid]);
        }
        __syncthreads();
        f32x4 acc[16];
#pragma unroll
        for (int nt = 0; nt < 16; ++nt) acc[nt] = (f32x4){0.f, 0.f, 0.f, 0.f};
#pragma unroll
        for (int ks = 0; ks < 2; ++ks) { const bf16x8 af = tr_frag(KE, KST, 32 * ks, 16 * F.wave, F.lane);
#pragma unroll
            for (int nt = 0; nt < 16; ++nt) { const bf16x8 bfr = tr_frag(VL, VST, 32 * ks, 16 * nt, F.lane); acc[nt] = MFMA16(af, bfr, acc[nt]); } }
        bf16* dsp = DS + ((size_t)(dir * 264 + c) * 4 + h) * 256 * 128;
#pragma unroll
        for (int nt = 0; nt < 16; ++nt) { v2u o; o.x = pk2(acc[nt][0], acc[nt][1]); o.y = pk2(acc[nt][2], acc[nt][3]);
            *(GAS v2u*)(dsp + (size_t)((((nt * 4 + (F.wave >> 1)) * 4 + ((2 * F.wave + (fq >> 1)) & 3)) * 16 + fr) * 8 + 4 * (fq & 1))) = o; }
        __syncthreads();
    }
}
__device__ __forceinline__ void p_gla_scan(Frame& F) {
    const bf16* DS = (const bf16*)(F.ws + WS_DS); bf16* SIN = (bf16*)(F.ws + WS_SIN); const float* DEC = (const float*)(F.ws + WS_DEC);
    LAS float* dl = (LAS float*)(F.lds);
    for (int job = F.vcu; job < 256; job += F.G) {
        const int vt = job & 15, h = (job >> 4) & 3, dir = (job >> 6) & 1, b = job >> 7;
        __syncthreads();
        for (int i = F.tid; i < 132 * 32; i += NTHREADS) { const int st = i >> 5, k4 = i & 31; int c;
            if (dir == 0) c = st < 4 ? 4 * b + st : 8 + 128 * b + (st - 4); else c = st < 4 ? 4 * b + 3 - st : 8 + 128 * b + 127 - (st - 4);
            *(LAS f32x4*)(dl + st * 128 + 4 * k4) = *(const GAS f32x4*)(DEC + ((size_t)(dir * 264 + c) * 4 + h) * 128 + 4 * k4); }
        __syncthreads();
        const int ks = F.wave >> 1, quad = 2 * (F.wave & 1) + (F.lane >> 5), fr = (F.lane >> 1) & 15, half = F.lane & 1;
        const int kk0 = 32 * ks + 8 * quad + 4 * half;
        const size_t eoff = (size_t)((((vt * 4 + ks) * 4 + quad) * 16 + fr) * 8 + 4 * half);
        f32x4 S = (f32x4){0.f, 0.f, 0.f, 0.f};
        for (int s0 = 0; s0 < 132; s0 += 12) {
            size_t o[12]; v2u d[12];
#pragma unroll
            for (int q = 0; q < 12; ++q) { const int st = s0 + q; int c;
                if (dir == 0) c = st < 4 ? 4 * b + st : 8 + 128 * b + (st - 4); else c = st < 4 ? 4 * b + 3 - st : 8 + 128 * b + 127 - (st - 4);
                o[q] = ((size_t)(dir * 264 + c) * 4 + h) * 32768 + eoff;
                d[q] = __builtin_nontemporal_load((const GAS v2u*)(DS + o[q])); }
#pragma unroll
            for (int q = 0; q < 12; ++q) { const f32x4 dc = *(const LAS f32x4*)(dl + (s0 + q) * 128 + kk0);
                v2u so; so.x = pk2(S.x, S.y); so.y = pk2(S.z, S.w);
                *(GAS v2u*)(SIN + o[q]) = so;
                S.x = S.x * dc.x + bflo(d[q].x); S.y = S.y * dc.y + bfhi(d[q].x); S.z = S.z * dc.z + bflo(d[q].y); S.w = S.w * dc.w + bfhi(d[q].y); }
        }
    }
}
__device__ __forceinline__ void p_gla_out(Frame& F, const Args& a) {
    const bf16* P = (const bf16*)(F.ws + WS_BIG); const float* ROPE = (const float*)(F.ws + WS_ROPE);
    const bf16* SIN = (const bf16*)(F.ws + WS_SIN); bf16* G = (bf16*)(F.ws + WS_G);
    constexpr int ST = 72;
    LAS float* cum = (LAS float*)(F.lds); LAS float* rt = cum + 64 * CST; LAS float* tot = rt + 64 * 16; LAS float* ssq = tot + 4 * 128;
    LAS bf16* VL = (LAS bf16*)(ssq + 8 * 64); LAS bf16* QD = VL + 64 * VST; LAS bf16* KI = QD + 64 * KST; LAS bf16* PL = KI + 64 * KST;
    const int fr = F.lane & 15, fq = F.lane >> 4;
    for (int u = F.vcu; u < 264 * 4; u += F.G) {
        const int c = u >> 2, h = u & 3; const bool lat = c >= 8; const int pr = (c - 8) & 127;
        f32x4 acc[2][4];
#pragma unroll
        for (int mt = 0; mt < 2; ++mt)
#pragma unroll
            for (int nt = 0; nt < 4; ++nt) acc[mt][nt] = (f32x4){0.f, 0.f, 0.f, 0.f};
        gla_stage_v(F, c, h, VL);
        float qv0[16], kv0[16];
#pragma unroll
        for (int dir = 0; dir < 2; ++dir) {
            RowRaw qraw0, kraw0; f32x4 tb0[8];
            const bf16* sp = SIN + ((size_t)(dir * 264 + c) * 4 + h) * 256 * 128;
            bf16x8 sfr[4][2];
#pragma unroll
            for (int ks = 0; ks < 4; ++ks)
#pragma unroll
                for (int mt = 0; mt < 2; ++mt) sfr[ks][mt] = *(const GAS bf16x8*)(sp + (size_t)(((((2 * F.wave + mt) * 4 + ks) * 4 + fq) * 16 + fr) * 8));
            { const int i = F.tid & 63, grp = F.tid >> 6; const size_t row = (size_t)(64 * c + i);
                if (dir == 0) { row16_load(P + row * PST + h * 128, grp, lat, qraw0); row16_load(P + row * PST + 512 + h * 128, grp, lat, kraw0); ropetab_load(ROPE, grp, pr, i, lat, tb0); } }
            gla_cum(F, a, c, h, dir, cum, rt, tot);
            {
                const int i = F.tid & 63, grp = F.tid >> 6;
                if (dir == 0) { rope16_apply(qraw0, tb0, grp, lat, qv0); rope16_apply(kraw0, tb0, grp, lat, kv0); }
                float qv[16], kv[16], ci[16];
                ld16cum(cum + i * CST + 16 * grp, ci);
#pragma unroll
                for (int e = 0; e < 16; ++e) { const float ex = __expf(ci[e]); qv[e] = qv0[e] * (0.08838834764831845f * ex); kv[e] = kv0[e] * __builtin_amdgcn_rcpf(ex); }
                st16bf(QD + i * KST + 16 * grp, qv); st16bf(KI + i * KST + 16 * grp, kv);
            }
            __syncthreads();
            {
                const int jt = F.wave >> 1;
#pragma unroll
                for (int t2 = 0; t2 < 2; ++t2) { const int it = 2 * (F.wave & 1) + t2; f32x4 s = (f32x4){0.f, 0.f, 0.f, 0.f};
#pragma unroll
                    for (int ks = 0; ks < 4; ++ks) { const bf16x8 af = *(const LAS bf16x8*)(KI + (16 * jt + fr) * KST + ks * 32 + fq * 8), bfr = *(const LAS bf16x8*)(QD + (16 * it + fr) * KST + ks * 32 + fq * 8); s = MFMA16(af, bfr, s); }
                    const int i = 16 * it + fr, j0 = 16 * jt + fq * 4; float pv[4];
#pragma unroll
                    for (int r = 0; r < 4; ++r) { const int j = j0 + r; const bool keep = dir == 0 ? (j <= i) : (j >= i); pv[r] = keep ? s[r] : 0.0f; }
                    v2u o; o.x = pk2(pv[0], pv[1]); o.y = pk2(pv[2], pv[3]);
                    *(LAS v2u*)(PL + i * ST + j0) = o; }
            }
            __syncthreads();
#pragma unroll
            for (int ks = 0; ks < 2; ++ks) {
                bf16x8 bfr[4];
#pragma unroll
                for (int nt = 0; nt < 4; ++nt) bfr[nt] = perm_frag(PL + (16 * nt + fr) * ST, 32 * ks, fq);
#pragma unroll
                for (int mt = 0; mt < 2; ++mt) { const bf16x8 af = tr_frag(VL, VST, 32 * ks, 32 * F.wave + 16 * mt, F.lane);
#pragma unroll
                    for (int nt = 0; nt < 4; ++nt) acc[mt][nt] = MFMA16(af, bfr[nt], acc[mt][nt]); } }
#pragma unroll
            for (int ks = 0; ks < 4; ++ks) {
                bf16x8 bfr[4];
#pragma unroll
                for (int nt = 0; nt < 4; ++nt) bfr[nt] = *(const LAS bf16x8*)(QD + (16 * nt + fr) * KST + ks * 32 + fq * 8);
#pragma unroll
                for (int mt = 0; mt < 2; ++mt) {
#pragma unroll
                    for (int nt = 0; nt < 4; ++nt) acc[mt][nt] = MFMA16(sfr[ks][mt], bfr[nt], acc[mt][nt]); } }
            __syncthreads();
        }
#pragma unroll
        for (int nt = 0; nt < 4; ++nt) { float s = 0.f;
#pragma unroll
            for (int mt = 0; mt < 2; ++mt)
#pragma unroll
                for (int j = 0; j < 4; ++j) s += acc[mt][nt][j] * acc[mt][nt][j];
            s += __shfl_xor(s, 16); s += __shfl_xor(s, 32);
            if (fq == 0) ssq[F.wave * 64 + 16 * nt + fr] = s; }
        __syncthreads();
#pragma unroll
        for (int nt = 0; nt < 4; ++nt) { const int i = 16 * nt + fr; float s = 0.f;
#pragma unroll
            for (int w8 = 0; w8 < 8; ++w8) s += ssq[w8 * 64 + i];
            const float rstd = 1.0f / sqrtf(s * (1.0f / 256.0f) + EPS); const size_t row = (size_t)(64 * c + i);
#pragma unroll
            for (int mt = 0; mt < 2; ++mt) { const int v0 = 32 * F.wave + 16 * mt + fq * 4;
                const v2u gg = *(const GAS v2u*)(P + row * PST + 2048 + h * 256 + v0); const f32x4 go = *(const GAS f32x4*)(a.in[I_BGO] + v0);
                const float g0 = bflo(gg.x), g1 = bfhi(gg.x), g2 = bflo(gg.y), g3 = bfhi(gg.y);
                const float o0 = acc[mt][nt][0] * rstd * go.x * (g0 / (1.0f + __expf(-g0))), o1 = acc[mt][nt][1] * rstd * go.y * (g1 / (1.0f + __expf(-g1)));
                const float o2 = acc[mt][nt][2] * rstd * go.z * (g2 / (1.0f + __expf(-g2))), o3 = acc[mt][nt][3] * rstd * go.w * (g3 / (1.0f + __expf(-g3)));
                v2u o; o.x = pk2(o0, o1); o.y = pk2(o2, o3);
                *(GAS v2u*)(G + row * D + h * 256 + v0) = o; } }
        __syncthreads();
    }
}

__device__ __forceinline__ int na_koff(int key, int c16) { return key * 128 + ((c16 ^ ((key >> 1) & 7)) << 4); }
__device__ __forceinline__ int na_voff(int key, int c16) { return key * 128 + (((((c16 >> 1) ^ ((key >> 1) & 3)) << 1) | (c16 & 1)) << 4); }
__device__ __forceinline__ bf16x8 na_vfrag(const LAS unsigned char* V, int kb, int dt, int lane) {
    const int g = lane >> 4, w = lane & 15, q = w >> 2, p = w & 3; const int r0 = kb + 4 * g + q, r1 = r0 + 16;
    const s16x4 lo = __builtin_amdgcn_ds_read_tr16_b64_v4i16((LAS s16x4*)(V + r0 * 128 + ((dt ^ ((r0 >> 1) & 3)) << 5) + 8 * p));
    const s16x4 hi = __builtin_amdgcn_ds_read_tr16_b64_v4i16((LAS s16x4*)(V + r1 * 128 + ((dt ^ ((r1 >> 1) & 3)) << 5) + 8 * p));
    return (bf16x8){lo[0], lo[1], lo[2], lo[3], hi[0], hi[1], hi[2], hi[3]};
}
#define LBAR() do { asm volatile("s_waitcnt lgkmcnt(0)" ::: "memory"); __builtin_amdgcn_s_barrier(); asm volatile("" ::: "memory"); } while (0)
struct NaState { bf16x8 qf[2], qn[2]; f32x4 o[4]; float m_run, l_run; int cur_bh; };
__device__ __forceinline__ int na_r0(int r) { return r < 4 ? 0 : (r > 124 ? 120 : r - 4); }
__device__ __forceinline__ void na_load(Frame& F, int u_lo, int st, v4u (&kr)[3], v4u (&vr)[3]) {
    const bf16* QKV = (const bf16*)(F.ws + WS_BIG);
    const int u = u_lo + st / 3, pass = st % 3, bh = u >> 6, rp = u & 63, b = bh >> 4, h = bh & 15;
    const int rbase = na_r0(2 * rp) + 3 * pass;
#pragma unroll
    for (int i = 0; i < 3; ++i) { const int id = F.tid + 512 * i, key = id >> 3, c = id & 7; int row = rbase + (key >> 6); row = row > 127 ? 127 : row;
        const bf16* p = QKV + ((size_t)NCTX + (size_t)b * SEQ + (size_t)row * 64 + (key & 63)) * 3072 + 1024 + h * 64 + 8 * c; kr[i] = *(const GAS v4u*)p; vr[i] = *(const GAS v4u*)(p + 1024); }
}
__device__ __forceinline__ void na_loadq(Frame& F, int u, int fq, bf16x8 (&q)[2]) {
    const bf16* QKV = (const bf16*)(F.ws + WS_BIG);
    const int bh = u >> 6, rp = u & 63, b = bh >> 4, h = bh & 15, r = 2 * rp + (F.wave >> 2), qcol = 16 * (F.wave & 3) + (F.lane & 15);
#pragma unroll
    for (int ks = 0; ks < 2; ++ks) q[ks] = *(const GAS bf16x8*)(QKV + ((size_t)NCTX + (size_t)b * SEQ + (size_t)r * 64 + qcol) * 3072 + h * 64 + ks * 32 + fq * 8);
}
__device__ __forceinline__ void na_stage(Frame& F, const Args& a, const int u_lo, const int nstage, const int stage, v4u (&kr)[3], v4u (&vr)[3], NaState& S) {
    const bf16* QKV = (const bf16*)(F.ws + WS_BIG); bf16* G = (bf16*)(F.ws + WS_G);
    constexpr int QS = 3072;
    LAS unsigned char* KC = F.lds; LAS unsigned char* VC = F.lds + 32768; LAS unsigned char* KL = F.lds + 65536; LAS unsigned char* VL = F.lds + 65536 + 24576;
    LAS float* RPB = (LAS float*)(F.lds + 65536 + 49152);
    const int fr = F.lane & 15, fq = F.lane >> 4;
    const int qr = F.wave >> 2, jb = F.wave & 3;
    const int bstart = jb == 0 ? 0 : (jb == 1 ? 8 : (jb == 2 ? 24 : 32));
    const int qcol = 16 * jb + fr; const int cstart = qcol < 8 ? 0 : (qcol > 56 ? 48 : qcol - 8);
    const int u = u_lo + stage / 3, pass = stage % 3;
    const int bh = u >> 6, rp = u & 63, b = bh >> 4, h = bh & 15;
    const int r = 2 * rp + qr, r0q = na_r0(r), rbase = na_r0(2 * rp) + 3 * pass;
    const size_t lat0 = (size_t)NCTX + (size_t)b * SEQ;
    LBAR();
    if (bh != S.cur_bh) {
        S.cur_bh = bh;
        for (int i = F.tid; i < 465; i += NTHREADS) RPB[i] = a.in[I_CRPB][h * 465 + i];
#pragma unroll
        for (int i = 0; i < 4; ++i) { const int id = F.tid + 512 * i, key = id >> 3, c = id & 7;
            const bf16* p = QKV + (size_t)(b * CTXL + key) * QS + 1024 + h * 64 + 8 * c;
            *(LAS v4u*)(KC + na_koff(key, c)) = *(const GAS v4u*)p; *(LAS v4u*)(VC + na_voff(key, c)) = *(const GAS v4u*)(p + 1024); }
    }
#pragma unroll
    for (int i = 0; i < 3; ++i) { const int id = F.tid + 512 * i, key = id >> 3, c = id & 7;
        *(LAS v4u*)(KL + na_koff(key, c)) = kr[i]; *(LAS v4u*)(VL + na_voff(key, c)) = vr[i]; }
    if (pass == 0) {
        S.qf[0] = S.qn[0]; S.qf[1] = S.qn[1];
#pragma unroll
        for (int dt = 0; dt < 4; ++dt) S.o[dt] = (f32x4){0.f, 0.f, 0.f, 0.f};
        S.m_run = -3.0e38f; S.l_run = 0.f;
        if (stage + 3 < nstage) na_loadq(F, u + 1, fq, S.qn);
    }
    if (stage + 1 < nstage) na_load(F, u_lo, stage + 1, kr, vr);
    LBAR();
    f32x4 s[12];
#pragma unroll
    for (int t = 0; t < 6; ++t) { const int kidx = (t >> 1) * 64 + bstart + 16 * (t & 1) + fr;
        const bf16x8 k0 = *(const LAS bf16x8*)(KL + na_koff(kidx, fq)), k1 = *(const LAS bf16x8*)(KL + na_koff(kidx, 4 + fq));
        f32x4 tt = (f32x4){0.f, 0.f, 0.f, 0.f}; tt = MFMA16(k0, S.qf[0], tt); tt = MFMA16(k1, S.qf[1], tt); s[t] = tt; }
#pragma unroll
    for (int t = 0; t < 6; ++t) { const int kidx = (16 * (6 * pass + t) + fr) & 255;
        const bf16x8 k0 = *(const LAS bf16x8*)(KC + na_koff(kidx, fq)), k1 = *(const LAS bf16x8*)(KC + na_koff(kidx, 4 + fq));
        f32x4 tt = (f32x4){0.f, 0.f, 0.f, 0.f}; tt = MFMA16(k0, S.qf[0], tt); tt = MFMA16(k1, S.qf[1], tt); s[6 + t] = tt; }
    float mx = S.m_run;
    {
        float bias[24];
#pragma unroll
        for (int q = 0; q < 24; ++q) { const int t = q >> 2, j = q & 3; const int krow = rbase + (t >> 1), kcol = bstart + 16 * (t & 1) + fq * 4 + j;
            int ci = kcol - qcol + 15; ci = ci < 0 ? 0 : (ci > 30 ? 30 : ci); int ri = krow - r + 7; ri = ri < 0 ? 0 : (ri > 14 ? 14 : ri); bias[q] = RPB[ri * 31 + ci]; }
        asm volatile("" : "+v"(bias[0]), "+v"(bias[1]), "+v"(bias[2]), "+v"(bias[3]), "+v"(bias[4]), "+v"(bias[5]), "+v"(bias[6]), "+v"(bias[7]),
                          "+v"(bias[8]), "+v"(bias[9]), "+v"(bias[10]), "+v"(bias[11]), "+v"(bias[12]), "+v"(bias[13]), "+v"(bias[14]), "+v"(bias[15]));
        asm volatile("" : "+v"(bias[16]), "+v"(bias[17]), "+v"(bias[18]), "+v"(bias[19]), "+v"(bias[20]), "+v"(bias[21]), "+v"(bias[22]), "+v"(bias[23]));
#pragma unroll
        for (int q = 0; q < 24; ++q) { const int t = q >> 2, j = q & 3; const int krow = rbase + (t >> 1), kcol = bstart + 16 * (t & 1) + fq * 4 + j;
            const bool ok = kcol >= cstart && kcol < cstart + 16 && krow >= r0q && krow <= r0q + 7;
            const float v = ok ? s[t][j] * 0.125f + bias[q] : -3.0e38f;
            s[t][j] = v; mx = fmaxf(mx, v); }
    }
#pragma unroll
    for (int t = 0; t < 6; ++t) { const bool ok = 6 * pass + t < 16;
#pragma unroll
        for (int j = 0; j < 4; ++j) { const float v = ok ? s[6 + t][j] * 0.125f : -3.0e38f; s[6 + t][j] = v; mx = fmaxf(mx, v); } }
    mx = fmaxf(mx, __shfl_xor(mx, 16)); mx = fmaxf(mx, __shfl_xor(mx, 32));
    const float alpha = __expf(S.m_run - mx); S.m_run = mx;
    float l = 0.f;
#pragma unroll
    for (int t = 0; t < 12; ++t)
#pragma unroll
        for (int j = 0; j < 4; ++j) { const float p = s[t][j] > -1.0e38f ? __expf(s[t][j] - mx) : 0.0f; s[t][j] = p; l += p; }
    S.l_run = S.l_run * alpha + l;
#pragma unroll
    for (int dt = 0; dt < 4; ++dt) S.o[dt] = S.o[dt] * alpha;
#pragma unroll
    for (int st = 0; st < 6; ++st) {
        v4u pw; pw.x = pk2(s[2 * st][0], s[2 * st][1]); pw.y = pk2(s[2 * st][2], s[2 * st][3]); pw.z = pk2(s[2 * st + 1][0], s[2 * st + 1][1]); pw.w = pk2(s[2 * st + 1][2], s[2 * st + 1][3]);
        const bf16x8 pf = __builtin_bit_cast(bf16x8, pw);
        const LAS unsigned char* VB = st < 3 ? VL : VC;
        const int kb = st < 3 ? st * 64 + bstart : (16 * (6 * pass + 2 * (st - 3))) & 255;
#pragma unroll
        for (int dt = 0; dt < 4; ++dt) S.o[dt] = MFMA16(na_vfrag(VB, kb, dt, F.lane), pf, S.o[dt]);
    }
    if (pass == 2) {
        float lt = S.l_run; lt += __shfl_xor(lt, 16); lt += __shfl_xor(lt, 32);
        const float inv = 1.0f / lt;
        bf16* op = G + (lat0 + (size_t)r * 64 + qcol) * D + h * 64 + fq * 4;
#pragma unroll
        for (int dt = 0; dt < 4; ++dt) { v2u w; w.x = pk2(S.o[dt][0] * inv, S.o[dt][1] * inv); w.y = pk2(S.o[dt][2] * inv, S.o[dt][3] * inv); *(GAS v2u*)(op + 16 * dt) = w; }
    }
}
__device__ __forceinline__ void p_natten(Frame& F, const Args& a) {
    const int u_lo = (int)(((long)F.vcu * 2048) / F.G), u_hi = (int)(((long)(F.vcu + 1) * 2048) / F.G);
    const int nstage = 3 * (u_hi - u_lo);
    if (nstage <= 0) return;
    const int fq = F.lane >> 4;
    v4u kA[3], vA[3];
    NaState S; S.cur_bh = -1; S.m_run = -3.0e38f; S.l_run = 0.f;
#pragma unroll
    for (int dt = 0; dt < 4; ++dt) S.o[dt] = (f32x4){0.f, 0.f, 0.f, 0.f};
    na_loadq(F, u_lo, fq, S.qn); S.qf[0] = S.qn[0]; S.qf[1] = S.qn[1];
    na_load(F, u_lo, 0, kA, vA);
    for (int stage = 0; stage < nstage; ++stage) na_stage(F, a, u_lo, nstage, stage, kA, vA, S);
}

template <int MODE>
__device__ __forceinline__ void sgemm_region(Frame& F, const bf16* A, const bf16* Bt, int R0, int nrb, int C0, int ncb, bf16* O, int ldo, float* X, const float* gate, int u_first, int u_stride) {
    constexpr int ST = 264;
    LAS bf16* As = (LAS bf16*)(F.lds); LAS bf16* Bs = As + 64 * ST;
    const int fr = F.lane & 15, fq = F.lane >> 4, mt = F.wave >> 1, nt0 = 2 * (F.wave & 1);
    for (int u = u_first; u < nrb * ncb; u += u_stride) {
        const int rb = u % nrb, cb = u / nrb; const int r0 = R0 + 64 * rb, c0 = C0 + 64 * cb;
        pg8::f32x4 acc[2] = {(pg8::f32x4){0.f, 0.f, 0.f, 0.f}, (pg8::f32x4){0.f, 0.f, 0.f, 0.f}};
        v4u ra[4], rbv[4];
#pragma unroll
        for (int i = 0; i < 4; ++i) { const int id = F.tid + 512 * i, row = id >> 5, c = id & 31;
            ra[i] = *(const GAS v4u*)(A + (size_t)(r0 + row) * 1024 + 8 * c); rbv[i] = *(const GAS v4u*)(Bt + (size_t)(c0 + row) * 1024 + 8 * c); }
        for (int kc = 0; kc < 4; ++kc) {
            __syncthreads();
#pragma unroll
            for (int i = 0; i < 4; ++i) { const int id = F.tid + 512 * i, row = id >> 5, c = id & 31;
                *(LAS v4u*)(As + row * ST + 8 * c) = ra[i]; *(LAS v4u*)(Bs + row * ST + 8 * c) = rbv[i]; }
            if (kc < 3) {
#pragma unroll
                for (int i = 0; i < 4; ++i) { const int id = F.tid + 512 * i, row = id >> 5, c = id & 31;
                    ra[i] = *(const GAS v4u*)(A + (size_t)(r0 + row) * 1024 + 256 * (kc + 1) + 8 * c); rbv[i] = *(const GAS v4u*)(Bt + (size_t)(c0 + row) * 1024 + 256 * (kc + 1) + 8 * c); } }
            __syncthreads();
#pragma unroll
            for (int ks = 0; ks < 8; ++ks) { const bf16x8 af = *(const LAS bf16x8*)(As + (16 * mt + fr) * ST + ks * 32 + fq * 8);
#pragma unroll
                for (int n = 0; n < 2; ++n) { const bf16x8 bfr = *(const LAS bf16x8*)(Bs + (16 * (nt0 + n) + fr) * ST + ks * 32 + fq * 8); acc[n] = MFMA16(bfr, af, acc[n]); } }
        }
        const size_t row = (size_t)(r0 + 16 * mt + fr);
#pragma unroll
        for (int n = 0; n < 2; ++n) { const int col = c0 + 16 * (nt0 + n) + 4 * fq;
            if (MODE == 2) { f32x4* p = (f32x4*)(X + row * 1024 + col); const f32x4 g = *(const f32x4*)(gate + col); *p = *p + g * acc[n]; }
            else { f32x4 v = acc[n];
                if (MODE == 1) { const pg8::f32x2 a2 = pg8::gelu_pk((pg8::f32x2){v[0], v[1]}), b2 = pg8::gelu_pk((pg8::f32x2){v[2], v[3]}); v = (f32x4){a2.x, a2.y, b2.x, b2.y}; }
                v2u o; o.x = pk2(v[0], v[1]); o.y = pk2(v[2], v[3]); *(GAS v2u*)(O + row * ldo + col) = o; } }
    }
    __syncthreads();
}

__device__ __forceinline__ void ph_moe_gu(Frame& F, const Args& args, const int layer) {
    moe_tables(F, layer);
    const LAS int* Mt = (const LAS int*)(F.lds + MISC_OFF); const int total = Mt[32];
    pg8::Gemm g{(const bf16*)(F.ws + WS_H), (const bf16*)(F.ws + WS_WGU) + (size_t)layer * 32 * 2048 * 1024, total, 2048, D};
    pg8::GroupedOrder S; S.init(total, 2048, F.G, (int)blockIdx.x); S.tile_e = Mt + 64;
    pg8::EpiSwiglu E{(bf16*)(F.ws + WS_ACT), D, args.in[I_MBGU] + (size_t)layer * 32 * 2048, 2048};
    pg8::gemm_phase<pg8::EpiSwiglu, pg8::GroupedOrder, true>(F.lds + RING_OFF, g, S, E, (const unsigned*)(F.ws + WS_LIST), Mt, NTOK);
}
__device__ __forceinline__ void ph_moe_dn(Frame& F, const Args& args, const int layer) {
    moe_tables(F, layer);
    const LAS int* Mt = (const LAS int*)(F.lds + MISC_OFF); const int total = Mt[32];
    pg8::Gemm g{(const bf16*)(F.ws + WS_ACT), (const bf16*)(F.ws + WS_WDN) + (size_t)layer * 32 * 1024 * 1024, total, D, D};
    pg8::GroupedOrder S; S.init(total, D, F.G, (int)blockIdx.x); S.tile_e = Mt + 64;
    pg8::EpiBf16<0> E{(bf16*)(F.ws + WS_YB), D, args.in[I_MBDN] + (size_t)layer * 32 * 1024, 1024};
    pg8::gemm_phase<pg8::EpiBf16<0>, pg8::GroupedOrder>(F.lds + RING_OFF, g, S, E);
}
template <int LAYER> __device__ __forceinline__ void ph_ingemm(Frame& F) {
    constexpr int layer = LAYER, kind = layer % 3;
    const bf16* H = (const bf16*)(F.ws + WS_H);
    const bf16* A = H + (size_t)2 * 256 * D; constexpr int M = 64 * 256;
    if constexpr (kind == 0) {
        const bf16* Bt = (const bf16*)(F.ws + WS_WAIN) + (size_t)(layer / 3) * 2048 * 1024;
        pg8::Gemm g{A, Bt, M, 2048, D}; pg8::StaticOrder S; S.init(M, 2048, F.G, (int)blockIdx.x);
        pg8::EpiBf16<1> E{(bf16*)(F.ws + WS_BIG) + (size_t)2 * 256 * 2048, 2048, nullptr, 0};
        pg8::gemm_phase<pg8::EpiBf16<1>, pg8::StaticOrder>(F.lds + RING_OFF, g, S, E);
        if constexpr (layer < 3) sgemm_region<1>(F, H, Bt, 0, 8, 0, 32, (bf16*)(F.ws + WS_BIG), 2048, nullptr, nullptr, F.vcu, F.G);
    } else if constexpr (kind == 1) {
        const bf16* Bt = (const bf16*)(F.ws + WS_WBIN);
        pg8::Gemm g{A, Bt, M, 3072, D}; pg8::StaticOrder S; S.init(M, 3072, F.G, (int)blockIdx.x);
        pg8::EpiBf16<0> E{(bf16*)(F.ws + WS_BIG) + (size_t)2 * 256 * GLA_INP, GLA_INP, nullptr, 0};
        pg8::gemm_phase<pg8::EpiBf16<0>, pg8::StaticOrder>(F.lds + RING_OFF, g, S, E);
        sgemm_region<0>(F, H, Bt, 0, 8, 0, 48, (bf16*)(F.ws + WS_BIG), GLA_INP, nullptr, nullptr, F.vcu, F.G);
        sgemm_region<0>(F, H, Bt, 0, 264, 3072, 1, (bf16*)(F.ws + WS_BIG), GLA_INP, nullptr, nullptr, (F.vcu + 128) % F.G, F.G);
    } else {
        const bf16* Bt = (const bf16*)(F.ws + WS_WCQKV);
        pg8::Gemm g{A, Bt, M, 3072, D}; pg8::StaticOrder S; S.init(M, 3072, F.G, (int)blockIdx.x);
        pg8::EpiBf16<0> E{(bf16*)(F.ws + WS_BIG) + (size_t)2 * 256 * 3072, 3072, nullptr, 0};
        pg8::gemm_phase<pg8::EpiBf16<0>, pg8::StaticOrder>(F.lds + RING_OFF, g, S, E);
        sgemm_region<0>(F, H, Bt, 0, 8, 1024, 32, (bf16*)(F.ws + WS_BIG), 3072, nullptr, nullptr, F.vcu, F.G);
    }
}

#define IN(k) (lo <= (k) && (k) < hi)
#define SEAM(k) do { if (IN(k) && IN((k) + 1)) { xcd_barrier(bar); if (PROBE_BAR) xcd_barrier(bar); } else __syncthreads(); } while (0)
template <int LAYER> __device__ __forceinline__ void run_layer(Frame& F, const Args& args, const XcdBarrier& bar, const int lo, const int hi) {
    {
        constexpr int layer = LAYER; constexpr int kind = layer % 3, base = 1 + 10 * layer;
        constexpr int mt0 = (layer >= 3) ? 2 : 0;
        constexpr int mo0 = (layer >= 2) ? 2 : 0;
        if (IN(base + 0)) { p_prenorm(F, args, layer, false);
#if PROBE_TOK
            __syncthreads(); p_prenorm(F, args, layer, false, true);
#endif
        } SEAM(base + 0);
        if (IN(base + 1)) { ph_ingemm<LAYER>(F);
#if PROBE_ING
            __syncthreads(); ph_ingemm<LAYER>(F);
#endif
        }
        SEAM(base + 1);
        if (IN(base + 2)) for (int rep = 0; rep < 1 + (kind == 1 ? PROBE_GLA : (kind == 0 ? PROBE_MIX : PROBE_NAT)); ++rep) { if (rep) __syncthreads(); if constexpr (kind == 0) p_spatial(F, args, layer); else if constexpr (kind == 1) p_gla_ds(F, args); else p_natten(F, args); } SEAM(base + 2);
        if constexpr (kind == 1) { if (IN(base + 3)) for (int rep = 0; rep < 1 + PROBE_GLA; ++rep) { p_gla_scan(F); } SEAM(base + 3); }
        if constexpr (kind == 1) { if (IN(base + 4)) for (int rep = 0; rep < 1 + PROBE_GLA; ++rep) { if (rep) __syncthreads(); p_gla_out(F, args); } SEAM(base + 4); }
        if (IN(base + 5)) {
            constexpr int M = 64 * 256;
            const bf16* Bt = (const bf16*)(F.ws + (kind == 0 ? WS_WAOUT : (kind == 1 ? WS_WBOUT : WS_WCOUT))) + (kind == 0 ? (size_t)(layer / 3) * 1024 * 1024 : 0);
            const float* gate = (const float*)(F.ws + WS_ADA) + (size_t)(layer * 3 * 6 + 2) * D;
            pg8::Gemm g{(const bf16*)(F.ws + WS_G) + (size_t)2 * 256 * D, Bt, M, D, D}; pg8::StaticOrder S; S.init(M, D, F.G, (int)blockIdx.x);
            pg8::EpiResid E{(float*)(F.ws + WS_X) + (size_t)2 * 256 * D, gate, 6 * D, 2, false};
            pg8::gemm_phase<pg8::EpiResid, pg8::StaticOrder>(F.lds + RING_OFF, g, S, E);
#if PROBE_OUTG
            { __syncthreads(); pg8::EpiResid E2{(float*)(F.ws + WS_X) + (size_t)2 * 256 * D, gate, 6 * D, 2, true}; pg8::gemm_phase<pg8::EpiResid, pg8::StaticOrder>(F.lds + RING_OFF, g, S, E2); }
#endif
            if constexpr (layer < 2) sgemm_region<2>(F, (const bf16*)(F.ws + WS_G), Bt, 0, 8, 0, 16, nullptr, 0, (float*)(F.ws + WS_X), gate, F.vcu, F.G);
        }
        SEAM(base + 5);
        if (IN(base + 6)) { p_router(F, args, layer);
#if PROBE_TOK
            __syncthreads(); p_router(F, args, layer, true);
#endif
        } SEAM(base + 6);
        if (IN(base + 8)) { ph_moe_gu(F, args, layer);
#if PROBE_MOE
            __syncthreads(); ph_moe_gu(F, args, layer);
#endif
        }
        SEAM(base + 8);
        if (IN(base + 9)) { ph_moe_dn(F, args, layer);
#if PROBE_MOE
            __syncthreads(); ph_moe_dn(F, args, layer);
#endif
        }
        SEAM(base + 9);
    }
}

__global__ void __launch_bounds__(NTHREADS, 2) fwd(Args args) {
    extern __shared__ __attribute__((aligned(16))) unsigned char lds[];
    Frame F;
    F.lds = (LAS unsigned char*)lds;
    F.tid = threadIdx.x; F.lane = F.tid & 63; F.wave = __builtin_amdgcn_readfirstlane(F.tid >> 6);
    F.G = gridDim.x; { const int bx = blockIdx.x; F.vcu = (F.G % 8 == 0) ? (bx % 8) * (F.G / 8) + bx / 8 : bx; }
    F.ws = args.ws; F.ctl = (unsigned*)(args.ws + WS_CTL);
    volatile LAS unsigned* BST = (volatile LAS unsigned*)(F.lds + LDS_BYTES - 16);
    if (F.tid < 4) BST[F.tid] = 0u;
    __syncthreads();
    const int lo = args.ph_lo, hi = args.ph_hi;
    XcdBarrier bar; bar.bar = (unsigned*)(F.ctl + CW_BAR); bar.x = 0; bar.st = BST;
    if (hi - lo > 1) bar = xcd_barrier_post((unsigned*)(F.ctl + CW_BAR), BST);
    if (IN(0)) { p_prologue(F, args);
#if PROBE_PRO
        __syncthreads(); p_prologue(F, args);
#endif
    } SEAM(0);

    run_layer<0>(F, args, bar, lo, hi);
    run_layer<1>(F, args, bar, lo, hi);
    run_layer<2>(F, args, bar, lo, hi);
    run_layer<3>(F, args, bar, lo, hi);
    if (IN(41)) { p_prenorm(F, args, 4, true); }
#undef IN
#undef SEAM
}

extern "C" void kernel_launch(void* const* d_in, const int* in_sizes, int n_in, void* d_out, int out_size, void* d_ws, size_t ws_size, hipStream_t stream) {
    static int grid = 0;
    if (grid == 0) {
        if (n_in != 28 || out_size != NLAT * D || ws_size < WS_END) { fprintf(stderr, "kernel_launch: unexpected problem (n_in %d, out %d, ws %zu < %zu)\n", n_in, out_size, ws_size, (size_t)WS_END); grid = -1; return; }
        int dev = 0, cus = 0, per_cu = 0;
        if (hipGetDevice(&dev) != hipSuccess || hipDeviceGetAttribute(&cus, hipDeviceAttributeMultiprocessorCount, dev) != hipSuccess) { grid = -1; return; }
        if (hipFuncSetAttribute((const void*)fwd, hipFuncAttributeMaxDynamicSharedMemorySize, LDS_BYTES) != hipSuccess) { fprintf(stderr, "kernel_launch: hipFuncSetAttribute failed\n"); grid = -1; return; }
        if (hipOccupancyMaxActiveBlocksPerMultiprocessor(&per_cu, (const void*)fwd, NTHREADS, LDS_BYTES) != hipSuccess || per_cu < 1) { fprintf(stderr, "kernel_launch: occupancy query reports %d\n", per_cu); }
        (void)hipGetLastError();
        grid = cus;
    }
    if (grid < 0) return;
    (void)hipMemsetAsync((char*)d_ws + WS_CTL, 0, CTL_ZERO_BYTES, stream);
    Args a{};
    for (int i = 0; i < 28; ++i) a.in[i] = (const float*)d_in[i];
    a.out = (float*)d_out; a.ws = (unsigned char*)d_ws;
#if MK_ONE_LAUNCH
    a.ph_lo = 0; a.ph_hi = 42;
    hipLaunchKernelGGL(fwd, dim3(grid), dim3(NTHREADS), LDS_BYTES, stream, a);
#else
    for (int p = 0; p < 42; ++p) {
        if (p >= 1 && p <= 40) { const int layer = (p - 1) / 10, loc = (p - 1) % 10; if (((loc == 3 || loc == 4) && (layer % 3) != 1) || loc == 7) continue; }
        a.ph_lo = p; a.ph_hi = p + 1;
        hipLaunchKernelGGL(fwd, dim3(grid), dim3(NTHREADS), LDS_BYTES, stream, a);
    }
#endif
}
```

```cpp
#include <hip/hip_runtime.h>
#include <cstdio>
#include <cstdint>

#ifndef MK_ONE_LAUNCH
#define MK_ONE_LAUNCH 1
#endif
#ifndef PROBE_PRO
#define PROBE_PRO 0
#endif
#ifndef PROBE_MOE
#define PROBE_MOE 0
#endif
#ifndef PROBE_ING
#define PROBE_ING 0
#endif
#ifndef PROBE_MIX
#define PROBE_MIX 0
#endif
#ifndef PROBE_GLA
#define PROBE_GLA 0
#endif
#ifndef PROBE_TOK
#define PROBE_TOK 0
#endif
#ifndef PROBE_BAR
#define PROBE_BAR 0
#endif
#ifndef PROBE_OUTG
#define PROBE_OUTG 0
#endif
#ifndef PROBE_STAMP
#define PROBE_STAMP 0
#endif
#ifndef PROBE_NAT
#define PROBE_NAT 0
#endif
#ifndef PROBE_GATHER
#define PROBE_GATHER 0
#endif

namespace pg8 {
#define PG8_LAS __attribute__((address_space(3)))
typedef unsigned short bf16_t;
typedef short bf16x8 __attribute__((ext_vector_type(8)));
typedef float f32x4 __attribute__((ext_vector_type(4)));
typedef unsigned u32x4 __attribute__((ext_vector_type(4)));
constexpr int BM = 256, BK = 64, HALF = 128, HTB = HALF * BK * 2, STAGE_BYTES = 8 * HTB, NXCD = 8, WGM = 8;

__host__ __device__ __forceinline__ int lds_byte(int r, int c) { const int st = (r >> 4) * 2 + (c >> 5), rr = r & 15, cc = c & 31, ob = rr * 64 + cc * 2; return st * 1024 + (ob ^ (((ob >> 9) & 1) << 5)); }
__host__ __device__ __forceinline__ void stage_rc(int b, int& R, int& C) { const int st = b / 1024, sb = b % 1024, swz = sb ^ (((sb >> 9) & 1) << 5); R = (st >> 1) * 16 + swz / 64; C = (st & 1) * 32 + (swz % 64) / 2; }
__host__ __device__ __forceinline__ int perm32(int rho) { const int n = rho >> 4, i = rho & 15; return 8 * (i >> 2) + 4 * n + (i & 3); }

struct Unit { int pm, pn, pb, e; };
struct Gemm { const bf16_t* A; const bf16_t* Bt; int M, N, K; };

struct StaticOrder {
    int nM, nN, nwg, G, c;
    __device__ void init(int M, int N, int G_, int c_) { nM = M / BM; nN = N / BM; nwg = nM * nN; G = G_; c = c_; }
    __device__ bool next(int i, Unit& u) const {
        const long L = (long)i * G + c; if (L >= nwg) return false;
        int wgid = (int)L; { const int q = nwg / NXCD, r = nwg % NXCD, xcd = wgid % NXCD, off = wgid / NXCD; wgid = (xcd < r ? xcd * (q + 1) : r * (q + 1) + (xcd - r) * q) + off; }
        const int nig = WGM * nN, gid = wgid / nig, fm = gid * WGM, gsz = (nM - fm) < WGM ? (nM - fm) : WGM;
        u.pm = fm + ((wgid % nig) % gsz); u.pn = (wgid % nig) / gsz; u.pb = u.pn; u.e = 0; return true;
    }
};
struct GroupedOrder : StaticOrder {
    const PG8_LAS int* tile_e;
    __device__ bool next(int i, Unit& u) const {
        if (!StaticOrder::next(i, u)) return false;
        u.e = __builtin_amdgcn_readfirstlane(tile_e[u.pm]); u.pb = u.e * nN + u.pn; return true;
    }
};

__device__ __forceinline__ unsigned cvt_pk_bf16(float lo, float hi) { unsigned r; asm volatile("v_cvt_pk_bf16_f32 %0, %1, %2" : "=v"(r) : "v"(lo), "v"(hi)); return r; }
typedef float f32x2 __attribute__((ext_vector_type(2)));
__device__ __forceinline__ f32x2 gelu_pk(f32x2 v) {
    const f32x2 av = __builtin_elementwise_abs(v), d = av * 0.2316418882f + 1.0f;
    f32x2 t; t.x = __builtin_amdgcn_rcpf(d.x); t.y = __builtin_amdgcn_rcpf(d.y);
    f32x2 q = t * 0.5307027145f + (-0.7265760135f); q = q * t + 0.7107068705f; q = q * t + (-0.142248368f); q = q * t + 0.127414796f; q = q * t;
    const f32x2 s = (v * v) * (-0.72134752044f);
    f32x2 e; e.x = __builtin_amdgcn_exp2f(s.x); e.y = __builtin_amdgcn_exp2f(s.y);
    const f32x2 m = v * (q * e), r = v - m;
    f32x2 o; o.x = v.x < 0.f ? m.x : r.x; o.y = v.y < 0.f ? m.y : r.y; return o;
}

template <int ACT> struct EpiBf16 {
    static constexpr bool PERM = true;
    bf16_t* O; int ldc; const float* bias; int bias_estride;
    __device__ __forceinline__ void operator()(const f32x4 (&acc)[2][2][4][2], const Unit& u, int wr, int wc, int fr, int fq) const {
        const int row0 = u.pm * BM + wr * 64 + fr; const int col0 = u.pn * BM + wc * 32 + 8 * fq;
        const float* bp = bias ? bias + (size_t)u.e * bias_estride : nullptr;
        f32x4 bv[2][2];
#pragma unroll
        for (int bj = 0; bj < 2; ++bj)
#pragma unroll
            for (int n = 0; n < 2; ++n) bv[bj][n] = bp ? *(const f32x4*)(bp + col0 + bj * HALF + 4 * n) : (f32x4){0.f, 0.f, 0.f, 0.f};
#pragma unroll
        for (int ai = 0; ai < 2; ++ai)
#pragma unroll
            for (int m = 0; m < 4; ++m) { bf16_t* rowp = O + (size_t)(row0 + ai * HALF + m * 16) * ldc + col0;
#pragma unroll
                for (int bj = 0; bj < 2; ++bj) { f32x4 v0 = acc[ai][bj][m][0] + bv[bj][0], v1 = acc[ai][bj][m][1] + bv[bj][1];
                    if (ACT == 1) { f32x2 a = gelu_pk((f32x2){v0[0], v0[1]}), b = gelu_pk((f32x2){v0[2], v0[3]}), c = gelu_pk((f32x2){v1[0], v1[1]}), d = gelu_pk((f32x2){v1[2], v1[3]});
                        v0 = (f32x4){a.x, a.y, b.x, b.y}; v1 = (f32x4){c.x, c.y, d.x, d.y}; }
                    u32x4 w; w.x = cvt_pk_bf16(v0[0], v0[1]); w.y = cvt_pk_bf16(v0[2], v0[3]); w.z = cvt_pk_bf16(v1[0], v1[1]); w.w = cvt_pk_bf16(v1[2], v1[3]);
                    *(u32x4*)(rowp + bj * HALF) = w; } }
    }
};
struct EpiSwiglu {
    static constexpr bool PERM = true;
    bf16_t* O; int ldc; const float* bias; int bias_estride;
    __device__ __forceinline__ void operator()(const f32x4 (&acc)[2][2][4][2], const Unit& u, int wr, int wc, int fr, int fq) const {
        const int row0 = u.pm * BM + wr * 64 + fr; const int col0 = u.pn * HALF + wc * 32 + 8 * fq;
        const float* bp = bias + (size_t)u.e * bias_estride;
        f32x4 bg[2], bl[2];
#pragma unroll
        for (int n = 0; n < 2; ++n) { bg[n] = *(const f32x4*)(bp + col0 + 4 * n); bl[n] = *(const f32x4*)(bp + 1024 + col0 + 4 * n); }
#pragma unroll
        for (int ai = 0; ai < 2; ++ai)
#pragma unroll
            for (int m = 0; m < 4; ++m) { bf16_t* rowp = O + (size_t)(row0 + ai * HALF + m * 16) * ldc + col0;
                f32x2 o[4];
#pragma unroll
                for (int n = 0; n < 2; ++n)
#pragma unroll
                    for (int h = 0; h < 2; ++h) {
                        f32x2 g = (f32x2){acc[ai][0][m][n][2 * h], acc[ai][0][m][n][2 * h + 1]} + (f32x2){bg[n][2 * h], bg[n][2 * h + 1]};
                        f32x2 l = (f32x2){acc[ai][1][m][n][2 * h], acc[ai][1][m][n][2 * h + 1]} + (f32x2){bl[n][2 * h], bl[n][2 * h + 1]};
                        g.x = fminf(g.x, 7.0f); g.y = fminf(g.y, 7.0f); l.x = fminf(fmaxf(l.x, -7.0f), 7.0f); l.y = fminf(fmaxf(l.y, -7.0f), 7.0f);
                        const f32x2 t = g * (-1.702f * 1.44269504089f);
                        f32x2 d; d.x = __builtin_amdgcn_exp2f(t.x); d.y = __builtin_amdgcn_exp2f(t.y); d = d + 1.0f;
                        f32x2 r; r.x = __builtin_amdgcn_rcpf(d.x); r.y = __builtin_amdgcn_rcpf(d.y);
                        const f32x2 gs = g * r;
                        o[2 * n + h] = gs * l + gs; }
                u32x4 w; w.x = cvt_pk_bf16(o[0].x, o[0].y); w.y = cvt_pk_bf16(o[1].x, o[1].y); w.z = cvt_pk_bf16(o[2].x, o[2].y); w.w = cvt_pk_bf16(o[3].x, o[3].y);
                *(u32x4*)rowp = w; }
    }
};
struct EpiResid {
    static constexpr bool PERM = false;
    float* X; const float* gate; int gstride; int pm0; bool dry;
    __device__ __forceinline__ void operator()(const f32x4 (&acc)[2][2][4][2], const Unit& u, int wr, int wc, int fr, int fq) const {
        const int t = u.pm + pm0; const int seg = t < 2 ? 0 : (t < 34 ? 1 : 2);
        const int row0 = u.pm * BM + wr * 64 + fr, col0 = u.pn * BM + wc * 32 + 4 * fq;
        const float* gp = gate + (size_t)seg * gstride;
        f32x4 gv[2][2];
#pragma unroll
        for (int bj = 0; bj < 2; ++bj)
#pragma unroll
            for (int n = 0; n < 2; ++n) gv[bj][n] = *(const f32x4*)(gp + col0 + bj * HALF + n * 16);
#pragma unroll
        for (int ai = 0; ai < 2; ++ai)
#pragma unroll
            for (int m = 0; m < 4; ++m) { float* rowp = X + (size_t)(row0 + ai * HALF + m * 16) * 1024 + col0;
#pragma unroll
                for (int bj = 0; bj < 2; ++bj)
#pragma unroll
                    for (int n = 0; n < 2; ++n) { f32x4* p = (f32x4*)(rowp + bj * HALF + n * 16); const f32x4 nv = *p + gv[bj][n] * acc[ai][bj][m][n]; if (!dry) *p = nv; else if (nv[0] == 1.2345e30f) *p = nv; } }
    }
};

template <class Epi, class Sched, bool GATHER = false>
__device__ __forceinline__ void gemm_phase(PG8_LAS unsigned char* lds, const Gemm g, const Sched& S, const Epi& E, const unsigned* glist = nullptr, const PG8_LAS int* gM = nullptr, int gstride = 0) {
    const int tid = threadIdx.x, wid = __builtin_amdgcn_readfirstlane(tid >> 6), lane = tid & 63, wr = wid >> 2, wc = wid & 3, fr = lane & 15, fq = lane >> 4;
    const int K = g.K, nt = K / BK;
    unsigned voffB[2], va[2][2], vn[2][2]; int aR[2], aC[2];
#pragma unroll
    for (int i = 0; i < 2; ++i) { int R, C; stage_rc(tid * 16 + i * 8192, R, C); const int Rb = Epi::PERM ? ((R & ~31) + perm32(R & 31)) : R;
        aR[i] = R; aC[i] = C; voffB[i] = (unsigned)(Rb * K + C) * 2u;
#pragma unroll
        for (int h = 0; h < 2; ++h) { va[h][i] = (unsigned)((HALF * h + R) * K + C) * 2u; vn[h][i] = va[h][i]; } }
#define PG8_GOFF(u, dst) do { if constexpr (GATHER) { const int _e = (u).e, _p0 = (u).pm * BM - gM[_e], _c1 = gM[400 + _e] - 1; _Pragma("unroll") for (int _h = 0; _h < 2; ++_h) _Pragma("unroll") for (int _i = 0; _i < 2; ++_i) { \
        int _rk = _p0 + HALF * _h + aR[_i]; _rk = _rk < _c1 ? _rk : _c1; const unsigned _tok = glist[(size_t)_e * gstride + _rk]; dst[_h][_i] = (_tok * (unsigned)K + (unsigned)aC[_i]) * 2u; } } } while (0)
#define PG8_GTOK(u, dst) do { const int _e = (u).e, _p0 = (u).pm * BM - gM[_e], _c1 = gM[400 + _e] - 1; _Pragma("unroll") for (int _h = 0; _h < 2; ++_h) _Pragma("unroll") for (int _i = 0; _i < 2; ++_i) { \
        int _rk = _p0 + HALF * _h + aR[_i]; _rk = _rk < _c1 ? _rk : _c1; dst[_h][_i] = glist[(size_t)_e * gstride + _rk]; } } while (0)
    const size_t kstep = (size_t)(BK * 2);
    const size_t hstep = (size_t)HALF * K * 2;
    const size_t tstep = 2 * hstep;
    const unsigned ldsw = (unsigned)wid * 1024u;
    const int aoff = lds_byte(wr * 64 + fr, fq * 8), boff = lds_byte(wc * 32 + fr, fq * 8);
#define PG8_SA(b, h) (((b) * 2 + (h)) * HTB)
#define PG8_SB(b, h) ((4 + (b) * 2 + (h)) * HTB)
#define PG8_STAGE(bufoff, gbase, voff) do { _Pragma("unroll") for (int _i = 0; _i < 2; ++_i) \
        __builtin_amdgcn_global_load_lds((const unsigned*)((const char*)(gbase) + (voff)[_i]), (PG8_LAS unsigned*)(lds + (bufoff) + ldsw + _i * 8192), 16, 0, 0); } while (0)
#define PG8_LDA(dst, b, h) do { _Pragma("unroll") for (int m = 0; m < 4; ++m) _Pragma("unroll") for (int k = 0; k < 2; ++k) dst[m][k] = *(const PG8_LAS bf16x8*)(lds + PG8_SA(b, h) + aoff + m * 2048 + k * 1024); } while (0)
#define PG8_LDB(dst, b, h) do { _Pragma("unroll") for (int n = 0; n < 2; ++n) _Pragma("unroll") for (int k = 0; k < 2; ++k) dst[n][k] = *(const PG8_LAS bf16x8*)(lds + PG8_SB(b, h) + boff + n * 2048 + k * 1024); } while (0)
#define PG8_MMA(ai, bj, At, Bt) do { __builtin_amdgcn_s_setprio(1); _Pragma("unroll") for (int m = 0; m < 4; ++m) _Pragma("unroll") for (int n = 0; n < 2; ++n) _Pragma("unroll") for (int k = 0; k < 2; ++k) \
        acc[ai][bj][m][n] = __builtin_amdgcn_mfma_f32_16x16x32_bf16(Bt[n][k], At[m][k], acc[ai][bj][m][n], 0, 0, 0); __builtin_amdgcn_s_setprio(0); } while (0)
#define PG8_WAIT_V(n) asm volatile("s_waitcnt vmcnt(" #n ")" ::: "memory")
#define PG8_WAIT_L(n) asm volatile("s_waitcnt lgkmcnt(" #n ")" ::: "memory")
#define PG8_BAR __builtin_amdgcn_s_barrier()
#define PG8_SCHED __builtin_amdgcn_sched_barrier(0)
    Unit cur, nxt, nx2; int ui = 0; bool has_next = false, has_nx2 = false;
    if (!S.next(0, cur)) return;
    f32x4 acc[2][2][4][2];
#pragma unroll
    for (int a = 0; a < 2; ++a)
#pragma unroll
        for (int b = 0; b < 2; ++b)
#pragma unroll
            for (int m = 0; m < 4; ++m)
#pragma unroll
                for (int n = 0; n < 2; ++n) acc[a][b][m][n] = (f32x4){0.f, 0.f, 0.f, 0.f};
    bf16x8 At[4][2], B0[2][2], B1[2][2];
    const char* cA = (const char*)g.A + (GATHER ? (size_t)0 : (size_t)cur.pm * tstep); const char* cB = (const char*)g.Bt + (size_t)cur.pb * tstep;
    PG8_GOFF(cur, va);
    if constexpr (GATHER) { has_next = S.next(1, nxt); if (has_next) PG8_GOFF(nxt, vn); }
    PG8_STAGE(PG8_SB(0, 0), cB, voffB); PG8_STAGE(PG8_SB(0, 1), cB + hstep, voffB); PG8_STAGE(PG8_SA(0, 0), cA, va[0]); PG8_STAGE(PG8_SA(0, 1), cA, va[1]);
    if (wr == 1) PG8_BAR;
    PG8_WAIT_V(2); PG8_BAR;
    PG8_STAGE(PG8_SB(1, 0), cB + kstep, voffB); PG8_STAGE(PG8_SA(1, 0), cA + kstep, va[0]); PG8_STAGE(PG8_SB(1, 1), cB + hstep + kstep, voffB);
    PG8_WAIT_V(6); PG8_BAR;
    for (;;) {
        if constexpr (!GATHER) has_next = S.next(ui + 1, nxt);
        const char* nA = (has_next && !GATHER) ? (const char*)g.A + (size_t)nxt.pm * tstep : cA; const char* nB = has_next ? (const char*)g.Bt + (size_t)nxt.pb * tstep : cB;
        for (int t = 0; t < nt; t += 2) {
            const bool last = (t == nt - 2);
            const char* a1 = cA + (size_t)(t + 1) * kstep;
            const char* a2 = last ? nA : cA + (size_t)(t + 2) * kstep; const char* b2 = last ? nB : cB + (size_t)(t + 2) * kstep;
            const char* a3 = a2 + kstep; const char* b3 = b2 + kstep;
            unsigned v2[2][2];
#pragma unroll
            for (int _h = 0; _h < 2; ++_h)
#pragma unroll
                for (int _i = 0; _i < 2; ++_i) v2[_h][_i] = (GATHER && last) ? vn[_h][_i] : va[_h][_i];
            PG8_LDB(B0, 0, 0); PG8_LDB(B1, 0, 1); PG8_SCHED; PG8_LDA(At, 0, 0); PG8_STAGE(PG8_SA(1, 1), a1, va[1]);
            PG8_WAIT_V(8); PG8_WAIT_L(0); PG8_BAR; PG8_MMA(0, 0, At, B0); PG8_MMA(0, 1, At, B1); PG8_BAR; PG8_SCHED;
            PG8_LDA(At, 0, 1); PG8_STAGE(PG8_SB(0, 0), b2, voffB); PG8_STAGE(PG8_SB(0, 1), b2 + hstep, voffB); PG8_STAGE(PG8_SA(0, 0), a2, v2[0]);
            PG8_WAIT_V(8); PG8_WAIT_L(0); PG8_BAR; PG8_MMA(1, 0, At, B0); PG8_MMA(1, 1, At, B1); PG8_BAR; PG8_SCHED;
            PG8_LDB(B0, 1, 0); PG8_LDB(B1, 1, 1); PG8_SCHED; PG8_LDA(At, 1, 0); PG8_STAGE(PG8_SA(0, 1), a2, v2[1]);
            PG8_WAIT_V(8); PG8_WAIT_L(0); PG8_BAR; PG8_MMA(0, 0, At, B0); PG8_MMA(0, 1, At, B1); PG8_BAR; PG8_SCHED;
            PG8_LDA(At, 1, 1); PG8_STAGE(PG8_SB(1, 0), b3, voffB); PG8_STAGE(PG8_SB(1, 1), b3 + hstep, voffB); PG8_STAGE(PG8_SA(1, 0), a3, v2[0]);
            PG8_WAIT_V(8); PG8_WAIT_L(0); PG8_BAR; PG8_MMA(1, 0, At, B0); PG8_MMA(1, 1, At, B1); PG8_BAR; PG8_SCHED;
        }
        if (wr == 0) PG8_BAR;
        unsigned tk[2][2] = {{0u, 0u}, {0u, 0u}};
        if constexpr (GATHER) { has_nx2 = has_next && S.next(ui + 2, nx2); if (!has_nx2) nx2 = cur; PG8_GTOK(nx2, tk); }
        E(acc, cur, wr, wc, fr, fq);
        if (!has_next) break;
#pragma unroll
        for (int a = 0; a < 2; ++a)
#pragma unroll
            for (int b = 0; b < 2; ++b)
#pragma unroll
                for (int m = 0; m < 4; ++m)
#pragma unroll
                    for (int n = 0; n < 2; ++n) acc[a][b][m][n] = (f32x4){0.f, 0.f, 0.f, 0.f};
        cur = nxt; cA = nA; cB = nB; ++ui;
        if constexpr (GATHER) { va[0][0] = vn[0][0]; va[0][1] = vn[0][1]; va[1][0] = vn[1][0]; va[1][1] = vn[1][1];
            if (has_nx2) { nxt = nx2;
#pragma unroll
                for (int _h = 0; _h < 2; ++_h)
#pragma unroll
                    for (int _i = 0; _i < 2; ++_i) vn[_h][_i] = (tk[_h][_i] * (unsigned)K + (unsigned)aC[_i]) * 2u; }
            has_next = has_nx2; }
        if (wr == 1) PG8_BAR;
    }
    PG8_WAIT_V(0);
    PG8_BAR;
#undef PG8_SA
#undef PG8_SB
#undef PG8_STAGE
#undef PG8_GOFF
#undef PG8_GTOK
#undef PG8_LDA
#undef PG8_LDB
#undef PG8_MMA
#undef PG8_WAIT_V
#undef PG8_WAIT_L
#undef PG8_BAR
#undef PG8_SCHED
}
}

constexpr int NWAVES = 8, NTHREADS = 512;
constexpr int D = 1024, NCTX = 512, NLAT = 16384, NTOK = NCTX + NLAT, SEQ = 8192, CTXL = 256;
constexpr int NEXP = 32, MAXPADROWS = 75776, MAXPADTILES = 296;
constexpr int GLA_IN = 3104, GLA_INP = 3328;
constexpr float EPS = 1e-6f;

constexpr size_t MiB = 1u << 20;
constexpr size_t WS_CTL = 0, CTL_ZERO_BYTES = 65536;
constexpr size_t WS_ADA = 1 * MiB;
constexpr size_t WS_ROPE = 1 * MiB + 512 * 1024;
constexpr size_t WS_TOKI = 2 * MiB;
constexpr size_t WS_TOKG = 2 * MiB + 512 * 1024;
constexpr size_t WS_LIST = 3 * MiB;
constexpr size_t WS_WRH = 6 * MiB, WS_WRL = 6 * MiB + 256 * 1024;
constexpr size_t WS_WSB = 7 * MiB;
constexpr size_t WS_WAIN = 8 * MiB;
constexpr size_t WS_WAOUT = 16 * MiB;
constexpr size_t WS_WBIN = 20 * MiB;
constexpr size_t WS_WBOUT = 27 * MiB;
constexpr size_t WS_WCQKV = 29 * MiB;
constexpr size_t WS_WCOUT = 35 * MiB;
constexpr size_t WS_WGU = 64 * MiB;
constexpr size_t WS_WDN = 576 * MiB;
constexpr size_t WS_X = 832 * MiB;
constexpr size_t WS_H = 898 * MiB;
constexpr size_t WS_G = 931 * MiB;
constexpr size_t WS_BIG = 964 * MiB;
constexpr size_t WS_DS = 1072 * MiB;
constexpr size_t WS_SIN = 1204 * MiB;
constexpr size_t WS_DEC = 1336 * MiB;
constexpr size_t WS_AS = 1338 * MiB;
constexpr size_t WS_YM = 1338 * MiB;
constexpr size_t WS_ACT = 1486 * MiB;
constexpr size_t WS_YB = 1634 * MiB;
constexpr size_t WS_END = 1782 * MiB;
constexpr int CW_TMO = 0;
constexpr int CW_BAR = 4096;
constexpr int CW_CNT = 8192;
static_assert((CW_CNT + 128 * 64) * 4 <= 65536 && (CW_BAR + 3456) <= CW_CNT, "control words inside the per-call memset");

constexpr int RING_OFF = 0, RING_BYTES = 131072;
constexpr int MISC_OFF = RING_BYTES;
constexpr int LDS_BYTES = 147456;

#define GAS __attribute__((address_space(1)))
#define LAS __attribute__((address_space(3)))
typedef unsigned short bf16;
typedef unsigned v4u __attribute__((ext_vector_type(4)));
typedef unsigned v2u __attribute__((ext_vector_type(2)));
typedef float f32x4 __attribute__((ext_vector_type(4)));
typedef short bf16x8 __attribute__((ext_vector_type(8)));
typedef short bf16x4 __attribute__((ext_vector_type(4)));
#define STAMPS(F) ((LAS unsigned long long*)((F).lds + MISC_OFF + 4096))
#define LDS_WAIT() asm volatile("s_waitcnt lgkmcnt(0)" ::: "memory")
#define VM_WAIT() asm volatile("s_waitcnt vmcnt(0)" ::: "memory")
#define LBAR() do { asm volatile("s_waitcnt lgkmcnt(0)" ::: "memory"); __builtin_amdgcn_s_barrier(); asm volatile("" ::: "memory"); } while (0)
__device__ __forceinline__ unsigned f2bf(float f) { unsigned u = __builtin_bit_cast(unsigned, f); return (u + 0x7fffu + ((u >> 16) & 1u)) >> 16; }
typedef float f32x2_t __attribute__((ext_vector_type(2)));
typedef __bf16 bf16x2_t __attribute__((ext_vector_type(2)));
__device__ __forceinline__ unsigned pk2(float lo, float hi) { const f32x2_t v = {lo, hi}; const bf16x2_t b = __builtin_convertvector(v, bf16x2_t); return __builtin_bit_cast(unsigned, b); }
__device__ __forceinline__ float bf2f(unsigned b) { return __builtin_bit_cast(float, b << 16); }
__device__ __forceinline__ float bflo(unsigned w) { return __builtin_bit_cast(float, w << 16); }
__device__ __forceinline__ float bfhi(unsigned w) { return __builtin_bit_cast(float, w & 0xffff0000u); }
#define MFMA16(a, b, c) __builtin_amdgcn_mfma_f32_16x16x32_bf16((a), (b), (c), 0, 0, 0)

#define XB_TMO      128
#define XB_XCNT(j)  (256  + 64 * (j))
#define XB_XSUB(j)  (1280 + 64 * (j))
#define XB_XGEN(j)  (2304 + 64 * (j))
#define XB_TOP      3328
#define XB_TOPGEN   3392
#define XCD_BAR_WORDS 3456
#define XB_SPIN_CAP (1u << 22)

__device__ __forceinline__ unsigned xb_ld(unsigned* p)              { return __hip_atomic_load(p, __ATOMIC_RELAXED, __HIP_MEMORY_SCOPE_AGENT); }
__device__ __forceinline__ unsigned xb_add(unsigned* p, unsigned v) { return __hip_atomic_fetch_add(p, v, __ATOMIC_RELAXED, __HIP_MEMORY_SCOPE_AGENT); }
__device__ __forceinline__ unsigned xb_xcc_id() { return (unsigned)__builtin_amdgcn_s_getreg((3 << 11) | 20) & 0xFu; }
#define XB_SPIN(cond, bar) do { unsigned _sp = 0; while (cond) { __builtin_amdgcn_s_sleep(1); \
    if ((++_sp & 255u) == 0u) { if (xb_ld(&(bar)[XB_TMO])) break; if (_sp > XB_SPIN_CAP) { atomicAdd(&(bar)[XB_TMO], 1u); break; } } } } while (0)

struct XcdBarrier { unsigned* bar; unsigned x; volatile LAS unsigned* st; };
__device__ __forceinline__ XcdBarrier xcd_barrier_post(unsigned* bar, volatile LAS unsigned* st) {
    XcdBarrier b; b.bar = bar; b.x = xb_xcc_id(); b.st = st;
    if (threadIdx.x == 0) (void)xb_add(&bar[XB_XCNT(b.x)], 1u);
    return b;
}
__device__ __forceinline__ void xcd_barrier_complete(unsigned* bar, unsigned x, unsigned& nloc, unsigned& nx) {
    const unsigned G = gridDim.x * gridDim.y * gridDim.z;
    unsigned sum, cnt, mine, sp = 0u;
    for (;;) {
        sum = 0u; cnt = 0u; mine = 0u;
#pragma unroll
        for (unsigned j = 0; j < 16; ++j) { const unsigned c = xb_ld(&bar[XB_XCNT(j)]); sum += c; cnt += (c > 0u) ? 1u : 0u; mine = (j == x) ? c : mine; }
        if (sum == G) break;
        __builtin_amdgcn_s_sleep(1);
        if ((++sp & 255u) == 0u) { if (xb_ld(&bar[XB_TMO])) break; if (sp > XB_SPIN_CAP) { atomicAdd(&bar[XB_TMO], 1u); break; } }
    }
    nloc = mine > 0u ? mine : 1u; nx = cnt > 0u ? cnt : 1u;
}
__device__ __forceinline__ void xcd_barrier(const XcdBarrier& b) {
    asm volatile("s_waitcnt vmcnt(0)" ::: "memory");
    __syncthreads();
    if (threadIdx.x == 0) {
        unsigned* bar = b.bar;
        __builtin_amdgcn_s_waitcnt(0);
        unsigned nloc = b.st[0], nx = b.st[1];
        if (nloc == 0u) { xcd_barrier_complete(bar, b.x, nloc, nx); b.st[0] = nloc; b.st[1] = nx; }
        const unsigned old = xb_add(&bar[XB_XSUB(b.x)], 1u);
        const unsigned gen = old / nloc;
        if (old + 1u == (gen + 1u) * nloc) {
            __builtin_amdgcn_fence(__ATOMIC_RELEASE, "agent");
            asm volatile("s_waitcnt vmcnt(0)" ::: "memory");
            const unsigned og = xb_add(&bar[XB_TOP], 1u);
            const unsigned tg = og / nx;
            if (og + 1u == (tg + 1u) * nx) xb_add(&bar[XB_TOPGEN], 1u);
            else XB_SPIN(xb_ld(&bar[XB_TOPGEN]) == tg, bar);
            __builtin_amdgcn_fence(__ATOMIC_ACQUIRE, "agent");
            xb_add(&bar[XB_XGEN(b.x)], 1u);
            asm volatile("s_waitcnt vmcnt(0)" ::: "memory");
        } else {
            XB_SPIN(xb_ld(&bar[XB_XGEN(b.x)]) == gen, bar);
            __builtin_amdgcn_fence(__ATOMIC_ACQUIRE, "agent");
            asm volatile("s_waitcnt vmcnt(0)" ::: "memory");
        }
    }
    __syncthreads();
}

struct Args { const float* in[28]; float* out; unsigned char* ws; int ph_lo, ph_hi; };
enum { I_X = 0, I_C, I_CTX, I_CCTX, I_ADAW, I_ADAB, I_NMIX, I_NFFN, I_NOUT, I_AWIN, I_AGV, I_AWS, I_ABS, I_AWOUT, I_BWIN, I_BWA2, I_BBA, I_BGO, I_BWOUT,
       I_CWQKV, I_CRPB, I_CWOUT, I_MWR, I_MBR, I_MWGU, I_MBGU, I_MWDN, I_MBDN };

struct Frame {
    LAS unsigned char* lds;
    unsigned* ctl;
    unsigned char* ws;
    int tid, lane, wave, vcu, G;
};

#define DPP_F(v, ctrl) __builtin_bit_cast(float, __builtin_amdgcn_update_dpp(0, __builtin_bit_cast(int, (v)), (ctrl), 0xf, 0xf, true))
#define DPP_I(v, ctrl) __builtin_amdgcn_update_dpp(0, (v), (ctrl), 0xf, 0xf, true)
constexpr int DPP_XOR1 = 0xB1, DPP_XOR2 = 0x4E, DPP_HMIRROR = 0x141, DPP_MIRROR = 0x140;
__device__ __forceinline__ float wave_sum(float v) {
    v += DPP_F(v, DPP_XOR1); v += DPP_F(v, DPP_XOR2); v += DPP_F(v, DPP_HMIRROR); v += DPP_F(v, DPP_MIRROR);
    const float r0 = __builtin_bit_cast(float, __builtin_amdgcn_readlane(__builtin_bit_cast(int, v), 0)), r1 = __builtin_bit_cast(float, __builtin_amdgcn_readlane(__builtin_bit_cast(int, v), 16));
    const float r2 = __builtin_bit_cast(float, __builtin_amdgcn_readlane(__builtin_bit_cast(int, v), 32)), r3 = __builtin_bit_cast(float, __builtin_amdgcn_readlane(__builtin_bit_cast(int, v), 48));
    return (r0 + r1) + (r2 + r3);
}
__device__ __forceinline__ int seg_of_row(int r) { return r < NCTX ? 0 : 1 + ((r - NCTX) >> 13); }

__device__ __forceinline__ void transpose_item64(const float* W, int N, int k0, int n0, bf16* WT, int K, int dst_row0, int ncols_valid, LAS float* scr, int lane) {
    f32x4 tv[16];
#pragma unroll
    for (int i = 0; i < 16; ++i) { const int row = 4 * i + (lane >> 4), c4 = (lane & 15) * 4;
        tv[i] = (f32x4){0.f, 0.f, 0.f, 0.f};
        if (c4 < ncols_valid) tv[i] = __builtin_nontemporal_load((const GAS f32x4*)(W + (size_t)(k0 + row) * N + n0 + c4)); }
#pragma unroll
    for (int i = 0; i < 16; ++i) { const int row = 4 * i + (lane >> 4), c4 = (lane & 15) * 4;
        LAS float* s = scr + row * 65 + c4; s[0] = tv[i].x; s[1] = tv[i].y; s[2] = tv[i].z; s[3] = tv[i].w; }
    LDS_WAIT(); asm volatile("" ::: "memory");
    const int c = lane & 7;
#pragma unroll
    for (int j = 0; j < 8; ++j) { const int n = (lane >> 3) + 8 * j; const LAS float* s = scr + (8 * c) * 65 + n;
        v4u o; o.x = pk2(s[0 * 65], s[1 * 65]); o.y = pk2(s[2 * 65], s[3 * 65]); o.z = pk2(s[4 * 65], s[5 * 65]); o.w = pk2(s[6 * 65], s[7 * 65]);
        __builtin_nontemporal_store(o, (GAS v4u*)(WT + (size_t)(dst_row0 + n) * K + k0 + 8 * c)); }
    LDS_WAIT(); asm volatile("" ::: "memory");
}

constexpr int MOE_ITEMS = 32 * 512 + 32 * 256;
typedef short cv_s16x4 __attribute__((ext_vector_type(4)));
struct ConvItem { const float* src; bf16* dst; int N; };
__device__ __forceinline__ ConvItem conv_item(const Frame& F, const Args& a, int g) {
    const int L = g / MOE_ITEMS, q = g % MOE_ITEMS; ConvItem it;
    if (q < 16384) { const int le = L * 32 + q / 512, qq = q % 512, kb = qq / 32, nb = qq % 32;
        const int n0 = 64 * nb, half = n0 >> 10, jj = n0 & 1023, dst = (jj >> 7) * 256 + half * 128 + (jj & 127);
        it.src = a.in[I_MWGU] + (size_t)le * 1024 * 2048 + (size_t)(64 * kb) * 2048 + n0; it.N = 2048;
        it.dst = (bf16*)(F.ws + WS_WGU) + (size_t)le * 2048 * 1024 + (size_t)dst * 1024 + 64 * kb; }
    else { const int r = q - 16384, le = L * 32 + r / 256, qq = r % 256, kb = qq / 16, nb = qq % 16;
        it.src = a.in[I_MWDN] + (size_t)le * 1024 * 1024 + (size_t)(64 * kb) * 1024 + 64 * nb; it.N = 1024;
        it.dst = (bf16*)(F.ws + WS_WDN) + (size_t)le * 1024 * 1024 + (size_t)(64 * nb) * 1024 + 64 * kb; }
    return it;
}
__device__ __forceinline__ void conv_load(const ConvItem& it, f32x4 (&tv)[16], int lane) {
#pragma unroll
    for (int i = 0; i < 16; ++i) { const int row = 16 * (lane >> 4) + i, c4 = (lane & 15) * 4; tv[i] = __builtin_nontemporal_load((const GAS f32x4*)(it.src + (size_t)row * it.N + c4)); }
}
__device__ __forceinline__ void conv_moe_items(Frame& F, const Args& a, int g_lo, int g_hi, int w_id, int n_w) {
    LAS unsigned char* Tn = F.lds + F.wave * 16640;
    const int lane = F.lane;
    int g = g_lo + w_id; if (g >= g_hi) return;
    ConvItem cur = conv_item(F, a, g); f32x4 tv[16];
    conv_load(cur, tv, lane);
    for (;;) {
        { const int r = lane >> 4, c4 = (lane & 15) * 4;
#pragma unroll
            for (int e = 0; e < 4; ++e)
#pragma unroll
                for (int hk = 0; hk < 2; ++hk) { v4u o; o.x = pk2(tv[8 * hk + 0][e], tv[8 * hk + 1][e]); o.y = pk2(tv[8 * hk + 2][e], tv[8 * hk + 3][e]); o.z = pk2(tv[8 * hk + 4][e], tv[8 * hk + 5][e]); o.w = pk2(tv[8 * hk + 6][e], tv[8 * hk + 7][e]);
                    *(LAS v4u*)(Tn + (c4 + e) * 144 + 32 * r + 16 * hk) = o; } }
        const int gn = g + n_w; const bool hn = gn < g_hi; ConvItem nxt = cur;
        if (hn) { nxt = conv_item(F, a, gn); conv_load(nxt, tv, lane); }
        LDS_WAIT(); asm volatile("" ::: "memory");
        { const int c = lane & 7, nn = lane >> 3;
#pragma unroll
            for (int j = 0; j < 8; ++j) { const int n = nn + 8 * j; const v4u o = *(const LAS v4u*)(Tn + n * 144 + 16 * c);
                __builtin_nontemporal_store(o, (GAS v4u*)(cur.dst + (size_t)n * 1024 + 8 * c)); } }
        LDS_WAIT(); asm volatile("" ::: "memory");
        if (!hn) break;
        cur = nxt; g = gn;
    }
}
__device__ __forceinline__ Frame mixer_frame(const Frame& F, int ncv) {
    Frame Fm = F; const int nm = F.G - ncv, bx = (int)blockIdx.x; Fm.G = nm; Fm.vcu = (nm % 8 == 0) ? (bx % 8) * (nm / 8) + bx / 8 : bx; return Fm;
}

__device__ __forceinline__ void p_prologue(Frame& F, const Args& a) {
    LAS float* scr = (LAS float*)(F.lds + F.wave * 16640);
    const int gw = F.vcu * NWAVES + F.wave, NGW = F.G * NWAVES;
    {
        constexpr int KB = 16;
        constexpr int I0 = 2 * KB * 32, I1 = 2 * KB * 16, I2 = KB * 52, I3 = KB * 16, I4 = KB * 48, I5 = KB * 16;
        constexpr int NI = I0 + I1 + I2 + I3 + I4 + I5;
        for (int it = gw; it < NI; it += NGW) {
            int r = it;
            if (r < I0) { const int j = r / (KB * 32), q = r % (KB * 32), kb = q / 32, nb = q % 32;
                transpose_item64(a.in[I_AWIN] + (size_t)j * 1024 * 2048, 2048, 64 * kb, 64 * nb, (bf16*)(F.ws + WS_WAIN) + (size_t)j * 2048 * 1024, 1024, 64 * nb, 64, scr, F.lane); continue; } r -= I0;
            if (r < I1) { const int j = r / (KB * 16), q = r % (KB * 16), kb = q / 16, nb = q % 16;
                transpose_item64(a.in[I_AWOUT] + (size_t)j * 1024 * 1024, 1024, 64 * kb, 64 * nb, (bf16*)(F.ws + WS_WAOUT) + (size_t)j * 1024 * 1024, 1024, 64 * nb, 64, scr, F.lane); continue; } r -= I1;
            if (r < I2) { const int kb = r / 52, nb = r % 52; const int nv = GLA_IN - 64 * nb;
                transpose_item64(a.in[I_BWIN], GLA_IN, 64 * kb, 64 * nb, (bf16*)(F.ws + WS_WBIN), 1024, 64 * nb, nv < 0 ? 0 : (nv > 64 ? 64 : nv), scr, F.lane); continue; } r -= I2;
            if (r < I3) { const int kb = r / 16, nb = r % 16;
                transpose_item64(a.in[I_BWOUT], 1024, 64 * kb, 64 * nb, (bf16*)(F.ws + WS_WBOUT), 1024, 64 * nb, 64, scr, F.lane); continue; } r -= I3;
            if (r < I4) { const int kb = r / 48, nb = r % 48;
                transpose_item64(a.in[I_CWQKV], 3072, 64 * kb, 64 * nb, (bf16*)(F.ws + WS_WCQKV), 1024, 64 * nb, 64, scr, F.lane); continue; } r -= I4;
            { const int kb = r / 16, nb = r % 16;
                transpose_item64(a.in[I_CWOUT], 1024, 64 * kb, 64 * nb, (bf16*)(F.ws + WS_WCOUT), 1024, 64 * nb, 64, scr, F.lane); }
        }
    }
    conv_moe_items(F, a, 0, MOE_ITEMS, gw, NGW);
    const int gt = F.vcu * NTHREADS + F.tid, NGT = F.G * NTHREADS;
    for (int i = gt; i < 2 * 8 * 128 * 128; i += NGT) ((bf16*)(F.ws + WS_WSB))[i] = (bf16)f2bf(a.in[I_AWS][i]);
    for (int i = gt; i < 4 * 32 * 1024; i += NGT) { const int l = i >> 15, e = (i >> 10) & 31, k = i & 1023;
        const float w = a.in[I_MWR][((size_t)l * 1024 + k) * 32 + e]; const unsigned h = f2bf(w); const float rem = w - bf2f(h);
        ((bf16*)(F.ws + WS_WRH))[i] = (bf16)h; ((bf16*)(F.ws + WS_WRL))[i] = (bf16)f2bf(rem); }
    for (int i = gt; i < 128 * 32; i += NGT) { const int pos = i >> 5, f = i & 31;
        const float fr = powf(10000.0f, -(float)f / 32.0f); const float ang = (float)pos * fr; float sn, cs; sincosf(ang, &sn, &cs);
        ((float*)(F.ws + WS_ROPE))[2 * i] = cs; ((float*)(F.ws + WS_ROPE))[2 * i + 1] = sn; }
    {
        __syncthreads();
        LAS float* sv = (LAS float*)(F.lds);
        LAS float* red = sv + 3 * 1024;
        for (int i = F.tid; i < 3 * 1024; i += NTHREADS) { const int s = i >> 10, k = i & 1023;
            const float v = s == 0 ? a.in[I_CCTX][k] : a.in[I_C][(s - 1) * 1024 + k]; sv[i] = v / (1.0f + __expf(-v)); }
        __syncthreads();
        for (int u = F.vcu; u < 4 * 96; u += F.G) { const int l = u / 96, n0 = (u % 96) * 64;
            const float* w = a.in[I_ADAW] + (size_t)l * 1024 * 6144 + n0 + F.lane;
            float a0 = 0.f, a1 = 0.f, a2 = 0.f;
#pragma unroll
            for (int kb = 0; kb < 2; ++kb) {
                float wv[64];
#pragma unroll
                for (int kk = 0; kk < 64; ++kk) wv[kk] = __builtin_nontemporal_load(w + (size_t)(F.wave * 128 + kb * 64 + kk) * 6144);
#pragma unroll
                for (int kk = 0; kk < 64; ++kk) { const int k = F.wave * 128 + kb * 64 + kk; a0 += sv[k] * wv[kk]; a1 += sv[1024 + k] * wv[kk]; a2 += sv[2048 + k] * wv[kk]; } }
            red[(F.wave * 3 + 0) * 64 + F.lane] = a0; red[(F.wave * 3 + 1) * 64 + F.lane] = a1; red[(F.wave * 3 + 2) * 64 + F.lane] = a2;
            __syncthreads();
            if (F.tid < 192) { const int s = F.tid >> 6, c = F.tid & 63; float t = a.in[I_ADAB][l * 6144 + n0 + c];
#pragma unroll
                for (int w8 = 0; w8 < 8; ++w8) t += red[(w8 * 3 + s) * 64 + c];
                ((float*)(F.ws + WS_ADA))[(size_t)(l * 3 + s) * 6144 + n0 + c] = t; }
            __syncthreads();
        }
    }
}

__device__ __forceinline__ void moe_tables(Frame& F, int layer) {
    LAS int* M = (LAS int*)(F.lds + MISC_OFF);
    __syncthreads();
    if (F.tid < 32) M[400 + F.tid] = (int)__hip_atomic_load(F.ctl + CW_CNT + (layer * 32 + F.tid) * 64, __ATOMIC_RELAXED, __HIP_MEMORY_SCOPE_AGENT);
    __syncthreads();
    if (F.tid < 64) { const int e = F.tid & 31; const int nt = (M[400 + e] + 255) >> 8; int incl = nt;
#pragma unroll
        for (int o = 1; o < 32; o <<= 1) { const int v = __shfl_up(incl, o, 32); if (e >= o) incl += v; }
        const int off = (incl - nt) << 8;
        if (F.tid < 32) { M[e] = off; for (int t = 0; t < nt; ++t) M[64 + (off >> 8) + t] = e; if (e == 31) M[32] = incl << 8; } }
    __syncthreads();
}

__device__ __forceinline__ void p_prenorm(Frame& F, const Args& a, int layer, bool fin, bool dry = false) {
    const int gw = F.vcu * NWAVES + F.wave, NGW = F.G * NWAVES;
    const int prev = layer - 1;
    const int row_lo = (layer >= 3) ? NCTX : 0;
    const bool combine = layer > 0;
    if (combine) moe_tables(F, prev);
    const LAS int* M = (const LAS int*)(F.lds + MISC_OFF);
    bf16* X = (bf16*)(F.ws + WS_X); bf16* H = (bf16*)(F.ws + (dry ? WS_AS : WS_H));
    const bf16* YB = (const bf16*)(F.ws + WS_YB);
    const float* ada = (const float*)(F.ws + WS_ADA);
    const v4u* TOKI = (const v4u*)(F.ws + WS_TOKI); const f32x4* TOKG = (const f32x4*)(F.ws + WS_TOKG);
    LAS float* V = (LAS float*)(F.lds);
    __syncthreads();
    for (int i = F.tid; i < 13 * D; i += NTHREADS) { const int w = i >> 10, c = i & 1023; float x;
        if (w == 0) x = fin ? a.in[I_NOUT][c] : a.in[I_NMIX][(size_t)layer * D + c];
        else if (w >= 10) x = combine ? ada[(size_t)((prev * 3 + (w - 10)) * 6 + 2) * D + c] : 0.f;
        else { const int seg = (w - 1) / 3, k = (w - 1) % 3; x = k == 2 ? (combine ? ada[(size_t)((prev * 3 + seg) * 6 + 5) * D + c] : 0.f) : (fin ? 0.f : ada[(size_t)((layer * 3 + seg) * 6 + k) * D + c]); }
        V[i] = x; }
    __syncthreads();
    for (int row0 = row_lo + gw; row0 < NTOK; row0 += 2 * NGW) {
        const int row1r = row0 + NGW; const bool has1 = row1r < NTOK; const int row1 = has1 ? row1r : row0;
        f32x4 v[2][4]; v4u ti[2]; f32x4 tg[2];
#pragma unroll
        for (int q = 0; q < 2; ++q) { const int row = q ? row1 : row0;
            if (layer == 0) { const float* src = row < NCTX ? a.in[I_CTX] + (size_t)row * D : a.in[I_X] + (size_t)(row - NCTX) * D;
#pragma unroll
                for (int j = 0; j < 4; ++j) v[q][j] = *(const GAS f32x4*)(src + 4 * F.lane + 256 * j); }
            else {
#pragma unroll
                for (int j = 0; j < 4; ++j) { const v2u xx = *(const GAS v2u*)(X + (size_t)row * D + 4 * F.lane + 256 * j); v[q][j] = (f32x4){bflo(xx.x), bfhi(xx.x), bflo(xx.y), bfhi(xx.y)}; } }
            if (combine) { ti[q] = TOKI[row]; tg[q] = TOKG[row]; } }
        if (combine) {
            v2u y[2][4][4]; v2u ym[2][4];
#pragma unroll
            for (int q = 0; q < 2; ++q)
#pragma unroll
                for (int j = 0; j < 4; ++j) ym[q][j] = *(const GAS v2u*)((const bf16*)(F.ws + WS_YM) + (size_t)(q ? row1 : row0) * D + 4 * F.lane + 256 * j);
#pragma unroll
            for (int q = 0; q < 2; ++q)
#pragma unroll
                for (int k = 0; k < 4; ++k) { const unsigned t = ti[q][k]; const int pos = M[t >> 16] + (int)(t & 0xffffu); const bf16* yr = YB + (size_t)pos * D + 4 * F.lane;
#pragma unroll
                    for (int j = 0; j < 4; ++j) y[q][k][j] = *(const GAS v2u*)(yr + 256 * j); }
#pragma unroll
            for (int q = 0; q < 2; ++q) { const int seg = seg_of_row(q ? row1 : row0);
#pragma unroll
                for (int j = 0; j < 4; ++j) { f32x4 acc = (f32x4){0.f, 0.f, 0.f, 0.f};
#pragma unroll
                    for (int k = 0; k < 4; ++k) { const float g = tg[q][k]; const v2u yy = y[q][k][j]; acc.x += g * bflo(yy.x); acc.y += g * bfhi(yy.x); acc.z += g * bflo(yy.y); acc.w += g * bfhi(yy.y); }
                    const f32x4 gg = *(const LAS f32x4*)(V + (1 + 3 * seg + 2) * D + 4 * F.lane + 256 * j), g2 = *(const LAS f32x4*)(V + (10 + seg) * D + 4 * F.lane + 256 * j);
                    const v2u yy = ym[q][j]; const f32x4 yv = (f32x4){bflo(yy.x), bfhi(yy.x), bflo(yy.y), bfhi(yy.y)};
                    v[q][j] = v[q][j] + g2 * yv + gg * acc; } }
        }
#pragma unroll
        for (int q = 0; q < 2; ++q) { if (q == 1 && !has1) break; const int row = q ? row1 : row0, seg = seg_of_row(row);
            if (!fin && !dry && (combine || layer == 0)) {
#pragma unroll
                for (int j = 0; j < 4; ++j) { v2u xo; xo.x = pk2(v[q][j].x, v[q][j].y); xo.y = pk2(v[q][j].z, v[q][j].w); *(GAS v2u*)(X + (size_t)row * D + 4 * F.lane + 256 * j) = xo; }
            }
            float ss = 0.f;
#pragma unroll
            for (int j = 0; j < 4; ++j) ss += (v[q][j].x * v[q][j].x + v[q][j].y * v[q][j].y) + (v[q][j].z * v[q][j].z + v[q][j].w * v[q][j].w);
            const float rstd = __builtin_amdgcn_rsqf(wave_sum(ss) * (1.0f / D) + EPS);
            if (fin) {
                float* o = a.out + (size_t)(row - NCTX) * D;
#pragma unroll
                for (int j = 0; j < 4; ++j) { const f32x4 g = *(const LAS f32x4*)(V + 4 * F.lane + 256 * j); *(GAS f32x4*)(o + 4 * F.lane + 256 * j) = v[q][j] * rstd * g; }
            } else {
#pragma unroll
                for (int j = 0; j < 4; ++j) { const int c = 4 * F.lane + 256 * j;
                    const f32x4 g = *(const LAS f32x4*)(V + c), s0 = *(const LAS f32x4*)(V + (1 + 3 * seg) * D + c), s1 = *(const LAS f32x4*)(V + (2 + 3 * seg) * D + c);
                    const f32x4 h = v[q][j] * rstd * g * (s1 + 1.0f) + s0;
                    v2u o; o.x = pk2(h.x, h.y); o.y = pk2(h.z, h.w);
                    *(GAS v2u*)(H + (size_t)row * D + c) = o; }
            }
        }
    }
}

__device__ __forceinline__ void p_router(Frame& F, const Args& a, int layer, bool dry = false) {
    const int row_lo = (layer >= 2) ? NCTX : 0;
    const int ntile = (NTOK - row_lo) / 16;
    const bf16* X = (const bf16*)(F.ws + WS_X); bf16* H = (bf16*)(F.ws + WS_H);
    const float* ada = (const float*)(F.ws + WS_ADA);
    constexpr int AST = 1032;
    LAS bf16* Ahi = (LAS bf16*)(F.lds); LAS bf16* Alo = Ahi + 16 * AST;
    LAS float* RED = (LAS float*)(F.lds + 2 * 16 * AST * 2);
    LAS float* LOG = RED + 8 * 16 * 32;
    const int fr = F.lane & 15, fq = F.lane >> 4;
    bf16x8 Bh[2][4], Bl[2][4];
    {
        const bf16* wh = (const bf16*)(F.ws + WS_WRH) + (size_t)layer * 32 * 1024; const bf16* wl = (const bf16*)(F.ws + WS_WRL) + (size_t)layer * 32 * 1024;
#pragma unroll
        for (int nt = 0; nt < 2; ++nt)
#pragma unroll
            for (int ks = 0; ks < 4; ++ks) { const size_t o = (size_t)(nt * 16 + fr) * 1024 + F.wave * 128 + ks * 32 + fq * 8;
                Bh[nt][ks] = *(const GAS bf16x8*)(wh + o); Bl[nt][ks] = *(const GAS bf16x8*)(wl + o); }
    }
    LAS float* VC = (LAS float*)(F.lds + 90112);
    for (int i = F.tid; i < 10 * D; i += NTHREADS) { const int w = i >> 10, c = i & 1023;
        VC[i] = w == 0 ? a.in[I_NFFN][(size_t)layer * D + c] : ada[(size_t)((layer * 3 + (w - 1) / 3) * 6 + ((w - 1) % 3 == 0 ? 3 : ((w - 1) % 3 == 1 ? 4 : 2))) * D + c]; }
    LAS int* WCNT = (LAS int*)LOG; LAS int* WBASE = WCNT + 32; LAS unsigned* ETOK = (LAS unsigned*)(WBASE + 32); LAS unsigned* EEL = ETOK + 512; LAS float* EG = (LAS float*)(EEL + 512);
    int tile = F.vcu;
    while (tile < ntile) {
      __syncthreads();
      if (F.tid < 32) WCNT[F.tid] = 0;
      int nb = 0;
      for (; tile < ntile && nb < 8; tile += F.G, ++nb) {
        const int r0 = row_lo + 16 * tile;
#pragma unroll
        for (int rr = 0; rr < 2; ++rr) {
            const int rl = 2 * F.wave + rr, row = r0 + rl, seg = seg_of_row(row);
            const LAS float* sh = VC + (1 + 3 * seg) * D; const LAS float* sc = sh + D; const LAS float* g2v = sc + D;
            f32x4 v[4]; float ss = 0.f;
#pragma unroll
            for (int j = 0; j < 4; ++j) { const int c = 4 * F.lane + 256 * j; { const v2u xx = *(const GAS v2u*)(X + (size_t)row * D + c); v[j] = (f32x4){bflo(xx.x), bfhi(xx.x), bflo(xx.y), bfhi(xx.y)}; }
                const v2u yy = *(const GAS v2u*)((const bf16*)(F.ws + WS_YM) + (size_t)row * D + c); const f32x4 g2 = *(const LAS f32x4*)(g2v + c);
                v[j] = v[j] + g2 * (f32x4){bflo(yy.x), bfhi(yy.x), bflo(yy.y), bfhi(yy.y)};
                ss += (v[j].x * v[j].x + v[j].y * v[j].y) + (v[j].z * v[j].z + v[j].w * v[j].w); }
            const float rstd = __builtin_amdgcn_rsqf(wave_sum(ss) * (1.0f / D) + EPS);
#pragma unroll
            for (int j = 0; j < 4; ++j) { const int c = 4 * F.lane + 256 * j;
                const f32x4 g = *(const LAS f32x4*)(VC + c), s1 = *(const LAS f32x4*)(sc + c), s0 = *(const LAS f32x4*)(sh + c);
                const f32x4 h = v[j] * rstd * g * (s1 + 1.0f) + s0;
                v2u o; o.x = pk2(h.x, h.y); o.y = pk2(h.z, h.w);
                const unsigned h0 = o.x & 0xffffu, h1 = o.x >> 16, h2 = o.y & 0xffffu, h3 = o.y >> 16;
                *(GAS v2u*)(H + (size_t)row * D + c) = o;
                *(LAS v2u*)(Ahi + rl * AST + c) = o;
                v2u l; l.x = pk2(h.x - bf2f(h0), h.y - bf2f(h1)); l.y = pk2(h.z - bf2f(h2), h.w - bf2f(h3));
                *(LAS v2u*)(Alo + rl * AST + c) = l; }
        }
        __syncthreads();
        f32x4 acc[2] = {(f32x4){0.f, 0.f, 0.f, 0.f}, (f32x4){0.f, 0.f, 0.f, 0.f}};
#pragma unroll
        for (int ks = 0; ks < 4; ++ks) { const int o = fr * AST + F.wave * 128 + ks * 32 + fq * 8;
            const bf16x8 ah = *(const LAS bf16x8*)(Ahi + o), al = *(const LAS bf16x8*)(Alo + o);
#pragma unroll
            for (int nt = 0; nt < 2; ++nt) { acc[nt] = MFMA16(ah, Bh[nt][ks], acc[nt]); acc[nt] = MFMA16(ah, Bl[nt][ks], acc[nt]); acc[nt] = MFMA16(al, Bh[nt][ks], acc[nt]); } }
#pragma unroll
        for (int nt = 0; nt < 2; ++nt)
#pragma unroll
            for (int j = 0; j < 4; ++j) RED[(F.wave * 16 + fq * 4 + j) * 32 + nt * 16 + fr] = acc[nt][j];
        __syncthreads();
        {
            const int rl = F.tid >> 5, e = F.tid & 31, row = r0 + rl;
            float lg = a.in[I_MBR][layer * 32 + e];
#pragma unroll
            for (int w8 = 0; w8 < 8; ++w8) lg += RED[(w8 * 16 + rl) * 32 + e];
            float cur = lg; float tv[4]; int tix[4];
#pragma unroll
            for (int k = 0; k < 4; ++k) { float bv = cur; int bi = e;
#define TK_STEP(ctrl) do { const float ov = DPP_F(bv, ctrl); const int oi = DPP_I(bi, ctrl); if (ov > bv || (ov == bv && oi < bi)) { bv = ov; bi = oi; } } while (0)
                TK_STEP(DPP_XOR1); TK_STEP(DPP_XOR2); TK_STEP(DPP_HMIRROR); TK_STEP(DPP_MIRROR);
#undef TK_STEP
                {
                    const int hb = (F.lane >> 5) * 32;
                    const float v0 = __builtin_bit_cast(float, __builtin_amdgcn_readlane(__builtin_bit_cast(int, bv), 0)), v1 = __builtin_bit_cast(float, __builtin_amdgcn_readlane(__builtin_bit_cast(int, bv), 16));
                    const float v2 = __builtin_bit_cast(float, __builtin_amdgcn_readlane(__builtin_bit_cast(int, bv), 32)), v3 = __builtin_bit_cast(float, __builtin_amdgcn_readlane(__builtin_bit_cast(int, bv), 48));
                    const int i0 = __builtin_amdgcn_readlane(bi, 0), i1 = __builtin_amdgcn_readlane(bi, 16), i2 = __builtin_amdgcn_readlane(bi, 32), i3 = __builtin_amdgcn_readlane(bi, 48);
                    const bool a01 = v1 > v0 || (v1 == v0 && i1 < i0), a23 = v3 > v2 || (v3 == v2 && i3 < i2);
                    const float w01 = a01 ? v1 : v0, w23 = a23 ? v3 : v2; const int j01 = a01 ? i1 : i0, j23 = a23 ? i3 : i2;
                    bv = hb ? w23 : w01; bi = hb ? j23 : j01; }
                tv[k] = bv; tix[k] = bi; if (e == bi) cur = -3.0e38f; }
            const float e1 = __expf(tv[1] - tv[0]), e2 = __expf(tv[2] - tv[0]), e3 = __expf(tv[3] - tv[0]); const float inv = 1.0f / (1.0f + e1 + e2 + e3);
            if (e < 4 && !dry) { const int k = e; const int ek = k == 0 ? tix[0] : (k == 1 ? tix[1] : (k == 2 ? tix[2] : tix[3])); const float gk = (k == 0 ? 1.0f : (k == 1 ? e1 : (k == 2 ? e2 : e3))) * inv;
                const int lr = __hip_atomic_fetch_add((int*)(WCNT + ek), 1, __ATOMIC_RELAXED, __HIP_MEMORY_SCOPE_WORKGROUP);
                const int idx = nb * 64 + rl * 4 + k;
                ETOK[idx] = (unsigned)(row * 4 + k); EEL[idx] = (unsigned)ek | ((unsigned)lr << 8); EG[idx] = gk; }
        }
        __syncthreads();
      }
      if (!dry) {
        if (F.tid < 32) { const int c = WCNT[F.tid]; WBASE[F.tid] = c ? (int)atomicAdd(F.ctl + CW_CNT + (layer * 32 + F.tid) * 64, (unsigned)c) : 0; }
        __syncthreads();
        for (int i = F.tid; i < nb * 64; i += NTHREADS) { const unsigned el = EEL[i], tk = ETOK[i]; const unsigned ek = el & 255u, rank = (unsigned)WBASE[ek] + (el >> 8);
            ((unsigned*)(F.ws + WS_LIST))[(size_t)ek * NTOK + rank] = tk >> 2;
            ((unsigned*)(F.ws + WS_TOKI))[tk] = (ek << 16) | rank;
            ((float*)(F.ws + WS_TOKG))[tk] = EG[i]; }
      }
    }
}

__device__ __forceinline__ void p_gather(Frame& F, int layer) {
    moe_tables(F, layer);
    const LAS int* M = (const LAS int*)(F.lds + MISC_OFF);
    const int total = M[32];
    const int gw = F.vcu * NWAVES + F.wave, NGW = F.G * NWAVES;
    const bf16* H = (const bf16*)(F.ws + WS_H); bf16* AS = (bf16*)(F.ws + WS_AS);
    const unsigned* LIST = (const unsigned*)(F.ws + WS_LIST);
    for (int p = gw; p < total; p += NGW) {
        const int e = M[64 + (p >> 8)]; const int rank = p - M[e];
        v4u x0 = (v4u){0u, 0u, 0u, 0u}, x1 = x0;
        if (rank < M[400 + e]) { const unsigned r = LIST[(size_t)e * NTOK + rank]; const GAS v4u* s = (const GAS v4u*)(H + (size_t)r * D); x0 = s[F.lane]; x1 = s[64 + F.lane]; }
        GAS v4u* d = (GAS v4u*)(AS + (size_t)p * D); d[F.lane] = x0; d[64 + F.lane] = x1;
    }
}

typedef short s16x4 __attribute__((ext_vector_type(4)));
__device__ __forceinline__ bf16x8 tr_frag(const LAS bf16* T, int stride, int kb, int c0, int lane) {
    const int g = lane >> 4, w = lane & 15, q = w >> 2, p = w & 3;
    const LAS bf16* a0 = T + (kb + 4 * g + q) * stride + c0 + 4 * p;
    const s16x4 lo = __builtin_amdgcn_ds_read_tr16_b64_v4i16((LAS s16x4*)a0);
    const s16x4 hi = __builtin_amdgcn_ds_read_tr16_b64_v4i16((LAS s16x4*)(a0 + 16 * stride));
    return (bf16x8){lo[0], lo[1], lo[2], lo[3], hi[0], hi[1], hi[2], hi[3]};
}
__device__ __forceinline__ bf16x8 perm_frag(const LAS bf16* rowp, int kb, int quad) {
    const v2u lo = *(const LAS v2u*)(rowp + kb + 4 * quad), hi = *(const LAS v2u*)(rowp + kb + 16 + 4 * quad);
    v4u w; w.x = lo.x; w.y = lo.y; w.z = hi.x; w.w = hi.y; return __builtin_bit_cast(bf16x8, w);
}
__device__ __forceinline__ void p_spatial(Frame& F, const Args& a, int layer) {
    const int jl = layer / 3;
    const int c_lo = (layer >= 3) ? 4 : 0;
    const int nunit = (132 - c_lo) * 8;
    const bf16* ZB = (const bf16*)(F.ws + WS_BIG); bf16* G = (bf16*)(F.ws + WS_G);
    constexpr int ST = 144;
    LAS bf16* As = (LAS bf16*)(F.lds); LAS bf16* Bs = As + 128 * ST; LAS float* rs = (LAS float*)(F.lds + 2 * 128 * ST * 2);
    const int fr = F.lane & 15, fq = F.lane >> 4;
    const int u_lo = (int)(((long)F.vcu * nunit) / F.G), u_hi = (int)(((long)(F.vcu + 1) * nunit) / F.G);
    int cur_c = -1;
    for (int u = u_lo; u < u_hi; ++u) {
        const int c = c_lo + (u >> 3), g = u & 7, r0 = 128 * c;
        if (c != cur_c) {
            cur_c = c;
            __syncthreads();
#pragma unroll
            for (int hb = 0; hb < 2; ++hb) {
                v4u x0[8], x1[8];
#pragma unroll
                for (int rr = 0; rr < 8; ++rr) { const GAS v4u* p = (const GAS v4u*)(ZB + (size_t)(r0 + F.wave * 16 + hb * 8 + rr) * 2048 + 1024 + 16 * F.lane); x0[rr] = p[0]; x1[rr] = p[1]; }
#pragma unroll
                for (int rr = 0; rr < 8; ++rr) { float ss = 0.f;
#pragma unroll
                    for (int i = 0; i < 4; ++i) { const float l0 = bflo(x0[rr][i]), h0 = bfhi(x0[rr][i]), l1 = bflo(x1[rr][i]), h1 = bfhi(x1[rr][i]); ss += l0 * l0 + h0 * h0 + l1 * l1 + h1 * h1; }
                    ss = wave_sum(ss); if (F.lane == 0) rs[F.wave * 16 + hb * 8 + rr] = __builtin_amdgcn_rsqf(ss * (1.0f / 1024.0f) + EPS); }
            }
        }
        __syncthreads();
        {
            const bf16* wsb = (const bf16*)(F.ws + WS_WSB) + (size_t)(jl * 8 + g) * 128 * 128;
            const float* gv = a.in[I_AGV] + (size_t)jl * 1024 + 128 * g;
#pragma unroll
            for (int i = 0; i < 4; ++i) { const int id = F.tid + 512 * i, p = id >> 4, qc = id & 15;
                *(LAS v4u*)(As + p * ST + qc * 8) = *(const GAS v4u*)(wsb + p * 128 + qc * 8);
                const v4u x = *(const GAS v4u*)(ZB + (size_t)(r0 + p) * 2048 + 1024 + 128 * g + 8 * qc); const float rq = rs[p];
                const f32x4 g0 = *(const GAS f32x4*)(gv + 8 * qc), g1 = *(const GAS f32x4*)(gv + 8 * qc + 4);
                v4u o; o.x = pk2(bflo(x.x) * rq * g0.x, bfhi(x.x) * rq * g0.y); o.y = pk2(bflo(x.y) * rq * g0.z, bfhi(x.y) * rq * g0.w);
                o.z = pk2(bflo(x.z) * rq * g1.x, bfhi(x.z) * rq * g1.y); o.w = pk2(bflo(x.w) * rq * g1.z, bfhi(x.w) * rq * g1.w);
                *(LAS v4u*)(Bs + p * ST + qc * 8) = o; }
        }
        __syncthreads();
        f32x4 acc[8];
#pragma unroll
        for (int nt = 0; nt < 8; ++nt) acc[nt] = (f32x4){0.f, 0.f, 0.f, 0.f};
#pragma unroll
        for (int ks = 0; ks < 4; ++ks) { const bf16x8 af = tr_frag(Bs, ST, 32 * ks, 16 * F.wave, F.lane);
#pragma unroll
            for (int nt = 0; nt < 8; ++nt) { const bf16x8 bfr = perm_frag(As + (16 * nt + fr) * ST, 32 * ks, fq); acc[nt] = MFMA16(af, bfr, acc[nt]); } }
        const float* bs = a.in[I_ABS] + (size_t)(jl * 8 + g) * 128;
#pragma unroll
        for (int nt = 0; nt < 8; ++nt) { const int p = 16 * nt + fr; const float bb = bs[p]; const size_t row = (size_t)(r0 + p); const int cc = 128 * g + 16 * F.wave + 4 * fq;
            const v2u uu = *(const GAS v2u*)(ZB + row * 2048 + cc);
            v2u o; o.x = pk2(bflo(uu.x) * (acc[nt][0] + bb), bfhi(uu.x) * (acc[nt][1] + bb)); o.y = pk2(bflo(uu.y) * (acc[nt][2] + bb), bfhi(uu.y) * (acc[nt][3] + bb));
            *(GAS v2u*)(G + row * D + cc) = o; }
        __syncthreads();
    }
}

constexpr int PST = GLA_INP;
constexpr int CST = 132;
constexpr int KST = 144;
constexpr int VST = 272;
__device__ __forceinline__ void gla_cum(Frame& F, const Args& a, int c, int h, int dir, LAS float* cum, LAS float* rt, LAS float* tot) {
    const bf16* P = (const bf16*)(F.ws + WS_BIG);
    for (int i = F.tid; i < 64 * 8; i += NTHREADS) { const int ii = i >> 3, j2 = i & 7; const unsigned x = *(const GAS unsigned*)(P + (size_t)(64 * c + ii) * PST + 3072 + dir * 16 + 2 * j2);
        rt[ii * 16 + 2 * j2] = bflo(x); rt[ii * 16 + 2 * j2 + 1] = bfhi(x); }
    const int kk = F.tid & 127, part = F.tid >> 7;
    float w[16];
#pragma unroll
    for (int j = 0; j < 16; ++j) w[j] = a.in[I_BWA2][(size_t)(dir * 16 + j) * 512 + h * 128 + kk];
    const float ba = a.in[I_BBA][dir * 512 + h * 128 + kk];
    __syncthreads();
    float la[16];
#pragma unroll
    for (int ii = 0; ii < 16; ++ii) { const int i = part * 16 + ii; float z = ba;
        const f32x4 r0 = *(const LAS f32x4*)(rt + i * 16), r1 = *(const LAS f32x4*)(rt + i * 16 + 4), r2 = *(const LAS f32x4*)(rt + i * 16 + 8), r3 = *(const LAS f32x4*)(rt + i * 16 + 12);
        z += r0.x * w[0] + r0.y * w[1] + r0.z * w[2] + r0.w * w[3]; z += r1.x * w[4] + r1.y * w[5] + r1.z * w[6] + r1.w * w[7];
        z += r2.x * w[8] + r2.y * w[9] + r2.z * w[10] + r2.w * w[11]; z += r3.x * w[12] + r3.y * w[13] + r3.z * w[14] + r3.w * w[15];
        const float ls = fminf(z, 0.0f) - __logf(1.0f + __expf(-fabsf(z)));
        la[ii] = ls * (1.0f / 16.0f); }
    float run = 0.f;
    if (dir == 0) {
#pragma unroll
        for (int ii = 0; ii < 16; ++ii) { run += la[ii]; la[ii] = run; } }
    else {
#pragma unroll
        for (int ii = 15; ii >= 0; --ii) { run += la[ii]; la[ii] = run; } }
    tot[part * 128 + kk] = run;
    __syncthreads();
    float off = 0.f;
#pragma unroll
    for (int p = 0; p < 4; ++p) { const float t = tot[p * 128 + kk]; if (dir == 0 ? (p < part) : (p > part)) off += t; }
#pragma unroll
    for (int ii = 0; ii < 16; ++ii) cum[(part * 16 + ii) * CST + kk] = la[ii] + off;
    __syncthreads();
}
struct CumIn { unsigned rx[2]; float w0[16], w1[16], ba0, ba1; };
__device__ __forceinline__ void gla_cum2_load(Frame& F, const Args& a, int c, int h, CumIn& ci) {
    const bf16* P = (const bf16*)(F.ws + WS_BIG);
#pragma unroll
    for (int k = 0; k < 2; ++k) { const int i = F.tid + 512 * k, ii = i >> 4, j2 = i & 15; ci.rx[k] = *(const GAS unsigned*)(P + (size_t)(64 * c + ii) * PST + 3072 + 2 * j2); }
    const int kk = F.tid & 127;
#pragma unroll
    for (int j = 0; j < 16; ++j) { ci.w0[j] = a.in[I_BWA2][(size_t)j * 512 + h * 128 + kk]; ci.w1[j] = a.in[I_BWA2][(size_t)(16 + j) * 512 + h * 128 + kk]; }
    ci.ba0 = a.in[I_BBA][h * 128 + kk]; ci.ba1 = a.in[I_BBA][512 + h * 128 + kk];
}
__device__ __forceinline__ void gla_cum2_run(Frame& F, LAS float* cum, float (&c1)[16], LAS float* rt, LAS float* tot, const CumIn& ci) {
#pragma unroll
    for (int k = 0; k < 2; ++k) { const int i = F.tid + 512 * k, ii = i >> 4, j2 = i & 15; rt[ii * 32 + 2 * j2] = bflo(ci.rx[k]); rt[ii * 32 + 2 * j2 + 1] = bfhi(ci.rx[k]); }
    const int kk = F.tid & 127, part = F.tid >> 7;
    LBAR();
    float la0[16];
#pragma unroll
    for (int ii = 0; ii < 16; ++ii) { const int i = part * 16 + ii; float z0 = ci.ba0, z1 = ci.ba1;
#pragma unroll
        for (int q = 0; q < 4; ++q) { const f32x4 r = *(const LAS f32x4*)(rt + i * 32 + 4 * q), t = *(const LAS f32x4*)(rt + i * 32 + 16 + 4 * q);
            z0 += r.x * ci.w0[4 * q] + r.y * ci.w0[4 * q + 1] + r.z * ci.w0[4 * q + 2] + r.w * ci.w0[4 * q + 3];
            z1 += t.x * ci.w1[4 * q] + t.y * ci.w1[4 * q + 1] + t.z * ci.w1[4 * q + 2] + t.w * ci.w1[4 * q + 3]; }
        la0[ii] = (fminf(z0, 0.0f) - __logf(1.0f + __expf(-fabsf(z0)))) * (1.0f / 16.0f);
        c1[ii] = (fminf(z1, 0.0f) - __logf(1.0f + __expf(-fabsf(z1)))) * (1.0f / 16.0f); }
    float run0 = 0.f, run1 = 0.f;
#pragma unroll
    for (int ii = 0; ii < 16; ++ii) { run0 += la0[ii]; la0[ii] = run0; }
#pragma unroll
    for (int ii = 15; ii >= 0; --ii) { run1 += c1[ii]; c1[ii] = run1; }
    tot[part * 128 + kk] = run0; tot[512 + part * 128 + kk] = run1;
    LBAR();
    float off0 = 0.f, off1 = 0.f;
#pragma unroll
    for (int p = 0; p < 4; ++p) { const float t0 = tot[p * 128 + kk], t1 = tot[512 + p * 128 + kk]; if (p < part) off0 += t0; if (p > part) off1 += t1; }
#pragma unroll
    for (int ii = 0; ii < 16; ++ii) { cum[(part * 16 + ii) * CST + kk] = la0[ii] + off0; c1[ii] += off1; }
    LBAR();
}
__device__ __forceinline__ void gla_cum_store(Frame& F, LAS float* cum, const float (&c1)[16]) {
    const int kk = F.tid & 127, part = F.tid >> 7;
#pragma unroll
    for (int ii = 0; ii < 16; ++ii) cum[(part * 16 + ii) * CST + kk] = c1[ii];
}
struct RowRaw { v4u o0, o1, p0, p1; };
__device__ __forceinline__ void row16_load(const bf16* x, int grp, bool lat, RowRaw& R) {
    R.o0 = *(const GAS v4u*)(x + 16 * grp); R.o1 = *(const GAS v4u*)(x + 16 * grp + 8);
    if (lat) { R.p0 = *(const GAS v4u*)(x + 16 * (grp ^ 2)); R.p1 = *(const GAS v4u*)(x + 16 * (grp ^ 2) + 8); } else { R.p0 = R.o0; R.p1 = R.o1; }
}
__device__ __forceinline__ void ropetab_load(const float* ROPE, int grp, int pr, int pc, bool lat, f32x4 (&tb)[8]) {
    const int pos = (grp >> 2) ? pc : pr; const float* t = ROPE + (size_t)(pos * 32 + 16 * (grp & 1)) * 2;
#pragma unroll
    for (int e2 = 0; e2 < 8; ++e2) tb[e2] = lat ? *(const GAS f32x4*)(t + 4 * e2) : (f32x4){1.f, 0.f, 1.f, 0.f};
}
__device__ __forceinline__ void rope16_apply(const RowRaw& R, const f32x4 (&tb)[8], int grp, bool lat, float (&out)[16]) {
    float own[16], par[16];
#pragma unroll
    for (int e = 0; e < 4; ++e) { own[2 * e] = bflo(R.o0[e]); own[2 * e + 1] = bfhi(R.o0[e]); own[8 + 2 * e] = bflo(R.o1[e]); own[8 + 2 * e + 1] = bfhi(R.o1[e]);
        par[2 * e] = bflo(R.p0[e]); par[2 * e + 1] = bfhi(R.p0[e]); par[8 + 2 * e] = bflo(R.p1[e]); par[8 + 2 * e + 1] = bfhi(R.p1[e]); }
    const float sg = ((grp >> 1) & 1) ? 1.0f : -1.0f; (void)lat;
#pragma unroll
    for (int e2 = 0; e2 < 8; ++e2) { const f32x4 t = tb[e2];
        out[2 * e2] = fmaf(par[2 * e2], sg * t.y, own[2 * e2] * t.x);
        out[2 * e2 + 1] = fmaf(par[2 * e2 + 1], sg * t.w, own[2 * e2 + 1] * t.z); }
}
__device__ __forceinline__ void st16bf(LAS bf16* dst, const float (&v)[16]) {
    v4u a, b; a.x = pk2(v[0], v[1]); a.y = pk2(v[2], v[3]); a.z = pk2(v[4], v[5]); a.w = pk2(v[6], v[7]); b.x = pk2(v[8], v[9]); b.y = pk2(v[10], v[11]); b.z = pk2(v[12], v[13]); b.w = pk2(v[14], v[15]);
    *(LAS v4u*)dst = a; *(LAS v4u*)(dst + 8) = b;
}
__device__ __forceinline__ void ld16cum(const LAS float* p, float (&v)[16]) {
#pragma unroll
    for (int e = 0; e < 4; ++e) { const f32x4 t = *(const LAS f32x4*)(p + 4 * e); v[4 * e] = t.x; v[4 * e + 1] = t.y; v[4 * e + 2] = t.z; v[4 * e + 3] = t.w; }
}
__device__ __forceinline__ void gla_load_v(Frame& F, int c, int h, v4u (&vr)[4]) {
    const bf16* P = (const bf16*)(F.ws + WS_BIG);
    const int i = F.tid & 63, grp = F.tid >> 6; const bf16* vp = P + (size_t)(64 * c + i) * PST + 1024 + h * 256 + grp * 32;
#pragma unroll
    for (int e = 0; e < 4; ++e) vr[e] = *(const GAS v4u*)(vp + 8 * e);
}
__device__ __forceinline__ void gla_store_v(Frame& F, const v4u (&vr)[4], LAS bf16* VL) {
    const int i = F.tid & 63, grp = F.tid >> 6;
#pragma unroll
    for (int e = 0; e < 4; ++e) *(LAS v4u*)(VL + i * VST + grp * 32 + 8 * e) = vr[e];
}
__device__ __forceinline__ void p_gla_ds(Frame& F, const Args& a) {
    const bf16* P = (const bf16*)(F.ws + WS_BIG); const float* ROPE = (const float*)(F.ws + WS_ROPE);
    bf16* DS = (bf16*)(F.ws + WS_DS); float* DEC = (float*)(F.ws + WS_DEC);
    LAS float* cum = (LAS float*)(F.lds); LAS float* rt = cum + 64 * CST; LAS float* tot = rt + 64 * 32;
    LAS bf16* KE = (LAS bf16*)(tot + 2 * 4 * 128); LAS bf16* VL = KE + 64 * KST;
    const int fr = F.lane & 15, fq = F.lane >> 4;
    for (int u = F.vcu; u < 264 * 4; u += F.G) {
        const int c = u >> 2, h = u & 3; const bool lat = c >= 8; const int pr = (c - 8) & 127;
        RowRaw kraw; f32x4 tb[8]; float c1[16], kv0[16]; v4u vreg[4]; CumIn cin;
        gla_cum2_load(F, a, c, h, cin);
        { const int i = F.tid & 63, grp = F.tid >> 6; row16_load(P + (size_t)(64 * c + i) * PST + 512 + h * 128, grp, lat, kraw); ropetab_load(ROPE, grp, pr, i, lat, tb); }
        gla_load_v(F, c, h, vreg);
        gla_cum2_run(F, cum, c1, rt, tot, cin);
#pragma unroll
        for (int dir = 0; dir < 2; ++dir) {
            const int lastrow = dir == 0 ? 63 : 0;
            if (dir == 1) { gla_cum_store(F, cum, c1); LBAR(); }
            {
                const int i = F.tid & 63, grp = F.tid >> 6;
                float kv[16], cl[16], ci[16];
                if (dir == 0) { rope16_apply(kraw, tb, grp, lat, kv0); gla_store_v(F, vreg, VL); }
                ld16cum(cum + lastrow * CST + 16 * grp, cl); ld16cum(cum + i * CST + 16 * grp, ci);
#pragma unroll
                for (int e = 0; e < 16; ++e) kv[e] = kv0[e] * __expf(cl[e] - ci[e]);
                st16bf(KE + i * KST + 16 * grp, kv);
                if (F.tid < 128) DEC[((size_t)(dir * 264 + c) * 4 + h) * 128 + F.tid] = __expf(cum[lastrow * CST + F.tid]);
            }
            LBAR();
            f32x4 acc[16];
#pragma unroll
            for (int nt = 0; nt < 16; ++nt) acc[nt] = (f32x4){0.f, 0.f, 0.f, 0.f};
#pragma unroll
            for (int ks = 0; ks < 2; ++ks) { const bf16x8 af = tr_frag(KE, KST, 32 * ks, 16 * F.wave, F.lane);
#pragma unroll
                for (int nt = 0; nt < 16; ++nt) { const bf16x8 bfr = tr_frag(VL, VST, 32 * ks, 16 * nt, F.lane); acc[nt] = MFMA16(af, bfr, acc[nt]); } }
            bf16* dsp = DS + ((size_t)(dir * 264 + c) * 4 + h) * 256 * 128;
#pragma unroll
            for (int nt = 0; nt < 16; ++nt) { v2u o; o.x = pk2(acc[nt][0], acc[nt][1]); o.y = pk2(acc[nt][2], acc[nt][3]);
                *(GAS v2u*)(dsp + (size_t)((((nt * 4 + (F.wave >> 1)) * 4 + ((2 * F.wave + (fq >> 1)) & 3)) * 16 + fr) * 8 + 4 * (fq & 1))) = o; }
            LBAR();
        }
    }
}
__device__ __forceinline__ void p_gla_scan(Frame& F) {
    const bf16* DS = (const bf16*)(F.ws + WS_DS); bf16* SIN = (bf16*)(F.ws + WS_SIN); const float* DEC = (const float*)(F.ws + WS_DEC);
    LAS float* dl = (LAS float*)(F.lds);
    for (int job = F.vcu; job < 256; job += F.G) {
        const int vt = job & 15, h = (job >> 4) & 3, dir = (job >> 6) & 1, b = job >> 7;
        __syncthreads();
        for (int i = F.tid; i < 132 * 32; i += NTHREADS) { const int st = i >> 5, k4 = i & 31; int c;
            if (dir == 0) c = st < 4 ? 4 * b + st : 8 + 128 * b + (st - 4); else c = st < 4 ? 4 * b + 3 - st : 8 + 128 * b + 127 - (st - 4);
            *(LAS f32x4*)(dl + st * 128 + 4 * k4) = *(const GAS f32x4*)(DEC + ((size_t)(dir * 264 + c) * 4 + h) * 128 + 4 * k4); }
        __syncthreads();
        const int ks = F.wave >> 1, quad = 2 * (F.wave & 1) + (F.lane >> 5), fr = (F.lane >> 1) & 15, half = F.lane & 1;
        const int kk0 = 32 * ks + 8 * quad + 4 * half;
        const size_t eoff = (size_t)((((vt * 4 + ks) * 4 + quad) * 16 + fr) * 8 + 4 * half);
        f32x4 S = (f32x4){0.f, 0.f, 0.f, 0.f};
        for (int s0 = 0; s0 < 132; s0 += 12) {
            size_t o[12]; v2u d[12];
#pragma unroll
            for (int q = 0; q < 12; ++q) { const int st = s0 + q; int c;
                if (dir == 0) c = st < 4 ? 4 * b + st : 8 + 128 * b + (st - 4); else c = st < 4 ? 4 * b + 3 - st : 8 + 128 * b + 127 - (st - 4);
                o[q] = ((size_t)(dir * 264 + c) * 4 + h) * 32768 + eoff;
                d[q] = __builtin_nontemporal_load((const GAS v2u*)(DS + o[q])); }
#pragma unroll
            for (int q = 0; q < 12; ++q) { const f32x4 dc = *(const LAS f32x4*)(dl + (s0 + q) * 128 + kk0);
                v2u so; so.x = pk2(S.x, S.y); so.y = pk2(S.z, S.w);
                *(GAS v2u*)(SIN + o[q]) = so;
                S.x = S.x * dc.x + bflo(d[q].x); S.y = S.y * dc.y + bfhi(d[q].x); S.z = S.z * dc.z + bflo(d[q].y); S.w = S.w * dc.w + bfhi(d[q].y); }
        }
    }
}
#define GST(slot) do { if (PROBE_STAMP >= 20 && blockIdx.x == 0 && threadIdx.x == 0) { const unsigned long long _t = wall_clock64(); STAMPS(F)[40 + (slot)] += _t - STAMPS(F)[99]; STAMPS(F)[99] = _t; } } while (0)
__device__ __forceinline__ void p_gla_out(Frame& F, const Args& a) {
    const bf16* P = (const bf16*)(F.ws + WS_BIG); const float* ROPE = (const float*)(F.ws + WS_ROPE);
    const bf16* SIN = (const bf16*)(F.ws + WS_SIN); bf16* G = (bf16*)(F.ws + WS_G);
    constexpr int ST = 72;
    LAS float* cum = (LAS float*)(F.lds); LAS float* rt = cum + 64 * CST; LAS float* tot = rt + 64 * 32; LAS float* ssq = tot + 2 * 4 * 128;
    LAS bf16* VL = (LAS bf16*)(ssq + 8 * 64); LAS bf16* QD = VL + 64 * VST; LAS bf16* KI = QD + 64 * KST; LAS bf16* PL = KI + 64 * KST;
    const int fr = F.lane & 15, fq = F.lane >> 4;
    if (PROBE_STAMP >= 20 && blockIdx.x == 0 && threadIdx.x == 0) STAMPS(F)[99] = wall_clock64();
    for (int u = F.vcu; u < 264 * 4; u += F.G) {
        const int c = u >> 2, h = u & 3; const bool lat = c >= 8; const int pr = (c - 8) & 127;
        f32x4 acc[2][4];
#pragma unroll
        for (int mt = 0; mt < 2; ++mt)
#pragma unroll
            for (int nt = 0; nt < 4; ++nt) acc[mt][nt] = (f32x4){0.f, 0.f, 0.f, 0.f};
        v4u vreg[4]; CumIn cin; v2u ggv[4][2];
        gla_cum2_load(F, a, c, h, cin);
        float qv0[16], kv0[16], c1[16];
#pragma unroll
        for (int dir = 0; dir < 2; ++dir) {
            RowRaw qraw0, kraw0; f32x4 tb0[8];
            { const int i = F.tid & 63, grp = F.tid >> 6; const size_t row = (size_t)(64 * c + i);
                if (dir == 0) { row16_load(P + row * PST + h * 128, grp, lat, qraw0); row16_load(P + row * PST + 512 + h * 128, grp, lat, kraw0); ropetab_load(ROPE, grp, pr, i, lat, tb0); gla_load_v(F, c, h, vreg); } }
            const bf16* sp = SIN + ((size_t)(dir * 264 + c) * 4 + h) * 256 * 128;
            bf16x8 sfr[4][2];
#pragma unroll
            for (int ks = 0; ks < 4; ++ks)
#pragma unroll
                for (int mt = 0; mt < 2; ++mt) sfr[ks][mt] = *(const GAS bf16x8*)(sp + (size_t)(((((2 * F.wave + mt) * 4 + ks) * 4 + fq) * 16 + fr) * 8));
            if (dir == 1) {
#pragma unroll
                for (int nt = 0; nt < 4; ++nt)
#pragma unroll
                    for (int mt = 0; mt < 2; ++mt) ggv[nt][mt] = *(const GAS v2u*)(P + (size_t)(64 * c + 16 * nt + fr) * PST + 2048 + h * 256 + 32 * F.wave + 16 * mt + fq * 4); }
            GST(60);
            if (dir == 0) gla_cum2_run(F, cum, c1, rt, tot, cin); else { gla_cum_store(F, cum, c1); LBAR(); }
            GST(61);
            {
                const int i = F.tid & 63, grp = F.tid >> 6;
                if (dir == 0) { rope16_apply(qraw0, tb0, grp, lat, qv0); rope16_apply(kraw0, tb0, grp, lat, kv0); gla_store_v(F, vreg, VL); }
                float qv[16], kv[16], ci[16];
                ld16cum(cum + i * CST + 16 * grp, ci);
#pragma unroll
                for (int e = 0; e < 16; ++e) { const float ex = __expf(ci[e]); qv[e] = qv0[e] * (0.08838834764831845f * ex); kv[e] = kv0[e] * __builtin_amdgcn_rcpf(ex); }
                st16bf(QD + i * KST + 16 * grp, qv); st16bf(KI + i * KST + 16 * grp, kv);
            }
            LBAR();
            GST(62);
            {
                const int jt = F.wave >> 1;
#pragma unroll
                for (int t2 = 0; t2 < 2; ++t2) { const int it = 2 * (F.wave & 1) + t2; f32x4 s = (f32x4){0.f, 0.f, 0.f, 0.f};
#pragma unroll
                    for (int ks = 0; ks < 4; ++ks) { const bf16x8 af = *(const LAS bf16x8*)(KI + (16 * jt + fr) * KST + ks * 32 + fq * 8), bfr = *(const LAS bf16x8*)(QD + (16 * it + fr) * KST + ks * 32 + fq * 8); s = MFMA16(af, bfr, s); }
                    const int i = 16 * it + fr, j0 = 16 * jt + fq * 4; float pv[4];
#pragma unroll
                    for (int r = 0; r < 4; ++r) { const int j = j0 + r; const bool keep = dir == 0 ? (j <= i) : (j >= i); pv[r] = keep ? s[r] : 0.0f; }
                    v2u o; o.x = pk2(pv[0], pv[1]); o.y = pk2(pv[2], pv[3]);
                    *(LAS v2u*)(PL + i * ST + j0) = o; }
            }
            LBAR();
            GST(63);
#pragma unroll
            for (int ks = 0; ks < 2; ++ks) {
                bf16x8 bfr[4];
#pragma unroll
                for (int nt = 0; nt < 4; ++nt) bfr[nt] = perm_frag(PL + (16 * nt + fr) * ST, 32 * ks, fq);
#pragma unroll
                for (int mt = 0; mt < 2; ++mt) { const bf16x8 af = tr_frag(VL, VST, 32 * ks, 32 * F.wave + 16 * mt, F.lane);
#pragma unroll
                    for (int nt = 0; nt < 4; ++nt) acc[mt][nt] = MFMA16(af, bfr[nt], acc[mt][nt]); } }
#pragma unroll
            for (int ks = 0; ks < 4; ++ks) {
                bf16x8 bfr[4];
#pragma unroll
                for (int nt = 0; nt < 4; ++nt) bfr[nt] = *(const LAS bf16x8*)(QD + (16 * nt + fr) * KST + ks * 32 + fq * 8);
#pragma unroll
                for (int mt = 0; mt < 2; ++mt) {
#pragma unroll
                    for (int nt = 0; nt < 4; ++nt) acc[mt][nt] = MFMA16(sfr[ks][mt], bfr[nt], acc[mt][nt]); } }
            LBAR();
            GST(64);
        }
#pragma unroll
        for (int nt = 0; nt < 4; ++nt) { float s = 0.f;
#pragma unroll
            for (int mt = 0; mt < 2; ++mt)
#pragma unroll
                for (int j = 0; j < 4; ++j) s += acc[mt][nt][j] * acc[mt][nt][j];
            s += __shfl_xor(s, 16); s += __shfl_xor(s, 32);
            if (fq == 0) ssq[F.wave * 64 + 16 * nt + fr] = s; }
        LBAR();
#pragma unroll
        for (int nt = 0; nt < 4; ++nt) { const int i = 16 * nt + fr; float s = 0.f;
#pragma unroll
            for (int w8 = 0; w8 < 8; ++w8) s += ssq[w8 * 64 + i];
            const float rstd = __builtin_amdgcn_rsqf(s * (1.0f / 256.0f) + EPS); const size_t row = (size_t)(64 * c + i);
#pragma unroll
            for (int mt = 0; mt < 2; ++mt) { const int v0 = 32 * F.wave + 16 * mt + fq * 4;
                const v2u gg = ggv[nt][mt]; const f32x4 go = *(const GAS f32x4*)(a.in[I_BGO] + v0);
                const float g0 = bflo(gg.x), g1 = bfhi(gg.x), g2 = bflo(gg.y), g3 = bfhi(gg.y);
                const float o0 = acc[mt][nt][0] * rstd * go.x * (g0 * __builtin_amdgcn_rcpf(1.0f + __expf(-g0))), o1 = acc[mt][nt][1] * rstd * go.y * (g1 * __builtin_amdgcn_rcpf(1.0f + __expf(-g1)));
                const float o2 = acc[mt][nt][2] * rstd * go.z * (g2 * __builtin_amdgcn_rcpf(1.0f + __expf(-g2))), o3 = acc[mt][nt][3] * rstd * go.w * (g3 * __builtin_amdgcn_rcpf(1.0f + __expf(-g3)));
                v2u o; o.x = pk2(o0, o1); o.y = pk2(o2, o3);
                *(GAS v2u*)(G + row * D + h * 256 + v0) = o; } }
        LBAR();
        GST(65);
    }
}
#undef GST

__device__ __forceinline__ int na_koff(int key, int c16) { return key * 128 + ((c16 ^ ((key >> 1) & 7)) << 4); }
__device__ __forceinline__ int na_voff(int key, int c16) { return key * 128 + (((((c16 >> 1) ^ ((key >> 1) & 3)) << 1) | (c16 & 1)) << 4); }
__device__ __forceinline__ bf16x8 na_vfrag(const LAS unsigned char* V, int kb, int dt, int lane) {
    const int g = lane >> 4, w = lane & 15, q = w >> 2, p = w & 3; const int r0 = kb + 4 * g + q, r1 = r0 + 16;
    const s16x4 lo = __builtin_amdgcn_ds_read_tr16_b64_v4i16((LAS s16x4*)(V + r0 * 128 + ((dt ^ ((r0 >> 1) & 3)) << 5) + 8 * p));
    const s16x4 hi = __builtin_amdgcn_ds_read_tr16_b64_v4i16((LAS s16x4*)(V + r1 * 128 + ((dt ^ ((r1 >> 1) & 3)) << 5) + 8 * p));
    return (bf16x8){lo[0], lo[1], lo[2], lo[3], hi[0], hi[1], hi[2], hi[3]};
}
struct NaState { bf16x8 qf[2], qn[2]; f32x4 o[4]; float m_run, l_run; int cur_bh; };
__device__ __forceinline__ int na_r0(int r) { return r < 4 ? 0 : (r > 124 ? 120 : r - 4); }
__device__ __forceinline__ void na_load(Frame& F, int u_lo, int st, v4u (&kr)[3], v4u (&vr)[3]) {
    const bf16* QKV = (const bf16*)(F.ws + WS_BIG);
    const int u = u_lo + st / 3, pass = st % 3, bh = u >> 6, rp = u & 63, b = bh >> 4, h = bh & 15;
    const int rbase = na_r0(2 * rp) + 3 * pass;
#pragma unroll
    for (int i = 0; i < 3; ++i) { const int id = F.tid + 512 * i, key = id >> 3, c = id & 7; int row = rbase + (key >> 6); row = row > 127 ? 127 : row;
        const bf16* p = QKV + ((size_t)NCTX + (size_t)b * SEQ + (size_t)row * 64 + (key & 63)) * 3072 + 1024 + h * 64 + 8 * c; kr[i] = *(const GAS v4u*)p; vr[i] = *(const GAS v4u*)(p + 1024); }
}
__device__ __forceinline__ void na_loadq(Frame& F, int u, int fq, bf16x8 (&q)[2]) {
    const bf16* QKV = (const bf16*)(F.ws + WS_BIG);
    const int bh = u >> 6, rp = u & 63, b = bh >> 4, h = bh & 15, r = 2 * rp + (F.wave >> 2), qcol = 16 * (F.wave & 3) + (F.lane & 15);
#pragma unroll
    for (int ks = 0; ks < 2; ++ks) q[ks] = *(const GAS bf16x8*)(QKV + ((size_t)NCTX + (size_t)b * SEQ + (size_t)r * 64 + qcol) * 3072 + h * 64 + ks * 32 + fq * 8);
}
__device__ __forceinline__ void na_stage(Frame& F, const Args& a, const int u_lo, const int nstage, const int stage, v4u (&kr)[3], v4u (&vr)[3], NaState& S) {
    const bf16* QKV = (const bf16*)(F.ws + WS_BIG); bf16* G = (bf16*)(F.ws + WS_G);
    constexpr int QS = 3072;
    LAS unsigned char* KC = F.lds; LAS unsigned char* VC = F.lds + 32768; LAS unsigned char* KL = F.lds + 65536; LAS unsigned char* VL = F.lds + 65536 + 24576;
    LAS float* RPB = (LAS float*)(F.lds + 65536 + 49152);
    const int fr = F.lane & 15, fq = F.lane >> 4;
    const int qr = F.wave >> 2, jb = F.wave & 3;
    const int bstart = jb == 0 ? 0 : (jb == 1 ? 8 : (jb == 2 ? 24 : 32));
    const int qcol = 16 * jb + fr; const int cstart = qcol < 8 ? 0 : (qcol > 56 ? 48 : qcol - 8);
    const int u = u_lo + stage / 3, pass = stage % 3;
    const int bh = u >> 6, rp = u & 63, b = bh >> 4, h = bh & 15;
    const int r = 2 * rp + qr, r0q = na_r0(r), rbase = na_r0(2 * rp) + 3 * pass;
    const size_t lat0 = (size_t)NCTX + (size_t)b * SEQ;
    LBAR();
    if (bh != S.cur_bh) {
        S.cur_bh = bh;
        for (int i = F.tid; i < 465; i += NTHREADS) RPB[i] = a.in[I_CRPB][h * 465 + i] * 1.4426950408889634f;
#pragma unroll
        for (int i = 0; i < 4; ++i) { const int id = F.tid + 512 * i, key = id >> 3, c = id & 7;
            const bf16* p = QKV + (size_t)(b * CTXL + key) * QS + 1024 + h * 64 + 8 * c;
            *(LAS v4u*)(KC + na_koff(key, c)) = *(const GAS v4u*)p; *(LAS v4u*)(VC + na_voff(key, c)) = *(const GAS v4u*)(p + 1024); }
    }
#pragma unroll
    for (int i = 0; i < 3; ++i) { const int id = F.tid + 512 * i, key = id >> 3, c = id & 7;
        *(LAS v4u*)(KL + na_koff(key, c)) = kr[i]; *(LAS v4u*)(VL + na_voff(key, c)) = vr[i]; }
    if (pass == 0) {
        S.qf[0] = S.qn[0]; S.qf[1] = S.qn[1];
#pragma unroll
        for (int dt = 0; dt < 4; ++dt) S.o[dt] = (f32x4){0.f, 0.f, 0.f, 0.f};
        S.m_run = -__builtin_inff(); S.l_run = 0.f;
        if (stage + 3 < nstage) na_loadq(F, u + 1, fq, S.qn);
    }
    if (stage + 1 < nstage) na_load(F, u_lo, stage + 1, kr, vr);
    LBAR();
    f32x4 s[12];
#pragma unroll
    for (int t = 0; t < 6; ++t) { const int kidx = (t >> 1) * 64 + bstart + 16 * (t & 1) + fr;
        const bf16x8 k0 = *(const LAS bf16x8*)(KL + na_koff(kidx, fq)), k1 = *(const LAS bf16x8*)(KL + na_koff(kidx, 4 + fq));
        f32x4 tt = (f32x4){0.f, 0.f, 0.f, 0.f}; tt = MFMA16(k0, S.qf[0], tt); tt = MFMA16(k1, S.qf[1], tt); s[t] = tt; }
#pragma unroll
    for (int t = 0; t < 6; ++t) { const int kidx = (16 * (6 * pass + t) + fr) & 255;
        const bf16x8 k0 = *(const LAS bf16x8*)(KC + na_koff(kidx, fq)), k1 = *(const LAS bf16x8*)(KC + na_koff(kidx, 4 + fq));
        f32x4 tt = (f32x4){0.f, 0.f, 0.f, 0.f}; tt = MFMA16(k0, S.qf[0], tt); tt = MFMA16(k1, S.qf[1], tt); s[6 + t] = tt; }
    constexpr float SC2 = 0.125f * 1.4426950408889634f;
    float mx = S.m_run;
    {
        int cidx[8]; bool cok[8];
#pragma unroll
        for (int q = 0; q < 8; ++q) { const int kcol = bstart + 16 * (q >> 2) + fq * 4 + (q & 3); int ci = kcol - qcol + 15; ci = ci < 0 ? 0 : (ci > 30 ? 30 : ci); cidx[q] = ci; cok[q] = kcol >= cstart && kcol < cstart + 16; }
        float bias[24];
#pragma unroll
        for (int q = 0; q < 24; ++q) { const int t = q >> 2, j = q & 3; const int krow = rbase + (t >> 1); int ri = krow - r + 7; ri = ri < 0 ? 0 : (ri > 14 ? 14 : ri); bias[q] = RPB[ri * 31 + cidx[4 * (t & 1) + j]]; }
        asm volatile("" : "+v"(bias[0]), "+v"(bias[1]), "+v"(bias[2]), "+v"(bias[3]), "+v"(bias[4]), "+v"(bias[5]), "+v"(bias[6]), "+v"(bias[7]),
                          "+v"(bias[8]), "+v"(bias[9]), "+v"(bias[10]), "+v"(bias[11]), "+v"(bias[12]), "+v"(bias[13]), "+v"(bias[14]), "+v"(bias[15]));
        asm volatile("" : "+v"(bias[16]), "+v"(bias[17]), "+v"(bias[18]), "+v"(bias[19]), "+v"(bias[20]), "+v"(bias[21]), "+v"(bias[22]), "+v"(bias[23]));
#pragma unroll
        for (int q = 0; q < 24; ++q) { const int t = q >> 2, j = q & 3; const int krow = rbase + (t >> 1);
            const bool ok = cok[4 * (t & 1) + j] && krow >= r0q && krow <= r0q + 7;
            const float v = ok ? fmaf(s[t][j], SC2, bias[q]) : -__builtin_inff();
            s[t][j] = v; mx = fmaxf(mx, v); }
    }
#pragma unroll
    for (int t = 0; t < 6; ++t) { const bool ok = 6 * pass + t < 16;
#pragma unroll
        for (int j = 0; j < 4; ++j) { const float v = ok ? s[6 + t][j] * SC2 : -__builtin_inff(); s[6 + t][j] = v; mx = fmaxf(mx, v); } }
    mx = fmaxf(mx, __shfl_xor(mx, 16)); mx = fmaxf(mx, __shfl_xor(mx, 32));
    const float alpha = __builtin_amdgcn_exp2f(S.m_run - mx); S.m_run = mx;
    float l = 0.f;
#pragma unroll
    for (int t = 0; t < 12; ++t)
#pragma unroll
        for (int j = 0; j < 4; ++j) { const float p = __builtin_amdgcn_exp2f(s[t][j] - mx); s[t][j] = p; l += p; }
    S.l_run = S.l_run * alpha + l;
#pragma unroll
    for (int dt = 0; dt < 4; ++dt) S.o[dt] = S.o[dt] * alpha;
#pragma unroll
    for (int st = 0; st < 6; ++st) {
        v4u pw; pw.x = pk2(s[2 * st][0], s[2 * st][1]); pw.y = pk2(s[2 * st][2], s[2 * st][3]); pw.z = pk2(s[2 * st + 1][0], s[2 * st + 1][1]); pw.w = pk2(s[2 * st + 1][2], s[2 * st + 1][3]);
        const bf16x8 pf = __builtin_bit_cast(bf16x8, pw);
        const LAS unsigned char* VB = st < 3 ? VL : VC;
        const int kb = st < 3 ? st * 64 + bstart : (16 * (6 * pass + 2 * (st - 3))) & 255;
#pragma unroll
        for (int dt = 0; dt < 4; ++dt) S.o[dt] = MFMA16(na_vfrag(VB, kb, dt, F.lane), pf, S.o[dt]);
    }
    if (pass == 2) {
        float lt = S.l_run; lt += __shfl_xor(lt, 16); lt += __shfl_xor(lt, 32);
        const float inv = 1.0f / lt;
        bf16* op = G + (lat0 + (size_t)r * 64 + qcol) * D + h * 64 + fq * 4;
#pragma unroll
        for (int dt = 0; dt < 4; ++dt) { v2u w; w.x = pk2(S.o[dt][0] * inv, S.o[dt][1] * inv); w.y = pk2(S.o[dt][2] * inv, S.o[dt][3] * inv); *(GAS v2u*)(op + 16 * dt) = w; }
    }
}
__device__ __forceinline__ void p_natten(Frame& F, const Args& a) {
    const int u_lo = (int)(((long)F.vcu * 2048) / F.G), u_hi = (int)(((long)(F.vcu + 1) * 2048) / F.G);
    const int nstage = 3 * (u_hi - u_lo);
    if (nstage <= 0) return;
    const int fq = F.lane >> 4;
    v4u kA[3], vA[3];
    NaState S; S.cur_bh = -1; S.m_run = -__builtin_inff(); S.l_run = 0.f;
#pragma unroll
    for (int dt = 0; dt < 4; ++dt) S.o[dt] = (f32x4){0.f, 0.f, 0.f, 0.f};
    na_loadq(F, u_lo, fq, S.qn); S.qf[0] = S.qn[0]; S.qf[1] = S.qn[1];
    na_load(F, u_lo, 0, kA, vA);
    for (int stage = 0; stage < nstage; ++stage) na_stage(F, a, u_lo, nstage, stage, kA, vA, S);
}

template <int MODE>
__device__ __forceinline__ void sgemm_region(Frame& F, const bf16* A, const bf16* Bt, int R0, int nrb, int C0, int ncb, bf16* O, int ldo, float* X, const float* gate, int u_first, int u_stride) {
    constexpr int ST = 264;
    LAS bf16* As = (LAS bf16*)(F.lds); LAS bf16* Bs = As + 64 * ST;
    const int fr = F.lane & 15, fq = F.lane >> 4, mt = F.wave >> 1, nt0 = 2 * (F.wave & 1);
    const int nu = nrb * ncb;
    v4u ra[4], rbv[4];
#define SG_LOAD(u_, kc_) do { const int _r0 = R0 + 64 * ((u_) % nrb), _c0 = C0 + 64 * ((u_) / nrb); _Pragma("unroll") for (int i = 0; i < 4; ++i) { const int id = F.tid + 512 * i, row = id >> 5, c = id & 31; \
        ra[i] = *(const GAS v4u*)(A + (size_t)(_r0 + row) * 1024 + 256 * (kc_) + 8 * c); rbv[i] = *(const GAS v4u*)(Bt + (size_t)(_c0 + row) * 1024 + 256 * (kc_) + 8 * c); } } while (0)
    if (u_first < nu) SG_LOAD(u_first, 0);
    for (int u = u_first; u < nu; u += u_stride) {
        const int rb = u % nrb, cb = u / nrb; const int r0 = R0 + 64 * rb, c0 = C0 + 64 * cb;
        pg8::f32x4 acc[2] = {(pg8::f32x4){0.f, 0.f, 0.f, 0.f}, (pg8::f32x4){0.f, 0.f, 0.f, 0.f}};
        for (int kc = 0; kc < 4; ++kc) {
            LBAR();
#pragma unroll
            for (int i = 0; i < 4; ++i) { const int id = F.tid + 512 * i, row = id >> 5, c = id & 31;
                *(LAS v4u*)(As + row * ST + 8 * c) = ra[i]; *(LAS v4u*)(Bs + row * ST + 8 * c) = rbv[i]; }
            if (kc < 3) SG_LOAD(u, kc + 1); else if (u + u_stride < nu) SG_LOAD(u + u_stride, 0);
            LBAR();
#pragma unroll
            for (int ks = 0; ks < 8; ++ks) { const bf16x8 af = *(const LAS bf16x8*)(As + (16 * mt + fr) * ST + ks * 32 + fq * 8);
#pragma unroll
                for (int n = 0; n < 2; ++n) { const bf16x8 bfr = *(const LAS bf16x8*)(Bs + (16 * (nt0 + n) + fr) * ST + ks * 32 + fq * 8); acc[n] = MFMA16(bfr, af, acc[n]); } }
        }
        const size_t row = (size_t)(r0 + 16 * mt + fr);
#pragma unroll
        for (int n = 0; n < 2; ++n) { const int col = c0 + 16 * (nt0 + n) + 4 * fq;
            if (MODE == 2) { f32x4* p = (f32x4*)(X + row * 1024 + col); const f32x4 g = *(const f32x4*)(gate + col); *p = *p + g * acc[n]; }
            else { f32x4 v = acc[n];
                if (MODE == 1) { const pg8::f32x2 a2 = pg8::gelu_pk((pg8::f32x2){v[0], v[1]}), b2 = pg8::gelu_pk((pg8::f32x2){v[2], v[3]}); v = (f32x4){a2.x, a2.y, b2.x, b2.y}; }
                v2u o; o.x = pk2(v[0], v[1]); o.y = pk2(v[2], v[3]); *(GAS v2u*)(O + row * ldo + col) = o; } }
    }
#undef SG_LOAD
    __syncthreads();
}

__device__ __forceinline__ void ph_moe_gu(Frame& F, const Args& args, const int layer) {
    moe_tables(F, layer);
    const LAS int* Mt = (const LAS int*)(F.lds + MISC_OFF); const int total = Mt[32];
    pg8::Gemm g{(const bf16*)(F.ws + WS_H), (const bf16*)(F.ws + WS_WGU) + (size_t)layer * 32 * 2048 * 1024, total, 2048, D};
    pg8::GroupedOrder S; S.init(total, 2048, F.G, (int)blockIdx.x); S.tile_e = Mt + 64;
    pg8::EpiSwiglu E{(bf16*)(F.ws + WS_ACT), D, args.in[I_MBGU] + (size_t)layer * 32 * 2048, 2048};
    pg8::gemm_phase<pg8::EpiSwiglu, pg8::GroupedOrder, true>(F.lds + RING_OFF, g, S, E, (const unsigned*)(F.ws + WS_LIST), Mt, NTOK);
}
__device__ __forceinline__ void ph_moe_dn(Frame& F, const Args& args, const int layer) {
    moe_tables(F, layer);
    const LAS int* Mt = (const LAS int*)(F.lds + MISC_OFF); const int total = Mt[32];
    pg8::Gemm g{(const bf16*)(F.ws + WS_ACT), (const bf16*)(F.ws + WS_WDN) + (size_t)layer * 32 * 1024 * 1024, total, D, D};
    pg8::GroupedOrder S; S.init(total, D, F.G, (int)blockIdx.x); S.tile_e = Mt + 64;
    pg8::EpiBf16<0> E{(bf16*)(F.ws + WS_YB), D, args.in[I_MBDN] + (size_t)layer * 32 * 1024, 1024};
    pg8::gemm_phase<pg8::EpiBf16<0>, pg8::GroupedOrder>(F.lds + RING_OFF, g, S, E);
}
template <int LAYER> __device__ __forceinline__ void ph_ingemm(Frame& F) {
    constexpr int layer = LAYER, kind = layer % 3;
    const bf16* H = (const bf16*)(F.ws + WS_H);
    const bf16* A = H + (size_t)2 * 256 * D; constexpr int M = 64 * 256;
    if constexpr (kind == 0) {
        const bf16* Bt = (const bf16*)(F.ws + WS_WAIN) + (size_t)(layer / 3) * 2048 * 1024;
        pg8::Gemm g{A, Bt, M, 2048, D}; pg8::StaticOrder S; S.init(M, 2048, F.G, (int)blockIdx.x);
        pg8::EpiBf16<1> E{(bf16*)(F.ws + WS_BIG) + (size_t)2 * 256 * 2048, 2048, nullptr, 0};
        pg8::gemm_phase<pg8::EpiBf16<1>, pg8::StaticOrder>(F.lds + RING_OFF, g, S, E);
        if constexpr (layer < 3) sgemm_region<1>(F, H, Bt, 0, 8, 0, 32, (bf16*)(F.ws + WS_BIG), 2048, nullptr, nullptr, F.vcu, F.G);
    } else if constexpr (kind == 1) {
        const bf16* Bt = (const bf16*)(F.ws + WS_WBIN);
        pg8::Gemm g{A, Bt, M, 3072, D}; pg8::StaticOrder S; S.init(M, 3072, F.G, (int)blockIdx.x);
        pg8::EpiBf16<0> E{(bf16*)(F.ws + WS_BIG) + (size_t)2 * 256 * GLA_INP, GLA_INP, nullptr, 0};
        pg8::gemm_phase<pg8::EpiBf16<0>, pg8::StaticOrder>(F.lds + RING_OFF, g, S, E);
        sgemm_region<0>(F, H, Bt, 0, 8, 0, 48, (bf16*)(F.ws + WS_BIG), GLA_INP, nullptr, nullptr, F.vcu, F.G);
        sgemm_region<0>(F, H, Bt, 0, 264, 3072, 1, (bf16*)(F.ws + WS_BIG), GLA_INP, nullptr, nullptr, (F.vcu + 128) % F.G, F.G);
    } else {
        const bf16* Bt = (const bf16*)(F.ws + WS_WCQKV);
        pg8::Gemm g{A, Bt, M, 3072, D}; pg8::StaticOrder S; S.init(M, 3072, F.G, (int)blockIdx.x);
        pg8::EpiBf16<0> E{(bf16*)(F.ws + WS_BIG) + (size_t)2 * 256 * 3072, 3072, nullptr, 0};
        pg8::gemm_phase<pg8::EpiBf16<0>, pg8::StaticOrder>(F.lds + RING_OFF, g, S, E);
        sgemm_region<0>(F, H, Bt, 0, 8, 1024, 32, (bf16*)(F.ws + WS_BIG), 3072, nullptr, nullptr, F.vcu, F.G);
    }
}

constexpr int NCV_GLA = 120, NCV_NAT = 120;
constexpr int CONV_SPLIT = MOE_ITEMS + MOE_ITEMS * 3 / 2;
#define IN(k) (lo <= (k) && (k) < hi)
#define SEAM(k) do { unsigned long long _te = 0ull; if (PROBE_STAMP && blockIdx.x == 0 && threadIdx.x == 0) _te = wall_clock64(); \
    if (IN(k) && IN((k) + 1)) { xcd_barrier(bar); if (PROBE_BAR) xcd_barrier(bar); } else __syncthreads(); \
    if (PROBE_STAMP && blockIdx.x == 0 && threadIdx.x == 0) { const unsigned long long _tx = wall_clock64(); STAMPS(F)[k] = _tx - STAMPS(F)[96]; STAMPS(F)[48 + (k)] = _tx - _te; STAMPS(F)[96] = _tx; } } while (0)
template <int LAYER> __device__ __forceinline__ void run_layer(Frame& F, const Args& args, const XcdBarrier& bar, const int lo, const int hi) {
    {
        constexpr int layer = LAYER; constexpr int kind = layer % 3, base = 1 + 10 * layer;
        constexpr int mt0 = (layer >= 3) ? 2 : 0;
        constexpr int mo0 = (layer >= 2) ? 2 : 0;
        if (IN(base + 0)) { p_prenorm(F, args, layer, false);
#if PROBE_TOK
            __syncthreads(); p_prenorm(F, args, layer, false, true);
#endif
        } SEAM(base + 0);
        if (IN(base + 1)) { ph_ingemm<LAYER>(F);
#if PROBE_ING
            __syncthreads(); ph_ingemm<LAYER>(F);
#endif
        }
        SEAM(base + 1);
        if (IN(base + 2)) {
            if constexpr (kind == 0) p_spatial(F, args, layer); else if constexpr (kind == 1) p_gla_ds(F, args);
            else {
                const int ncv = F.G >= 2 * NCV_NAT ? NCV_NAT : 0, nm = F.G - ncv;
                if ((int)blockIdx.x < nm) { Frame Fm = mixer_frame(F, ncv); p_natten(Fm, args); }
                if (ncv == 0) { __syncthreads(); conv_moe_items(F, args, CONV_SPLIT, 4 * MOE_ITEMS, F.vcu * NWAVES + F.wave, F.G * NWAVES); }
                else if ((int)blockIdx.x >= nm) conv_moe_items(F, args, CONV_SPLIT, 4 * MOE_ITEMS, ((int)blockIdx.x - nm) * NWAVES + F.wave, ncv * NWAVES); }
        } SEAM(base + 2);
        if constexpr (kind == 1) { if (IN(base + 3)) for (int rep = 0; rep < 1 + PROBE_GLA; ++rep) { p_gla_scan(F); } SEAM(base + 3); }
        if constexpr (kind == 1) { if (IN(base + 4)) {
                const int ncv = F.G >= 2 * NCV_GLA ? NCV_GLA : 0, nm = F.G - ncv;
                if ((int)blockIdx.x < nm) { Frame Fm = mixer_frame(F, ncv); p_gla_out(Fm, args); }
                if (ncv == 0) { __syncthreads(); conv_moe_items(F, args, MOE_ITEMS, CONV_SPLIT, F.vcu * NWAVES + F.wave, F.G * NWAVES); }
                else if ((int)blockIdx.x >= nm) conv_moe_items(F, args, MOE_ITEMS, CONV_SPLIT, ((int)blockIdx.x - nm) * NWAVES + F.wave, ncv * NWAVES); }
            SEAM(base + 4); }
        if (IN(base + 5)) {
            constexpr int M = 64 * 256;
            const bf16* Bt = (const bf16*)(F.ws + (kind == 0 ? WS_WAOUT : (kind == 1 ? WS_WBOUT : WS_WCOUT))) + (kind == 0 ? (size_t)(layer / 3) * 1024 * 1024 : 0);
            pg8::Gemm g{(const bf16*)(F.ws + WS_G) + (size_t)2 * 256 * D, Bt, M, D, D}; pg8::StaticOrder S; S.init(M, D, F.G, (int)blockIdx.x);
            pg8::EpiBf16<0> E{(bf16*)(F.ws + WS_YM) + (size_t)2 * 256 * D, D, nullptr, 0};
            pg8::gemm_phase<pg8::EpiBf16<0>, pg8::StaticOrder>(F.lds + RING_OFF, g, S, E);
            if constexpr (layer < 2) sgemm_region<0>(F, (const bf16*)(F.ws + WS_G), Bt, 0, 8, 0, 16, (bf16*)(F.ws + WS_YM), D, nullptr, nullptr, F.vcu, F.G);
        }
        SEAM(base + 5);
        if (IN(base + 6)) { p_router(F, args, layer);
#if PROBE_TOK
            __syncthreads(); p_router(F, args, layer, true);
#endif
        } SEAM(base + 6);
        if (IN(base + 8)) { ph_moe_gu(F, args, layer);
#if PROBE_MOE
            __syncthreads(); ph_moe_gu(F, args, layer);
#endif
        }
        SEAM(base + 8);
        if (IN(base + 9)) { ph_moe_dn(F, args, layer);
#if PROBE_MOE
            __syncthreads(); ph_moe_dn(F, args, layer);
#endif
        }
        SEAM(base + 9);
    }
}

__global__ void __launch_bounds__(NTHREADS, 2) fwd(Args args) {
    extern __shared__ __attribute__((aligned(16))) unsigned char lds[];
    Frame F;
    F.lds = (LAS unsigned char*)lds;
    F.tid = threadIdx.x; F.lane = F.tid & 63; F.wave = __builtin_amdgcn_readfirstlane(F.tid >> 6);
    F.G = gridDim.x; { const int bx = blockIdx.x; F.vcu = (F.G % 8 == 0) ? (bx % 8) * (F.G / 8) + bx / 8 : bx; }
    F.ws = args.ws; F.ctl = (unsigned*)(args.ws + WS_CTL);
    volatile LAS unsigned* BST = (volatile LAS unsigned*)(F.lds + LDS_BYTES - 16);
    if (F.tid < 4) BST[F.tid] = 0u;
    __syncthreads();
    const int lo = args.ph_lo, hi = args.ph_hi;
    XcdBarrier bar; bar.bar = (unsigned*)(F.ctl + CW_BAR); bar.x = 0; bar.st = BST;
    if (hi - lo > 1) bar = xcd_barrier_post((unsigned*)(F.ctl + CW_BAR), BST);
    if (PROBE_STAMP && blockIdx.x == 0 && F.tid == 0) { for (int i = 0; i < 128; ++i) STAMPS(F)[i] = 0ull; STAMPS(F)[96] = wall_clock64(); }
    if (IN(0)) { p_prologue(F, args);
#if PROBE_PRO
        __syncthreads(); p_prologue(F, args);
#endif
    } SEAM(0);

    run_layer<0>(F, args, bar, lo, hi);
    run_layer<1>(F, args, bar, lo, hi);
    run_layer<2>(F, args, bar, lo, hi);
    run_layer<3>(F, args, bar, lo, hi);
    if (IN(41)) { p_prenorm(F, args, 4, true); }
    if (PROBE_STAMP && blockIdx.x == 0) { __syncthreads(); if (F.tid == 0) {
        const unsigned long long tnow = wall_clock64(); STAMPS(F)[41] = tnow - STAMPS(F)[96];
        unsigned long long sum = 0ull;
        for (int k = 0; k < 42; ++k) { const int loc = k >= 1 && k <= 40 ? (k - 1) % 10 : -1; bool sel = false;
            if (PROBE_STAMP == 1) sel = k == 0;
            if (PROBE_STAMP == 2) sel = loc == 1 || loc == 5;
            if (PROBE_STAMP == 3) sel = loc == 8 || loc == 9;
            if (PROBE_STAMP == 4) sel = loc == 2 || loc == 3 || loc == 4;
            if (PROBE_STAMP == 6) sel = loc == 0 || loc == 6 || k == 41;
            if (PROBE_STAMP == 7) sel = loc == 2 && (k - 1) / 10 == 1;
            if (PROBE_STAMP == 8) sel = loc == 3;
            if (PROBE_STAMP == 9) sel = loc == 4;
            if (PROBE_STAMP == 10) sel = loc == 2 && (k - 1) / 10 == 2;
            if (PROBE_STAMP == 11) sel = loc == 6;
            if (PROBE_STAMP == 12) sel = loc == 8;
            if (PROBE_STAMP == 13) sel = loc == 9;
            if (PROBE_STAMP == 14) sel = loc == 5;
            if (sel) sum += STAMPS(F)[k];
            if (PROBE_STAMP == 5) sum += STAMPS(F)[48 + k];
            if (PROBE_STAMP == 15 && (loc == 8 || loc == 9)) sum += STAMPS(F)[48 + k];
            if (PROBE_STAMP == 16 && (loc == 1 || loc == 5)) sum += STAMPS(F)[48 + k];
            if (PROBE_STAMP == 17 && (loc == 0 || loc == 6)) sum += STAMPS(F)[48 + k];
            if (PROBE_STAMP == 18 && (loc == 2 || loc == 3 || loc == 4)) sum += STAMPS(F)[48 + k];
            if (PROBE_STAMP == 19 && k == 0) sum += STAMPS(F)[48 + k]; }
        if (PROBE_STAMP >= 20 && PROBE_STAMP <= 25) sum = STAMPS(F)[100 + PROBE_STAMP - 20];
        const unsigned long long t0 = wall_clock64();
        while (wall_clock64() - t0 < 4ull * sum) __builtin_amdgcn_s_sleep(8);
    } }
#undef IN
#undef SEAM
}

extern "C" void kernel_launch(void* const* d_in, const int* in_sizes, int n_in, void* d_out, int out_size, void* d_ws, size_t ws_size, hipStream_t stream) {
    static int grid = 0;
    if (grid == 0) {
        if (n_in != 28 || out_size != NLAT * D || ws_size < WS_END) { fprintf(stderr, "kernel_launch: unexpected problem (n_in %d, out %d, ws %zu < %zu)\n", n_in, out_size, ws_size, (size_t)WS_END); grid = -1; return; }
        int dev = 0, cus = 0, per_cu = 0;
        if (hipGetDevice(&dev) != hipSuccess || hipDeviceGetAttribute(&cus, hipDeviceAttributeMultiprocessorCount, dev) != hipSuccess) { grid = -1; return; }
        if (hipFuncSetAttribute((const void*)fwd, hipFuncAttributeMaxDynamicSharedMemorySize, LDS_BYTES) != hipSuccess) { fprintf(stderr, "kernel_launch: hipFuncSetAttribute failed\n"); grid = -1; return; }
        if (hipOccupancyMaxActiveBlocksPerMultiprocessor(&per_cu, (const void*)fwd, NTHREADS, LDS_BYTES) != hipSuccess || per_cu < 1) { fprintf(stderr, "kernel_launch: occupancy query reports %d\n", per_cu); }
        (void)hipGetLastError();
        grid = cus;
    }
    if (grid < 0) return;
    (void)hipMemsetAsync((char*)d_ws + WS_CTL, 0, CTL_ZERO_BYTES, stream);
    Args a{};
    for (int i = 0; i < 28; ++i) a.in[i] = (const float*)d_in[i];
    a.out = (float*)d_out; a.ws = (unsigned char*)d_ws;
#if MK_ONE_LAUNCH
    a.ph_lo = 0; a.ph_hi = 42;
    hipLaunchKernelGGL(fwd, dim3(grid), dim3(NTHREADS), LDS_BYTES, stream, a);
#else
    for (int p = 0; p < 42; ++p) {
        if (p >= 1 && p <= 40) { const int layer = (p - 1) / 10, loc = (p - 1) % 10; if (((loc == 3 || loc == 4) && (layer % 3) != 1) || loc == 7) continue; }
        a.ph_lo = p; a.ph_hi = p + 1;
        hipLaunchKernelGGL(fwd, dim3(grid), dim3(NTHREADS), LDS_BYTES, stream, a);
    }
#endif
}
```

```cpp
#include <hip/hip_runtime.h>
#include <cstdio>
#include <cstdint>

#ifndef MK_ONE_LAUNCH
#define MK_ONE_LAUNCH 1
#endif
#ifndef PROBE_PRO
#define PROBE_PRO 0
#endif
#ifndef PROBE_MOE
#define PROBE_MOE 0
#endif
#ifndef PROBE_ING
#define PROBE_ING 0
#endif
#ifndef PROBE_MIX
#define PROBE_MIX 0
#endif
#ifndef PROBE_GLA
#define PROBE_GLA 0
#endif
#ifndef PROBE_TOK
#define PROBE_TOK 0
#endif
#ifndef PROBE_BAR
#define PROBE_BAR 0
#endif
#ifndef PROBE_OUTG
#define PROBE_OUTG 0
#endif
#ifndef PROBE_STAMP
#define PROBE_STAMP 0
#endif
#ifndef PROBE_NAT
#define PROBE_NAT 0
#endif
#ifndef PROBE_GATHER
#define PROBE_GATHER 0
#endif

namespace pg8 {
#define PG8_LAS __attribute__((address_space(3)))
typedef unsigned short bf16_t;
typedef short bf16x8 __attribute__((ext_vector_type(8)));
typedef float f32x4 __attribute__((ext_vector_type(4)));
typedef unsigned u32x4 __attribute__((ext_vector_type(4)));
constexpr int BM = 256, BK = 64, HALF = 128, HTB = HALF * BK * 2, STAGE_BYTES = 8 * HTB, NXCD = 8, WGM = 8;

__host__ __device__ __forceinline__ int lds_byte(int r, int c) { const int st = (r >> 4) * 2 + (c >> 5), rr = r & 15, cc = c & 31, ob = rr * 64 + cc * 2; return st * 1024 + (ob ^ (((ob >> 9) & 1) << 5)); }
__host__ __device__ __forceinline__ void stage_rc(int b, int& R, int& C) { const int st = b / 1024, sb = b % 1024, swz = sb ^ (((sb >> 9) & 1) << 5); R = (st >> 1) * 16 + swz / 64; C = (st & 1) * 32 + (swz % 64) / 2; }
__host__ __device__ __forceinline__ int perm32(int rho) { const int n = rho >> 4, i = rho & 15; return 8 * (i >> 2) + 4 * n + (i & 3); }

struct Unit { int pm, pn, pb, e; };
struct Gemm { const bf16_t* A; const bf16_t* Bt; int M, N, K; };

struct StaticOrder {
    int nM, nN, nwg, G, c;
    __device__ void init(int M, int N, int G_, int c_) { nM = M / BM; nN = N / BM; nwg = nM * nN; G = G_; c = c_; }
    __device__ bool next(int i, Unit& u) const {
        const long L = (long)i * G + c; if (L >= nwg) return false;
        int wgid = (int)L; { const int q = nwg / NXCD, r = nwg % NXCD, xcd = wgid % NXCD, off = wgid / NXCD; wgid = (xcd < r ? xcd * (q + 1) : r * (q + 1) + (xcd - r) * q) + off; }
        const int nig = WGM * nN, gid = wgid / nig, fm = gid * WGM, gsz = (nM - fm) < WGM ? (nM - fm) : WGM;
        u.pm = fm + ((wgid % nig) % gsz); u.pn = (wgid % nig) / gsz; u.pb = u.pn; u.e = 0; return true;
    }
};
struct GroupedOrder : StaticOrder {
    const PG8_LAS int* tile_e;
    __device__ bool next(int i, Unit& u) const {
        if (!StaticOrder::next(i, u)) return false;
        u.e = __builtin_amdgcn_readfirstlane(tile_e[u.pm]); u.pb = u.e * nN + u.pn; return true;
    }
};

__device__ __forceinline__ unsigned cvt_pk_bf16(float lo, float hi) { unsigned r; asm volatile("v_cvt_pk_bf16_f32 %0, %1, %2" : "=v"(r) : "v"(lo), "v"(hi)); return r; }
typedef float f32x2 __attribute__((ext_vector_type(2)));
__device__ __forceinline__ f32x2 gelu_pk(f32x2 v) {
    const f32x2 av = __builtin_elementwise_abs(v), d = av * 0.2316418882f + 1.0f;
    f32x2 t; t.x = __builtin_amdgcn_rcpf(d.x); t.y = __builtin_amdgcn_rcpf(d.y);
    f32x2 q = t * 0.5307027145f + (-0.7265760135f); q = q * t + 0.7107068705f; q = q * t + (-0.142248368f); q = q * t + 0.127414796f; q = q * t;
    const f32x2 s = (v * v) * (-0.72134752044f);
    f32x2 e; e.x = __builtin_amdgcn_exp2f(s.x); e.y = __builtin_amdgcn_exp2f(s.y);
    const f32x2 m = v * (q * e), r = v - m;
    f32x2 o; o.x = v.x < 0.f ? m.x : r.x; o.y = v.y < 0.f ? m.y : r.y; return o;
}

template <int ACT> struct EpiBf16 {
    static constexpr bool PERM = true;
    bf16_t* O; int ldc; const float* bias; int bias_estride;
    __device__ __forceinline__ void operator()(const f32x4 (&acc)[2][2][4][2], const Unit& u, int wr, int wc, int fr, int fq) const {
        const int row0 = u.pm * BM + wr * 64 + fr; const int col0 = u.pn * BM + wc * 32 + 8 * fq;
        const float* bp = bias ? bias + (size_t)u.e * bias_estride : nullptr;
        f32x4 bv[2][2];
#pragma unroll
        for (int bj = 0; bj < 2; ++bj)
#pragma unroll
            for (int n = 0; n < 2; ++n) bv[bj][n] = bp ? *(const f32x4*)(bp + col0 + bj * HALF + 4 * n) : (f32x4){0.f, 0.f, 0.f, 0.f};
#pragma unroll
        for (int ai = 0; ai < 2; ++ai)
#pragma unroll
            for (int m = 0; m < 4; ++m) { bf16_t* rowp = O + (size_t)(row0 + ai * HALF + m * 16) * ldc + col0;
#pragma unroll
                for (int bj = 0; bj < 2; ++bj) { f32x4 v0 = acc[ai][bj][m][0] + bv[bj][0], v1 = acc[ai][bj][m][1] + bv[bj][1];
                    if (ACT == 1) { f32x2 a = gelu_pk((f32x2){v0[0], v0[1]}), b = gelu_pk((f32x2){v0[2], v0[3]}), c = gelu_pk((f32x2){v1[0], v1[1]}), d = gelu_pk((f32x2){v1[2], v1[3]});
                        v0 = (f32x4){a.x, a.y, b.x, b.y}; v1 = (f32x4){c.x, c.y, d.x, d.y}; }
                    u32x4 w; w.x = cvt_pk_bf16(v0[0], v0[1]); w.y = cvt_pk_bf16(v0[2], v0[3]); w.z = cvt_pk_bf16(v1[0], v1[1]); w.w = cvt_pk_bf16(v1[2], v1[3]);
                    *(u32x4*)(rowp + bj * HALF) = w; } }
    }
};
struct EpiSwiglu {
    static constexpr bool PERM = true;
    bf16_t* O; int ldc; const float* bias; int bias_estride;
    __device__ __forceinline__ void operator()(const f32x4 (&acc)[2][2][4][2], const Unit& u, int wr, int wc, int fr, int fq) const {
        const int row0 = u.pm * BM + wr * 64 + fr; const int col0 = u.pn * HALF + wc * 32 + 8 * fq;
        const float* bp = bias + (size_t)u.e * bias_estride;
        f32x4 bg[2], bl[2];
#pragma unroll
        for (int n = 0; n < 2; ++n) { bg[n] = *(const f32x4*)(bp + col0 + 4 * n); bl[n] = *(const f32x4*)(bp + 1024 + col0 + 4 * n); }
#pragma unroll
        for (int ai = 0; ai < 2; ++ai)
#pragma unroll
            for (int m = 0; m < 4; ++m) { bf16_t* rowp = O + (size_t)(row0 + ai * HALF + m * 16) * ldc + col0;
                f32x2 o[4];
#pragma unroll
                for (int n = 0; n < 2; ++n)
#pragma unroll
                    for (int h = 0; h < 2; ++h) {
                        f32x2 g = (f32x2){acc[ai][0][m][n][2 * h], acc[ai][0][m][n][2 * h + 1]} + (f32x2){bg[n][2 * h], bg[n][2 * h + 1]};
                        f32x2 l = (f32x2){acc[ai][1][m][n][2 * h], acc[ai][1][m][n][2 * h + 1]} + (f32x2){bl[n][2 * h], bl[n][2 * h + 1]};
                        g.x = fminf(g.x, 7.0f); g.y = fminf(g.y, 7.0f); l.x = fminf(fmaxf(l.x, -7.0f), 7.0f); l.y = fminf(fmaxf(l.y, -7.0f), 7.0f);
                        const f32x2 t = g * (-1.702f * 1.44269504089f);
                        f32x2 d; d.x = __builtin_amdgcn_exp2f(t.x); d.y = __builtin_amdgcn_exp2f(t.y); d = d + 1.0f;
                        f32x2 r; r.x = __builtin_amdgcn_rcpf(d.x); r.y = __builtin_amdgcn_rcpf(d.y);
                        const f32x2 gs = g * r;
                        o[2 * n + h] = gs * l + gs; }
                u32x4 w; w.x = cvt_pk_bf16(o[0].x, o[0].y); w.y = cvt_pk_bf16(o[1].x, o[1].y); w.z = cvt_pk_bf16(o[2].x, o[2].y); w.w = cvt_pk_bf16(o[3].x, o[3].y);
                *(u32x4*)rowp = w; }
    }
};
struct EpiResid {
    static constexpr bool PERM = false;
    float* X; const float* gate; int gstride; int pm0; bool dry;
    __device__ __forceinline__ void operator()(const f32x4 (&acc)[2][2][4][2], const Unit& u, int wr, int wc, int fr, int fq) const {
        const int t = u.pm + pm0; const int seg = t < 2 ? 0 : (t < 34 ? 1 : 2);
        const int row0 = u.pm * BM + wr * 64 + fr, col0 = u.pn * BM + wc * 32 + 4 * fq;
        const float* gp = gate + (size_t)seg * gstride;
        f32x4 gv[2][2];
#pragma unroll
        for (int bj = 0; bj < 2; ++bj)
#pragma unroll
            for (int n = 0; n < 2; ++n) gv[bj][n] = *(const f32x4*)(gp + col0 + bj * HALF + n * 16);
#pragma unroll
        for (int ai = 0; ai < 2; ++ai)
#pragma unroll
            for (int m = 0; m < 4; ++m) { float* rowp = X + (size_t)(row0 + ai * HALF + m * 16) * 1024 + col0;
#pragma unroll
                for (int bj = 0; bj < 2; ++bj)
#pragma unroll
                    for (int n = 0; n < 2; ++n) { f32x4* p = (f32x4*)(rowp + bj * HALF + n * 16); const f32x4 nv = *p + gv[bj][n] * acc[ai][bj][m][n]; if (!dry) *p = nv; else if (nv[0] == 1.2345e30f) *p = nv; } }
    }
};

template <class Epi, class Sched, bool GATHER = false>
__device__ __forceinline__ void gemm_phase(PG8_LAS unsigned char* lds, const Gemm g, const Sched& S, const Epi& E, const unsigned* glist = nullptr, const PG8_LAS int* gM = nullptr, int gstride = 0) {
    const int tid = threadIdx.x, wid = __builtin_amdgcn_readfirstlane(tid >> 6), lane = tid & 63, wr = wid >> 2, wc = wid & 3, fr = lane & 15, fq = lane >> 4;
    const int K = g.K, nt = K / BK;
    unsigned voffB[2], va[2][2], vn[2][2]; int aR[2], aC[2];
#pragma unroll
    for (int i = 0; i < 2; ++i) { int R, C; stage_rc(tid * 16 + i * 8192, R, C); const int Rb = Epi::PERM ? ((R & ~31) + perm32(R & 31)) : R;
        aR[i] = R; aC[i] = C; voffB[i] = (unsigned)(Rb * K + C) * 2u;
#pragma unroll
        for (int h = 0; h < 2; ++h) { va[h][i] = (unsigned)((HALF * h + R) * K + C) * 2u; vn[h][i] = va[h][i]; } }
#define PG8_GOFF(u, dst) do { if constexpr (GATHER) { const int _e = (u).e, _p0 = (u).pm * BM - gM[_e], _c1 = gM[400 + _e] - 1; _Pragma("unroll") for (int _h = 0; _h < 2; ++_h) _Pragma("unroll") for (int _i = 0; _i < 2; ++_i) { \
        int _rk = _p0 + HALF * _h + aR[_i]; _rk = _rk < _c1 ? _rk : _c1; const unsigned _tok = glist[(size_t)_e * gstride + _rk]; dst[_h][_i] = (_tok * (unsigned)K + (unsigned)aC[_i]) * 2u; } } } while (0)
#define PG8_GTOK(u, dst) do { const int _e = (u).e, _p0 = (u).pm * BM - gM[_e], _c1 = gM[400 + _e] - 1; _Pragma("unroll") for (int _h = 0; _h < 2; ++_h) _Pragma("unroll") for (int _i = 0; _i < 2; ++_i) { \
        int _rk = _p0 + HALF * _h + aR[_i]; _rk = _rk < _c1 ? _rk : _c1; dst[_h][_i] = glist[(size_t)_e * gstride + _rk]; } } while (0)
    const size_t kstep = (size_t)(BK * 2);
    const size_t hstep = (size_t)HALF * K * 2;
    const size_t tstep = 2 * hstep;
    const unsigned ldsw = (unsigned)wid * 1024u;
    const int aoff = lds_byte(wr * 64 + fr, fq * 8), boff = lds_byte(wc * 32 + fr, fq * 8);
#define PG8_SA(b, h) (((b) * 2 + (h)) * HTB)
#define PG8_SB(b, h) ((4 + (b) * 2 + (h)) * HTB)
#define PG8_STAGE(bufoff, gbase, voff) do { _Pragma("unroll") for (int _i = 0; _i < 2; ++_i) \
        __builtin_amdgcn_global_load_lds((const unsigned*)((const char*)(gbase) + (voff)[_i]), (PG8_LAS unsigned*)(lds + (bufoff) + ldsw + _i * 8192), 16, 0, 0); } while (0)
#define PG8_LDA(dst, b, h) do { _Pragma("unroll") for (int m = 0; m < 4; ++m) _Pragma("unroll") for (int k = 0; k < 2; ++k) dst[m][k] = *(const PG8_LAS bf16x8*)(lds + PG8_SA(b, h) + aoff + m * 2048 + k * 1024); } while (0)
#define PG8_LDB(dst, b, h) do { _Pragma("unroll") for (int n = 0; n < 2; ++n) _Pragma("unroll") for (int k = 0; k < 2; ++k) dst[n][k] = *(const PG8_LAS bf16x8*)(lds + PG8_SB(b, h) + boff + n * 2048 + k * 1024); } while (0)
#define PG8_MMA(ai, bj, At, Bt) do { __builtin_amdgcn_s_setprio(1); _Pragma("unroll") for (int m = 0; m < 4; ++m) _Pragma("unroll") for (int n = 0; n < 2; ++n) _Pragma("unroll") for (int k = 0; k < 2; ++k) \
        acc[ai][bj][m][n] = __builtin_amdgcn_mfma_f32_16x16x32_bf16(Bt[n][k], At[m][k], acc[ai][bj][m][n], 0, 0, 0); __builtin_amdgcn_s_setprio(0); } while (0)
#define PG8_WAIT_V(n) asm volatile("s_waitcnt vmcnt(" #n ")" ::: "memory")
#define PG8_WAIT_L(n) asm volatile("s_waitcnt lgkmcnt(" #n ")" ::: "memory")
#define PG8_BAR __builtin_amdgcn_s_barrier()
#define PG8_SCHED __builtin_amdgcn_sched_barrier(0)
    Unit cur, nxt, nx2; int ui = 0; bool has_next = false, has_nx2 = false;
    if (!S.next(0, cur)) return;
    f32x4 acc[2][2][4][2];
#pragma unroll
    for (int a = 0; a < 2; ++a)
#pragma unroll
        for (int b = 0; b < 2; ++b)
#pragma unroll
            for (int m = 0; m < 4; ++m)
#pragma unroll
                for (int n = 0; n < 2; ++n) acc[a][b][m][n] = (f32x4){0.f, 0.f, 0.f, 0.f};
    bf16x8 At[4][2], B0[2][2], B1[2][2];
    const char* cA = (const char*)g.A + (GATHER ? (size_t)0 : (size_t)cur.pm * tstep); const char* cB = (const char*)g.Bt + (size_t)cur.pb * tstep;
    PG8_GOFF(cur, va);
    if constexpr (GATHER) { has_next = S.next(1, nxt); if (has_next) PG8_GOFF(nxt, vn); }
    PG8_STAGE(PG8_SB(0, 0), cB, voffB); PG8_STAGE(PG8_SB(0, 1), cB + hstep, voffB); PG8_STAGE(PG8_SA(0, 0), cA, va[0]); PG8_STAGE(PG8_SA(0, 1), cA, va[1]);
    if (wr == 1) PG8_BAR;
    PG8_WAIT_V(2); PG8_BAR;
    PG8_STAGE(PG8_SB(1, 0), cB + kstep, voffB); PG8_STAGE(PG8_SA(1, 0), cA + kstep, va[0]); PG8_STAGE(PG8_SB(1, 1), cB + hstep + kstep, voffB);
    PG8_WAIT_V(6); PG8_BAR;
    for (;;) {
        if constexpr (!GATHER) has_next = S.next(ui + 1, nxt);
        const char* nA = (has_next && !GATHER) ? (const char*)g.A + (size_t)nxt.pm * tstep : cA; const char* nB = has_next ? (const char*)g.Bt + (size_t)nxt.pb * tstep : cB;
        for (int t = 0; t < nt; t += 2) {
            const bool last = (t == nt - 2);
            const char* a1 = cA + (size_t)(t + 1) * kstep;
            const char* a2 = last ? nA : cA + (size_t)(t + 2) * kstep; const char* b2 = last ? nB : cB + (size_t)(t + 2) * kstep;
            const char* a3 = a2 + kstep; const char* b3 = b2 + kstep;
            unsigned v2[2][2];
#pragma unroll
            for (int _h = 0; _h < 2; ++_h)
#pragma unroll
                for (int _i = 0; _i < 2; ++_i) v2[_h][_i] = (GATHER && last) ? vn[_h][_i] : va[_h][_i];
            PG8_LDB(B0, 0, 0); PG8_LDB(B1, 0, 1); PG8_SCHED; PG8_LDA(At, 0, 0); PG8_STAGE(PG8_SA(1, 1), a1, va[1]);
            PG8_WAIT_V(8); PG8_WAIT_L(0); PG8_BAR; PG8_MMA(0, 0, At, B0); PG8_MMA(0, 1, At, B1); PG8_BAR; PG8_SCHED;
            PG8_LDA(At, 0, 1); PG8_STAGE(PG8_SB(0, 0), b2, voffB); PG8_STAGE(PG8_SB(0, 1), b2 + hstep, voffB); PG8_STAGE(PG8_SA(0, 0), a2, v2[0]);
            PG8_WAIT_V(8); PG8_WAIT_L(0); PG8_BAR; PG8_MMA(1, 0, At, B0); PG8_MMA(1, 1, At, B1); PG8_BAR; PG8_SCHED;
            PG8_LDB(B0, 1, 0); PG8_LDB(B1, 1, 1); PG8_SCHED; PG8_LDA(At, 1, 0); PG8_STAGE(PG8_SA(0, 1), a2, v2[1]);
            PG8_WAIT_V(8); PG8_WAIT_L(0); PG8_BAR; PG8_MMA(0, 0, At, B0); PG8_MMA(0, 1, At, B1); PG8_BAR; PG8_SCHED;
            PG8_LDA(At, 1, 1); PG8_STAGE(PG8_SB(1, 0), b3, voffB); PG8_STAGE(PG8_SB(1, 1), b3 + hstep, voffB); PG8_STAGE(PG8_SA(1, 0), a3, v2[0]);
            PG8_WAIT_V(8); PG8_WAIT_L(0); PG8_BAR; PG8_MMA(1, 0, At, B0); PG8_MMA(1, 1, At, B1); PG8_BAR; PG8_SCHED;
        }
        if (wr == 0) PG8_BAR;
        unsigned tk[2][2] = {{0u, 0u}, {0u, 0u}};
        if constexpr (GATHER) { has_nx2 = has_next && S.next(ui + 2, nx2); if (!has_nx2) nx2 = cur; PG8_GTOK(nx2, tk); }
        E(acc, cur, wr, wc, fr, fq);
        if (!has_next) break;
#pragma unroll
        for (int a = 0; a < 2; ++a)
#pragma unroll
            for (int b = 0; b < 2; ++b)
#pragma unroll
                for (int m = 0; m < 4; ++m)
#pragma unroll
                    for (int n = 0; n < 2; ++n) acc[a][b][m][n] = (f32x4){0.f, 0.f, 0.f, 0.f};
        cur = nxt; cA = nA; cB = nB; ++ui;
        if constexpr (GATHER) { va[0][0] = vn[0][0]; va[0][1] = vn[0][1]; va[1][0] = vn[1][0]; va[1][1] = vn[1][1];
            if (has_nx2) { nxt = nx2;
#pragma unroll
                for (int _h = 0; _h < 2; ++_h)
#pragma unroll
                    for (int _i = 0; _i < 2; ++_i) vn[_h][_i] = (tk[_h][_i] * (unsigned)K + (unsigned)aC[_i]) * 2u; }
            has_next = has_nx2; }
        if (wr == 1) PG8_BAR;
    }
    PG8_WAIT_V(0);
    PG8_BAR;
#undef PG8_SA
#undef PG8_SB
#undef PG8_STAGE
#undef PG8_GOFF
#undef PG8_GTOK
#undef PG8_LDA
#undef PG8_LDB
#undef PG8_MMA
#undef PG8_WAIT_V
#undef PG8_WAIT_L
#undef PG8_BAR
#undef PG8_SCHED
}
}

constexpr int NWAVES = 8, NTHREADS = 512;
constexpr int D = 1024, NCTX = 512, NLAT = 16384, NTOK = NCTX + NLAT, SEQ = 8192, CTXL = 256;
constexpr int NEXP = 32, MAXPADROWS = 75776, MAXPADTILES = 296;
constexpr int GLA_IN = 3104, GLA_INP = 3328;
constexpr float EPS = 1e-6f;

constexpr size_t MiB = 1u << 20;
constexpr size_t WS_CTL = 0, CTL_ZERO_BYTES = 65536;
constexpr size_t WS_ADA = 1 * MiB;
constexpr size_t WS_ROPE = 1 * MiB + 512 * 1024;
constexpr size_t WS_TOKI = 2 * MiB;
constexpr size_t WS_TOKG = 2 * MiB + 512 * 1024;
constexpr size_t WS_LIST = 3 * MiB;
constexpr size_t WS_WRH = 6 * MiB, WS_WRL = 6 * MiB + 256 * 1024;
constexpr size_t WS_WSB = 7 * MiB;
constexpr size_t WS_WAIN = 8 * MiB;
constexpr size_t WS_WAOUT = 16 * MiB;
constexpr size_t WS_WBIN = 20 * MiB;
constexpr size_t WS_WBOUT = 27 * MiB;
constexpr size_t WS_WCQKV = 29 * MiB;
constexpr size_t WS_WCOUT = 35 * MiB;
constexpr size_t WS_WGU = 64 * MiB;
constexpr size_t WS_WDN = 576 * MiB;
constexpr size_t WS_X = 832 * MiB;
constexpr size_t WS_H = 898 * MiB;
constexpr size_t WS_G = 931 * MiB;
constexpr size_t WS_BIG = 964 * MiB;
constexpr size_t WS_DS = 1072 * MiB;
constexpr size_t WS_SIN = 1204 * MiB;
constexpr size_t WS_DEC = 1336 * MiB;
constexpr size_t WS_AS = 1338 * MiB;
constexpr size_t WS_YM = 1338 * MiB;
constexpr size_t WS_ACT = 1486 * MiB;
constexpr size_t WS_YB = 1634 * MiB;
constexpr size_t WS_END = 1782 * MiB;
constexpr int CW_TMO = 0;
constexpr int CW_BAR = 4096;
constexpr int CW_CNT = 8192;
static_assert((CW_CNT + 128 * 64) * 4 <= 65536 && (CW_BAR + 3456) <= CW_CNT, "control words inside the per-call memset");

constexpr int RING_OFF = 0, RING_BYTES = 131072;
constexpr int MISC_OFF = RING_BYTES;
constexpr int LDS_BYTES = 147456;

#define GAS __attribute__((address_space(1)))
#define LAS __attribute__((address_space(3)))
typedef unsigned short bf16;
typedef unsigned v4u __attribute__((ext_vector_type(4)));
typedef unsigned v2u __attribute__((ext_vector_type(2)));
typedef float f32x4 __attribute__((ext_vector_type(4)));
typedef short bf16x8 __attribute__((ext_vector_type(8)));
typedef short bf16x4 __attribute__((ext_vector_type(4)));
#define STAMPS(F) ((LAS unsigned long long*)((F).lds + MISC_OFF + 4096))
#define LDS_WAIT() asm volatile("s_waitcnt lgkmcnt(0)" ::: "memory")
#define VM_WAIT() asm volatile("s_waitcnt vmcnt(0)" ::: "memory")
#define LBAR() do { asm volatile("s_waitcnt lgkmcnt(0)" ::: "memory"); __builtin_amdgcn_s_barrier(); asm volatile("" ::: "memory"); } while (0)
__device__ __forceinline__ unsigned f2bf(float f) { unsigned u = __builtin_bit_cast(unsigned, f); return (u + 0x7fffu + ((u >> 16) & 1u)) >> 16; }
typedef float f32x2_t __attribute__((ext_vector_type(2)));
typedef __bf16 bf16x2_t __attribute__((ext_vector_type(2)));
__device__ __forceinline__ unsigned pk2(float lo, float hi) { const f32x2_t v = {lo, hi}; const bf16x2_t b = __builtin_convertvector(v, bf16x2_t); return __builtin_bit_cast(unsigned, b); }
__device__ __forceinline__ float bf2f(unsigned b) { return __builtin_bit_cast(float, b << 16); }
__device__ __forceinline__ float bflo(unsigned w) { return __builtin_bit_cast(float, w << 16); }
__device__ __forceinline__ float bfhi(unsigned w) { return __builtin_bit_cast(float, w & 0xffff0000u); }
#define MFMA16(a, b, c) __builtin_amdgcn_mfma_f32_16x16x32_bf16((a), (b), (c), 0, 0, 0)

#define XB_TMO      128
#define XB_XCNT(j)  (256  + 64 * (j))
#define XB_XSUB(j)  (1280 + 64 * (j))
#define XB_XGEN(j)  (2304 + 64 * (j))
#define XB_TOP      3328
#define XB_TOPGEN   3392
#define XCD_BAR_WORDS 3456
#define XB_SPIN_CAP (1u << 22)

__device__ __forceinline__ unsigned xb_ld(unsigned* p)              { return __hip_atomic_load(p, __ATOMIC_RELAXED, __HIP_MEMORY_SCOPE_AGENT); }
__device__ __forceinline__ unsigned xb_add(unsigned* p, unsigned v) { return __hip_atomic_fetch_add(p, v, __ATOMIC_RELAXED, __HIP_MEMORY_SCOPE_AGENT); }
__device__ __forceinline__ unsigned xb_xcc_id() { return (unsigned)__builtin_amdgcn_s_getreg((3 << 11) | 20) & 0xFu; }
#define XB_SPIN(cond, bar) do { unsigned _sp = 0; while (cond) { __builtin_amdgcn_s_sleep(1); \
    if ((++_sp & 255u) == 0u) { if (xb_ld(&(bar)[XB_TMO])) break; if (_sp > XB_SPIN_CAP) { atomicAdd(&(bar)[XB_TMO], 1u); break; } } } } while (0)

struct XcdBarrier { unsigned* bar; unsigned x; volatile LAS unsigned* st; };
__device__ __forceinline__ XcdBarrier xcd_barrier_post(unsigned* bar, volatile LAS unsigned* st) {
    XcdBarrier b; b.bar = bar; b.x = xb_xcc_id(); b.st = st;
    if (threadIdx.x == 0) (void)xb_add(&bar[XB_XCNT(b.x)], 1u);
    return b;
}
__device__ __forceinline__ void xcd_barrier_complete(unsigned* bar, unsigned x, unsigned& nloc, unsigned& nx) {
    const unsigned G = gridDim.x * gridDim.y * gridDim.z;
    unsigned sum, cnt, mine, sp = 0u;
    for (;;) {
        sum = 0u; cnt = 0u; mine = 0u;
#pragma unroll
        for (unsigned j = 0; j < 16; ++j) { const unsigned c = xb_ld(&bar[XB_XCNT(j)]); sum += c; cnt += (c > 0u) ? 1u : 0u; mine = (j == x) ? c : mine; }
        if (sum == G) break;
        __builtin_amdgcn_s_sleep(1);
        if ((++sp & 255u) == 0u) { if (xb_ld(&bar[XB_TMO])) break; if (sp > XB_SPIN_CAP) { atomicAdd(&bar[XB_TMO], 1u); break; } }
    }
    nloc = mine > 0u ? mine : 1u; nx = cnt > 0u ? cnt : 1u;
}
__device__ __forceinline__ void xcd_barrier(const XcdBarrier& b) {
    asm volatile("s_waitcnt vmcnt(0)" ::: "memory");
    __syncthreads();
    if (threadIdx.x == 0) {
        unsigned* bar = b.bar;
        __builtin_amdgcn_s_waitcnt(0);
        unsigned nloc = b.st[0], nx = b.st[1];
        if (nloc == 0u) { xcd_barrier_complete(bar, b.x, nloc, nx); b.st[0] = nloc; b.st[1] = nx; }
        const unsigned old = xb_add(&bar[XB_XSUB(b.x)], 1u);
        const unsigned gen = old / nloc;
        if (old + 1u == (gen + 1u) * nloc) {
            __builtin_amdgcn_fence(__ATOMIC_RELEASE, "agent");
            asm volatile("s_waitcnt vmcnt(0)" ::: "memory");
            const unsigned og = xb_add(&bar[XB_TOP], 1u);
            const unsigned tg = og / nx;
            if (og + 1u == (tg + 1u) * nx) xb_add(&bar[XB_TOPGEN], 1u);
            else XB_SPIN(xb_ld(&bar[XB_TOPGEN]) == tg, bar);
            __builtin_amdgcn_fence(__ATOMIC_ACQUIRE, "agent");
            xb_add(&bar[XB_XGEN(b.x)], 1u);
            asm volatile("s_waitcnt vmcnt(0)" ::: "memory");
        } else {
            XB_SPIN(xb_ld(&bar[XB_XGEN(b.x)]) == gen, bar);
            __builtin_amdgcn_fence(__ATOMIC_ACQUIRE, "agent");
            asm volatile("s_waitcnt vmcnt(0)" ::: "memory");
        }
    }
    __syncthreads();
}

struct Args { const float* in[28]; float* out; unsigned char* ws; int ph_lo, ph_hi; };
enum { I_X = 0, I_C, I_CTX, I_CCTX, I_ADAW, I_ADAB, I_NMIX, I_NFFN, I_NOUT, I_AWIN, I_AGV, I_AWS, I_ABS, I_AWOUT, I_BWIN, I_BWA2, I_BBA, I_BGO, I_BWOUT,
       I_CWQKV, I_CRPB, I_CWOUT, I_MWR, I_MBR, I_MWGU, I_MBGU, I_MWDN, I_MBDN };

struct Frame {
    LAS unsigned char* lds;
    unsigned* ctl;
    unsigned char* ws;
    int tid, lane, wave, vcu, G;
};

#define DPP_F(v, ctrl) __builtin_bit_cast(float, __builtin_amdgcn_update_dpp(0, __builtin_bit_cast(int, (v)), (ctrl), 0xf, 0xf, true))
#define DPP_I(v, ctrl) __builtin_amdgcn_update_dpp(0, (v), (ctrl), 0xf, 0xf, true)
constexpr int DPP_XOR1 = 0xB1, DPP_XOR2 = 0x4E, DPP_HMIRROR = 0x141, DPP_MIRROR = 0x140;
__device__ __forceinline__ float wave_sum(float v) {
    v += DPP_F(v, DPP_XOR1); v += DPP_F(v, DPP_XOR2); v += DPP_F(v, DPP_HMIRROR); v += DPP_F(v, DPP_MIRROR);
    const float r0 = __builtin_bit_cast(float, __builtin_amdgcn_readlane(__builtin_bit_cast(int, v), 0)), r1 = __builtin_bit_cast(float, __builtin_amdgcn_readlane(__builtin_bit_cast(int, v), 16));
    const float r2 = __builtin_bit_cast(float, __builtin_amdgcn_readlane(__builtin_bit_cast(int, v), 32)), r3 = __builtin_bit_cast(float, __builtin_amdgcn_readlane(__builtin_bit_cast(int, v), 48));
    return (r0 + r1) + (r2 + r3);
}
__device__ __forceinline__ int seg_of_row(int r) { return r < NCTX ? 0 : 1 + ((r - NCTX) >> 13); }

__device__ __forceinline__ void transpose_item64(const float* W, int N, int k0, int n0, bf16* WT, int K, int dst_row0, int ncols_valid, LAS float* scr, int lane) {
    f32x4 tv[16];
#pragma unroll
    for (int i = 0; i < 16; ++i) { const int row = 4 * i + (lane >> 4), c4 = (lane & 15) * 4;
        tv[i] = (f32x4){0.f, 0.f, 0.f, 0.f};
        if (c4 < ncols_valid) tv[i] = __builtin_nontemporal_load((const GAS f32x4*)(W + (size_t)(k0 + row) * N + n0 + c4)); }
#pragma unroll
    for (int i = 0; i < 16; ++i) { const int row = 4 * i + (lane >> 4), c4 = (lane & 15) * 4;
        LAS float* s = scr + row * 65 + c4; s[0] = tv[i].x; s[1] = tv[i].y; s[2] = tv[i].z; s[3] = tv[i].w; }
    LDS_WAIT(); asm volatile("" ::: "memory");
    const int c = lane & 7;
#pragma unroll
    for (int j = 0; j < 8; ++j) { const int n = (lane >> 3) + 8 * j; const LAS float* s = scr + (8 * c) * 65 + n;
        v4u o; o.x = pk2(s[0 * 65], s[1 * 65]); o.y = pk2(s[2 * 65], s[3 * 65]); o.z = pk2(s[4 * 65], s[5 * 65]); o.w = pk2(s[6 * 65], s[7 * 65]);
        __builtin_nontemporal_store(o, (GAS v4u*)(WT + (size_t)(dst_row0 + n) * K + k0 + 8 * c)); }
    LDS_WAIT(); asm volatile("" ::: "memory");
}

constexpr int MOE_ITEMS = 32 * 512 + 32 * 256;
typedef short cv_s16x4 __attribute__((ext_vector_type(4)));
struct ConvItem { const float* src; bf16* dst; int N; };
__device__ __forceinline__ ConvItem conv_item(const Frame& F, const Args& a, int g) {
    const int L = g / MOE_ITEMS, q = g % MOE_ITEMS; ConvItem it;
    if (q < 16384) { const int le = L * 32 + q / 512, qq = q % 512, kb = qq / 32, nb = qq % 32;
        const int n0 = 64 * nb, half = n0 >> 10, jj = n0 & 1023, dst = (jj >> 7) * 256 + half * 128 + (jj & 127);
        it.src = a.in[I_MWGU] + (size_t)le * 1024 * 2048 + (size_t)(64 * kb) * 2048 + n0; it.N = 2048;
        it.dst = (bf16*)(F.ws + WS_WGU) + (size_t)le * 2048 * 1024 + (size_t)dst * 1024 + 64 * kb; }
    else { const int r = q - 16384, le = L * 32 + r / 256, qq = r % 256, kb = qq / 16, nb = qq % 16;
        it.src = a.in[I_MWDN] + (size_t)le * 1024 * 1024 + (size_t)(64 * kb) * 1024 + 64 * nb; it.N = 1024;
        it.dst = (bf16*)(F.ws + WS_WDN) + (size_t)le * 1024 * 1024 + (size_t)(64 * nb) * 1024 + 64 * kb; }
    return it;
}
__device__ __forceinline__ void conv_load(const ConvItem& it, f32x4 (&tv)[16], int lane) {
#pragma unroll
    for (int i = 0; i < 16; ++i) { const int row = 16 * (lane >> 4) + i, c4 = (lane & 15) * 4; tv[i] = __builtin_nontemporal_load((const GAS f32x4*)(it.src + (size_t)row * it.N + c4)); }
}
__device__ __forceinline__ void conv_moe_items(Frame& F, const Args& a, int g_lo, int g_hi, int w_id, int n_w) {
    LAS unsigned char* Tn = F.lds + F.wave * 16640;
    const int lane = F.lane;
    int g = g_lo + w_id; if (g >= g_hi) return;
    ConvItem cur = conv_item(F, a, g); f32x4 tv[16];
    conv_load(cur, tv, lane);
    for (;;) {
        { const int r = lane >> 4, c4 = (lane & 15) * 4;
#pragma unroll
            for (int e = 0; e < 4; ++e)
#pragma unroll
                for (int hk = 0; hk < 2; ++hk) { v4u o; o.x = pk2(tv[8 * hk + 0][e], tv[8 * hk + 1][e]); o.y = pk2(tv[8 * hk + 2][e], tv[8 * hk + 3][e]); o.z = pk2(tv[8 * hk + 4][e], tv[8 * hk + 5][e]); o.w = pk2(tv[8 * hk + 6][e], tv[8 * hk + 7][e]);
                    *(LAS v4u*)(Tn + (c4 + e) * 144 + 32 * r + 16 * hk) = o; } }
        const int gn = g + n_w; const bool hn = gn < g_hi; ConvItem nxt = cur;
        if (hn) { nxt = conv_item(F, a, gn); conv_load(nxt, tv, lane); }
        LDS_WAIT(); asm volatile("" ::: "memory");
        { const int c = lane & 7, nn = lane >> 3;
#pragma unroll
            for (int j = 0; j < 8; ++j) { const int n = nn + 8 * j; const v4u o = *(const LAS v4u*)(Tn + n * 144 + 16 * c);
                __builtin_nontemporal_store(o, (GAS v4u*)(cur.dst + (size_t)n * 1024 + 8 * c)); } }
        LDS_WAIT(); asm volatile("" ::: "memory");
        if (!hn) break;
        cur = nxt; g = gn;
    }
}
__device__ __forceinline__ Frame mixer_frame(const Frame& F, int ncv) {
    Frame Fm = F; const int nm = F.G - ncv, bx = (int)blockIdx.x; Fm.G = nm; Fm.vcu = (nm % 8 == 0) ? (bx % 8) * (nm / 8) + bx / 8 : bx; return Fm;
}

__device__ __forceinline__ void p_prologue(Frame& F, const Args& a) {
    LAS float* scr = (LAS float*)(F.lds + F.wave * 16640);
    const int gw = F.vcu * NWAVES + F.wave, NGW = F.G * NWAVES;
    {
        constexpr int KB = 16;
        constexpr int I0 = 2 * KB * 32, I1 = 2 * KB * 16, I2 = KB * 52, I3 = KB * 16, I4 = KB * 48, I5 = KB * 16;
        constexpr int NI = I0 + I1 + I2 + I3 + I4 + I5;
        for (int it = gw; it < NI; it += NGW) {
            int r = it;
            if (r < I0) { const int j = r / (KB * 32), q = r % (KB * 32), kb = q / 32, nb = q % 32;
                transpose_item64(a.in[I_AWIN] + (size_t)j * 1024 * 2048, 2048, 64 * kb, 64 * nb, (bf16*)(F.ws + WS_WAIN) + (size_t)j * 2048 * 1024, 1024, 64 * nb, 64, scr, F.lane); continue; } r -= I0;
            if (r < I1) { const int j = r / (KB * 16), q = r % (KB * 16), kb = q / 16, nb = q % 16;
                transpose_item64(a.in[I_AWOUT] + (size_t)j * 1024 * 1024, 1024, 64 * kb, 64 * nb, (bf16*)(F.ws + WS_WAOUT) + (size_t)j * 1024 * 1024, 1024, 64 * nb, 64, scr, F.lane); continue; } r -= I1;
            if (r < I2) { const int kb = r / 52, nb = r % 52; const int nv = GLA_IN - 64 * nb;
                transpose_item64(a.in[I_BWIN], GLA_IN, 64 * kb, 64 * nb, (bf16*)(F.ws + WS_WBIN), 1024, 64 * nb, nv < 0 ? 0 : (nv > 64 ? 64 : nv), scr, F.lane); continue; } r -= I2;
            if (r < I3) { const int kb = r / 16, nb = r % 16;
                transpose_item64(a.in[I_BWOUT], 1024, 64 * kb, 64 * nb, (bf16*)(F.ws + WS_WBOUT), 1024, 64 * nb, 64, scr, F.lane); continue; } r -= I3;
            if (r < I4) { const int kb = r / 48, nb = r % 48;
                transpose_item64(a.in[I_CWQKV], 3072, 64 * kb, 64 * nb, (bf16*)(F.ws + WS_WCQKV), 1024, 64 * nb, 64, scr, F.lane); continue; } r -= I4;
            { const int kb = r / 16, nb = r % 16;
                transpose_item64(a.in[I_CWOUT], 1024, 64 * kb, 64 * nb, (bf16*)(F.ws + WS_WCOUT), 1024, 64 * nb, 64, scr, F.lane); }
        }
    }
    conv_moe_items(F, a, 0, MOE_ITEMS, gw, NGW);
    const int gt = F.vcu * NTHREADS + F.tid, NGT = F.G * NTHREADS;
    for (int i = gt; i < 2 * 8 * 128 * 128; i += NGT) ((bf16*)(F.ws + WS_WSB))[i] = (bf16)f2bf(a.in[I_AWS][i]);
    for (int i = gt; i < 4 * 32 * 1024; i += NGT) { const int l = i >> 15, e = (i >> 10) & 31, k = i & 1023;
        const float w = a.in[I_MWR][((size_t)l * 1024 + k) * 32 + e]; const unsigned h = f2bf(w); const float rem = w - bf2f(h);
        ((bf16*)(F.ws + WS_WRH))[i] = (bf16)h; ((bf16*)(F.ws + WS_WRL))[i] = (bf16)f2bf(rem); }
    for (int i = gt; i < 128 * 32; i += NGT) { const int pos = i >> 5, f = i & 31;
        const float fr = powf(10000.0f, -(float)f / 32.0f); const float ang = (float)pos * fr; float sn, cs; sincosf(ang, &sn, &cs);
        ((float*)(F.ws + WS_ROPE))[2 * i] = cs; ((float*)(F.ws + WS_ROPE))[2 * i + 1] = sn; }
    {
        __syncthreads();
        LAS float* sv = (LAS float*)(F.lds);
        LAS float* red = sv + 3 * 1024;
        for (int i = F.tid; i < 3 * 1024; i += NTHREADS) { const int s = i >> 10, k = i & 1023;
            const float v = s == 0 ? a.in[I_CCTX][k] : a.in[I_C][(s - 1) * 1024 + k]; sv[i] = v / (1.0f + __expf(-v)); }
        __syncthreads();
        for (int u = F.vcu; u < 4 * 96; u += F.G) { const int l = u / 96, n0 = (u % 96) * 64;
            const float* w = a.in[I_ADAW] + (size_t)l * 1024 * 6144 + n0 + F.lane;
            float a0 = 0.f, a1 = 0.f, a2 = 0.f;
#pragma unroll
            for (int kb = 0; kb < 2; ++kb) {
                float wv[64];
#pragma unroll
                for (int kk = 0; kk < 64; ++kk) wv[kk] = __builtin_nontemporal_load(w + (size_t)(F.wave * 128 + kb * 64 + kk) * 6144);
#pragma unroll
                for (int kk = 0; kk < 64; ++kk) { const int k = F.wave * 128 + kb * 64 + kk; a0 += sv[k] * wv[kk]; a1 += sv[1024 + k] * wv[kk]; a2 += sv[2048 + k] * wv[kk]; } }
            red[(F.wave * 3 + 0) * 64 + F.lane] = a0; red[(F.wave * 3 + 1) * 64 + F.lane] = a1; red[(F.wave * 3 + 2) * 64 + F.lane] = a2;
            __syncthreads();
            if (F.tid < 192) { const int s = F.tid >> 6, c = F.tid & 63; float t = a.in[I_ADAB][l * 6144 + n0 + c];
#pragma unroll
                for (int w8 = 0; w8 < 8; ++w8) t += red[(w8 * 3 + s) * 64 + c];
                ((float*)(F.ws + WS_ADA))[(size_t)(l * 3 + s) * 6144 + n0 + c] = t; }
            __syncthreads();
        }
    }
}

__device__ __forceinline__ void moe_tables(Frame& F, int layer) {
    LAS int* M = (LAS int*)(F.lds + MISC_OFF);
    __syncthreads();
    if (F.tid < 32) M[400 + F.tid] = (int)__hip_atomic_load(F.ctl + CW_CNT + (layer * 32 + F.tid) * 64, __ATOMIC_RELAXED, __HIP_MEMORY_SCOPE_AGENT);
    __syncthreads();
    if (F.tid < 64) { const int e = F.tid & 31; const int nt = (M[400 + e] + 255) >> 8; int incl = nt;
#pragma unroll
        for (int o = 1; o < 32; o <<= 1) { const int v = __shfl_up(incl, o, 32); if (e >= o) incl += v; }
        const int off = (incl - nt) << 8;
        if (F.tid < 32) { M[e] = off; for (int t = 0; t < nt; ++t) M[64 + (off >> 8) + t] = e; if (e == 31) M[32] = incl << 8; } }
    __syncthreads();
}

__device__ __forceinline__ void p_prenorm(Frame& F, const Args& a, int layer, bool fin, bool dry = false) {
    const int gw = F.vcu * NWAVES + F.wave, NGW = F.G * NWAVES;
    const int prev = layer - 1;
    const int row_lo = (layer >= 3) ? NCTX : 0;
    const bool combine = layer > 0;
    if (combine) moe_tables(F, prev);
    const LAS int* M = (const LAS int*)(F.lds + MISC_OFF);
    bf16* X = (bf16*)(F.ws + WS_X); bf16* H = (bf16*)(F.ws + (dry ? WS_AS : WS_H));
    const bf16* YB = (const bf16*)(F.ws + WS_YB);
    const float* ada = (const float*)(F.ws + WS_ADA);
    const v4u* TOKI = (const v4u*)(F.ws + WS_TOKI); const f32x4* TOKG = (const f32x4*)(F.ws + WS_TOKG);
    LAS float* V = (LAS float*)(F.lds);
    __syncthreads();
    for (int i = F.tid; i < 13 * D; i += NTHREADS) { const int w = i >> 10, c = i & 1023; float x;
        if (w == 0) x = fin ? a.in[I_NOUT][c] : a.in[I_NMIX][(size_t)layer * D + c];
        else if (w >= 10) x = combine ? ada[(size_t)((prev * 3 + (w - 10)) * 6 + 2) * D + c] : 0.f;
        else { const int seg = (w - 1) / 3, k = (w - 1) % 3; x = k == 2 ? (combine ? ada[(size_t)((prev * 3 + seg) * 6 + 5) * D + c] : 0.f) : (fin ? 0.f : ada[(size_t)((layer * 3 + seg) * 6 + k) * D + c]); }
        V[i] = x; }
    __syncthreads();
    for (int row0 = row_lo + gw; row0 < NTOK; row0 += 2 * NGW) {
        const int row1r = row0 + NGW; const bool has1 = row1r < NTOK; const int row1 = has1 ? row1r : row0;
        f32x4 v[2][4]; v4u ti[2]; f32x4 tg[2];
#pragma unroll
        for (int q = 0; q < 2; ++q) { const int row = q ? row1 : row0;
            if (layer == 0) { const float* src = row < NCTX ? a.in[I_CTX] + (size_t)row * D : a.in[I_X] + (size_t)(row - NCTX) * D;
#pragma unroll
                for (int j = 0; j < 4; ++j) v[q][j] = *(const GAS f32x4*)(src + 4 * F.lane + 256 * j); }
            else {
#pragma unroll
                for (int j = 0; j < 4; ++j) { const v2u xx = *(const GAS v2u*)(X + (size_t)row * D + 4 * F.lane + 256 * j); v[q][j] = (f32x4){bflo(xx.x), bfhi(xx.x), bflo(xx.y), bfhi(xx.y)}; } }
            if (combine) { ti[q] = TOKI[row]; tg[q] = TOKG[row]; } }
        if (combine) {
            v2u y[2][4][4]; v2u ym[2][4];
#pragma unroll
            for (int q = 0; q < 2; ++q)
#pragma unroll
                for (int j = 0; j < 4; ++j) ym[q][j] = *(const GAS v2u*)((const bf16*)(F.ws + WS_YM) + (size_t)(q ? row1 : row0) * D + 4 * F.lane + 256 * j);
#pragma unroll
            for (int q = 0; q < 2; ++q)
#pragma unroll
                for (int k = 0; k < 4; ++k) { const unsigned t = ti[q][k]; const int pos = M[t >> 16] + (int)(t & 0xffffu); const bf16* yr = YB + (size_t)pos * D + 4 * F.lane;
#pragma unroll
                    for (int j = 0; j < 4; ++j) y[q][k][j] = *(const GAS v2u*)(yr + 256 * j); }
#pragma unroll
            for (int q = 0; q < 2; ++q) { const int seg = seg_of_row(q ? row1 : row0);
#pragma unroll
                for (int j = 0; j < 4; ++j) { f32x4 acc = (f32x4){0.f, 0.f, 0.f, 0.f};
#pragma unroll
                    for (int k = 0; k < 4; ++k) { const float g = tg[q][k]; const v2u yy = y[q][k][j]; acc.x += g * bflo(yy.x); acc.y += g * bfhi(yy.x); acc.z += g * bflo(yy.y); acc.w += g * bfhi(yy.y); }
                    const f32x4 gg = *(const LAS f32x4*)(V + (1 + 3 * seg + 2) * D + 4 * F.lane + 256 * j), g2 = *(const LAS f32x4*)(V + (10 + seg) * D + 4 * F.lane + 256 * j);
                    const v2u yy = ym[q][j]; const f32x4 yv = (f32x4){bflo(yy.x), bfhi(yy.x), bflo(yy.y), bfhi(yy.y)};
                    v[q][j] = v[q][j] + g2 * yv + gg * acc; } }
        }
#pragma unroll
        for (int q = 0; q < 2; ++q) { if (q == 1 && !has1) break; const int row = q ? row1 : row0, seg = seg_of_row(row);
            if (!fin && !dry && (combine || layer == 0)) {
#pragma unroll
                for (int j = 0; j < 4; ++j) { v2u xo; xo.x = pk2(v[q][j].x, v[q][j].y); xo.y = pk2(v[q][j].z, v[q][j].w); *(GAS v2u*)(X + (size_t)row * D + 4 * F.lane + 256 * j) = xo; }
            }
            float ss = 0.f;
#pragma unroll
            for (int j = 0; j < 4; ++j) ss += (v[q][j].x * v[q][j].x + v[q][j].y * v[q][j].y) + (v[q][j].z * v[q][j].z + v[q][j].w * v[q][j].w);
            const float rstd = __builtin_amdgcn_rsqf(wave_sum(ss) * (1.0f / D) + EPS);
            if (fin) {
                float* o = a.out + (size_t)(row - NCTX) * D;
#pragma unroll
                for (int j = 0; j < 4; ++j) { const f32x4 g = *(const LAS f32x4*)(V + 4 * F.lane + 256 * j); *(GAS f32x4*)(o + 4 * F.lane + 256 * j) = v[q][j] * rstd * g; }
            } else {
#pragma unroll
                for (int j = 0; j < 4; ++j) { const int c = 4 * F.lane + 256 * j;
                    const f32x4 g = *(const LAS f32x4*)(V + c), s0 = *(const LAS f32x4*)(V + (1 + 3 * seg) * D + c), s1 = *(const LAS f32x4*)(V + (2 + 3 * seg) * D + c);
                    const f32x4 h = v[q][j] * rstd * g * (s1 + 1.0f) + s0;
                    v2u o; o.x = pk2(h.x, h.y); o.y = pk2(h.z, h.w);
                    *(GAS v2u*)(H + (size_t)row * D + c) = o; }
            }
        }
    }
}

__device__ __forceinline__ void p_router(Frame& F, const Args& a, int layer, bool dry = false) {
    const int row_lo = (layer >= 2) ? NCTX : 0;
    const int ntile = (NTOK - row_lo) / 16;
    const bf16* X = (const bf16*)(F.ws + WS_X); bf16* H = (bf16*)(F.ws + WS_H);
    const float* ada = (const float*)(F.ws + WS_ADA);
    constexpr int AST = 1032;
    LAS bf16* Ahi = (LAS bf16*)(F.lds); LAS bf16* Alo = Ahi + 16 * AST;
    LAS float* RED = (LAS float*)(F.lds + 2 * 16 * AST * 2);
    LAS float* LOG = RED + 8 * 16 * 32;
    const int fr = F.lane & 15, fq = F.lane >> 4;
    bf16x8 Bh[2][4], Bl[2][4];
    {
        const bf16* wh = (const bf16*)(F.ws + WS_WRH) + (size_t)layer * 32 * 1024; const bf16* wl = (const bf16*)(F.ws + WS_WRL) + (size_t)layer * 32 * 1024;
#pragma unroll
        for (int nt = 0; nt < 2; ++nt)
#pragma unroll
            for (int ks = 0; ks < 4; ++ks) { const size_t o = (size_t)(nt * 16 + fr) * 1024 + F.wave * 128 + ks * 32 + fq * 8;
                Bh[nt][ks] = *(const GAS bf16x8*)(wh + o); Bl[nt][ks] = *(const GAS bf16x8*)(wl + o); }
    }
    LAS float* VC = (LAS float*)(F.lds + 90112);
    for (int i = F.tid; i < 10 * D; i += NTHREADS) { const int w = i >> 10, c = i & 1023;
        VC[i] = w == 0 ? a.in[I_NFFN][(size_t)layer * D + c] : ada[(size_t)((layer * 3 + (w - 1) / 3) * 6 + ((w - 1) % 3 == 0 ? 3 : ((w - 1) % 3 == 1 ? 4 : 2))) * D + c]; }
    LAS int* WCNT = (LAS int*)LOG; LAS int* WBASE = WCNT + 32; LAS unsigned* ETOK = (LAS unsigned*)(WBASE + 32); LAS unsigned* EEL = ETOK + 512; LAS float* EG = (LAS float*)(EEL + 512);
    int tile = F.vcu;
    while (tile < ntile) {
      __syncthreads();
      if (F.tid < 32) WCNT[F.tid] = 0;
      int nb = 0;
      for (; tile < ntile && nb < 8; tile += F.G, ++nb) {
        const int r0 = row_lo + 16 * tile;
#pragma unroll
        for (int rr = 0; rr < 2; ++rr) {
            const int rl = 2 * F.wave + rr, row = r0 + rl, seg = seg_of_row(row);
            const LAS float* sh = VC + (1 + 3 * seg) * D; const LAS float* sc = sh + D; const LAS float* g2v = sc + D;
            f32x4 v[4]; float ss = 0.f;
#pragma unroll
            for (int j = 0; j < 4; ++j) { const int c = 4 * F.lane + 256 * j; { const v2u xx = *(const GAS v2u*)(X + (size_t)row * D + c); v[j] = (f32x4){bflo(xx.x), bfhi(xx.x), bflo(xx.y), bfhi(xx.y)}; }
                const v2u yy = *(const GAS v2u*)((const bf16*)(F.ws + WS_YM) + (size_t)row * D + c); const f32x4 g2 = *(const LAS f32x4*)(g2v + c);
                v[j] = v[j] + g2 * (f32x4){bflo(yy.x), bfhi(yy.x), bflo(yy.y), bfhi(yy.y)};
                ss += (v[j].x * v[j].x + v[j].y * v[j].y) + (v[j].z * v[j].z + v[j].w * v[j].w); }
            const float rstd = __builtin_amdgcn_rsqf(wave_sum(ss) * (1.0f / D) + EPS);
#pragma unroll
            for (int j = 0; j < 4; ++j) { const int c = 4 * F.lane + 256 * j;
                const f32x4 g = *(const LAS f32x4*)(VC + c), s1 = *(const LAS f32x4*)(sc + c), s0 = *(const LAS f32x4*)(sh + c);
                const f32x4 h = v[j] * rstd * g * (s1 + 1.0f) + s0;
                v2u o; o.x = pk2(h.x, h.y); o.y = pk2(h.z, h.w);
                const unsigned h0 = o.x & 0xffffu, h1 = o.x >> 16, h2 = o.y & 0xffffu, h3 = o.y >> 16;
                *(GAS v2u*)(H + (size_t)row * D + c) = o;
                *(LAS v2u*)(Ahi + rl * AST + c) = o;
                v2u l; l.x = pk2(h.x - bf2f(h0), h.y - bf2f(h1)); l.y = pk2(h.z - bf2f(h2), h.w - bf2f(h3));
                *(LAS v2u*)(Alo + rl * AST + c) = l; }
        }
        __syncthreads();
        f32x4 acc[2] = {(f32x4){0.f, 0.f, 0.f, 0.f}, (f32x4){0.f, 0.f, 0.f, 0.f}};
#pragma unroll
        for (int ks = 0; ks < 4; ++ks) { const int o = fr * AST + F.wave * 128 + ks * 32 + fq * 8;
            const bf16x8 ah = *(const LAS bf16x8*)(Ahi + o), al = *(const LAS bf16x8*)(Alo + o);
#pragma unroll
            for (int nt = 0; nt < 2; ++nt) { acc[nt] = MFMA16(ah, Bh[nt][ks], acc[nt]); acc[nt] = MFMA16(ah, Bl[nt][ks], acc[nt]); acc[nt] = MFMA16(al, Bh[nt][ks], acc[nt]); } }
#pragma unroll
        for (int nt = 0; nt < 2; ++nt)
#pragma unroll
            for (int j = 0; j < 4; ++j) RED[(F.wave * 16 + fq * 4 + j) * 32 + nt * 16 + fr] = acc[nt][j];
        __syncthreads();
        {
            const int rl = F.tid >> 5, e = F.tid & 31, row = r0 + rl;
            float lg = a.in[I_MBR][layer * 32 + e];
#pragma unroll
            for (int w8 = 0; w8 < 8; ++w8) lg += RED[(w8 * 16 + rl) * 32 + e];
            float cur = lg; float tv[4]; int tix[4];
#pragma unroll
            for (int k = 0; k < 4; ++k) { float bv = cur; int bi = e;
#define TK_STEP(ctrl) do { const float ov = DPP_F(bv, ctrl); const int oi = DPP_I(bi, ctrl); if (ov > bv || (ov == bv && oi < bi)) { bv = ov; bi = oi; } } while (0)
                TK_STEP(DPP_XOR1); TK_STEP(DPP_XOR2); TK_STEP(DPP_HMIRROR); TK_STEP(DPP_MIRROR);
#undef TK_STEP
                {
                    const int hb = (F.lane >> 5) * 32;
                    const float v0 = __builtin_bit_cast(float, __builtin_amdgcn_readlane(__builtin_bit_cast(int, bv), 0)), v1 = __builtin_bit_cast(float, __builtin_amdgcn_readlane(__builtin_bit_cast(int, bv), 16));
                    const float v2 = __builtin_bit_cast(float, __builtin_amdgcn_readlane(__builtin_bit_cast(int, bv), 32)), v3 = __builtin_bit_cast(float, __builtin_amdgcn_readlane(__builtin_bit_cast(int, bv), 48));
                    const int i0 = __builtin_amdgcn_readlane(bi, 0), i1 = __builtin_amdgcn_readlane(bi, 16), i2 = __builtin_amdgcn_readlane(bi, 32), i3 = __builtin_amdgcn_readlane(bi, 48);
                    const bool a01 = v1 > v0 || (v1 == v0 && i1 < i0), a23 = v3 > v2 || (v3 == v2 && i3 < i2);
                    const float w01 = a01 ? v1 : v0, w23 = a23 ? v3 : v2; const int j01 = a01 ? i1 : i0, j23 = a23 ? i3 : i2;
                    bv = hb ? w23 : w01; bi = hb ? j23 : j01; }
                tv[k] = bv; tix[k] = bi; if (e == bi) cur = -3.0e38f; }
            const float e1 = __expf(tv[1] - tv[0]), e2 = __expf(tv[2] - tv[0]), e3 = __expf(tv[3] - tv[0]); const float inv = 1.0f / (1.0f + e1 + e2 + e3);
            if (e < 4 && !dry) { const int k = e; const int ek = k == 0 ? tix[0] : (k == 1 ? tix[1] : (k == 2 ? tix[2] : tix[3])); const float gk = (k == 0 ? 1.0f : (k == 1 ? e1 : (k == 2 ? e2 : e3))) * inv;
                const int lr = __hip_atomic_fetch_add((int*)(WCNT + ek), 1, __ATOMIC_RELAXED, __HIP_MEMORY_SCOPE_WORKGROUP);
                const int idx = nb * 64 + rl * 4 + k;
                ETOK[idx] = (unsigned)(row * 4 + k); EEL[idx] = (unsigned)ek | ((unsigned)lr << 8); EG[idx] = gk; }
        }
        __syncthreads();
      }
      if (!dry) {
        if (F.tid < 32) { const int c = WCNT[F.tid]; WBASE[F.tid] = c ? (int)atomicAdd(F.ctl + CW_CNT + (layer * 32 + F.tid) * 64, (unsigned)c) : 0; }
        __syncthreads();
        for (int i = F.tid; i < nb * 64; i += NTHREADS) { const unsigned el = EEL[i], tk = ETOK[i]; const unsigned ek = el & 255u, rank = (unsigned)WBASE[ek] + (el >> 8);
            ((unsigned*)(F.ws + WS_LIST))[(size_t)ek * NTOK + rank] = tk >> 2;
            ((unsigned*)(F.ws + WS_TOKI))[tk] = (ek << 16) | rank;
            ((float*)(F.ws + WS_TOKG))[tk] = EG[i]; }
      }
    }
}

__device__ __forceinline__ void p_gather(Frame& F, int layer) {
    moe_tables(F, layer);
    const LAS int* M = (const LAS int*)(F.lds + MISC_OFF);
    const int total = M[32];
    const int gw = F.vcu * NWAVES + F.wave, NGW = F.G * NWAVES;
    const bf16* H = (const bf16*)(F.ws + WS_H); bf16* AS = (bf16*)(F.ws + WS_AS);
    const unsigned* LIST = (const unsigned*)(F.ws + WS_LIST);
    for (int p = gw; p < total; p += NGW) {
        const int e = M[64 + (p >> 8)]; const int rank = p - M[e];
        v4u x0 = (v4u){0u, 0u, 0u, 0u}, x1 = x0;
        if (rank < M[400 + e]) { const unsigned r = LIST[(size_t)e * NTOK + rank]; const GAS v4u* s = (const GAS v4u*)(H + (size_t)r * D); x0 = s[F.lane]; x1 = s[64 + F.lane]; }
        GAS v4u* d = (GAS v4u*)(AS + (size_t)p * D); d[F.lane] = x0; d[64 + F.lane] = x1;
    }
}

typedef short s16x4 __attribute__((ext_vector_type(4)));
__device__ __forceinline__ bf16x8 tr_frag(const LAS bf16* T, int stride, int kb, int c0, int lane) {
    const int g = lane >> 4, w = lane & 15, q = w >> 2, p = w & 3;
    const LAS bf16* a0 = T + (kb + 4 * g + q) * stride + c0 + 4 * p;
    const s16x4 lo = __builtin_amdgcn_ds_read_tr16_b64_v4i16((LAS s16x4*)a0);
    const s16x4 hi = __builtin_amdgcn_ds_read_tr16_b64_v4i16((LAS s16x4*)(a0 + 16 * stride));
    return (bf16x8){lo[0], lo[1], lo[2], lo[3], hi[0], hi[1], hi[2], hi[3]};
}
__device__ __forceinline__ bf16x8 perm_frag(const LAS bf16* rowp, int kb, int quad) {
    const v2u lo = *(const LAS v2u*)(rowp + kb + 4 * quad), hi = *(const LAS v2u*)(rowp + kb + 16 + 4 * quad);
    v4u w; w.x = lo.x; w.y = lo.y; w.z = hi.x; w.w = hi.y; return __builtin_bit_cast(bf16x8, w);
}
__device__ __forceinline__ void p_spatial(Frame& F, const Args& a, int layer) {
    const int jl = layer / 3;
    const int c_lo = (layer >= 3) ? 4 : 0;
    const int nunit = (132 - c_lo) * 8;
    const bf16* ZB = (const bf16*)(F.ws + WS_BIG); bf16* G = (bf16*)(F.ws + WS_G);
    constexpr int ST = 144;
    LAS bf16* As = (LAS bf16*)(F.lds); LAS bf16* Bs = As + 128 * ST; LAS float* rs = (LAS float*)(F.lds + 2 * 128 * ST * 2);
    const int fr = F.lane & 15, fq = F.lane >> 4;
    const int u_lo = (int)(((long)F.vcu * nunit) / F.G), u_hi = (int)(((long)(F.vcu + 1) * nunit) / F.G);
    int cur_c = -1;
    for (int u = u_lo; u < u_hi; ++u) {
        const int c = c_lo + (u >> 3), g = u & 7, r0 = 128 * c;
        if (c != cur_c) {
            cur_c = c;
            __syncthreads();
#pragma unroll
            for (int hb = 0; hb < 2; ++hb) {
                v4u x0[8], x1[8];
#pragma unroll
                for (int rr = 0; rr < 8; ++rr) { const GAS v4u* p = (const GAS v4u*)(ZB + (size_t)(r0 + F.wave * 16 + hb * 8 + rr) * 2048 + 1024 + 16 * F.lane); x0[rr] = p[0]; x1[rr] = p[1]; }
#pragma unroll
                for (int rr = 0; rr < 8; ++rr) { float ss = 0.f;
#pragma unroll
                    for (int i = 0; i < 4; ++i) { const float l0 = bflo(x0[rr][i]), h0 = bfhi(x0[rr][i]), l1 = bflo(x1[rr][i]), h1 = bfhi(x1[rr][i]); ss += l0 * l0 + h0 * h0 + l1 * l1 + h1 * h1; }
                    ss = wave_sum(ss); if (F.lane == 0) rs[F.wave * 16 + hb * 8 + rr] = __builtin_amdgcn_rsqf(ss * (1.0f / 1024.0f) + EPS); }
            }
        }
        __syncthreads();
        {
            const bf16* wsb = (const bf16*)(F.ws + WS_WSB) + (size_t)(jl * 8 + g) * 128 * 128;
            const float* gv = a.in[I_AGV] + (size_t)jl * 1024 + 128 * g;
#pragma unroll
            for (int i = 0; i < 4; ++i) { const int id = F.tid + 512 * i, p = id >> 4, qc = id & 15;
                *(LAS v4u*)(As + p * ST + qc * 8) = *(const GAS v4u*)(wsb + p * 128 + qc * 8);
                const v4u x = *(const GAS v4u*)(ZB + (size_t)(r0 + p) * 2048 + 1024 + 128 * g + 8 * qc); const float rq = rs[p];
                const f32x4 g0 = *(const GAS f32x4*)(gv + 8 * qc), g1 = *(const GAS f32x4*)(gv + 8 * qc + 4);
                v4u o; o.x = pk2(bflo(x.x) * rq * g0.x, bfhi(x.x) * rq * g0.y); o.y = pk2(bflo(x.y) * rq * g0.z, bfhi(x.y) * rq * g0.w);
                o.z = pk2(bflo(x.z) * rq * g1.x, bfhi(x.z) * rq * g1.y); o.w = pk2(bflo(x.w) * rq * g1.z, bfhi(x.w) * rq * g1.w);
                *(LAS v4u*)(Bs + p * ST + qc * 8) = o; }
        }
        __syncthreads();
        f32x4 acc[8];
#pragma unroll
        for (int nt = 0; nt < 8; ++nt) acc[nt] = (f32x4){0.f, 0.f, 0.f, 0.f};
#pragma unroll
        for (int ks = 0; ks < 4; ++ks) { const bf16x8 af = tr_frag(Bs, ST, 32 * ks, 16 * F.wave, F.lane);
#pragma unroll
            for (int nt = 0; nt < 8; ++nt) { const bf16x8 bfr = perm_frag(As + (16 * nt + fr) * ST, 32 * ks, fq); acc[nt] = MFMA16(af, bfr, acc[nt]); } }
        const float* bs = a.in[I_ABS] + (size_t)(jl * 8 + g) * 128;
#pragma unroll
        for (int nt = 0; nt < 8; ++nt) { const int p = 16 * nt + fr; const float bb = bs[p]; const size_t row = (size_t)(r0 + p); const int cc = 128 * g + 16 * F.wave + 4 * fq;
            const v2u uu = *(const GAS v2u*)(ZB + row * 2048 + cc);
            v2u o; o.x = pk2(bflo(uu.x) * (acc[nt][0] + bb), bfhi(uu.x) * (acc[nt][1] + bb)); o.y = pk2(bflo(uu.y) * (acc[nt][2] + bb), bfhi(uu.y) * (acc[nt][3] + bb));
            *(GAS v2u*)(G + row * D + cc) = o; }
        __syncthreads();
    }
}

constexpr int PST = GLA_INP;
constexpr int CST = 132;
constexpr int KST = 144;
constexpr int VST = 272;
__device__ __forceinline__ void gla_cum(Frame& F, const Args& a, int c, int h, int dir, LAS float* cum, LAS float* rt, LAS float* tot) {
    const bf16* P = (const bf16*)(F.ws + WS_BIG);
    for (int i = F.tid; i < 64 * 8; i += NTHREADS) { const int ii = i >> 3, j2 = i & 7; const unsigned x = *(const GAS unsigned*)(P + (size_t)(64 * c + ii) * PST + 3072 + dir * 16 + 2 * j2);
        rt[ii * 16 + 2 * j2] = bflo(x); rt[ii * 16 + 2 * j2 + 1] = bfhi(x); }
    const int kk = F.tid & 127, part = F.tid >> 7;
    float w[16];
#pragma unroll
    for (int j = 0; j < 16; ++j) w[j] = a.in[I_BWA2][(size_t)(dir * 16 + j) * 512 + h * 128 + kk];
    const float ba = a.in[I_BBA][dir * 512 + h * 128 + kk];
    __syncthreads();
    float la[16];
#pragma unroll
    for (int ii = 0; ii < 16; ++ii) { const int i = part * 16 + ii; float z = ba;
        const f32x4 r0 = *(const LAS f32x4*)(rt + i * 16), r1 = *(const LAS f32x4*)(rt + i * 16 + 4), r2 = *(const LAS f32x4*)(rt + i * 16 + 8), r3 = *(const LAS f32x4*)(rt + i * 16 + 12);
        z += r0.x * w[0] + r0.y * w[1] + r0.z * w[2] + r0.w * w[3]; z += r1.x * w[4] + r1.y * w[5] + r1.z * w[6] + r1.w * w[7];
        z += r2.x * w[8] + r2.y * w[9] + r2.z * w[10] + r2.w * w[11]; z += r3.x * w[12] + r3.y * w[13] + r3.z * w[14] + r3.w * w[15];
        const float ls = fminf(z, 0.0f) - __logf(1.0f + __expf(-fabsf(z)));
        la[ii] = ls * (1.0f / 16.0f); }
    float run = 0.f;
    if (dir == 0) {
#pragma unroll
        for (int ii = 0; ii < 16; ++ii) { run += la[ii]; la[ii] = run; } }
    else {
#pragma unroll
        for (int ii = 15; ii >= 0; --ii) { run += la[ii]; la[ii] = run; } }
    tot[part * 128 + kk] = run;
    __syncthreads();
    float off = 0.f;
#pragma unroll
    for (int p = 0; p < 4; ++p) { const float t = tot[p * 128 + kk]; if (dir == 0 ? (p < part) : (p > part)) off += t; }
#pragma unroll
    for (int ii = 0; ii < 16; ++ii) cum[(part * 16 + ii) * CST + kk] = la[ii] + off;
    __syncthreads();
}
struct CumIn { unsigned rx[2]; float w0[16], w1[16], ba0, ba1; };
__device__ __forceinline__ void gla_cum2_load(Frame& F, const Args& a, int c, int h, CumIn& ci) {
    const bf16* P = (const bf16*)(F.ws + WS_BIG);
#pragma unroll
    for (int k = 0; k < 2; ++k) { const int i = F.tid + 512 * k, ii = i >> 4, j2 = i & 15; ci.rx[k] = *(const GAS unsigned*)(P + (size_t)(64 * c + ii) * PST + 3072 + 2 * j2); }
    const int kk = F.tid & 127;
#pragma unroll
    for (int j = 0; j < 16; ++j) { ci.w0[j] = a.in[I_BWA2][(size_t)j * 512 + h * 128 + kk]; ci.w1[j] = a.in[I_BWA2][(size_t)(16 + j) * 512 + h * 128 + kk]; }
    ci.ba0 = a.in[I_BBA][h * 128 + kk]; ci.ba1 = a.in[I_BBA][512 + h * 128 + kk];
}
__device__ __forceinline__ void gla_cum2_run(Frame& F, LAS float* cum, float (&c1)[16], LAS float* rt, LAS float* tot, const CumIn& ci) {
#pragma unroll
    for (int k = 0; k < 2; ++k) { const int i = F.tid + 512 * k, ii = i >> 4, j2 = i & 15; rt[ii * 32 + 2 * j2] = bflo(ci.rx[k]); rt[ii * 32 + 2 * j2 + 1] = bfhi(ci.rx[k]); }
    const int kk = F.tid & 127, part = F.tid >> 7;
    LBAR();
    float la0[16];
#pragma unroll
    for (int ii = 0; ii < 16; ++ii) { const int i = part * 16 + ii; float z0 = ci.ba0, z1 = ci.ba1;
#pragma unroll
        for (int q = 0; q < 4; ++q) { const f32x4 r = *(const LAS f32x4*)(rt + i * 32 + 4 * q), t = *(const LAS f32x4*)(rt + i * 32 + 16 + 4 * q);
            z0 += r.x * ci.w0[4 * q] + r.y * ci.w0[4 * q + 1] + r.z * ci.w0[4 * q + 2] + r.w * ci.w0[4 * q + 3];
            z1 += t.x * ci.w1[4 * q] + t.y * ci.w1[4 * q + 1] + t.z * ci.w1[4 * q + 2] + t.w * ci.w1[4 * q + 3]; }
        la0[ii] = (fminf(z0, 0.0f) - __logf(1.0f + __expf(-fabsf(z0)))) * (1.0f / 16.0f);
        c1[ii] = (fminf(z1, 0.0f) - __logf(1.0f + __expf(-fabsf(z1)))) * (1.0f / 16.0f); }
    float run0 = 0.f, run1 = 0.f;
#pragma unroll
    for (int ii = 0; ii < 16; ++ii) { run0 += la0[ii]; la0[ii] = run0; }
#pragma unroll
    for (int ii = 15; ii >= 0; --ii) { run1 += c1[ii]; c1[ii] = run1; }
    tot[part * 128 + kk] = run0; tot[512 + part * 128 + kk] = run1;
    LBAR();
    float off0 = 0.f, off1 = 0.f;
#pragma unroll
    for (int p = 0; p < 4; ++p) { const float t0 = tot[p * 128 + kk], t1 = tot[512 + p * 128 + kk]; if (p < part) off0 += t0; if (p > part) off1 += t1; }
#pragma unroll
    for (int ii = 0; ii < 16; ++ii) { cum[(part * 16 + ii) * CST + kk] = la0[ii] + off0; c1[ii] += off1; }
    LBAR();
}
__device__ __forceinline__ void gla_cum_store(Frame& F, LAS float* cum, const float (&c1)[16]) {
    const int kk = F.tid & 127, part = F.tid >> 7;
#pragma unroll
    for (int ii = 0; ii < 16; ++ii) cum[(part * 16 + ii) * CST + kk] = c1[ii];
}
struct RowRaw { v4u o0, o1, p0, p1; };
__device__ __forceinline__ void row16_load(const bf16* x, int grp, bool lat, RowRaw& R) {
    R.o0 = *(const GAS v4u*)(x + 16 * grp); R.o1 = *(const GAS v4u*)(x + 16 * grp + 8);
    if (lat) { R.p0 = *(const GAS v4u*)(x + 16 * (grp ^ 2)); R.p1 = *(const GAS v4u*)(x + 16 * (grp ^ 2) + 8); } else { R.p0 = R.o0; R.p1 = R.o1; }
}
__device__ __forceinline__ void ropetab_load(const float* ROPE, int grp, int pr, int pc, bool lat, f32x4 (&tb)[8]) {
    const int pos = (grp >> 2) ? pc : pr; const float* t = ROPE + (size_t)(pos * 32 + 16 * (grp & 1)) * 2;
#pragma unroll
    for (int e2 = 0; e2 < 8; ++e2) tb[e2] = lat ? *(const GAS f32x4*)(t + 4 * e2) : (f32x4){1.f, 0.f, 1.f, 0.f};
}
__device__ __forceinline__ void rope16_apply(const RowRaw& R, const f32x4 (&tb)[8], int grp, bool lat, float (&out)[16]) {
    float own[16], par[16];
#pragma unroll
    for (int e = 0; e < 4; ++e) { own[2 * e] = bflo(R.o0[e]); own[2 * e + 1] = bfhi(R.o0[e]); own[8 + 2 * e] = bflo(R.o1[e]); own[8 + 2 * e + 1] = bfhi(R.o1[e]);
        par[2 * e] = bflo(R.p0[e]); par[2 * e + 1] = bfhi(R.p0[e]); par[8 + 2 * e] = bflo(R.p1[e]); par[8 + 2 * e + 1] = bfhi(R.p1[e]); }
    const float sg = ((grp >> 1) & 1) ? 1.0f : -1.0f; (void)lat;
#pragma unroll
    for (int e2 = 0; e2 < 8; ++e2) { const f32x4 t = tb[e2];
        out[2 * e2] = fmaf(par[2 * e2], sg * t.y, own[2 * e2] * t.x);
        out[2 * e2 + 1] = fmaf(par[2 * e2 + 1], sg * t.w, own[2 * e2 + 1] * t.z); }
}
__device__ __forceinline__ void st16bf(LAS bf16* dst, const float (&v)[16]) {
    v4u a, b; a.x = pk2(v[0], v[1]); a.y = pk2(v[2], v[3]); a.z = pk2(v[4], v[5]); a.w = pk2(v[6], v[7]); b.x = pk2(v[8], v[9]); b.y = pk2(v[10], v[11]); b.z = pk2(v[12], v[13]); b.w = pk2(v[14], v[15]);
    *(LAS v4u*)dst = a; *(LAS v4u*)(dst + 8) = b;
}
__device__ __forceinline__ void ld16cum(const LAS float* p, float (&v)[16]) {
#pragma unroll
    for (int e = 0; e < 4; ++e) { const f32x4 t = *(const LAS f32x4*)(p + 4 * e); v[4 * e] = t.x; v[4 * e + 1] = t.y; v[4 * e + 2] = t.z; v[4 * e + 3] = t.w; }
}
__device__ __forceinline__ void gla_load_v(Frame& F, int c, int h, v4u (&vr)[4]) {
    const bf16* P = (const bf16*)(F.ws + WS_BIG);
    const int i = F.tid & 63, grp = F.tid >> 6; const bf16* vp = P + (size_t)(64 * c + i) * PST + 1024 + h * 256 + grp * 32;
#pragma unroll
    for (int e = 0; e < 4; ++e) vr[e] = *(const GAS v4u*)(vp + 8 * e);
}
__device__ __forceinline__ void gla_store_v(Frame& F, const v4u (&vr)[4], LAS bf16* VL) {
    const int i = F.tid & 63, grp = F.tid >> 6;
#pragma unroll
    for (int e = 0; e < 4; ++e) *(LAS v4u*)(VL + i * VST + grp * 32 + 8 * e) = vr[e];
}
__device__ __forceinline__ void p_gla_ds(Frame& F, const Args& a) {
    const bf16* P = (const bf16*)(F.ws + WS_BIG); const float* ROPE = (const float*)(F.ws + WS_ROPE);
    bf16* DS = (bf16*)(F.ws + WS_DS); float* DEC = (float*)(F.ws + WS_DEC);
    LAS float* cum = (LAS float*)(F.lds); LAS float* rt = cum + 64 * CST; LAS float* tot = rt + 64 * 32;
    LAS bf16* KE = (LAS bf16*)(tot + 2 * 4 * 128); LAS bf16* VL = KE + 64 * KST;
    const int fr = F.lane & 15, fq = F.lane >> 4;
    for (int u = F.vcu; u < 264 * 4; u += F.G) {
        const int c = u >> 2, h = u & 3; const bool lat = c >= 8; const int pr = (c - 8) & 127;
        RowRaw kraw; f32x4 tb[8]; float c1[16], kv0[16]; v4u vreg[4]; CumIn cin;
        gla_cum2_load(F, a, c, h, cin);
        { const int i = F.tid & 63, grp = F.tid >> 6; row16_load(P + (size_t)(64 * c + i) * PST + 512 + h * 128, grp, lat, kraw); ropetab_load(ROPE, grp, pr, i, lat, tb); }
        gla_load_v(F, c, h, vreg);
        gla_cum2_run(F, cum, c1, rt, tot, cin);
#pragma unroll
        for (int dir = 0; dir < 2; ++dir) {
            const int lastrow = dir == 0 ? 63 : 0;
            if (dir == 1) { gla_cum_store(F, cum, c1); LBAR(); }
            {
                const int i = F.tid & 63, grp = F.tid >> 6;
                float kv[16], cl[16], ci[16];
                if (dir == 0) { rope16_apply(kraw, tb, grp, lat, kv0); gla_store_v(F, vreg, VL); }
                ld16cum(cum + lastrow * CST + 16 * grp, cl); ld16cum(cum + i * CST + 16 * grp, ci);
#pragma unroll
                for (int e = 0; e < 16; ++e) kv[e] = kv0[e] * __expf(cl[e] - ci[e]);
                st16bf(KE + i * KST + 16 * grp, kv);
                if (F.tid < 128) DEC[((size_t)(dir * 264 + c) * 4 + h) * 128 + F.tid] = __expf(cum[lastrow * CST + F.tid]);
            }
            LBAR();
            f32x4 acc[16];
#pragma unroll
            for (int nt = 0; nt < 16; ++nt) acc[nt] = (f32x4){0.f, 0.f, 0.f, 0.f};
#pragma unroll
            for (int ks = 0; ks < 2; ++ks) { const bf16x8 af = tr_frag(KE, KST, 32 * ks, 16 * F.wave, F.lane);
#pragma unroll
                for (int nt = 0; nt < 16; ++nt) { const bf16x8 bfr = tr_frag(VL, VST, 32 * ks, 16 * nt, F.lane); acc[nt] = MFMA16(af, bfr, acc[nt]); } }
            bf16* dsp = DS + ((size_t)(dir * 264 + c) * 4 + h) * 256 * 128;
#pragma unroll
            for (int nt = 0; nt < 16; ++nt) { v2u o; o.x = pk2(acc[nt][0], acc[nt][1]); o.y = pk2(acc[nt][2], acc[nt][3]);
                *(GAS v2u*)(dsp + (size_t)((((nt * 4 + (F.wave >> 1)) * 4 + ((2 * F.wave + (fq >> 1)) & 3)) * 16 + fr) * 8 + 4 * (fq & 1))) = o; }
            LBAR();
        }
    }
}
__device__ __forceinline__ void p_gla_scan(Frame& F) {
    const bf16* DS = (const bf16*)(F.ws + WS_DS); bf16* SIN = (bf16*)(F.ws + WS_SIN); const float* DEC = (const float*)(F.ws + WS_DEC);
    LAS float* dl = (LAS float*)(F.lds);
    for (int job = F.vcu; job < 256; job += F.G) {
        const int vt = job & 15, h = (job >> 4) & 3, dir = (job >> 6) & 1, b = job >> 7;
        __syncthreads();
        for (int i = F.tid; i < 132 * 32; i += NTHREADS) { const int st = i >> 5, k4 = i & 31; int c;
            if (dir == 0) c = st < 4 ? 4 * b + st : 8 + 128 * b + (st - 4); else c = st < 4 ? 4 * b + 3 - st : 8 + 128 * b + 127 - (st - 4);
            *(LAS f32x4*)(dl + st * 128 + 4 * k4) = *(const GAS f32x4*)(DEC + ((size_t)(dir * 264 + c) * 4 + h) * 128 + 4 * k4); }
        __syncthreads();
        const int ks = F.wave >> 1, quad = 2 * (F.wave & 1) + (F.lane >> 5), fr = (F.lane >> 1) & 15, half = F.lane & 1;
        const int kk0 = 32 * ks + 8 * quad + 4 * half;
        const size_t eoff = (size_t)((((vt * 4 + ks) * 4 + quad) * 16 + fr) * 8 + 4 * half);
        f32x4 S = (f32x4){0.f, 0.f, 0.f, 0.f};
        for (int s0 = 0; s0 < 132; s0 += 12) {
            size_t o[12]; v2u d[12];
#pragma unroll
            for (int q = 0; q < 12; ++q) { const int st = s0 + q; int c;
                if (dir == 0) c = st < 4 ? 4 * b + st : 8 + 128 * b + (st - 4); else c = st < 4 ? 4 * b + 3 - st : 8 + 128 * b + 127 - (st - 4);
                o[q] = ((size_t)(dir * 264 + c) * 4 + h) * 32768 + eoff;
                d[q] = __builtin_nontemporal_load((const GAS v2u*)(DS + o[q])); }
#pragma unroll
            for (int q = 0; q < 12; ++q) { const f32x4 dc = *(const LAS f32x4*)(dl + (s0 + q) * 128 + kk0);
                v2u so; so.x = pk2(S.x, S.y); so.y = pk2(S.z, S.w);
                *(GAS v2u*)(SIN + o[q]) = so;
                S.x = S.x * dc.x + bflo(d[q].x); S.y = S.y * dc.y + bfhi(d[q].x); S.z = S.z * dc.z + bflo(d[q].y); S.w = S.w * dc.w + bfhi(d[q].y); }
        }
    }
}
#define GST(slot) do { if (PROBE_STAMP >= 20 && blockIdx.x == 0 && threadIdx.x == 0) { const unsigned long long _t = wall_clock64(); STAMPS(F)[40 + (slot)] += _t - STAMPS(F)[99]; STAMPS(F)[99] = _t; } } while (0)
__device__ __forceinline__ void p_gla_out(Frame& F, const Args& a) {
    const bf16* P = (const bf16*)(F.ws + WS_BIG); const float* ROPE = (const float*)(F.ws + WS_ROPE);
    const bf16* SIN = (const bf16*)(F.ws + WS_SIN); bf16* G = (bf16*)(F.ws + WS_G);
    constexpr int ST = 72;
    LAS float* cum = (LAS float*)(F.lds); LAS float* rt = cum + 64 * CST; LAS float* tot = rt + 64 * 32; LAS float* ssq = tot + 2 * 4 * 128;
    LAS bf16* VL = (LAS bf16*)(ssq + 8 * 64); LAS bf16* QD = VL + 64 * VST; LAS bf16* KI = QD + 64 * KST; LAS bf16* PL = KI + 64 * KST;
    const int fr = F.lane & 15, fq = F.lane >> 4;
    if (PROBE_STAMP >= 20 && blockIdx.x == 0 && threadIdx.x == 0) STAMPS(F)[99] = wall_clock64();
    for (int u = F.vcu; u < 264 * 4; u += F.G) {
        const int c = u >> 2, h = u & 3; const bool lat = c >= 8; const int pr = (c - 8) & 127;
        f32x4 acc[2][4];
#pragma unroll
        for (int mt = 0; mt < 2; ++mt)
#pragma unroll
            for (int nt = 0; nt < 4; ++nt) acc[mt][nt] = (f32x4){0.f, 0.f, 0.f, 0.f};
        v4u vreg[4]; CumIn cin; v2u ggv[4][2];
        gla_cum2_load(F, a, c, h, cin);
        float qv0[16], kv0[16], c1[16];
#pragma unroll
        for (int dir = 0; dir < 2; ++dir) {
            RowRaw qraw0, kraw0; f32x4 tb0[8];
            { const int i = F.tid & 63, grp = F.tid >> 6; const size_t row = (size_t)(64 * c + i);
                if (dir == 0) { row16_load(P + row * PST + h * 128, grp, lat, qraw0); row16_load(P + row * PST + 512 + h * 128, grp, lat, kraw0); ropetab_load(ROPE, grp, pr, i, lat, tb0); gla_load_v(F, c, h, vreg); } }
            const bf16* sp = SIN + ((size_t)(dir * 264 + c) * 4 + h) * 256 * 128;
            bf16x8 sfr[4][2];
#pragma unroll
            for (int ks = 0; ks < 4; ++ks)
#pragma unroll
                for (int mt = 0; mt < 2; ++mt) sfr[ks][mt] = *(const GAS bf16x8*)(sp + (size_t)(((((2 * F.wave + mt) * 4 + ks) * 4 + fq) * 16 + fr) * 8));
            if (dir == 1) {
#pragma unroll
                for (int nt = 0; nt < 4; ++nt)
#pragma unroll
                    for (int mt = 0; mt < 2; ++mt) ggv[nt][mt] = *(const GAS v2u*)(P + (size_t)(64 * c + 16 * nt + fr) * PST + 2048 + h * 256 + 32 * F.wave + 16 * mt + fq * 4); }
            GST(60);
            if (dir == 0) gla_cum2_run(F, cum, c1, rt, tot, cin); else { gla_cum_store(F, cum, c1); LBAR(); }
            GST(61);
            {
                const int i = F.tid & 63, grp = F.tid >> 6;
                if (dir == 0) { rope16_apply(qraw0, tb0, grp, lat, qv0); rope16_apply(kraw0, tb0, grp, lat, kv0); gla_store_v(F, vreg, VL); }
                float qv[16], kv[16], ci[16];
                ld16cum(cum + i * CST + 16 * grp, ci);
#pragma unroll
                for (int e = 0; e < 16; ++e) { const float ex = __expf(ci[e]); qv[e] = qv0[e] * (0.08838834764831845f * ex); kv[e] = kv0[e] * __builtin_amdgcn_rcpf(ex); }
                st16bf(QD + i * KST + 16 * grp, qv); st16bf(KI + i * KST + 16 * grp, kv);
            }
            LBAR();
            GST(62);
            {
                const int jt = F.wave >> 1;
#pragma unroll
                for (int t2 = 0; t2 < 2; ++t2) { const int it = 2 * (F.wave & 1) + t2; f32x4 s = (f32x4){0.f, 0.f, 0.f, 0.f};
#pragma unroll
                    for (int ks = 0; ks < 4; ++ks) { const bf16x8 af = *(const LAS bf16x8*)(KI + (16 * jt + fr) * KST + ks * 32 + fq * 8), bfr = *(const LAS bf16x8*)(QD + (16 * it + fr) * KST + ks * 32 + fq * 8); s = MFMA16(af, bfr, s); }
                    const int i = 16 * it + fr, j0 = 16 * jt + fq * 4; float pv[4];
#pragma unroll
                    for (int r = 0; r < 4; ++r) { const int j = j0 + r; const bool keep = dir == 0 ? (j <= i) : (j >= i); pv[r] = keep ? s[r] : 0.0f; }
                    v2u o; o.x = pk2(pv[0], pv[1]); o.y = pk2(pv[2], pv[3]);
                    *(LAS v2u*)(PL + i * ST + j0) = o; }
            }
            LBAR();
            GST(63);
#pragma unroll
            for (int ks = 0; ks < 2; ++ks) {
                bf16x8 bfr[4];
#pragma unroll
                for (int nt = 0; nt < 4; ++nt) bfr[nt] = perm_frag(PL + (16 * nt + fr) * ST, 32 * ks, fq);
#pragma unroll
                for (int mt = 0; mt < 2; ++mt) { const bf16x8 af = tr_frag(VL, VST, 32 * ks, 32 * F.wave + 16 * mt, F.lane);
#pragma unroll
                    for (int nt = 0; nt < 4; ++nt) acc[mt][nt] = MFMA16(af, bfr[nt], acc[mt][nt]); } }
#pragma unroll
            for (int ks = 0; ks < 4; ++ks) {
                bf16x8 bfr[4];
#pragma unroll
                for (int nt = 0; nt < 4; ++nt) bfr[nt] = *(const LAS bf16x8*)(QD + (16 * nt + fr) * KST + ks * 32 + fq * 8);
#pragma unroll
                for (int mt = 0; mt < 2; ++mt) {
#pragma unroll
                    for (int nt = 0; nt < 4; ++nt) acc[mt][nt] = MFMA16(sfr[ks][mt], bfr[nt], acc[mt][nt]); } }
            LBAR();
            GST(64);
        }
#pragma unroll
        for (int nt = 0; nt < 4; ++nt) { float s = 0.f;
#pragma unroll
            for (int mt = 0; mt < 2; ++mt)
#pragma unroll
                for (int j = 0; j < 4; ++j) s += acc[mt][nt][j] * acc[mt][nt][j];
            s += __shfl_xor(s, 16); s += __shfl_xor(s, 32);
            if (fq == 0) ssq[F.wave * 64 + 16 * nt + fr] = s; }
        LBAR();
#pragma unroll
        for (int nt = 0; nt < 4; ++nt) { const int i = 16 * nt + fr; float s = 0.f;
#pragma unroll
            for (int w8 = 0; w8 < 8; ++w8) s += ssq[w8 * 64 + i];
            const float rstd = __builtin_amdgcn_rsqf(s * (1.0f / 256.0f) + EPS); const size_t row = (size_t)(64 * c + i);
#pragma unroll
            for (int mt = 0; mt < 2; ++mt) { const int v0 = 32 * F.wave + 16 * mt + fq * 4;
                const v2u gg = ggv[nt][mt]; const f32x4 go = *(const GAS f32x4*)(a.in[I_BGO] + v0);
                const float g0 = bflo(gg.x), g1 = bfhi(gg.x), g2 = bflo(gg.y), g3 = bfhi(gg.y);
                const float o0 = acc[mt][nt][0] * rstd * go.x * (g0 * __builtin_amdgcn_rcpf(1.0f + __expf(-g0))), o1 = acc[mt][nt][1] * rstd * go.y * (g1 * __builtin_amdgcn_rcpf(1.0f + __expf(-g1)));
                const float o2 = acc[mt][nt][2] * rstd * go.z * (g2 * __builtin_amdgcn_rcpf(1.0f + __expf(-g2))), o3 = acc[mt][nt][3] * rstd * go.w * (g3 * __builtin_amdgcn_rcpf(1.0f + __expf(-g3)));
                v2u o; o.x = pk2(o0, o1); o.y = pk2(o2, o3);
                *(GAS v2u*)(G + row * D + h * 256 + v0) = o; } }
        LBAR();
        GST(65);
    }
}
#undef GST

__device__ __forceinline__ int na_koff(int key, int c16) { return key * 128 + ((c16 ^ ((key >> 1) & 7)) << 4); }
__device__ __forceinline__ int na_voff(int key, int c16) { return key * 128 + (((((c16 >> 1) ^ ((key >> 1) & 3)) << 1) | (c16 & 1)) << 4); }
__device__ __forceinline__ bf16x8 na_vfrag(const LAS unsigned char* V, int kb, int dt, int lane) {
    const int g = lane >> 4, w = lane & 15, q = w >> 2, p = w & 3; const int r0 = kb + 4 * g + q, r1 = r0 + 16;
    const s16x4 lo = __builtin_amdgcn_ds_read_tr16_b64_v4i16((LAS s16x4*)(V + r0 * 128 + ((dt ^ ((r0 >> 1) & 3)) << 5) + 8 * p));
    const s16x4 hi = __builtin_amdgcn_ds_read_tr16_b64_v4i16((LAS s16x4*)(V + r1 * 128 + ((dt ^ ((r1 >> 1) & 3)) << 5) + 8 * p));
    return (bf16x8){lo[0], lo[1], lo[2], lo[3], hi[0], hi[1], hi[2], hi[3]};
}
struct NaState { bf16x8 qf[2], qn[2]; f32x4 o[4]; float m_run, l_run; int cur_bh; };
__device__ __forceinline__ int na_r0(int r) { return r < 4 ? 0 : (r > 124 ? 120 : r - 4); }
__device__ __forceinline__ void na_load(Frame& F, int u_lo, int st, v4u (&kr)[3], v4u (&vr)[3]) {
    const bf16* QKV = (const bf16*)(F.ws + WS_BIG);
    const int u = u_lo + st / 3, pass = st % 3, bh = u >> 6, rp = u & 63, b = bh >> 4, h = bh & 15;
    const int rbase = na_r0(2 * rp) + 3 * pass;
#pragma unroll
    for (int i = 0; i < 3; ++i) { const int id = F.tid + 512 * i, key = id >> 3, c = id & 7; int row = rbase + (key >> 6); row = row > 127 ? 127 : row;
        const bf16* p = QKV + ((size_t)NCTX + (size_t)b * SEQ + (size_t)row * 64 + (key & 63)) * 3072 + 1024 + h * 64 + 8 * c; kr[i] = *(const GAS v4u*)p; vr[i] = *(const GAS v4u*)(p + 1024); }
}
__device__ __forceinline__ void na_loadq(Frame& F, int u, int fq, bf16x8 (&q)[2]) {
    const bf16* QKV = (const bf16*)(F.ws + WS_BIG);
    const int bh = u >> 6, rp = u & 63, b = bh >> 4, h = bh & 15, r = 2 * rp + (F.wave >> 2), qcol = 16 * (F.wave & 3) + (F.lane & 15);
#pragma unroll
    for (int ks = 0; ks < 2; ++ks) q[ks] = *(const GAS bf16x8*)(QKV + ((size_t)NCTX + (size_t)b * SEQ + (size_t)r * 64 + qcol) * 3072 + h * 64 + ks * 32 + fq * 8);
}
__device__ __forceinline__ void na_stage(Frame& F, const Args& a, const int u_lo, const int nstage, const int stage, v4u (&kr)[3], v4u (&vr)[3], NaState& S) {
    const bf16* QKV = (const bf16*)(F.ws + WS_BIG); bf16* G = (bf16*)(F.ws + WS_G);
    constexpr int QS = 3072;
    LAS unsigned char* KC = F.lds; LAS unsigned char* VC = F.lds + 32768; LAS unsigned char* KL = F.lds + 65536; LAS unsigned char* VL = F.lds + 65536 + 24576;
    LAS float* RPB = (LAS float*)(F.lds + 65536 + 49152);
    const int fr = F.lane & 15, fq = F.lane >> 4;
    const int qr = F.wave >> 2, jb = F.wave & 3;
    const int bstart = jb == 0 ? 0 : (jb == 1 ? 8 : (jb == 2 ? 24 : 32));
    const int qcol = 16 * jb + fr; const int cstart = qcol < 8 ? 0 : (qcol > 56 ? 48 : qcol - 8);
    const int u = u_lo + stage / 3, pass = stage % 3;
    const int bh = u >> 6, rp = u & 63, b = bh >> 4, h = bh & 15;
    const int r = 2 * rp + qr, r0q = na_r0(r), rbase = na_r0(2 * rp) + 3 * pass;
    const size_t lat0 = (size_t)NCTX + (size_t)b * SEQ;
    LBAR();
    if (bh != S.cur_bh) {
        S.cur_bh = bh;
        for (int i = F.tid; i < 465; i += NTHREADS) RPB[i] = a.in[I_CRPB][h * 465 + i] * 1.4426950408889634f;
#pragma unroll
        for (int i = 0; i < 4; ++i) { const int id = F.tid + 512 * i, key = id >> 3, c = id & 7;
            const bf16* p = QKV + (size_t)(b * CTXL + key) * QS + 1024 + h * 64 + 8 * c;
            *(LAS v4u*)(KC + na_koff(key, c)) = *(const GAS v4u*)p; *(LAS v4u*)(VC + na_voff(key, c)) = *(const GAS v4u*)(p + 1024); }
    }
#pragma unroll
    for (int i = 0; i < 3; ++i) { const int id = F.tid + 512 * i, key = id >> 3, c = id & 7;
        *(LAS v4u*)(KL + na_koff(key, c)) = kr[i]; *(LAS v4u*)(VL + na_voff(key, c)) = vr[i]; }
    if (pass == 0) {
        S.qf[0] = S.qn[0]; S.qf[1] = S.qn[1];
#pragma unroll
        for (int dt = 0; dt < 4; ++dt) S.o[dt] = (f32x4){0.f, 0.f, 0.f, 0.f};
        S.m_run = -__builtin_inff(); S.l_run = 0.f;
        if (stage + 3 < nstage) na_loadq(F, u + 1, fq, S.qn);
    }
    if (stage + 1 < nstage) na_load(F, u_lo, stage + 1, kr, vr);
    LBAR();
    f32x4 s[12];
#pragma unroll
    for (int t = 0; t < 6; ++t) { const int kidx = (t >> 1) * 64 + bstart + 16 * (t & 1) + fr;
        const bf16x8 k0 = *(const LAS bf16x8*)(KL + na_koff(kidx, fq)), k1 = *(const LAS bf16x8*)(KL + na_koff(kidx, 4 + fq));
        f32x4 tt = (f32x4){0.f, 0.f, 0.f, 0.f}; tt = MFMA16(k0, S.qf[0], tt); tt = MFMA16(k1, S.qf[1], tt); s[t] = tt; }
#pragma unroll
    for (int t = 0; t < 6; ++t) { const int kidx = (16 * (6 * pass + t) + fr) & 255;
        const bf16x8 k0 = *(const LAS bf16x8*)(KC + na_koff(kidx, fq)), k1 = *(const LAS bf16x8*)(KC + na_koff(kidx, 4 + fq));
        f32x4 tt = (f32x4){0.f, 0.f, 0.f, 0.f}; tt = MFMA16(k0, S.qf[0], tt); tt = MFMA16(k1, S.qf[1], tt); s[6 + t] = tt; }
    constexpr float SC2 = 0.125f * 1.4426950408889634f;
    float mx = S.m_run;
    {
        int cidx[8]; bool cok[8];
#pragma unroll
        for (int q = 0; q < 8; ++q) { const int kcol = bstart + 16 * (q >> 2) + fq * 4 + (q & 3); int ci = kcol - qcol + 15; ci = ci < 0 ? 0 : (ci > 30 ? 30 : ci); cidx[q] = ci; cok[q] = kcol >= cstart && kcol < cstart + 16; }
        float bias[24];
#pragma unroll
        for (int q = 0; q < 24; ++q) { const int t = q >> 2, j = q & 3; const int krow = rbase + (t >> 1); int ri = krow - r + 7; ri = ri < 0 ? 0 : (ri > 14 ? 14 : ri); bias[q] = RPB[ri * 31 + cidx[4 * (t & 1) + j]]; }
        asm volatile("" : "+v"(bias[0]), "+v"(bias[1]), "+v"(bias[2]), "+v"(bias[3]), "+v"(bias[4]), "+v"(bias[5]), "+v"(bias[6]), "+v"(bias[7]),
                          "+v"(bias[8]), "+v"(bias[9]), "+v"(bias[10]), "+v"(bias[11]), "+v"(bias[12]), "+v"(bias[13]), "+v"(bias[14]), "+v"(bias[15]));
        asm volatile("" : "+v"(bias[16]), "+v"(bias[17]), "+v"(bias[18]), "+v"(bias[19]), "+v"(bias[20]), "+v"(bias[21]), "+v"(bias[22]), "+v"(bias[23]));
#pragma unroll
        for (int q = 0; q < 24; ++q) { const int t = q >> 2, j = q & 3; const int krow = rbase + (t >> 1);
            const bool ok = cok[4 * (t & 1) + j] && krow >= r0q && krow <= r0q + 7;
            const float v = ok ? fmaf(s[t][j], SC2, bias[q]) : -__builtin_inff();
            s[t][j] = v; mx = fmaxf(mx, v); }
    }
#pragma unroll
    for (int t = 0; t < 6; ++t) { const bool ok = 6 * pass + t < 16;
#pragma unroll
        for (int j = 0; j < 4; ++j) { const float v = ok ? s[6 + t][j] * SC2 : -__builtin_inff(); s[6 + t][j] = v; mx = fmaxf(mx, v); } }
    mx = fmaxf(mx, __shfl_xor(mx, 16)); mx = fmaxf(mx, __shfl_xor(mx, 32));
    const float alpha = __builtin_amdgcn_exp2f(S.m_run - mx); S.m_run = mx;
    float l = 0.f;
#pragma unroll
    for (int t = 0; t < 12; ++t)
#pragma unroll
        for (int j = 0; j < 4; ++j) { const float p = __builtin_amdgcn_exp2f(s[t][j] - mx); s[t][j] = p; l += p; }
    S.l_run = S.l_run * alpha + l;
#pragma unroll
    for (int dt = 0; dt < 4; ++dt) S.o[dt] = S.o[dt] * alpha;
#pragma unroll
    for (int st = 0; st < 6; ++st) {
        v4u pw; pw.x = pk2(s[2 * st][0], s[2 * st][1]); pw.y = pk2(s[2 * st][2], s[2 * st][3]); pw.z = pk2(s[2 * st + 1][0], s[2 * st + 1][1]); pw.w = pk2(s[2 * st + 1][2], s[2 * st + 1][3]);
        const bf16x8 pf = __builtin_bit_cast(bf16x8, pw);
        const LAS unsigned char* VB = st < 3 ? VL : VC;
        const int kb = st < 3 ? st * 64 + bstart : (16 * (6 * pass + 2 * (st - 3))) & 255;
#pragma unroll
        for (int dt = 0; dt < 4; ++dt) S.o[dt] = MFMA16(na_vfrag(VB, kb, dt, F.lane), pf, S.o[dt]);
    }
    if (pass == 2) {
        float lt = S.l_run; lt += __shfl_xor(lt, 16); lt += __shfl_xor(lt, 32);
        const float inv = 1.0f / lt;
        bf16* op = G + (lat0 + (size_t)r * 64 + qcol) * D + h * 64 + fq * 4;
#pragma unroll
        for (int dt = 0; dt < 4; ++dt) { v2u w; w.x = pk2(S.o[dt][0] * inv, S.o[dt][1] * inv); w.y = pk2(S.o[dt][2] * inv, S.o[dt][3] * inv); *(GAS v2u*)(op + 16 * dt) = w; }
    }
}
__device__ __forceinline__ void p_natten(Frame& F, const Args& a) {
    const int u_lo = (int)(((long)F.vcu * 2048) / F.G), u_hi = (int)(((long)(F.vcu + 1) * 2048) / F.G);
    const int nstage = 3 * (u_hi - u_lo);
    if (nstage <= 0) return;
    const int fq = F.lane >> 4;
    v4u kA[3], vA[3];
    NaState S; S.cur_bh = -1; S.m_run = -__builtin_inff(); S.l_run = 0.f;
#pragma unroll
    for (int dt = 0; dt < 4; ++dt) S.o[dt] = (f32x4){0.f, 0.f, 0.f, 0.f};
    na_loadq(F, u_lo, fq, S.qn); S.qf[0] = S.qn[0]; S.qf[1] = S.qn[1];
    na_load(F, u_lo, 0, kA, vA);
    for (int stage = 0; stage < nstage; ++stage) na_stage(F, a, u_lo, nstage, stage, kA, vA, S);
}

template <int MODE>
__device__ __forceinline__ void sgemm_region(Frame& F, const bf16* A, const bf16* Bt, int R0, int nrb, int C0, int ncb, bf16* O, int ldo, float* X, const float* gate, int u_first, int u_stride) {
    constexpr int ST = 264;
    LAS bf16* As = (LAS bf16*)(F.lds); LAS bf16* Bs = As + 64 * ST;
    const int fr = F.lane & 15, fq = F.lane >> 4, mt = F.wave >> 1, nt0 = 2 * (F.wave & 1);
    const int nu = nrb * ncb;
    v4u ra0[4], rb0[4], ra1[4], rb1[4];
#define SG_LOAD(ra_, rb_, u_, kc_) do { const int _r0 = R0 + 64 * ((u_) % nrb), _c0 = C0 + 64 * ((u_) / nrb); _Pragma("unroll") for (int i = 0; i < 4; ++i) { const int id = F.tid + 512 * i, row = id >> 5, c = id & 31; \
        ra_[i] = *(const GAS v4u*)(A + (size_t)(_r0 + row) * 1024 + 256 * (kc_) + 8 * c); rb_[i] = *(const GAS v4u*)(Bt + (size_t)(_c0 + row) * 1024 + 256 * (kc_) + 8 * c); } } while (0)
#define SG_PUT(ra_, rb_) do { _Pragma("unroll") for (int i = 0; i < 4; ++i) { const int id = F.tid + 512 * i, row = id >> 5, c = id & 31; \
        *(LAS v4u*)(As + row * ST + 8 * c) = ra_[i]; *(LAS v4u*)(Bs + row * ST + 8 * c) = rb_[i]; } } while (0)
    if (u_first < nu) { SG_LOAD(ra0, rb0, u_first, 0); SG_LOAD(ra1, rb1, u_first, 1); }
    for (int u = u_first; u < nu; u += u_stride) {
        const int rb = u % nrb, cb = u / nrb; const int r0 = R0 + 64 * rb, c0 = C0 + 64 * cb;
        const bool more = u + u_stride < nu;
        pg8::f32x4 acc[2] = {(pg8::f32x4){0.f, 0.f, 0.f, 0.f}, (pg8::f32x4){0.f, 0.f, 0.f, 0.f}};
#pragma unroll
        for (int kc = 0; kc < 4; ++kc) {
            LBAR();
            if (kc & 1) SG_PUT(ra1, rb1); else SG_PUT(ra0, rb0);
            if (kc == 0) SG_LOAD(ra0, rb0, u, 2); else if (kc == 1) SG_LOAD(ra1, rb1, u, 3);
            else if (kc == 2) { if (more) SG_LOAD(ra0, rb0, u + u_stride, 0); } else { if (more) SG_LOAD(ra1, rb1, u + u_stride, 1); }
            LBAR();
#pragma unroll
            for (int ks = 0; ks < 8; ++ks) { const bf16x8 af = *(const LAS bf16x8*)(As + (16 * mt + fr) * ST + ks * 32 + fq * 8);
#pragma unroll
                for (int n = 0; n < 2; ++n) { const bf16x8 bfr = *(const LAS bf16x8*)(Bs + (16 * (nt0 + n) + fr) * ST + ks * 32 + fq * 8); acc[n] = MFMA16(bfr, af, acc[n]); } }
        }
        const size_t row = (size_t)(r0 + 16 * mt + fr);
#pragma unroll
        for (int n = 0; n < 2; ++n) { const int col = c0 + 16 * (nt0 + n) + 4 * fq;
            if (MODE == 2) { f32x4* p = (f32x4*)(X + row * 1024 + col); const f32x4 g = *(const f32x4*)(gate + col); *p = *p + g * acc[n]; }
            else { f32x4 v = acc[n];
                if (MODE == 1) { const pg8::f32x2 a2 = pg8::gelu_pk((pg8::f32x2){v[0], v[1]}), b2 = pg8::gelu_pk((pg8::f32x2){v[2], v[3]}); v = (f32x4){a2.x, a2.y, b2.x, b2.y}; }
                v2u o; o.x = pk2(v[0], v[1]); o.y = pk2(v[2], v[3]); *(GAS v2u*)(O + row * ldo + col) = o; } }
    }
#undef SG_LOAD
#undef SG_PUT
    __syncthreads();
}

constexpr int NCV_GLA = 104, NCV_NAT = 96;
constexpr int NCV_DN = 24, DN_ITEMS = NCV_DN * NWAVES * 28;
constexpr int CONV_SPLIT = MOE_ITEMS + DN_ITEMS + 28672;
constexpr int CV_DN0_LO = MOE_ITEMS,             CV_DN0_HI = MOE_ITEMS + DN_ITEMS;
constexpr int NCV_DS = 40, DS_ITEMS = NCV_DS * NWAVES * 10;
constexpr int CV_DS_LO  = CV_DN0_HI,             CV_DS_HI  = CV_DN0_HI + DS_ITEMS;
constexpr int CV_GLA_LO = CV_DS_HI,              CV_GLA_HI = CONV_SPLIT;
constexpr int CV_DN1_LO = CONV_SPLIT,            CV_DN1_HI = CONV_SPLIT + DN_ITEMS;
constexpr int CV_NAT_LO = CV_DN1_HI,             CV_NAT_HI = 4 * MOE_ITEMS - DN_ITEMS;
constexpr int CV_DN2_LO = CV_NAT_HI,             CV_DN2_HI = 4 * MOE_ITEMS;
__device__ __forceinline__ void ph_moe_gu(Frame& F, const Args& args, const int layer) {
    moe_tables(F, layer);
    const LAS int* Mt = (const LAS int*)(F.lds + MISC_OFF); const int total = Mt[32];
    pg8::Gemm g{(const bf16*)(F.ws + WS_H), (const bf16*)(F.ws + WS_WGU) + (size_t)layer * 32 * 2048 * 1024, total, 2048, D};
    pg8::GroupedOrder S; S.init(total, 2048, F.G, (int)blockIdx.x); S.tile_e = Mt + 64;
    pg8::EpiSwiglu E{(bf16*)(F.ws + WS_ACT), D, args.in[I_MBGU] + (size_t)layer * 32 * 2048, 2048};
    pg8::gemm_phase<pg8::EpiSwiglu, pg8::GroupedOrder, true>(F.lds + RING_OFF, g, S, E, (const unsigned*)(F.ws + WS_LIST), Mt, NTOK);
}
__device__ __forceinline__ void ph_moe_dn(Frame& F, const Args& args, const int layer) {
    moe_tables(F, layer);
    const LAS int* Mt = (const LAS int*)(F.lds + MISC_OFF); const int total = Mt[32];
    pg8::Gemm g{(const bf16*)(F.ws + WS_ACT), (const bf16*)(F.ws + WS_WDN) + (size_t)layer * 32 * 1024 * 1024, total, D, D};
    const int ncv = (layer <= 2 && F.G >= 2 * NCV_GLA) ? NCV_DN : 0, ng = F.G - ncv, bx = (int)blockIdx.x;
    if (bx < ng) {
        pg8::GroupedOrder S; S.init(total, D, ng, bx); S.tile_e = Mt + 64;
        pg8::EpiBf16<0> E{(bf16*)(F.ws + WS_YB), D, args.in[I_MBDN] + (size_t)layer * 32 * 1024, 1024};
        pg8::gemm_phase<pg8::EpiBf16<0>, pg8::GroupedOrder>(F.lds + RING_OFF, g, S, E);
    }
    if (layer <= 2) { const int lo = layer == 0 ? CV_DN0_LO : (layer == 1 ? CV_DN1_LO : CV_DN2_LO), hi = layer == 0 ? CV_DN0_HI : (layer == 1 ? CV_DN1_HI : CV_DN2_HI);
        if (ncv) { if (bx >= ng) conv_moe_items(F, args, lo, hi, (bx - ng) * NWAVES + F.wave, ncv * NWAVES); }
        else { __syncthreads(); conv_moe_items(F, args, lo, hi, F.vcu * NWAVES + F.wave, F.G * NWAVES); } }
}
template <int LAYER> __device__ __forceinline__ void ph_ingemm(Frame& F) {
    constexpr int layer = LAYER, kind = layer % 3;
    const bf16* H = (const bf16*)(F.ws + WS_H);
    const bf16* A = H + (size_t)2 * 256 * D; constexpr int M = 64 * 256;
    if constexpr (kind == 0) {
        const bf16* Bt = (const bf16*)(F.ws + WS_WAIN) + (size_t)(layer / 3) * 2048 * 1024;
        pg8::Gemm g{A, Bt, M, 2048, D}; pg8::StaticOrder S; S.init(M, 2048, F.G, (int)blockIdx.x);
        pg8::EpiBf16<1> E{(bf16*)(F.ws + WS_BIG) + (size_t)2 * 256 * 2048, 2048, nullptr, 0};
        pg8::gemm_phase<pg8::EpiBf16<1>, pg8::StaticOrder>(F.lds + RING_OFF, g, S, E);
        if constexpr (layer < 3) sgemm_region<1>(F, H, Bt, 0, 8, 0, 32, (bf16*)(F.ws + WS_BIG), 2048, nullptr, nullptr, F.vcu, F.G);
    } else if constexpr (kind == 1) {
        const bf16* Bt = (const bf16*)(F.ws + WS_WBIN);
        pg8::Gemm g{A, Bt, M, 3072, D}; pg8::StaticOrder S; S.init(M, 3072, F.G, (int)blockIdx.x);
        pg8::EpiBf16<0> E{(bf16*)(F.ws + WS_BIG) + (size_t)2 * 256 * GLA_INP, GLA_INP, nullptr, 0};
        pg8::gemm_phase<pg8::EpiBf16<0>, pg8::StaticOrder>(F.lds + RING_OFF, g, S, E);
        sgemm_region<0>(F, H, Bt, 0, 8, 0, 48, (bf16*)(F.ws + WS_BIG), GLA_INP, nullptr, nullptr, F.vcu, F.G);
        sgemm_region<0>(F, H, Bt, 0, 264, 3072, 1, (bf16*)(F.ws + WS_BIG), GLA_INP, nullptr, nullptr, (F.vcu + 128) % F.G, F.G);
    } else {
        const bf16* Bt = (const bf16*)(F.ws + WS_WCQKV);
        pg8::Gemm g{A, Bt, M, 3072, D}; pg8::StaticOrder S; S.init(M, 3072, F.G, (int)blockIdx.x);
        pg8::EpiBf16<0> E{(bf16*)(F.ws + WS_BIG) + (size_t)2 * 256 * 3072, 3072, nullptr, 0};
        pg8::gemm_phase<pg8::EpiBf16<0>, pg8::StaticOrder>(F.lds + RING_OFF, g, S, E);
        sgemm_region<0>(F, H, Bt, 0, 8, 1024, 32, (bf16*)(F.ws + WS_BIG), 3072, nullptr, nullptr, F.vcu, F.G);
    }
}

#define IN(k) (lo <= (k) && (k) < hi)
#define SEAM(k) do { unsigned long long _te = 0ull; if (PROBE_STAMP && blockIdx.x == 0 && threadIdx.x == 0) _te = wall_clock64(); \
    if (IN(k) && IN((k) + 1)) { xcd_barrier(bar); if (PROBE_BAR) xcd_barrier(bar); } else __syncthreads(); \
    if (PROBE_STAMP && blockIdx.x == 0 && threadIdx.x == 0) { const unsigned long long _tx = wall_clock64(); STAMPS(F)[k] = _tx - STAMPS(F)[96]; STAMPS(F)[48 + (k)] = _tx - _te; STAMPS(F)[96] = _tx; } } while (0)
template <int LAYER> __device__ __forceinline__ void run_layer(Frame& F, const Args& args, const XcdBarrier& bar, const int lo, const int hi) {
    {
        constexpr int layer = LAYER; constexpr int kind = layer % 3, base = 1 + 10 * layer;
        constexpr int mt0 = (layer >= 3) ? 2 : 0;
        constexpr int mo0 = (layer >= 2) ? 2 : 0;
        if (IN(base + 0)) { p_prenorm(F, args, layer, false);
#if PROBE_TOK
            __syncthreads(); p_prenorm(F, args, layer, false, true);
#endif
        } SEAM(base + 0);
        if (IN(base + 1)) { ph_ingemm<LAYER>(F);
#if PROBE_ING
            __syncthreads(); ph_ingemm<LAYER>(F);
#endif
        }
        SEAM(base + 1);
        if (IN(base + 2)) {
            if constexpr (kind == 0) p_spatial(F, args, layer); else if constexpr (kind == 1) {
                const int ncv = F.G >= 2 * NCV_GLA ? NCV_DS : 0, nm = F.G - ncv;
                if ((int)blockIdx.x < nm) { Frame Fm = mixer_frame(F, ncv); p_gla_ds(Fm, args); }
                if (ncv == 0) { __syncthreads(); conv_moe_items(F, args, CV_DS_LO, CV_DS_HI, F.vcu * NWAVES + F.wave, F.G * NWAVES); }
                else if ((int)blockIdx.x >= nm) conv_moe_items(F, args, CV_DS_LO, CV_DS_HI, ((int)blockIdx.x - nm) * NWAVES + F.wave, ncv * NWAVES); }
            else {
                const int ncv = F.G >= 2 * NCV_NAT ? NCV_NAT : 0, nm = F.G - ncv;
                if ((int)blockIdx.x < nm) { Frame Fm = mixer_frame(F, ncv); p_natten(Fm, args); }
                if (ncv == 0) { __syncthreads(); conv_moe_items(F, args, CV_NAT_LO, CV_NAT_HI, F.vcu * NWAVES + F.wave, F.G * NWAVES); }
                else if ((int)blockIdx.x >= nm) conv_moe_items(F, args, CV_NAT_LO, CV_NAT_HI, ((int)blockIdx.x - nm) * NWAVES + F.wave, ncv * NWAVES); }
        } SEAM(base + 2);
        if constexpr (kind == 1) { if (IN(base + 3)) for (int rep = 0; rep < 1 + PROBE_GLA; ++rep) { p_gla_scan(F); } SEAM(base + 3); }
        if constexpr (kind == 1) { if (IN(base + 4)) {
                const int ncv = F.G >= 2 * NCV_GLA ? NCV_GLA : 0, nm = F.G - ncv;
                if ((int)blockIdx.x < nm) { Frame Fm = mixer_frame(F, ncv); p_gla_out(Fm, args); }
                if (ncv == 0) { __syncthreads(); conv_moe_items(F, args, CV_GLA_LO, CV_GLA_HI, F.vcu * NWAVES + F.wave, F.G * NWAVES); }
                else if ((int)blockIdx.x >= nm) conv_moe_items(F, args, CV_GLA_LO, CV_GLA_HI, ((int)blockIdx.x - nm) * NWAVES + F.wave, ncv * NWAVES); }
            SEAM(base + 4); }
        if (IN(base + 5)) {
            constexpr int M = 64 * 256;
            const bf16* Bt = (const bf16*)(F.ws + (kind == 0 ? WS_WAOUT : (kind == 1 ? WS_WBOUT : WS_WCOUT))) + (kind == 0 ? (size_t)(layer / 3) * 1024 * 1024 : 0);
            pg8::Gemm g{(const bf16*)(F.ws + WS_G) + (size_t)2 * 256 * D, Bt, M, D, D}; pg8::StaticOrder S; S.init(M, D, F.G, (int)blockIdx.x);
            pg8::EpiBf16<0> E{(bf16*)(F.ws + WS_YM) + (size_t)2 * 256 * D, D, nullptr, 0};
            pg8::gemm_phase<pg8::EpiBf16<0>, pg8::StaticOrder>(F.lds + RING_OFF, g, S, E);
            if constexpr (layer < 2) sgemm_region<0>(F, (const bf16*)(F.ws + WS_G), Bt, 0, 8, 0, 16, (bf16*)(F.ws + WS_YM), D, nullptr, nullptr, F.vcu, F.G);
        }
        SEAM(base + 5);
        if (IN(base + 6)) { p_router(F, args, layer);
#if PROBE_TOK
            __syncthreads(); p_router(F, args, layer, true);
#endif
        } SEAM(base + 6);
        if (IN(base + 8)) { ph_moe_gu(F, args, layer);
#if PROBE_MOE
            __syncthreads(); ph_moe_gu(F, args, layer);
#endif
        }
        SEAM(base + 8);
        if (IN(base + 9)) { ph_moe_dn(F, args, layer);
#if PROBE_MOE
            __syncthreads(); ph_moe_dn(F, args, layer);
#endif
        }
        SEAM(base + 9);
    }
}

__global__ void __launch_bounds__(NTHREADS, 2) fwd(Args args) {
    extern __shared__ __attribute__((aligned(16))) unsigned char lds[];
    Frame F;
    F.lds = (LAS unsigned char*)lds;
    F.tid = threadIdx.x; F.lane = F.tid & 63; F.wave = __builtin_amdgcn_readfirstlane(F.tid >> 6);
    F.G = gridDim.x; { const int bx = blockIdx.x; F.vcu = (F.G % 8 == 0) ? (bx % 8) * (F.G / 8) + bx / 8 : bx; }
    F.ws = args.ws; F.ctl = (unsigned*)(args.ws + WS_CTL);
    volatile LAS unsigned* BST = (volatile LAS unsigned*)(F.lds + LDS_BYTES - 16);
    if (F.tid < 4) BST[F.tid] = 0u;
    __syncthreads();
    const int lo = args.ph_lo, hi = args.ph_hi;
    XcdBarrier bar; bar.bar = (unsigned*)(F.ctl + CW_BAR); bar.x = 0; bar.st = BST;
    if (hi - lo > 1) bar = xcd_barrier_post((unsigned*)(F.ctl + CW_BAR), BST);
    if (PROBE_STAMP && blockIdx.x == 0 && F.tid == 0) { for (int i = 0; i < 128; ++i) STAMPS(F)[i] = 0ull; STAMPS(F)[96] = wall_clock64(); }
    if (IN(0)) { p_prologue(F, args);
#if PROBE_PRO
        __syncthreads(); p_prologue(F, args);
#endif
    } SEAM(0);

    run_layer<0>(F, args, bar, lo, hi);
    run_layer<1>(F, args, bar, lo, hi);
    run_layer<2>(F, args, bar, lo, hi);
    run_layer<3>(F, args, bar, lo, hi);
    if (IN(41)) { p_prenorm(F, args, 4, true); }
    if (PROBE_STAMP && blockIdx.x == 0) { __syncthreads(); if (F.tid == 0) {
        const unsigned long long tnow = wall_clock64(); STAMPS(F)[41] = tnow - STAMPS(F)[96];
        unsigned long long sum = 0ull;
        for (int k = 0; k < 42; ++k) { const int loc = k >= 1 && k <= 40 ? (k - 1) % 10 : -1; bool sel = false;
            if (PROBE_STAMP == 1) sel = k == 0;
            if (PROBE_STAMP == 2) sel = loc == 1 || loc == 5;
            if (PROBE_STAMP == 3) sel = loc == 8 || loc == 9;
            if (PROBE_STAMP == 4) sel = loc == 2 || loc == 3 || loc == 4;
            if (PROBE_STAMP == 6) sel = loc == 0 || loc == 6 || k == 41;
            if (PROBE_STAMP == 7) sel = loc == 2 && (k - 1) / 10 == 1;
            if (PROBE_STAMP == 8) sel = loc == 3;
            if (PROBE_STAMP == 9) sel = loc == 4;
            if (PROBE_STAMP == 10) sel = loc == 2 && (k - 1) / 10 == 2;
            if (PROBE_STAMP == 11) sel = loc == 6;
            if (PROBE_STAMP == 12) sel = loc == 8;
            if (PROBE_STAMP == 13) sel = loc == 9;
            if (PROBE_STAMP == 14) sel = loc == 5;
            if (sel) sum += STAMPS(F)[k];
            if (PROBE_STAMP == 5) sum += STAMPS(F)[48 + k];
            if (PROBE_STAMP == 15 && (loc == 8 || loc == 9)) sum += STAMPS(F)[48 + k];
            if (PROBE_STAMP == 16 && (loc == 1 || loc == 5)) sum += STAMPS(F)[48 + k];
            if (PROBE_STAMP == 17 && (loc == 0 || loc == 6)) sum += STAMPS(F)[48 + k];
            if (PROBE_STAMP == 18 && (loc == 2 || loc == 3 || loc == 4)) sum += STAMPS(F)[48 + k];
            if (PROBE_STAMP == 19 && k == 0) sum += STAMPS(F)[48 + k]; }
        if (PROBE_STAMP >= 20 && PROBE_STAMP <= 25) sum = STAMPS(F)[100 + PROBE_STAMP - 20];
        const unsigned long long t0 = wall_clock64();
        while (wall_clock64() - t0 < 4ull * sum) __builtin_amdgcn_s_sleep(8);
    } }
#undef IN
#undef SEAM
}

extern "C" void kernel_launch(void* const* d_in, const int* in_sizes, int n_in, void* d_out, int out_size, void* d_ws, size_t ws_size, hipStream_t stream) {
    static int grid = 0;
    if (grid == 0) {
        if (n_in != 28 || out_size != NLAT * D || ws_size < WS_END) { fprintf(stderr, "kernel_launch: unexpected problem (n_in %d, out %d, ws %zu < %zu)\n", n_in, out_size, ws_size, (size_t)WS_END); grid = -1; return; }
        int dev = 0, cus = 0, per_cu = 0;
        if (hipGetDevice(&dev) != hipSuccess || hipDeviceGetAttribute(&cus, hipDeviceAttributeMultiprocessorCount, dev) != hipSuccess) { grid = -1; return; }
        if (hipFuncSetAttribute((const void*)fwd, hipFuncAttributeMaxDynamicSharedMemorySize, LDS_BYTES) != hipSuccess) { fprintf(stderr, "kernel_launch: hipFuncSetAttribute failed\n"); grid = -1; return; }
        if (hipOccupancyMaxActiveBlocksPerMultiprocessor(&per_cu, (const void*)fwd, NTHREADS, LDS_BYTES) != hipSuccess || per_cu < 1) { fprintf(stderr, "kernel_launch: occupancy query reports %d\n", per_cu); }
        (void)hipGetLastError();
        grid = cus;
    }
    if (grid < 0) return;
    (void)hipMemsetAsync((char*)d_ws + WS_CTL, 0, CTL_ZERO_BYTES, stream);
    Args a{};
    for (int i = 0; i < 28; ++i) a.in[i] = (const float*)d_in[i];
    a.out = (float*)d_out; a.ws = (unsigned char*)d_ws;
#if MK_ONE_LAUNCH
    a.ph_lo = 0; a.ph_hi = 42;
    hipLaunchKernelGGL(fwd, dim3(grid), dim3(NTHREADS), LDS_BYTES, stream, a);
#else
    for (int p = 0; p < 42; ++p) {
        if (p >= 1 && p <= 40) { const int layer = (p - 1) / 10, loc = (p - 1) % 10; if (((loc == 3 || loc == 4) && (layer % 3) != 1) || loc == 7) continue; }
        a.ph_lo = p; a.ph_hi = p + 1;
        hipLaunchKernelGGL(fwd, dim3(grid), dim3(NTHREADS), LDS_BYTES, stream, a);
    }
#endif
}
```
